# Optimizing an MI355X kernel written in HIP

```python
import math
import jax, jax.numpy as jnp
from jax import lax
import numpy as np

D_MODEL = 1024
BATCH = 4
SEQ = 4096
DEPTH = 2

D_MIX = D_MODEL
N_DIR = 2
RG_WIDTH = 384
RG_HEADS = 6
RG_HEAD_DIM = RG_WIDTH // RG_HEADS
RG_CONV = 4
RG_C = 8.0
S5_WIDTH = 384
S5_GROUP = 16
S5_GROUPS = S5_WIDTH // S5_GROUP
S5_STATE = 64
HY_WIDTH = D_MIX - RG_WIDTH - S5_WIDTH
HY_CONV = 3
HY_BANDS = 16
HY_FEAT = 1 + 2 * HY_BANDS
HY_FILT_HIDDEN = 64
HY_FAST_DECAY = 0.3
HY_SLOW_DECAY = 1.5
HY_DECAY_TARGET = 1e-2
D_FF = 2816
FFN_CONV = 3
RMS_EPS = 1e-6
IN_COLS = 2 * RG_WIDTH + S5_WIDTH + 3 * HY_WIDTH

kernel_name = "hymba_style_rglru_s5_hyena_encoder"


def rmsnorm(x, g):
    xf = x.astype(jnp.float32)
    inv = lax.rsqrt(jnp.mean(xf * xf, axis=-1, keepdims=True) + RMS_EPS)
    return xf * inv * g.astype(jnp.float32)


def rms_nogain(x):
    xf = x.astype(jnp.float32)
    return xf * lax.rsqrt(jnp.mean(xf * xf, axis=-1, keepdims=True) + RMS_EPS)


def dwconv_centred(u, w, b):
    K = w.shape[0]
    L = u.shape[1]
    left = (K - 1) // 2
    up = jnp.pad(u, ((0, 0), (left, K - 1 - left), (0, 0)))
    out = b
    for k in range(K):
        out = out + up[:, k:k + L] * w[k]
    return out


def _lin_combine(e1, e2):
    a1, b1 = e1
    a2, b2 = e2
    return a1 * a2, a2 * b1 + b2


def _clin_combine(e1, e2):
    ar1, ai1, br1, bi1 = e1
    ar2, ai2, br2, bi2 = e2
    return (ar2 * ar1 - ai2 * ai1,
            ar2 * ai1 + ai2 * ar1,
            ar2 * br1 - ai2 * bi1 + br2,
            ar2 * bi1 + ai2 * br1 + bi2)


def rglru_mixer(xb, gb, conv_w, conv_b, wa, ba, wx, bx, lam):
    Bsz, L, _ = xb.shape
    u = dwconv_centred(xb, conv_w, conv_b)
    uh = u.reshape(Bsz, L, RG_HEADS, RG_HEAD_DIM)
    h_sum = jnp.zeros_like(u)
    for d in range(N_DIR):
        r = jax.nn.sigmoid(jnp.einsum('blhi,hij->blhj', uh, wa[d]).reshape(Bsz, L, RG_WIDTH) + ba[d])
        i = jax.nn.sigmoid(jnp.einsum('blhi,hij->blhj', uh, wx[d]).reshape(Bsz, L, RG_WIDTH) + bx[d])
        log_a = -RG_C * r * jax.nn.softplus(-lam[d].astype(jnp.float32))
        a = jnp.exp(log_a)
        mult = jnp.sqrt(-jnp.expm1(2.0 * log_a))
        _, h = lax.associative_scan(_lin_combine, (a, mult * (i * u)), reverse=(d == 1), axis=1)
        h_sum = h_sum + h
    return h_sum * jax.nn.gelu(gb)


def s5_mixer(u, a_re, a_im, log_dt, b_re, b_im, c_re, c_im, d_skip, glu_w, glu_b):
    Bsz, L, _ = u.shape
    ug = u.reshape(Bsz, L, S5_GROUPS, S5_GROUP)
    y = ug * d_skip.reshape(S5_GROUPS, S5_GROUP)
    for d in range(N_DIR):
        lr = a_re[d].astype(jnp.float32)
        li = a_im[d].astype(jnp.float32)
        dt = jnp.exp(log_dt[d].astype(jnp.float32))[:, None]
        mag = jnp.exp(lr * dt)
        abar_r = mag * jnp.cos(li * dt)
        abar_i = mag * jnp.sin(li * dt)
        den = lr * lr + li * li
        nr = abar_r - 1.0
        ni = abar_i
        coef_r = (nr * lr + ni * li) / den
        coef_i = (ni * lr - nr * li) / den
        bbar_r = coef_r[..., None] * b_re[d] - coef_i[..., None] * b_im[d]
        bbar_i = coef_r[..., None] * b_im[d] + coef_i[..., None] * b_re[d]
        bu_r = jnp.einsum('blgc,gpc->blgp', ug, bbar_r)
        bu_i = jnp.einsum('blgc,gpc->blgp', ug, bbar_i)
        ar = jnp.broadcast_to(abar_r, bu_r.shape)
        ai = jnp.broadcast_to(abar_i, bu_r.shape)
        _, _, hr, hi = lax.associative_scan(_clin_combine, (ar, ai, bu_r, bu_i), reverse=(d == 1), axis=1)
        y = y + jnp.einsum('blgp,gcp->blgc', hr, c_re[d]) - jnp.einsum('blgp,gcp->blgc', hi, c_im[d])
    y = jax.nn.gelu(y.reshape(Bsz, L, S5_WIDTH))
    return y * jax.nn.sigmoid(y @ glu_w + glu_b)


def hyena_filters(L, w1, b1, freq1, w2, b2, freq2, w3):
    pos = jnp.arange(L, dtype=jnp.float32)
    t = pos / max(L - 1, 1)
    w = (2.0 * math.pi / L) * pos
    bands = jnp.linspace(1e-4, HY_BANDS - 1, HY_BANDS, dtype=jnp.float32)
    ang = w[:, None] * bands
    feats = jnp.concatenate([t[:, None], jnp.cos(ang), -jnp.sin(ang)], axis=-1)
    hid = jnp.sin(freq1 * (feats @ w1 + b1))
    hid = jnp.sin(freq2 * (hid @ w2 + b2))
    k = hid @ w3
    max_decay = math.log(HY_DECAY_TARGET) / HY_FAST_DECAY
    min_decay = math.log(HY_DECAY_TARGET) / HY_SLOW_DECAY
    deltas = jnp.abs(jnp.linspace(min_decay, max_decay, HY_WIDTH, dtype=jnp.float32))
    k = k * jnp.exp(-t[:, None] * jnp.tile(deltas, N_DIR))
    return k[:, :HY_WIDTH], k[:, HY_WIDTH:]


def bidir_fft_conv(z, k_fwd, k_bwd):
    L = z.shape[1]
    zero = jnp.zeros((1, HY_WIDTH), jnp.float32)
    kern = jnp.concatenate([k_fwd[:1] + k_bwd[:1], k_fwd[1:], zero, k_bwd[:0:-1]], axis=0)
    zf = jnp.fft.rfft(z.astype(jnp.float32), n=2 * L, axis=1)
    kf = jnp.fft.rfft(kern, axis=0)
    return jnp.fft.irfft(zf * kf, n=2 * L, axis=1)[:, :L]


def hyena_mixer(pc, conv_w, conv_b, w1, b1, freq1, w2, b2, freq2, w3, bias):
    L = pc.shape[1]
    q = dwconv_centred(pc, conv_w, conv_b)
    x0, x1, v = jnp.split(q, 3, axis=-1)
    k_fwd, k_bwd = hyena_filters(L, w1, b1, freq1, w2, b2, freq2, w3)
    z = v * x1
    z = bidir_fft_conv(z, k_fwd, k_bwd) + z * bias
    return z * x0


def conv_ffn(h, w_up, conv_w, conv_b, w_down):
    u = dwconv_centred(h @ w_up, conv_w, conv_b)
    a, v = jnp.split(u, 2, axis=-1)
    return (jax.nn.gelu(a) * v) @ w_down


def setup_inputs(seed: int = 0) -> dict:
    key = jax.random.key(seed)
    ks = jax.random.split(key, 40)
    f32 = jnp.float32

    def nrm(k, shape, scale):
        return jax.random.normal(k, shape, f32) * scale

    def gain(k, shape):
        return 1.0 + 0.02 * jax.random.normal(k, shape, f32)

    a_target = jax.random.uniform(ks[9], (DEPTH, N_DIR, RG_WIDTH), f32, 0.9, 0.999)
    s = a_target ** (1.0 / RG_C)
    rg_lambda = jnp.log(s) - jnp.log1p(-s)
    n_idx = jnp.arange(S5_STATE, dtype=f32)
    return {
        "x": nrm(ks[0], (BATCH, SEQ, D_MODEL), 1.0),
        "norm1_g": gain(ks[1], (DEPTH, D_MODEL)),
        "w_in": nrm(ks[2], (DEPTH, D_MODEL, IN_COLS), D_MODEL ** -0.5),
        "rg_conv_w": nrm(ks[3], (DEPTH, RG_CONV, RG_WIDTH), RG_CONV ** -0.5),
        "rg_conv_b": nrm(ks[4], (DEPTH, RG_WIDTH), 0.01),
        "rg_wa": nrm(ks[5], (DEPTH, N_DIR, RG_HEADS, RG_HEAD_DIM, RG_HEAD_DIM), RG_HEAD_DIM ** -0.5),
        "rg_ba": nrm(ks[6], (DEPTH, N_DIR, RG_WIDTH), 0.01),
        "rg_wx": nrm(ks[7], (DEPTH, N_DIR, RG_HEADS, RG_HEAD_DIM, RG_HEAD_DIM), RG_HEAD_DIM ** -0.5),
        "rg_bx": nrm(ks[8], (DEPTH, N_DIR, RG_WIDTH), 0.01),
        "rg_lambda": rg_lambda,
        "s5_a_re": -0.5 + nrm(ks[10], (DEPTH, N_DIR, S5_GROUPS, S5_STATE), 0.01),
        "s5_a_im": math.pi * n_idx + nrm(ks[11], (DEPTH, N_DIR, S5_GROUPS, S5_STATE), 0.01),
        "s5_log_dt": jax.random.uniform(ks[12], (DEPTH, N_DIR, S5_GROUPS), f32, math.log(1e-3), math.log(1e-1)),
        "s5_b_re": nrm(ks[13], (DEPTH, N_DIR, S5_GROUPS, S5_STATE, S5_GROUP), (2 * S5_GROUP) ** -0.5),
        "s5_b_im": nrm(ks[14], (DEPTH, N_DIR, S5_GROUPS, S5_STATE, S5_GROUP), (2 * S5_GROUP) ** -0.5),
        "s5_c_re": nrm(ks[15], (DEPTH, N_DIR, S5_GROUPS, S5_GROUP, S5_STATE), (2 * S5_STATE) ** -0.5),
        "s5_c_im": nrm(ks[16], (DEPTH, N_DIR, S5_GROUPS, S5_GROUP, S5_STATE), (2 * S5_STATE) ** -0.5),
        "s5_d": nrm(ks[17], (DEPTH, S5_WIDTH), 1.0),
        "s5_glu_w": nrm(ks[18], (DEPTH, S5_WIDTH, S5_WIDTH), S5_WIDTH ** -0.5),
        "s5_glu_b": nrm(ks[19], (DEPTH, S5_WIDTH), 0.01),
        "hy_conv_w": nrm(ks[20], (DEPTH, HY_CONV, 3 * HY_WIDTH), HY_CONV ** -0.5),
        "hy_conv_b": nrm(ks[21], (DEPTH, 3 * HY_WIDTH), 0.01),
        "hy_filt_w1": nrm(ks[22], (DEPTH, HY_FEAT, HY_FILT_HIDDEN), HY_FEAT ** -0.5),
        "hy_filt_b1": nrm(ks[23], (DEPTH, HY_FILT_HIDDEN), 0.1),
        "hy_filt_freq1": gain(ks[24], (DEPTH, HY_FILT_HIDDEN)),
        "hy_filt_w2": nrm(ks[25], (DEPTH, HY_FILT_HIDDEN, HY_FILT_HIDDEN), HY_FILT_HIDDEN ** -0.5),
        "hy_filt_b2": nrm(ks[26], (DEPTH, HY_FILT_HIDDEN), 0.1),
        "hy_filt_freq2": gain(ks[27], (DEPTH, HY_FILT_HIDDEN)),
        "hy_filt_w3": nrm(ks[28], (DEPTH, HY_FILT_HIDDEN, N_DIR * HY_WIDTH), 0.1 * HY_FILT_HIDDEN ** -0.5),
        "hy_bias": nrm(ks[29], (DEPTH, HY_WIDTH), 1.0),
        "mix_norm_g": gain(ks[30], (DEPTH, D_MIX)),
        "w_out": nrm(ks[31], (DEPTH, D_MIX, D_MODEL), D_MIX ** -0.5),
        "norm2_g": gain(ks[32], (DEPTH, D_MODEL)),
        "w_up": nrm(ks[33], (DEPTH, D_MODEL, 2 * D_FF), D_MODEL ** -0.5),
        "ffn_conv_w": nrm(ks[34], (DEPTH, FFN_CONV, 2 * D_FF), FFN_CONV ** -0.5),
        "ffn_conv_b": nrm(ks[35], (DEPTH, 2 * D_FF), 0.01),
        "w_down": nrm(ks[36], (DEPTH, D_FF, D_MODEL), D_FF ** -0.5),
        "final_norm_g": gain(ks[37], (D_MODEL,)),
    }


def reference(x, norm1_g, w_in, rg_conv_w, rg_conv_b, rg_wa, rg_ba, rg_wx, rg_bx, rg_lambda,
              s5_a_re, s5_a_im, s5_log_dt, s5_b_re, s5_b_im, s5_c_re, s5_c_im, s5_d, s5_glu_w, s5_glu_b,
              hy_conv_w, hy_conv_b, hy_filt_w1, hy_filt_b1, hy_filt_freq1, hy_filt_w2, hy_filt_b2,
              hy_filt_freq2, hy_filt_w3, hy_bias, mix_norm_g, w_out,
              norm2_g, w_up, ffn_conv_w, ffn_conv_b, w_down, final_norm_g):
    h = x.astype(jnp.float32)
    split_idx = [RG_WIDTH, 2 * RG_WIDTH, 2 * RG_WIDTH + S5_WIDTH]
    for l in range(DEPTH):
        n = rmsnorm(h, norm1_g[l])
        proj = n @ w_in[l]
        xa, ga, ub, pc = jnp.split(proj, split_idx, axis=-1)
        ya = rglru_mixer(xa, ga, rg_conv_w[l], rg_conv_b[l], rg_wa[l], rg_ba[l],
                         rg_wx[l], rg_bx[l], rg_lambda[l])
        yb = s5_mixer(ub, s5_a_re[l], s5_a_im[l], s5_log_dt[l], s5_b_re[l], s5_b_im[l],
                      s5_c_re[l], s5_c_im[l], s5_d[l], s5_glu_w[l], s5_glu_b[l])
        yc = hyena_mixer(pc, hy_conv_w[l], hy_conv_b[l], hy_filt_w1[l], hy_filt_b1[l], hy_filt_freq1[l],
                         hy_filt_w2[l], hy_filt_b2[l], hy_filt_freq2[l], hy_filt_w3[l], hy_bias[l])
        ymix = jnp.concatenate([rms_nogain(ya), rms_nogain(yb), rms_nogain(yc)], axis=-1) * mix_norm_g[l]
        h = h + ymix @ w_out[l]
        h = h + conv_ffn(rmsnorm(h, norm2_g[l]), w_up[l], ffn_conv_w[l], ffn_conv_b[l], w_down[l])
    return rmsnorm(h, final_norm_g).astype(x.dtype)
```

```cpp
#ifdef CPU_EMU
#include <cmath>
#include <cstring>
#include <cstdio>
#include <cstdlib>
struct dim3 { unsigned x, y, z; dim3(unsigned x_ = 1, unsigned y_ = 1, unsigned z_ = 1) : x(x_), y(y_), z(z_) {} };
static thread_local dim3 threadIdx, blockIdx; static dim3 blockDim, gridDim;
struct float4 { float x, y, z, w; };
#define __global__
#define __device__
#define __host__
#define __forceinline__ inline
#define __launch_bounds__(...)
typedef void* hipStream_t;
template <class F> static void cpu_launch(dim3 g, dim3 b, F f) {
    gridDim = g; blockDim = b;
#pragma omp parallel for collapse(2) schedule(dynamic)
    for (unsigned by = 0; by < g.y; ++by) for (unsigned bx = 0; bx < g.x; ++bx) {
        blockIdx = dim3(bx, by, 0);
        for (unsigned tx = 0; tx < b.x; ++tx) { threadIdx = dim3(tx, 0, 0); f(); }
    }
}
#define LAUNCH(kern, grid, block, stream, ...) cpu_launch(grid, block, [&]() { kern(__VA_ARGS__); })
void dbg_dump(const char* name, const float* p, size_t n);
#define DBG(name, p, n) dbg_dump(name, p, n)
#else
#include <hip/hip_runtime.h>
#define LAUNCH(kern, grid, block, stream, ...) hipLaunchKernelGGL(kern, grid, block, 0, stream, __VA_ARGS__)
#define DBG(name, p, n)
#endif

#ifndef BATCH
#define BATCH 4
#endif
#ifndef SEQ
#define SEQ 4096
#endif
constexpr int Bn = BATCH, L = SEQ, M = Bn * L, D = 1024, NIN = 1920, RGW = 384, S5W = 384, HYW = 256, FF = 2816, FF2 = 5632;

__device__ __forceinline__ float gelu_f(float x) { return 0.5f * x * (1.0f + tanhf(0.7978845608028654f * (x + 0.044715f * x * x * x))); }
__device__ __forceinline__ float sigmoid_f(float x) { return 1.0f / (1.0f + expf(-x)); }
__device__ __forceinline__ float softplus_f(float x) { return x > 0.f ? x + log1pf(expf(-x)) : log1pf(expf(x)); }

__global__ void k_rmsnorm_rows(const float* h, const float* g, float* out, int rows) {
    int r = blockIdx.x * 256 + threadIdx.x; if (r >= rows) return;
    const float* x = h + (size_t)r * D; float s = 0.f;
    for (int i = 0; i < D; ++i) s += x[i] * x[i];
    float inv = 1.0f / sqrtf(s / D + 1e-6f);
    float* o = out + (size_t)r * D;
    for (int i = 0; i < D; ++i) o[i] = x[i] * inv * g[i];
}
__global__ void k_gemm(const float* A, int lda, const float* W, int ldw, float* C, int ldc, int K, int N, int accumulate) {
    int n = (blockIdx.x * 256 + threadIdx.x) * 4; if (n >= N) return;
    int m0 = blockIdx.y * 8;
    float acc[8][4];
#pragma unroll
    for (int i = 0; i < 8; ++i) { acc[i][0] = 0.f; acc[i][1] = 0.f; acc[i][2] = 0.f; acc[i][3] = 0.f; }
    for (int k = 0; k < K; ++k) {
        const float4 w = *(const float4*)(W + (size_t)k * ldw + n);
#pragma unroll
        for (int i = 0; i < 8; ++i) { float a = A[(size_t)(m0 + i) * lda + k]; acc[i][0] += a * w.x; acc[i][1] += a * w.y; acc[i][2] += a * w.z; acc[i][3] += a * w.w; }
    }
#pragma unroll
    for (int i = 0; i < 8; ++i) { float* c = C + (size_t)(m0 + i) * ldc + n;
        if (accumulate) { c[0] += acc[i][0]; c[1] += acc[i][1]; c[2] += acc[i][2]; c[3] += acc[i][3]; } else { c[0] = acc[i][0]; c[1] = acc[i][1]; c[2] = acc[i][2]; c[3] = acc[i][3]; } }
}

__global__ void k_rg_conv(const float* proj, const float* cw, const float* cb, float* u) {
    int i = blockIdx.x * 256 + threadIdx.x; if (i >= M * RGW) return;
    int m = i / RGW, c = i % RGW, t = m % L; float s = cb[c];
#pragma unroll
    for (int k = 0; k < 4; ++k) { int tt = t + k - 1; if (tt >= 0 && tt < L) s += cw[k * RGW + c] * proj[(size_t)(m + k - 1) * NIN + c]; }
    u[i] = s;
}
__global__ void k_rg_scan(const float* u, const float* proj, const float* wa, const float* ba, const float* wx, const float* bx, const float* lam, float* ya) {
    int i = blockIdx.x * 256 + threadIdx.x; if (i >= Bn * RGW) return;
    int b = i / RGW, c = i % RGW, hd = c / 64, j = c % 64;
    for (int d = 0; d < 2; ++d) {
        const float sp = softplus_f(-lam[d * RGW + c]);
        const float* Wa = wa + ((size_t)(d * 6 + hd) * 64) * 64 + j; const float* Wx = wx + ((size_t)(d * 6 + hd) * 64) * 64 + j;
        const float bra = ba[d * RGW + c], brx = bx[d * RGW + c];
        float h = 0.f;
        for (int s = 0; s < L; ++s) {
            int t = d == 0 ? s : L - 1 - s; size_t m = (size_t)b * L + t;
            const float* ur = u + m * RGW + hd * 64; float ar = bra, ax = brx;
            for (int q = 0; q < 64; ++q) { float uu = ur[q]; ar += uu * Wa[q * 64]; ax += uu * Wx[q * 64]; }
            float r = sigmoid_f(ar), ig = sigmoid_f(ax);
            float la = -8.0f * r * sp, a = expf(la), mult = sqrtf(-expm1f(2.0f * la));
            h = a * h + mult * (ig * ur[j]);
            if (d == 0) ya[m * RGW + c] = h; else ya[m * RGW + c] = (ya[m * RGW + c] + h) * gelu_f(proj[m * NIN + RGW + c]);
        }
    }
}

__global__ void k_s5_disc(const float* a_re, const float* a_im, const float* log_dt, const float* b_re, const float* b_im, float* abar, float* bbr, float* bbi) {
    int i = blockIdx.x * 256 + threadIdx.x; if (i >= 2 * 24 * 64) return;
    int dg = i / 64;
    float lr = a_re[i], li = a_im[i], dt = expf(log_dt[dg]);
    float mag = expf(lr * dt), ar = mag * cosf(li * dt), ai = mag * sinf(li * dt);
    float den = lr * lr + li * li, nr = ar - 1.0f, ni = ai;
    float cr = (nr * lr + ni * li) / den, ci = (ni * lr - nr * li) / den;
    abar[2 * i] = ar; abar[2 * i + 1] = ai;
    for (int c = 0; c < 16; ++c) { float br = b_re[i * 16 + c], bi = b_im[i * 16 + c]; bbr[i * 16 + c] = cr * br - ci * bi; bbi[i * 16 + c] = cr * bi + ci * br; }
}
__global__ void __launch_bounds__(256) k_s5_scan(const float* proj, const float* abar, const float* bbr, const float* bbi, const float* c_re, const float* c_im, float* y2) {
    int i = blockIdx.x * 256 + threadIdx.x; if (i >= Bn * 2 * 24 * 16) return;
    int c = i % 16, g = (i / 16) % 24, d = (i / (16 * 24)) % 2, b = i / (16 * 24 * 2);
    const int dg = d * 24 + g;
    const float* Ab = abar + (size_t)dg * 64 * 2; const float* Br = bbr + (size_t)dg * 64 * 16; const float* Bi = bbi + (size_t)dg * 64 * 16;
    const float* Cr = c_re + ((size_t)dg * 16 + c) * 64; const float* Ci = c_im + ((size_t)dg * 16 + c) * 64;
    float hr[64], hi[64];
#pragma unroll
    for (int p = 0; p < 64; ++p) { hr[p] = 0.f; hi[p] = 0.f; }
    for (int s = 0; s < L; ++s) {
        int t = d == 0 ? s : L - 1 - s; size_t m = (size_t)b * L + t;
        const float* ur = proj + m * NIN + 2 * RGW + g * 16;
        float uu[16];
#pragma unroll
        for (int q = 0; q < 16; ++q) uu[q] = ur[q];
        float y = 0.f;
#pragma unroll
        for (int p = 0; p < 64; ++p) {
            float br = 0.f, bi = 0.f;
#pragma unroll
            for (int q = 0; q < 16; ++q) { br += Br[p * 16 + q] * uu[q]; bi += Bi[p * 16 + q] * uu[q]; }
            float ar = Ab[2 * p], ai = Ab[2 * p + 1];
            float nr = ar * hr[p] - ai * hi[p] + br, ni = ar * hi[p] + ai * hr[p] + bi;
            hr[p] = nr; hi[p] = ni;
            y += nr * Cr[p] - ni * Ci[p];
        }
        y2[((size_t)d * M + m) * S5W + g * 16 + c] = y;
    }
}
__global__ void k_s5_gelu(const float* y2, const float* proj, const float* dsk, float* yg) {
    int i = blockIdx.x * 256 + threadIdx.x; if (i >= M * S5W) return;
    int m = i / S5W, c = i % S5W;
    float y = proj[(size_t)m * NIN + 2 * RGW + c] * dsk[c] + y2[i] + y2[(size_t)M * S5W + i];
    yg[i] = gelu_f(y);
}

__global__ void k_hy_h1(const float* w1, const float* b1, const float* f1, float* hid1) {
    int i = blockIdx.x * 256 + threadIdx.x; if (i >= L * 64) return;
    int pos = i / 64, mm = i % 64;
    float t = (float)pos / (float)(L - 1 > 1 ? L - 1 : 1), w = (6.283185307179586f / (float)L) * (float)pos;
    float acc = b1[mm] + t * w1[mm];
    for (int q = 0; q < 16; ++q) { float band = 1e-4f + (float)q * ((15.0f - 1e-4f) / 15.0f); float ang = w * band;
        acc += cosf(ang) * w1[(1 + q) * 64 + mm] - sinf(ang) * w1[(17 + q) * 64 + mm]; }
    hid1[i] = sinf(f1[mm] * acc);
}
__global__ void k_hy_h2(const float* hid1, const float* w2, const float* b2, const float* f2, float* hid2) {
    int i = blockIdx.x * 256 + threadIdx.x; if (i >= L * 64) return;
    int pos = i / 64, mm = i % 64; float acc = b2[mm];
    for (int q = 0; q < 64; ++q) acc += hid1[pos * 64 + q] * w2[q * 64 + mm];
    hid2[i] = sinf(f2[mm] * acc);
}
__global__ void k_hy_k(const float* hid2, const float* w3, float* kfb) {
    int i = blockIdx.x * 256 + threadIdx.x; if (i >= L * 512) return;
    int pos = i / 512, c2 = i % 512, c = c2 % 256; float acc = 0.f;
    for (int q = 0; q < 64; ++q) acc += hid2[pos * 64 + q] * w3[q * 512 + c2];
    const float maxd = logf(1e-2f) / 0.3f, mind = logf(1e-2f) / 1.5f;
    float delta = fabsf(mind + (float)c * ((maxd - mind) / 255.0f));
    float t = (float)pos / (float)(L - 1 > 1 ? L - 1 : 1);
    kfb[i] = acc * expf(-t * delta);
}
__global__ void k_hy_pre(const float* proj, const float* cw, const float* cb, float* z, float* x0c) {
    int i = blockIdx.x * 256 + threadIdx.x; if (i >= M * HYW) return;
    int m = i / HYW, c = i % HYW, t = m % L;
    float q[3];
#pragma unroll
    for (int part = 0; part < 3; ++part) { int col = part * HYW + c; float s = cb[col];
#pragma unroll
        for (int k = 0; k < 3; ++k) { int tt = t + k - 1; if (tt >= 0 && tt < L) s += cw[k * 768 + col] * proj[(size_t)(m + k - 1) * NIN + 3 * RGW + col]; }
        q[part] = s; }
    z[i] = q[2] * q[1]; x0c[i] = q[0];
}
__global__ void k_hy_conv(const float* z, const float* x0c, const float* kfb, const float* bias, float* yc) {
    int i = blockIdx.x * 256 + threadIdx.x; if (i >= M * HYW) return;
    int m = i / HYW, c = i % HYW, t = m % L, b = m / L;
    const float* zb = z + (size_t)b * L * HYW + c; float acc = 0.f;
    for (int s = 0; s <= t; ++s) acc += kfb[(size_t)(t - s) * 512 + c] * zb[(size_t)s * HYW];
    for (int s = t; s < L; ++s) acc += kfb[(size_t)(s - t) * 512 + 256 + c] * zb[(size_t)s * HYW];
    yc[i] = (acc + z[i] * bias[c]) * x0c[i];
}

__global__ void k_mixnorm(const float* ya, const float* yg, const float* gl, const float* glb, const float* yc, const float* mg, float* ymix) {
    int m = blockIdx.x * 256 + threadIdx.x; if (m >= M) return;
    float sa = 0.f, sb = 0.f, sc = 0.f;
    for (int c = 0; c < RGW; ++c) { float v = ya[(size_t)m * RGW + c]; sa += v * v; }
    for (int c = 0; c < S5W; ++c) { float y = yg[(size_t)m * S5W + c]; float v = y * sigmoid_f(gl[(size_t)m * S5W + c] + glb[c]); sb += v * v; }
    for (int c = 0; c < HYW; ++c) { float v = yc[(size_t)m * HYW + c]; sc += v * v; }
    float ia = 1.0f / sqrtf(sa / RGW + 1e-6f), ib = 1.0f / sqrtf(sb / S5W + 1e-6f), ic = 1.0f / sqrtf(sc / HYW + 1e-6f);
    float* o = ymix + (size_t)m * D;
    for (int c = 0; c < RGW; ++c) o[c] = ya[(size_t)m * RGW + c] * ia * mg[c];
    for (int c = 0; c < S5W; ++c) { float y = yg[(size_t)m * S5W + c]; float v = y * sigmoid_f(gl[(size_t)m * S5W + c] + glb[c]); o[RGW + c] = v * ib * mg[RGW + c]; }
    for (int c = 0; c < HYW; ++c) o[RGW + S5W + c] = yc[(size_t)m * HYW + c] * ic * mg[RGW + S5W + c];
}
__global__ void k_ffn_gate(const float* u, const float* cw, const float* cb, float* g) {
    int i = blockIdx.x * 256 + threadIdx.x; if (i >= L * FF) return;
    int t = i / FF, j = i % FF; float a = cb[j], v = cb[FF + j];
#pragma unroll
    for (int k = 0; k < 3; ++k) { int tt = t + k - 1; if (tt >= 0 && tt < L) { a += cw[k * FF2 + j] * u[(size_t)tt * FF2 + j]; v += cw[k * FF2 + FF + j] * u[(size_t)tt * FF2 + FF + j]; } }
    g[i] = gelu_f(a) * v;
}

static inline dim3 g1(size_t n) { return dim3((unsigned)((n + 255) / 256)); }

extern "C" void kernel_launch(void* const* d_in, const int* in_sizes, int n_in, void* d_out, int out_size, void* d_ws, size_t ws_size, hipStream_t stream) {
    const float* in[38]; for (int i = 0; i < 38; ++i) in[i] = (const float*)d_in[i];
    float* h = (float*)d_out; float* ws = (float*)d_ws;
    float* A0 = ws; float* A1 = ws + (size_t)M * 1024; float* A2 = ws + (size_t)M * 2944;
    const size_t q24 = (size_t)M * 384;
    float* u_conv = A0; float* ya = A0 + q24;
#ifdef CPU_EMU
    float* small = ws + (size_t)M * 4096;
#else
    float* small = A0 + 2 * q24;
#endif
    float* proj = A1; float* ymix = A1;
    float* y2 = A2; float* gl = A2 + 2 * q24; float* yg = A0;
    float* z = A2; float* x0c = A2 + (size_t)M * 256; float* yc = A2 + (size_t)M * 512;
    float* abar = small; float* bbr = small + 8192; float* bbi = bbr + 2 * 24 * 64 * 16; float* hid1 = bbi + 2 * 24 * 64 * 16; float* hid2 = hid1 + (size_t)L * 64; float* kfb = hid2 + (size_t)L * 64;
#ifdef CPU_EMU
    memcpy(h, in[0], sizeof(float) * (size_t)M * D);
#else
    hipMemcpyAsync(h, in[0], sizeof(float) * (size_t)M * D, hipMemcpyDeviceToDevice, stream);
#endif
    for (int l = 0; l < 2; ++l) {
        LAUNCH(k_rmsnorm_rows, g1(M), dim3(256), stream, h, in[1] + l * 1024, A0, M);
        LAUNCH(k_gemm, dim3((NIN / 4 + 255) / 256, M / 8), dim3(256), stream, A0, D, in[2] + (size_t)l * D * NIN, NIN, proj, NIN, D, NIN, 0);
        DBG("proj", proj, (size_t)M * NIN);
        LAUNCH(k_rg_conv, g1((size_t)M * RGW), dim3(256), stream, proj, in[3] + l * 4 * RGW, in[4] + l * RGW, u_conv);
        LAUNCH(k_rg_scan, g1(Bn * RGW), dim3(256), stream, u_conv, proj, in[5] + (size_t)l * 2 * 6 * 64 * 64, in[6] + l * 2 * RGW, in[7] + (size_t)l * 2 * 6 * 64 * 64, in[8] + l * 2 * RGW, in[9] + l * 2 * RGW, ya);
        DBG("ya", ya, (size_t)M * RGW);
        LAUNCH(k_s5_disc, g1(2 * 24 * 64), dim3(256), stream, in[10] + l * 3072, in[11] + l * 3072, in[12] + l * 48, in[13] + (size_t)l * 49152, in[14] + (size_t)l * 49152, abar, bbr, bbi);
        LAUNCH(k_s5_scan, g1(Bn * 2 * 24 * 16), dim3(256), stream, proj, abar, bbr, bbi, in[15] + (size_t)l * 49152, in[16] + (size_t)l * 49152, y2);
        LAUNCH(k_s5_gelu, g1((size_t)M * S5W), dim3(256), stream, y2, proj, in[17] + l * S5W, yg);
        LAUNCH(k_gemm, dim3(1, M / 8), dim3(256), stream, yg, S5W, in[18] + (size_t)l * S5W * S5W, S5W, gl, S5W, S5W, S5W, 0);
        LAUNCH(k_hy_h1, g1((size_t)L * 64), dim3(256), stream, in[22] + l * 33 * 64, in[23] + l * 64, in[24] + l * 64, hid1);
        LAUNCH(k_hy_h2, g1((size_t)L * 64), dim3(256), stream, hid1, in[25] + l * 4096, in[26] + l * 64, in[27] + l * 64, hid2);
        LAUNCH(k_hy_k, g1((size_t)L * 512), dim3(256), stream, hid2, in[28] + (size_t)l * 64 * 512, kfb);
        LAUNCH(k_hy_pre, g1((size_t)M * HYW), dim3(256), stream, proj, in[20] + l * 3 * 768, in[21] + l * 768, z, x0c);
        LAUNCH(k_hy_conv, g1((size_t)M * HYW), dim3(256), stream, z, x0c, kfb, in[29] + l * HYW, yc);
        DBG("yc", yc, (size_t)M * HYW);
        LAUNCH(k_mixnorm, g1(M), dim3(256), stream, ya, yg, gl, in[19] + l * S5W, yc, in[30] + l * D, ymix);
        DBG("ymix", ymix, (size_t)M * D);
        LAUNCH(k_gemm, dim3(1, M / 8), dim3(256), stream, ymix, D, in[31] + (size_t)l * D * D, D, h, D, D, D, 1);
        DBG("hmid", h, (size_t)M * D);
        for (int b = 0; b < Bn; ++b) {
            float* hb = h + (size_t)b * L * D; float* n2 = A0; float* u = A1; float* g = A2;
            LAUNCH(k_rmsnorm_rows, g1(L), dim3(256), stream, hb, in[32] + l * D, n2, L);
            LAUNCH(k_gemm, dim3((FF2 / 4 + 255) / 256, L / 8), dim3(256), stream, n2, D, in[33] + (size_t)l * D * FF2, FF2, u, FF2, D, FF2, 0);
            LAUNCH(k_ffn_gate, g1((size_t)L * FF), dim3(256), stream, u, in[34] + l * 3 * FF2, in[35] + l * FF2, g);
            LAUNCH(k_gemm, dim3(1, L / 8), dim3(256), stream, g, FF, in[36] + (size_t)l * FF * D, D, hb, D, FF, D, 1);
        }
        DBG("hout", h, (size_t)M * D);
    }
    LAUNCH(k_rmsnorm_rows, g1(M), dim3(256), stream, h, in[37], h, M);
}
```

```cpp
#ifdef CPU_EMU
#include "emu.h"
#define LAS
#define GAS
#define DEVFN static inline
#define MEMFN inline
#define WAVE_LDS_FENCE() emu::wave_sync()
#else
#include <hip/hip_runtime.h>
#include <cstdio>
#include <cstdint>
#define LAS __attribute__((address_space(3)))
#define GAS __attribute__((address_space(1)))
#define DEVFN __device__ __forceinline__
#define MEMFN __device__ __forceinline__
#define WAVE_LDS_FENCE() do { asm volatile("s_waitcnt lgkmcnt(0)" ::: "memory"); } while (0)
typedef short bf16x8 __attribute__((ext_vector_type(8)));
typedef float f32x4 __attribute__((ext_vector_type(4)));
typedef float f32x2 __attribute__((ext_vector_type(2)));
typedef float f32x16 __attribute__((ext_vector_type(16)));
typedef unsigned u32x4 __attribute__((ext_vector_type(4)));
typedef unsigned u32x2 __attribute__((ext_vector_type(2)));
typedef __bf16 bf16x2_t __attribute__((ext_vector_type(2)));
DEVFN void sync_block() { __syncthreads(); }
DEVFN int lane_id() { int l; asm volatile("v_mbcnt_lo_u32_b32 %0, -1, 0\n\tv_mbcnt_hi_u32_b32 %0, -1, %0" : "=v"(l)); return l; }
DEVFN f32x16 mfma32(bf16x8 a, bf16x8 b, f32x16 c) { return __builtin_amdgcn_mfma_f32_32x32x16_bf16(a, b, c, 0, 0, 0); }
DEVFN f32x4 mfma16(bf16x8 a, bf16x8 b, f32x4 c) { return __builtin_amdgcn_mfma_f32_16x16x32_bf16(a, b, c, 0, 0, 0); }
DEVFN float shfl_f32(float v, int src) { return __builtin_bit_cast(float, __builtin_amdgcn_ds_bpermute(src << 2, __builtin_bit_cast(int, v))); }
DEVFN float shfl_xor_f32(float v, int m) { return shfl_f32(v, lane_id() ^ m); }
DEVFN float dpp_row_shr1(float old, float src) { return __builtin_bit_cast(float, __builtin_amdgcn_update_dpp(__builtin_bit_cast(int, old), __builtin_bit_cast(int, src), 0x111, 0xf, 0xf, false)); }
DEVFN float dpp_row_shl1(float old, float src) { return __builtin_bit_cast(float, __builtin_amdgcn_update_dpp(__builtin_bit_cast(int, old), __builtin_bit_cast(int, src), 0x101, 0xf, 0xf, false)); }
DEVFN float dpp_row_ror1(float src) { return __builtin_bit_cast(float, __builtin_amdgcn_update_dpp(0, __builtin_bit_cast(int, src), 0x121, 0xf, 0xf, false)); }
DEVFN float dpp_row_ror15(float src) { return __builtin_bit_cast(float, __builtin_amdgcn_update_dpp(0, __builtin_bit_cast(int, src), 0x12f, 0xf, 0xf, false)); }
DEVFN unsigned pk_bf16(float lo, float hi) { f32x2 v = {lo, hi}; bf16x2_t b = __builtin_convertvector(v, bf16x2_t); return __builtin_bit_cast(unsigned, b); }
DEVFN float bf_lo(unsigned u) { return __builtin_bit_cast(float, u << 16); }
DEVFN float bf_hi(unsigned u) { return __builtin_bit_cast(float, u & 0xffff0000u); }
DEVFN float fast_rcp(float x) { return __builtin_amdgcn_rcpf(x); }
DEVFN float fast_exp2(float x) { return __builtin_amdgcn_exp2f(x); }
#endif

#ifndef BATCH
#define BATCH 4
#endif
#ifndef SEQ
#define SEQ 4096
#endif
typedef unsigned short bf16;
constexpr int Bn = BATCH, L = SEQ, M = Bn * L, D = 1024, NIN = 1920, NINP = 2048, RGW = 384, S5W = 384, HYW = 256, FF = 2816, FF2 = 5632, GLUP = 512;
constexpr int NWAVES = 8, NT = NWAVES * 64;
constexpr int UPS = 254, NQ = (L + UPS - 1) / UPS;

constexpr size_t al256(size_t x) { return (x + 255) & ~(size_t)255; }
constexpr size_t WS_CTL = 0, CTL_BYTES = 1u << 20;
constexpr size_t SZ_WIN = (size_t)NINP * D * 2, SZ_WOUT = (size_t)D * D * 2, SZ_WUP = (size_t)FF2 * D * 2, SZ_WDN = (size_t)D * FF * 2, SZ_WGLU = (size_t)GLUP * S5W * 2;
constexpr size_t WS_WIN = WS_CTL + CTL_BYTES, WS_WOUT = WS_WIN + 2 * SZ_WIN, WS_WUP = WS_WOUT + 2 * SZ_WOUT, WS_WDN = WS_WUP + 2 * SZ_WUP, WS_WGLU = WS_WDN + 2 * SZ_WDN;
constexpr size_t WS_HBPAD = WS_WGLU + 2 * SZ_WGLU, HB_FRONT = (size_t)256 * D * 2, WS_HB = WS_HBPAD + HB_FRONT, SZ_HBPAD = (size_t)(M + 768) * D * 2;
constexpr size_t WS_SSQ = WS_HBPAD + SZ_HBPAD, SZ_SSQ = (size_t)M * 16 * 4;
constexpr size_t WS_PROJ = WS_SSQ + SZ_SSQ, SZ_PROJ = (size_t)M * NINP * 2;
constexpr size_t WS_YMIX = WS_PROJ + SZ_PROJ, SZ_YMIX = (size_t)M * D * 2;
constexpr size_t WS_G = WS_PROJ;
constexpr size_t WS_T0 = WS_YMIX + SZ_YMIX, SZ_T0 = (size_t)M * 384 * 4;
constexpr size_t WS_YG = WS_T0;
constexpr size_t WS_THF = WS_T0 + SZ_T0, SZ_THF = (size_t)M * 384 * 2;
constexpr size_t WS_T1 = WS_THF + SZ_THF, SZ_T1 = (size_t)M * 384 * 4;
constexpr size_t WS_KFB = WS_T1 + SZ_T1, SZ_KFB = (size_t)L * 512 * 4;
constexpr size_t WS_HID = WS_KFB + SZ_KFB, SZ_HID = (size_t)4 * L * 64 * 4;
constexpr size_t WS_S5T = WS_HID + SZ_HID, SZ_S5T = al256((size_t)2 * (2 * 24 * 64 * 2 + 2 * 2 * 24 * 64 * 16) * 4);
constexpr size_t WS_SSQB = WS_S5T + SZ_S5T, SZ_SSQB = (size_t)M * 8 * 4;
constexpr size_t WS_RGSP = WS_SSQB + SZ_SSQB, SZ_RGSP = al256((size_t)2 * 2 * 384 * 4);
constexpr size_t WS_END = WS_RGSP + SZ_RGSP;
constexpr size_t WS_Z = WS_HB, WS_X0C = WS_HB + (size_t)M * 256 * 4;
static_assert(SZ_PROJ + SZ_YMIX >= (size_t)M * FF * 2, "g overlay");
static_assert((size_t)2 * M * 256 * 4 <= (size_t)M * D * 2, "z/x0c overlay");
static_assert(BATCH != 4 || SEQ != 4096 || WS_END <= ((size_t)256 << 20), "workspace over 256 MiB");

DEVFN float gelu_f(float x) { const float y = 1.5957691216057308f * (x + 0.044715f * x * x * x); return x * fast_rcp(1.0f + fast_exp2(-1.4426950408889634f * y)); }
DEVFN float sigmoid_f(float x) { return fast_rcp(1.0f + fast_exp2(-1.4426950408889634f * x)); }
DEVFN float softplus_f(float x) { return x > 0.f ? x + log1pf(expf(-x)) : log1pf(expf(x)); }
DEVFN float exp_f(float x) { return fast_exp2(1.4426950408889634f * x); }
DEVFN float expm1_f(float x) {
    const float p = x * (1.0f + x * (0.5f + x * (0.16666667f + x * (0.041666668f + x * (0.008333334f + x * 0.0013888889f)))));
    return fabsf(x) < 0.25f ? p : exp_f(x) - 1.0f; }
DEVFN float bf2f_(bf16 h) { return bf_lo((unsigned)h); }
DEVFN bf16 f2bf_(float f) { return (bf16)(pk_bf16(f, 0.f) & 0xffffu); }

namespace pg8 {
constexpr int BM = 256, BK = 64, HALF = 128, HTB = HALF * BK * 2, STAGE_BYTES = 8 * HTB, NXCD = 8, WGM = 8;
__host__ __device__ __forceinline__ int lds_byte(int r, int c) { const int st = (r >> 4) * 2 + (c >> 5), rr = r & 15, cc = c & 31, ob = rr * 64 + cc * 2; return st * 1024 + (ob ^ (((ob >> 9) & 1) << 5)); }
__host__ __device__ __forceinline__ void stage_rc(int b, int& R, int& C) { const int st = b / 1024, sb = b % 1024, swz = sb ^ (((sb >> 9) & 1) << 5); R = (st >> 1) * 16 + swz / 64; C = (st & 1) * 32 + (swz % 64) / 2; }
__host__ __device__ __forceinline__ int perm32(int rho) { const int n = rho >> 4, i = rho & 15; return 8 * (i >> 2) + 4 * n + (i & 3); }

struct Unit { int pm, pn; int arow; };
struct Gemm { const bf16* A; const bf16* Bt; int K; };

struct StaticOrder {
    int nM, nN, nwg, G, c;
    __host__ __device__ void init(int nM_, int nN_, int G_, int c_) { nM = nM_; nN = nN_; nwg = nM * nN; G = G_; c = c_; }
    __host__ __device__ bool next(int i, Unit& u) const {
        const long Lx = (long)i * G + c; if (Lx >= nwg) return false;
        int wgid = (int)Lx; { const int q = nwg / NXCD, r = nwg % NXCD, xcd = wgid % NXCD, off = wgid / NXCD; wgid = (xcd < r ? xcd * (q + 1) : r * (q + 1) + (xcd - r) * q) + off; }
        const int nig = WGM * nN, gid = wgid / nig, fm = gid * WGM, gsz = (nM - fm) < WGM ? (nM - fm) : WGM;
        u.pm = fm + ((wgid % nig) % gsz); u.pn = (wgid % nig) / gsz; u.arow = u.pm * BM; return true;
    }
};
struct UpOrder : StaticOrder {
    __host__ __device__ bool next(int i, Unit& u) const { if (!StaticOrder::next(i, u)) return false; const int b = u.pm / NQ, q = u.pm % NQ; u.arow = b * L + UPS * q - 1; return true; }
};

#ifndef CPU_EMU
#define PG8_LAS __attribute__((address_space(3)))
template <class Epi, class Sched, bool ALIGN_EPI = false, bool SP2 = false>
__device__ __forceinline__ void gemm_phase(PG8_LAS unsigned char* lds, const int tid, const Gemm g, const Sched& S, const Epi& E) {
    const int wid = __builtin_amdgcn_readfirstlane(tid >> 6), lane = tid & 63, wr = wid >> 2, wc = wid & 3, fr = lane & 15, fq = lane >> 4;
    const int K = g.K, nt = K / BK;
    unsigned voffA[2], voffB[2];
#pragma unroll
    for (int i = 0; i < 2; ++i) { int R, C; stage_rc(tid * 16 + i * 8192, R, C); const int Rb = Epi::PERM ? ((R & ~31) + perm32(R & 31)) : R;
        voffA[i] = (unsigned)(R * K + C) * 2u; voffB[i] = (unsigned)(Rb * K + C) * 2u; }
    const size_t kstep = (size_t)(BK * 2);
    const size_t hstep = (size_t)HALF * K * 2;
    const size_t tstep = 2 * hstep;
    const size_t rstep = (size_t)K * 2;
    const unsigned ldsw = (unsigned)wid * 1024u;
    const int aoff = lds_byte(wr * 64 + fr, fq * 8), boff = lds_byte(wc * 32 + fr, fq * 8);
#define PG8_SA(b, h) (((b) * 2 + (h)) * HTB)
#define PG8_SB(b, h) ((4 + (b) * 2 + (h)) * HTB)
#define PG8_STAGE(bufoff, gbase, voff) do { _Pragma("unroll") for (int _i = 0; _i < 2; ++_i) \
        __builtin_amdgcn_global_load_lds((const unsigned*)((const char*)(gbase) + (voff)[_i]), (PG8_LAS unsigned*)(lds + (bufoff) + ldsw + _i * 8192), 16, 0, 0); } while (0)
#define PG8_LDA(dst, b, h) do { _Pragma("unroll") for (int m = 0; m < 4; ++m) _Pragma("unroll") for (int k = 0; k < 2; ++k) dst[m][k] = *(const PG8_LAS bf16x8*)(lds + PG8_SA(b, h) + aoff + m * 2048 + k * 1024); } while (0)
#define PG8_LDB(dst, b, h) do { _Pragma("unroll") for (int n = 0; n < 2; ++n) _Pragma("unroll") for (int k = 0; k < 2; ++k) dst[n][k] = *(const PG8_LAS bf16x8*)(lds + PG8_SB(b, h) + boff + n * 2048 + k * 1024); } while (0)
#define PG8_MMA(ai, bj, At, Bt) do { __builtin_amdgcn_s_setprio(1); _Pragma("unroll") for (int m = 0; m < 4; ++m) _Pragma("unroll") for (int n = 0; n < 2; ++n) _Pragma("unroll") for (int k = 0; k < 2; ++k) \
        acc[ai][bj][m][n] = __builtin_amdgcn_mfma_f32_16x16x32_bf16(Bt[n][k], At[m][k], acc[ai][bj][m][n], 0, 0, 0); __builtin_amdgcn_s_setprio(0); } while (0)
#define PG8_WAIT_V(n) asm volatile("s_waitcnt vmcnt(" #n ")" ::: "memory")
#define PG8_WAIT_L(n) asm volatile("s_waitcnt lgkmcnt(" #n ")" ::: "memory")
#define PG8_BAR __builtin_amdgcn_s_barrier()
#define PG8_SCHED __builtin_amdgcn_sched_barrier(0)
    Unit cur, nxt; int ui = 0;
    if (!S.next(0, cur)) return;
    f32x4 acc[2][2][4][2];
#pragma unroll
    for (int a = 0; a < 2; ++a)
#pragma unroll
        for (int b = 0; b < 2; ++b)
#pragma unroll
            for (int m = 0; m < 4; ++m)
#pragma unroll
                for (int n = 0; n < 2; ++n) acc[a][b][m][n] = (f32x4){0.f, 0.f, 0.f, 0.f};
    bf16x8 At[4][2], B0[2][2], B1[2][2];
    const char* cA = (const char*)g.A + (long)cur.arow * (long)rstep; const char* cB = (const char*)g.Bt + (size_t)cur.pn * tstep;
    if constexpr (SP2) {
        PG8_STAGE(PG8_SB(0, 0), cB, voffB); PG8_STAGE(PG8_SB(0, 1), cB + hstep, voffB); PG8_STAGE(PG8_SA(0, 0), cA, voffA); PG8_STAGE(PG8_SA(0, 1), cA + hstep, voffA);
        if (wr == 1) PG8_BAR;
        PG8_WAIT_V(2); PG8_BAR;
        PG8_STAGE(PG8_SB(1, 0), cB + kstep, voffB); PG8_STAGE(PG8_SA(1, 0), cA + kstep, voffA); PG8_STAGE(PG8_SB(1, 1), cB + hstep + kstep, voffB);
        PG8_WAIT_V(6); PG8_BAR;
    } else {
        PG8_STAGE(PG8_SB(0, 0), cB, voffB); PG8_STAGE(PG8_SA(0, 0), cA, voffA); PG8_STAGE(PG8_SB(0, 1), cB + hstep, voffB); PG8_STAGE(PG8_SA(0, 1), cA + hstep, voffA);
        if (wr == 1) PG8_BAR;
        PG8_WAIT_V(4); PG8_BAR;
        PG8_STAGE(PG8_SB(1, 0), cB + kstep, voffB); PG8_STAGE(PG8_SA(1, 0), cA + kstep, voffA); PG8_STAGE(PG8_SB(1, 1), cB + hstep + kstep, voffB);
        PG8_WAIT_V(6); PG8_BAR;
    }
    for (;;) {
        const bool has_next = S.next(ui + 1, nxt);
        const char* nA = has_next ? (const char*)g.A + (long)nxt.arow * (long)rstep : cA; const char* nB = has_next ? (const char*)g.Bt + (size_t)nxt.pn * tstep : cB;
        for (int t = 0; t < nt; t += 2) {
            const bool last = (t == nt - 2);
            const char* a1 = cA + (size_t)(t + 1) * kstep;
            const char* a2 = last ? nA : cA + (size_t)(t + 2) * kstep; const char* b2 = last ? nB : cB + (size_t)(t + 2) * kstep;
            const char* a3 = a2 + kstep; const char* b3 = b2 + kstep;
            if constexpr (SP2) {
            PG8_LDB(B0, 0, 0); PG8_LDB(B1, 0, 1); PG8_SCHED; PG8_LDA(At, 0, 0); PG8_STAGE(PG8_SA(1, 1), a1 + hstep, voffA);
            PG8_WAIT_V(8); PG8_WAIT_L(0); PG8_BAR; PG8_MMA(0, 0, At, B0); PG8_MMA(0, 1, At, B1); PG8_BAR; PG8_SCHED;
            PG8_LDA(At, 0, 1); PG8_STAGE(PG8_SB(0, 0), b2, voffB); PG8_STAGE(PG8_SB(0, 1), b2 + hstep, voffB); PG8_STAGE(PG8_SA(0, 0), a2, voffA);
            PG8_WAIT_V(8); PG8_WAIT_L(0); PG8_BAR; PG8_MMA(1, 0, At, B0); PG8_MMA(1, 1, At, B1); PG8_BAR; PG8_SCHED;
            PG8_LDB(B0, 1, 0); PG8_LDB(B1, 1, 1); PG8_SCHED; PG8_LDA(At, 1, 0); PG8_STAGE(PG8_SA(0, 1), a2 + hstep, voffA);
            PG8_WAIT_V(8); PG8_WAIT_L(0); PG8_BAR; PG8_MMA(0, 0, At, B0); PG8_MMA(0, 1, At, B1); PG8_BAR; PG8_SCHED;
            PG8_LDA(At, 1, 1); PG8_STAGE(PG8_SB(1, 0), b3, voffB); PG8_STAGE(PG8_SB(1, 1), b3 + hstep, voffB); PG8_STAGE(PG8_SA(1, 0), a3, voffA);
            PG8_WAIT_V(8); PG8_WAIT_L(0); PG8_BAR; PG8_MMA(1, 0, At, B0); PG8_MMA(1, 1, At, B1); PG8_BAR; PG8_SCHED;
            } else {
            PG8_LDB(B0, 0, 0); PG8_SCHED; PG8_LDA(At, 0, 0); PG8_STAGE(PG8_SA(1, 1), a1 + hstep, voffA);
            PG8_WAIT_L(8); PG8_BAR; PG8_WAIT_L(0); PG8_MMA(0, 0, At, B0); PG8_BAR; PG8_SCHED;
            PG8_LDB(B1, 0, 1); PG8_STAGE(PG8_SB(0, 0), b2, voffB);
            PG8_BAR; PG8_WAIT_L(0); PG8_MMA(0, 1, At, B1); PG8_BAR;
            PG8_LDA(At, 0, 1); PG8_STAGE(PG8_SA(0, 0), a2, voffA);
            PG8_BAR; PG8_WAIT_L(0); PG8_MMA(1, 0, At, B0); PG8_BAR; PG8_SCHED;
            PG8_STAGE(PG8_SB(0, 1), b2 + hstep, voffB);
            PG8_WAIT_V(6); PG8_BAR; PG8_MMA(1, 1, At, B1); PG8_BAR;
            PG8_LDB(B0, 1, 0); PG8_SCHED; PG8_LDA(At, 1, 0); PG8_STAGE(PG8_SA(0, 1), a2 + hstep, voffA);
            PG8_WAIT_L(8); PG8_BAR; PG8_WAIT_L(0); PG8_MMA(0, 0, At, B0); PG8_BAR; PG8_SCHED;
            PG8_LDB(B1, 1, 1); PG8_STAGE(PG8_SB(1, 0), b3, voffB);
            PG8_BAR; PG8_WAIT_L(0); PG8_MMA(0, 1, At, B1); PG8_BAR;
            PG8_LDA(At, 1, 1); PG8_STAGE(PG8_SA(1, 0), a3, voffA);
            PG8_BAR; PG8_WAIT_L(0); PG8_MMA(1, 0, At, B0); PG8_BAR; PG8_SCHED;
            PG8_STAGE(PG8_SB(1, 1), b3 + hstep, voffB);
            PG8_WAIT_V(6); PG8_BAR; PG8_MMA(1, 1, At, B1); PG8_BAR;
            }
        }
        if constexpr (ALIGN_EPI) { if (wr == 0) PG8_BAR; }
        { int t_ = tid; asm volatile("" : "+v"(t_));
          E(acc, cur, wr, wc, t_ & 15, (t_ >> 4) & 3, lds + STAGE_BYTES); }
        if (!has_next) break;
#pragma unroll
        for (int a = 0; a < 2; ++a)
#pragma unroll
            for (int b = 0; b < 2; ++b)
#pragma unroll
                for (int m = 0; m < 4; ++m)
#pragma unroll
                    for (int n = 0; n < 2; ++n) acc[a][b][m][n] = (f32x4){0.f, 0.f, 0.f, 0.f};
        cur = nxt; cA = nA; cB = nB; ++ui;
        if constexpr (ALIGN_EPI) { if (wr == 1) PG8_BAR; }
    }
    PG8_WAIT_V(0);
    if constexpr (!ALIGN_EPI) { if (wr == 0) PG8_BAR; }
    PG8_BAR;
#undef PG8_SA
#undef PG8_SB
#undef PG8_STAGE
#undef PG8_LDA
#undef PG8_LDB
#undef PG8_MMA
#undef PG8_WAIT_V
#undef PG8_WAIT_L
#undef PG8_BAR
#undef PG8_SCHED
}
#else
template <class Epi, class Sched, bool ALIGN_EPI = false, bool SP2 = false>
static inline void gemm_phase(unsigned char* lds, const int tid, const Gemm g, const Sched& S, const Epi& E) {
    const int wid = tid >> 6, lane = tid & 63, wr = wid >> 2, wc = wid & 3, fr = lane & 15, fq = lane >> 4;
    static thread_local std::vector<float> Af, Bf;
    Unit cur;
    for (int ui = 0; S.next(ui, cur); ++ui) {
        const int K = g.K;
        sync_block();
        if (tid == 0) { Af.resize((size_t)256 * K); Bf.resize((size_t)256 * K);
            for (int r = 0; r < 256; ++r) for (int k = 0; k < K; ++k) { Af[(size_t)r * K + k] = bf2f_(g.A[((long)cur.arow + r) * K + k]); Bf[(size_t)r * K + k] = bf2f_(g.Bt[((size_t)cur.pn * 256 + r) * K + k]); } }
        sync_block();
        f32x4 acc[2][2][4][2];
        for (int ai = 0; ai < 2; ++ai) for (int bj = 0; bj < 2; ++bj) for (int m = 0; m < 4; ++m) for (int n = 0; n < 2; ++n) for (int e = 0; e < 4; ++e) {
            const int r = 128 * ai + 64 * wr + 16 * m + fr, c = 128 * bj + 32 * wc + (Epi::PERM ? 8 * fq + 4 * n + e : 16 * n + 4 * fq + e);
            const float* a = &Af[(size_t)r * K]; const float* b = &Bf[(size_t)c * K]; float s = 0.f;
            for (int k = 0; k < K; ++k) s += a[k] * b[k];
            acc[ai][bj][m][n][e] = s; }
        E(acc, cur, wr, wc, fr, fq, lds + STAGE_BYTES);
    }
    sync_block();
}
#endif

DEVFN float row_inv(const float* ssq, int row) {
    const f32x4* p = (const f32x4*)(ssq + (size_t)row * 16); const f32x4 a = p[0], b = p[1], c = p[2], d = p[3];
    const float s = ((a[0] + a[1]) + (a[2] + a[3])) + ((b[0] + b[1]) + (b[2] + b[3])) + ((c[0] + c[1]) + (c[2] + c[3])) + ((d[0] + d[1]) + (d[2] + d[3]));
    return 1.0f / sqrtf(s * (1.0f / D) + 1e-6f);
}
struct EpiIn {
    static constexpr bool PERM = true;
    bf16* O; const float* ssq;
    MEMFN void operator()(const f32x4 (&acc)[2][2][4][2], const Unit& u, int wr, int wc, int fr, int fq, LAS unsigned char*) const {
        const int row0 = u.pm * BM + wr * 64 + fr, col0 = u.pn * BM + wc * 32 + 8 * fq;
#pragma unroll
        for (int ai = 0; ai < 2; ++ai)
#pragma unroll
            for (int m = 0; m < 4; ++m) { const int row = row0 + ai * HALF + m * 16; const float sc = row_inv(ssq, row); bf16* rowp = O + (size_t)row * NINP + col0;
#pragma unroll
                for (int bj = 0; bj < 2; ++bj) { const f32x4 v0 = acc[ai][bj][m][0] * sc, v1 = acc[ai][bj][m][1] * sc;
                    u32x4 w; w.x = pk_bf16(v0[0], v0[1]); w.y = pk_bf16(v0[2], v0[3]); w.z = pk_bf16(v1[0], v1[1]); w.w = pk_bf16(v1[2], v1[3]);
                    *(u32x4*)(rowp + bj * HALF) = w; } }
    }
};
struct EpiRes {
    static constexpr bool PERM = false;
    float* H; bf16* HB; float* ssq;
    MEMFN void operator()(const f32x4 (&acc)[2][2][4][2], const Unit& u, int wr, int wc, int fr, int fq, LAS unsigned char*) const {
        const int row0 = u.pm * BM + wr * 64 + fr, col0 = u.pn * BM + wc * 32 + 4 * fq;
#pragma unroll
        for (int ai = 0; ai < 2; ++ai)
#pragma unroll
            for (int m = 0; m < 4; ++m) { const int row = row0 + ai * HALF + m * 16; const size_t off = (size_t)row * D + col0; float s = 0.f;
#pragma unroll
                for (int bj = 0; bj < 2; ++bj)
#pragma unroll
                    for (int n = 0; n < 2; ++n) { float* hp = H + off + bj * HALF + n * 16; const f32x4 h = *(const f32x4*)hp + acc[ai][bj][m][n]; *(f32x4*)hp = h;
                        u32x2 w; w.x = pk_bf16(h[0], h[1]); w.y = pk_bf16(h[2], h[3]); *(u32x2*)(HB + off + bj * HALF + n * 16) = w;
                        s += (h[0] * h[0] + h[1] * h[1]) + (h[2] * h[2] + h[3] * h[3]); }
                s += shfl_xor_f32(s, 16); s += shfl_xor_f32(s, 32);
                if (fq == 0) ssq[(size_t)row * 16 + u.pn * 4 + wc] = s;
                if (m & 1) asm volatile("" ::: "memory"); }
    }
};
struct EpiGlu {
    static constexpr bool PERM = true;
    const bf16* YG; const float* bias; bf16* YM;
    MEMFN void operator()(const f32x4 (&acc)[2][2][4][2], const Unit& u, int wr, int wc, int fr, int fq, LAS unsigned char*) const {
        const int row0 = u.pm * BM + wr * 64 + fr, col0 = u.pn * BM + wc * 32 + 8 * fq;
#pragma unroll
        for (int bj = 0; bj < 2; ++bj) { const int col = col0 + bj * HALF; if (u.pn == 1 && bj == 1) continue;
            const f32x4 b0 = *(const f32x4*)(bias + col), b1 = *(const f32x4*)(bias + col + 4);
#pragma unroll
            for (int ai = 0; ai < 2; ++ai)
#pragma unroll
                for (int m = 0; m < 4; ++m) { const int row = row0 + ai * HALF + m * 16;
                    const u32x4 y = *(const u32x4*)(YG + (size_t)row * S5W + col); const f32x4 a0 = acc[ai][bj][m][0] + b0, a1 = acc[ai][bj][m][1] + b1;
                    u32x4 w; w.x = pk_bf16(bf_lo(y.x) * sigmoid_f(a0[0]), bf_hi(y.x) * sigmoid_f(a0[1])); w.y = pk_bf16(bf_lo(y.y) * sigmoid_f(a0[2]), bf_hi(y.y) * sigmoid_f(a0[3]));
                    w.z = pk_bf16(bf_lo(y.z) * sigmoid_f(a1[0]), bf_hi(y.z) * sigmoid_f(a1[1])); w.w = pk_bf16(bf_lo(y.w) * sigmoid_f(a1[2]), bf_hi(y.w) * sigmoid_f(a1[3]));
                    *(u32x4*)(YM + (size_t)row * D + RGW + col) = w;
                    if (m & 1) asm volatile("" ::: "memory"); } }
    }
};
struct EpiUp {
    static constexpr bool PERM = true;
    bf16* G; const float* ssq; const float* cw; const float* cb;
    MEMFN void operator()(f32x4 (&acc)[2][2][4][2], const Unit& u, int wr, int wc, int fr, int fq, LAS unsigned char* xl) const {
        const int b = u.pm / NQ, q = u.pm % NQ, t0 = UPS * q - 1;
        LAS float* XB = (LAS float*)xl;
        const int cs = wc * 32 + 8 * fq;
#pragma unroll
        for (int ai = 0; ai < 2; ++ai)
#pragma unroll
            for (int m = 0; m < 4; ++m) { const int lr = 128 * ai + 64 * wr + 16 * m + fr, t = t0 + lr; const bool ok = (t >= 0) && (t < L);
                const float sc = ok ? row_inv(ssq, b * L + t) : 0.f;
#pragma unroll
                for (int bj = 0; bj < 2; ++bj)
#pragma unroll
                    for (int n = 0; n < 2; ++n)
#pragma unroll
                        for (int e = 0; e < 4; ++e) acc[ai][bj][m][n][e] = ok ? acc[ai][bj][m][n][e] * sc : 0.f; }
#pragma unroll
        for (int ai = 0; ai < 2; ++ai) { const int s = 2 * ai + wr;
            if (fr == 0) {
#pragma unroll
                for (int bj = 0; bj < 2; ++bj)
#pragma unroll
                    for (int n = 0; n < 2; ++n) *(LAS f32x4*)(XB + (2 * s) * 256 + bj * 128 + cs + 4 * n) = acc[ai][bj][0][n]; }
            if (fr == 15) {
#pragma unroll
                for (int bj = 0; bj < 2; ++bj)
#pragma unroll
                    for (int n = 0; n < 2; ++n) *(LAS f32x4*)(XB + (2 * s + 1) * 256 + bj * 128 + cs + 4 * n) = acc[ai][bj][3][n]; } }
#ifdef CPU_EMU
        sync_block();
#else
        asm volatile("s_waitcnt lgkmcnt(0)" ::: "memory"); __builtin_amdgcn_s_barrier(); asm volatile("" ::: "memory");
#endif
        const int j0 = u.pn * 128 + cs;
#pragma unroll
        for (int n = 0; n < 2; ++n) {
            f32x4 wa[3], wv[3]; const f32x4 ba = *(const f32x4*)(cb + j0 + 4 * n), bv = *(const f32x4*)(cb + FF + j0 + 4 * n);
#pragma unroll
            for (int k = 0; k < 3; ++k) { wa[k] = *(const f32x4*)(cw + k * FF2 + j0 + 4 * n); wv[k] = *(const f32x4*)(cw + k * FF2 + FF + j0 + 4 * n); }
#pragma unroll
            for (int ai = 0; ai < 2; ++ai) { const int s = 2 * ai + wr;
#pragma unroll
                for (int m = 0; m < 4; ++m) { const int lr = 64 * s + 16 * m + fr, t = t0 + lr;
                    f32x4 up[2], dn[2];
#pragma unroll
                    for (int bj = 0; bj < 2; ++bj) {
                        f32x4 pu, pd;
                        if (m > 0) { const f32x4 p = acc[ai][bj][m > 0 ? m - 1 : 0][n]; pu = (f32x4){dpp_row_ror1(p[0]), dpp_row_ror1(p[1]), dpp_row_ror1(p[2]), dpp_row_ror1(p[3])}; }
                        else if (s > 0) pu = *(const LAS f32x4*)(XB + (2 * (s - 1) + 1) * 256 + bj * 128 + cs + 4 * n);
                        else pu = (f32x4){0.f, 0.f, 0.f, 0.f};
                        if (m < 3) { const f32x4 p = acc[ai][bj][m < 3 ? m + 1 : 3][n]; pd = (f32x4){dpp_row_ror15(p[0]), dpp_row_ror15(p[1]), dpp_row_ror15(p[2]), dpp_row_ror15(p[3])}; }
                        else if (s < 3) pd = *(const LAS f32x4*)(XB + (2 * (s + 1)) * 256 + bj * 128 + cs + 4 * n);
                        else pd = (f32x4){0.f, 0.f, 0.f, 0.f};
                        const f32x4 x = acc[ai][bj][m][n];
#pragma unroll
                        for (int e = 0; e < 4; ++e) { up[bj][e] = dpp_row_shr1(pu[e], x[e]); dn[bj][e] = dpp_row_shl1(pd[e], x[e]); }
                    }
                    const f32x4 a = ba + wa[0] * up[0] + wa[1] * acc[ai][0][m][n] + wa[2] * dn[0];
                    const f32x4 v = bv + wv[0] * up[1] + wv[1] * acc[ai][1][m][n] + wv[2] * dn[1];
                    if (lr >= 1 && lr <= UPS && t < L) { u32x2 w; w.x = pk_bf16(gelu_f(a[0]) * v[0], gelu_f(a[1]) * v[1]); w.y = pk_bf16(gelu_f(a[2]) * v[2], gelu_f(a[3]) * v[3]);
                        *(u32x2*)(G + (size_t)(b * L + t) * FF + j0 + 4 * n) = w; }
                } } }
    }
};
}

constexpr int RING_BYTES = 131072, XCH_OFF = RING_BYTES, XCH_BYTES = 8192, MISC_OFF = XCH_OFF + XCH_BYTES, LDS_BYTES = 147456;
constexpr int CW_TMO = 0, CW_BAR = 4096;
#ifndef CPU_EMU
typedef GAS unsigned gu32;
#define XB_TMO      128
#define XB_XCNT(j)  (256  + 64 * (j))
#define XB_XSUB(j)  (1280 + 64 * (j))
#define XB_XGEN(j)  (2304 + 64 * (j))
#define XB_TOP      3328
#define XB_TOPGEN   3392
#define XCD_BAR_WORDS 3456
#define XB_SPIN_CAP (1u << 22)
__device__ __forceinline__ unsigned xb_ld(unsigned* p)              { return __hip_atomic_load(p, __ATOMIC_RELAXED, __HIP_MEMORY_SCOPE_AGENT); }
__device__ __forceinline__ unsigned xb_add(unsigned* p, unsigned v) { return __hip_atomic_fetch_add(p, v, __ATOMIC_RELAXED, __HIP_MEMORY_SCOPE_AGENT); }
__device__ __forceinline__ unsigned xb_xcc_id() { return (unsigned)__builtin_amdgcn_s_getreg((3 << 11) | 20) & 0xFu; }
#define XB_SPIN(cond, bar) do { unsigned _sp = 0; while (cond) { __builtin_amdgcn_s_sleep(1); \
    if ((++_sp & 255u) == 0u) { if (xb_ld(&(bar)[XB_TMO])) break; if (_sp > XB_SPIN_CAP) { atomicAdd(&(bar)[XB_TMO], 1u); break; } } } } while (0)
struct XcdBarrier { unsigned* bar; unsigned x; volatile LAS unsigned* st; };
__device__ __forceinline__ XcdBarrier xcd_barrier_post(unsigned* bar, volatile LAS unsigned* st) {
    XcdBarrier b; b.bar = bar; b.x = xb_xcc_id(); b.st = st;
    if (threadIdx.x == 0) (void)xb_add(&bar[XB_XCNT(b.x)], 1u);
    return b;
}
__device__ __forceinline__ void xcd_barrier_complete(unsigned* bar, unsigned x, unsigned& nloc, unsigned& nx) {
    const unsigned G = gridDim.x * gridDim.y * gridDim.z;
    unsigned sum, cnt, mine, sp = 0u;
    for (;;) {
        sum = 0u; cnt = 0u; mine = 0u;
#pragma unroll
        for (unsigned j = 0; j < 16; ++j) { const unsigned c = xb_ld(&bar[XB_XCNT(j)]); sum += c; cnt += (c > 0u) ? 1u : 0u; mine = (j == x) ? c : mine; }
        if (sum == G) break;
        __builtin_amdgcn_s_sleep(1);
        if ((++sp & 255u) == 0u) { if (xb_ld(&bar[XB_TMO])) break; if (sp > XB_SPIN_CAP) { atomicAdd(&bar[XB_TMO], 1u); break; } }
    }
    nloc = mine > 0u ? mine : 1u; nx = cnt > 0u ? cnt : 1u;
}
__device__ __forceinline__ void xcd_barrier(const XcdBarrier& b) {
    asm volatile("s_waitcnt vmcnt(0)" ::: "memory");
    __syncthreads();
    if (threadIdx.x == 0) {
        unsigned* bar = b.bar;
        __builtin_amdgcn_s_waitcnt(0);
        unsigned nloc = b.st[0], nx = b.st[1];
        if (nloc == 0u) { xcd_barrier_complete(bar, b.x, nloc, nx); b.st[0] = nloc; b.st[1] = nx; }
        const unsigned old = xb_add(&bar[XB_XSUB(b.x)], 1u);
        const unsigned gen = old / nloc;
        if (old + 1u == (gen + 1u) * nloc) {
            __builtin_amdgcn_fence(__ATOMIC_RELEASE, "agent");
            asm volatile("s_waitcnt vmcnt(0)" ::: "memory");
            const unsigned og = xb_add(&bar[XB_TOP], 1u);
            const unsigned tg = og / nx;
            if (og + 1u == (tg + 1u) * nx) xb_add(&bar[XB_TOPGEN], 1u);
            else XB_SPIN(xb_ld(&bar[XB_TOPGEN]) == tg, bar);
            __builtin_amdgcn_fence(__ATOMIC_ACQUIRE, "agent");
            xb_add(&bar[XB_XGEN(b.x)], 1u);
            asm volatile("s_waitcnt vmcnt(0)" ::: "memory");
        } else {
            XB_SPIN(xb_ld(&bar[XB_XGEN(b.x)]) == gen, bar);
            __builtin_amdgcn_fence(__ATOMIC_ACQUIRE, "agent");
            asm volatile("s_waitcnt vmcnt(0)" ::: "memory");
        }
    }
    __syncthreads();
}
#endif

#ifdef CPU_EMU
struct Args; static void emu_phase_hook(int ph, const Args& a);
#endif
struct Args { const float* in[38]; float* out; unsigned char* ws; int ph_lo, ph_hi; };
#ifdef CPU_EMU
typedef const Args* KARG_PTR;
#else
typedef const __attribute__((address_space(4))) Args* KARG_PTR;
#endif
struct Frame {
    LAS unsigned char* lds; int tid, lane, wave, G, gtid, gsize, gw, ngw;
    KARG_PTR ap; float* out; unsigned char* ws;
};
#define FIN(i) (F.ap->in[i])
#ifdef CPU_EMU
#define LAUNDER(F, l) do {} while (0)
#else
#define LAUNDER(F, l) do { size_t z_ = 0; asm volatile("" : "+s"(z_), "+s"(F.ap), "+s"(l), "+v"(F.tid)); F.ws = args.ws + z_; F.out = args.out + z_; F.lane = F.tid & 63; F.wave = __builtin_amdgcn_readfirstlane(F.tid >> 6); \
    F.gtid = blockIdx.x * NT + F.tid; F.gw = blockIdx.x * NWAVES + F.wave; } while (0)
#endif

DEVFN void transpose_item(const float* W, int ldw, int K, bf16* WT, int src_col0, int dst_row0, int k0, const float* sc, LAS float* scr, int lane) {
#pragma unroll 8
    for (int i = 0; i < 32; ++i) { const int kk = 2 * i + (lane >> 5); float v = W[(size_t)(k0 + kk) * ldw + src_col0 + (lane & 31)]; if (sc) v *= sc[k0 + kk]; scr[kk * 33 + (lane & 31)] = v; }
    WAVE_LDS_FENCE();
    const int c = lane & 7;
#pragma unroll
    for (int j = 0; j < 4; ++j) { const int n = (lane >> 3) + 8 * j; const LAS float* s = scr + (8 * c) * 33 + n;
        u32x4 o; o.x = pk_bf16(s[0 * 33], s[1 * 33]); o.y = pk_bf16(s[2 * 33], s[3 * 33]); o.z = pk_bf16(s[4 * 33], s[5 * 33]); o.w = pk_bf16(s[6 * 33], s[7 * 33]);
        *(u32x4*)(WT + (size_t)(dst_row0 + n) * K + k0 + 8 * c) = o; }
    WAVE_LDS_FENCE();
}
DEVFN float wave_sum(float v) {
#pragma unroll
    for (int o = 1; o < 64; o <<= 1) v += shfl_xor_f32(v, o);
    return v;
}
DEVFN void p_prologue(Frame& F) {
    LAS float* scr = (LAS float*)(F.lds + F.wave * 16384);
    constexpr int I_IN = 16 * 60, I_OUT = 16 * 32, I_UP = 16 * 176, I_DN = 44 * 32, I_GLU = 6 * 12, I_L = I_IN + I_OUT + I_UP + I_DN + I_GLU;
    for (int it = F.gw; it < 2 * I_L; it += F.ngw) {
        const int l = it / I_L; int r = it % I_L;
        if (r < I_IN) { const int kb = r / 60, nb = r % 60; transpose_item(FIN(2) + (size_t)l * D * NIN, NIN, D, (bf16*)(F.ws + WS_WIN + l * SZ_WIN), 32 * nb, 32 * nb, 64 * kb, FIN(1) + l * D, scr, F.lane); continue; } r -= I_IN;
        if (r < I_OUT) { const int kb = r / 32, nb = r % 32; transpose_item(FIN(31) + (size_t)l * D * D, D, D, (bf16*)(F.ws + WS_WOUT + l * SZ_WOUT), 32 * nb, 32 * nb, 64 * kb, FIN(30) + l * D, scr, F.lane); continue; } r -= I_OUT;
        if (r < I_UP) { const int kb = r / 176, nb = r % 176, sc0 = 32 * nb, half = sc0 / FF, jj = sc0 % FF, pn = jj / 128;
            transpose_item(FIN(33) + (size_t)l * D * FF2, FF2, D, (bf16*)(F.ws + WS_WUP + l * SZ_WUP), sc0, 256 * pn + 128 * half + (jj % 128), 64 * kb, FIN(32) + l * D, scr, F.lane); continue; } r -= I_UP;
        if (r < I_DN) { const int kb = r / 32, nb = r % 32; transpose_item(FIN(36) + (size_t)l * FF * D, D, FF, (bf16*)(F.ws + WS_WDN + l * SZ_WDN), 32 * nb, 32 * nb, 64 * kb, nullptr, scr, F.lane); continue; } r -= I_DN;
        { const int kb = r / 12, nb = r % 12; transpose_item(FIN(18) + (size_t)l * S5W * S5W, S5W, S5W, (bf16*)(F.ws + WS_WGLU + l * SZ_WGLU), 32 * nb, 32 * nb, 64 * kb, nullptr, scr, F.lane); }
    }
    for (int i = F.gtid; i < 2 * (128 * D / 8); i += F.gsize) { const int l = i / (128 * D / 8), r = i % (128 * D / 8); ((u32x4*)(F.ws + WS_WIN + l * SZ_WIN + (size_t)NIN * D * 2))[r] = (u32x4){0u, 0u, 0u, 0u}; }
    for (int i = F.gtid; i < 2 * (128 * S5W / 8); i += F.gsize) { const int l = i / (128 * S5W / 8), r = i % (128 * S5W / 8); ((u32x4*)(F.ws + WS_WGLU + l * SZ_WGLU + (size_t)S5W * S5W * 2))[r] = (u32x4){0u, 0u, 0u, 0u}; }
    float* ssq = (float*)(F.ws + WS_SSQ); bf16* hb = (bf16*)(F.ws + WS_HB);
    for (int m = F.gw; m < M; m += F.ngw) {
        const f32x4* xr = (const f32x4*)(FIN(0) + (size_t)m * D) + F.lane; f32x4* hr = (f32x4*)(F.out + (size_t)m * D) + F.lane; u32x2* br = (u32x2*)(hb + (size_t)m * D) + F.lane; float s = 0.f;
#pragma unroll
        for (int j = 0; j < 4; ++j) { const f32x4 v = xr[64 * j]; hr[64 * j] = v; u32x2 w; w.x = pk_bf16(v[0], v[1]); w.y = pk_bf16(v[2], v[3]); br[64 * j] = w; s += (v[0] * v[0] + v[1] * v[1]) + (v[2] * v[2] + v[3] * v[3]); }
        s = wave_sum(s);
        if (F.lane < 16) ssq[(size_t)m * 16 + F.lane] = F.lane == 0 ? s : 0.f;
    }
    for (int i = F.gtid; i < 2 * 3072; i += F.gsize) { const int l = i / 3072, r = i % 3072, dg = r / 64;
        float* tab = (float*)(F.ws + WS_S5T) + (size_t)l * (6144 + 2 * 49152); float* abar = tab; float* bbr = tab + 6144; float* bbi = bbr + 49152;
        const float lr = FIN(10)[i], li = FIN(11)[i], dt = expf(FIN(12)[l * 48 + dg]);
        const float mag = expf(lr * dt), ar = mag * cosf(li * dt), ai = mag * sinf(li * dt);
        const float den = lr * lr + li * li, nr = ar - 1.0f, ni = ai, cr = (nr * lr + ni * li) / den, ci = (ni * lr - nr * li) / den;
        abar[2 * r] = ar; abar[2 * r + 1] = ai;
        for (int c = 0; c < 16; ++c) { const float br = FIN(13)[(size_t)i * 16 + c], bi = FIN(14)[(size_t)i * 16 + c]; bbr[r * 16 + c] = cr * br - ci * bi; bbi[r * 16 + c] = cr * bi + ci * br; } }
    for (int i = F.gtid; i < 2 * 2 * RGW; i += F.gsize) ((float*)(F.ws + WS_RGSP))[i] = 8.0f * softplus_f(-FIN(9)[i]);
    for (int i = F.gtid; i < 2 * L * 64; i += F.gsize) { const int l = i / (L * 64), r = i % (L * 64), pos = r / 64, mm = r % 64;
        const float* w1 = FIN(22) + l * 33 * 64; const float t = (float)pos / (float)(L - 1 > 1 ? L - 1 : 1), w = (6.283185307179586f / (float)L) * (float)pos;
        float acc = FIN(23)[l * 64 + mm] + t * w1[mm];
        for (int q = 0; q < 16; ++q) { const float band = 1e-4f + (float)q * ((15.0f - 1e-4f) / 15.0f), ang = w * band; acc += cosf(ang) * w1[(1 + q) * 64 + mm] - sinf(ang) * w1[(17 + q) * 64 + mm]; }
        ((float*)(F.ws + WS_HID))[i] = sinf(FIN(24)[l * 64 + mm] * acc); }
}
DEVFN void p_hid2(Frame& F, int l) {
    const float* hid1 = (const float*)(F.ws + WS_HID) + (size_t)l * L * 64; float* hid2 = (float*)(F.ws + WS_HID) + (size_t)(2 + l) * L * 64;
    for (int i = F.gtid; i < L * 64; i += F.gsize) { const int pos = i / 64, mm = i % 64; float acc = FIN(26)[l * 64 + mm];
        for (int q = 0; q < 64; ++q) acc += hid1[pos * 64 + q] * FIN(25)[l * 4096 + q * 64 + mm];
        hid2[i] = sinf(FIN(27)[l * 64 + mm] * acc); }
}

DEVFN float ldproj(const bf16* proj, size_t m, int col) { return bf2f_(proj[m * NINP + col]); }
DEVFN void p_mix1(Frame& F, int l) {
    const bf16* proj = (const bf16*)(F.ws + WS_PROJ);
    { float* u = (float*)(F.ws + WS_T0); const float* cw = FIN(3) + l * 4 * RGW; const float* cb = FIN(4) + l * RGW;
      for (int i = F.gtid; i < M * RGW; i += F.gsize) { const int m = i / RGW, c = i % RGW, t = m % L; float s = cb[c];
#pragma unroll
          for (int k = 0; k < 4; ++k) { const int tt = t + k - 1; if (tt >= 0 && tt < L) s += cw[k * RGW + c] * ldproj(proj, m + k - 1, c); }
          u[i] = s; } }
    { float* z = (float*)(F.ws + WS_Z); float* x0c = (float*)(F.ws + WS_X0C); const float* cw = FIN(20) + l * 3 * 768; const float* cb = FIN(21) + l * 768;
      for (int i = F.gtid; i < M * HYW; i += F.gsize) { const int m = i / HYW, c = i % HYW, t = m % L; float q[3];
#pragma unroll
          for (int part = 0; part < 3; ++part) { const int col = part * HYW + c; float s = cb[col];
#pragma unroll
              for (int k = 0; k < 3; ++k) { const int tt = t + k - 1; if (tt >= 0 && tt < L) s += cw[k * 768 + col] * ldproj(proj, m + k - 1, 3 * RGW + col); }
              q[part] = s; }
          z[i] = q[2] * q[1]; x0c[i] = q[0]; } }
    { const float* hid2 = (const float*)(F.ws + WS_HID) + (size_t)(2 + l) * L * 64; const float* w3 = FIN(28) + (size_t)l * 64 * 512; float* kfb = (float*)(F.ws + WS_KFB);
      const float maxd = logf(1e-2f) / 0.3f, mind = logf(1e-2f) / 1.5f;
      for (int i = F.gtid; i < L * 512; i += F.gsize) { const int pos = i / 512, c2 = i % 512, c = c2 % 256; float acc = 0.f;
          for (int q = 0; q < 64; ++q) acc += hid2[pos * 64 + q] * w3[q * 512 + c2];
          const float delta = fabsf(mind + (float)c * ((maxd - mind) / 255.0f)), t = (float)pos / (float)(L - 1 > 1 ? L - 1 : 1);
          kfb[i] = acc * expf(-t * delta); } }
}
DEVFN void p_mix2(Frame& F, int l) {
    const bf16* proj = (const bf16*)(F.ws + WS_PROJ); bf16* ymix = (bf16*)(F.ws + WS_YMIX);
    if (F.gtid < Bn * RGW) { const int i = F.gtid, b = i / RGW, c = i % RGW, hd = c / 64, j = c % 64;
        const float* u = (const float*)(F.ws + WS_T0); bf16* hf = (bf16*)(F.ws + WS_THF);
        const float* wa = FIN(5) + (size_t)l * 2 * 6 * 4096; const float* wx = FIN(7) + (size_t)l * 2 * 6 * 4096;
        for (int d = 0; d < 2; ++d) {
            const float sp8 = ((const float*)(F.ws + WS_RGSP))[l * 2 * RGW + d * RGW + c];
            const float* Wa = wa + ((size_t)(d * 6 + hd) * 64) * 64 + j; const float* Wx = wx + ((size_t)(d * 6 + hd) * 64) * 64 + j;
            const float bra = FIN(6)[l * 2 * RGW + d * RGW + c], brx = FIN(8)[l * 2 * RGW + d * RGW + c];
            float h = 0.f;
            for (int s = 0; s < L; ++s) { const int t = d == 0 ? s : L - 1 - s; const size_t m = (size_t)b * L + t;
                const float* ur = u + m * RGW + hd * 64; float ar = bra, ax = brx;
                for (int q = 0; q < 64; ++q) { const float uu = ur[q]; ar += uu * Wa[q * 64]; ax += uu * Wx[q * 64]; }
                const float r = sigmoid_f(ar), ig = sigmoid_f(ax);
                const float la = -r * sp8, a = exp_f(la), mult = sqrtf(-expm1_f(2.0f * la));
                h = a * h + mult * (ig * ur[j]);
                if (d == 0) hf[m * RGW + c] = f2bf_(h); else ymix[m * D + c] = f2bf_((bf2f_(hf[m * RGW + c]) + h) * gelu_f(ldproj(proj, m, RGW + c))); } } }
    { const int wbase = F.ngw / 2;
      for (int wi = F.gw - wbase; wi < Bn * 24; wi += F.ngw - wbase) { if (wi < 0) break; const int g = wi % 24, b = wi / 24, p = F.lane, cl = F.lane & 15;
        float* ypre = (float*)(F.ws + WS_T1); const float dsk = FIN(17)[l * S5W + g * 16 + cl];
        for (int d = 0; d < 2; ++d) {
            const int dg = d * 24 + g; const float* tab = (const float*)(F.ws + WS_S5T) + (size_t)l * (6144 + 2 * 49152);
            const float ar = tab[(size_t)dg * 128 + 2 * p], ai = tab[(size_t)dg * 128 + 2 * p + 1];
            float br[16], bi[16], cr[16], ci[16];
#pragma unroll
            for (int q = 0; q < 16; ++q) { br[q] = tab[6144 + (size_t)dg * 1024 + p * 16 + q]; bi[q] = tab[6144 + 49152 + (size_t)dg * 1024 + p * 16 + q];
                cr[q] = FIN(15)[(size_t)l * 49152 + ((size_t)dg * 16 + q) * 64 + p]; ci[q] = FIN(16)[(size_t)l * 49152 + ((size_t)dg * 16 + q) * 64 + p]; }
            float hr = 0.f, hi = 0.f;
            for (int s = 0; s < L; ++s) { const int t = d == 0 ? s : L - 1 - s; const size_t m = (size_t)b * L + t;
                const u32x4* up = (const u32x4*)(proj + m * NINP + 2 * RGW + g * 16); const u32x4 u0 = up[0], u1 = up[1];
                const float uu[16] = {bf_lo(u0.x), bf_hi(u0.x), bf_lo(u0.y), bf_hi(u0.y), bf_lo(u0.z), bf_hi(u0.z), bf_lo(u0.w), bf_hi(u0.w), bf_lo(u1.x), bf_hi(u1.x), bf_lo(u1.y), bf_hi(u1.y), bf_lo(u1.z), bf_hi(u1.z), bf_lo(u1.w), bf_hi(u1.w)};
                float bur = 0.f, bui = 0.f;
#pragma unroll
                for (int q = 0; q < 16; ++q) { bur += br[q] * uu[q]; bui += bi[q] * uu[q]; }
                const float nr = ar * hr - ai * hi + bur, ni = ar * hi + ai * hr + bui; hr = nr; hi = ni;
                float yv = 0.f;
#pragma unroll
                for (int c = 0; c < 16; ++c) { const float v = wave_sum(hr * cr[c] - hi * ci[c]); if (cl == c) yv = v; }
                if (F.lane < 16) { float* yp = ypre + m * S5W + g * 16 + cl;
                    if (d == 0) *yp = bf2f_(proj[m * NINP + 2 * RGW + g * 16 + cl]) * dsk + yv; else *yp += yv; } } } } }
    { const float* z = (const float*)(F.ws + WS_Z); const float* x0c = (const float*)(F.ws + WS_X0C); const float* kfb = (const float*)(F.ws + WS_KFB); const float* bias = FIN(29) + l * HYW;
      for (int i = F.gtid; i < M * HYW; i += F.gsize) { const int m = i / HYW, c = i % HYW, t = m % L, b = m / L;
          const float* zb = z + (size_t)b * L * HYW + c; float acc = 0.f;
          for (int s = 0; s <= t; ++s) acc += kfb[(size_t)(t - s) * 512 + c] * zb[(size_t)s * HYW];
          for (int s = t; s < L; ++s) acc += kfb[(size_t)(s - t) * 512 + 256 + c] * zb[(size_t)s * HYW];
          ymix[(size_t)m * D + RGW + S5W + c] = f2bf_((acc + z[i] * bias[c]) * x0c[i]); } }
}
DEVFN void p_mix3(Frame& F, int l) {
    const float* ypre = (const float*)(F.ws + WS_T1); bf16* yg = (bf16*)(F.ws + WS_YG);
    for (int i = F.gtid; i < M * S5W; i += F.gsize) yg[i] = f2bf_(gelu_f(ypre[i]));
}
DEVFN void p_glu(Frame& F, int l) {
    const bf16* yg = (const bf16*)(F.ws + WS_YG); bf16* ymix = (bf16*)(F.ws + WS_YMIX); const float* W = FIN(18) + (size_t)l * S5W * S5W; const float* bias = FIN(19) + l * S5W;
    for (int i = F.gtid; i < M * (S5W / 4); i += F.gsize) { const int m = i / (S5W / 4), n = (i % (S5W / 4)) * 4; const bf16* yr = yg + (size_t)m * S5W;
        f32x4 acc = *(const f32x4*)(bias + n);
        for (int k = 0; k < S5W; ++k) acc += bf2f_(yr[k]) * *(const f32x4*)(W + (size_t)k * S5W + n);
        const u32x2 y = *(const u32x2*)(yr + n); u32x2 o; o.x = pk_bf16(bf_lo(y.x) * sigmoid_f(acc[0]), bf_hi(y.x) * sigmoid_f(acc[1])); o.y = pk_bf16(bf_lo(y.y) * sigmoid_f(acc[2]), bf_hi(y.y) * sigmoid_f(acc[3]));
        *(u32x2*)(ymix + (size_t)m * D + RGW + n) = o; }
}
DEVFN void p_mixnorm(Frame& F) {
    bf16* ymix = (bf16*)(F.ws + WS_YMIX);
    for (int m = F.gw; m < M; m += F.ngw) { u32x4* row = (u32x4*)(ymix + (size_t)m * D);
        u32x4 v[2]; float s[2];
#pragma unroll
        for (int j = 0; j < 2; ++j) { v[j] = row[F.lane + 64 * j]; const float a0 = bf_lo(v[j].x), a1 = bf_hi(v[j].x), a2 = bf_lo(v[j].y), a3 = bf_hi(v[j].y), a4 = bf_lo(v[j].z), a5 = bf_hi(v[j].z), a6 = bf_lo(v[j].w), a7 = bf_hi(v[j].w);
            s[j] = ((a0 * a0 + a1 * a1) + (a2 * a2 + a3 * a3)) + ((a4 * a4 + a5 * a5) + (a6 * a6 + a7 * a7)); }
        const float sa = wave_sum(F.lane < 48 ? s[0] : 0.f), sb = wave_sum((F.lane >= 48 ? s[0] : 0.f) + (F.lane < 32 ? s[1] : 0.f)), sc = wave_sum(F.lane >= 32 ? s[1] : 0.f);
        const float ia = 1.0f / sqrtf(sa * (1.0f / RGW) + 1e-6f), ib = 1.0f / sqrtf(sb * (1.0f / S5W) + 1e-6f), ic = 1.0f / sqrtf(sc * (1.0f / HYW) + 1e-6f);
#pragma unroll
        for (int j = 0; j < 2; ++j) { const int ch = F.lane + 64 * j; const float f = ch < 48 ? ia : (ch < 96 ? ib : ic); u32x4 o;
            o.x = pk_bf16(bf_lo(v[j].x) * f, bf_hi(v[j].x) * f); o.y = pk_bf16(bf_lo(v[j].y) * f, bf_hi(v[j].y) * f); o.z = pk_bf16(bf_lo(v[j].z) * f, bf_hi(v[j].z) * f); o.w = pk_bf16(bf_lo(v[j].w) * f, bf_hi(v[j].w) * f);
            row[ch] = o; } }
}
DEVFN void p_final(Frame& F) {
    const float* ssq = (const float*)(F.ws + WS_SSQ); const f32x4* g4 = (const f32x4*)FIN(37) + F.lane;
    for (int m = F.gw; m < M; m += F.ngw) { const float inv = pg8::row_inv(ssq, m); f32x4* hr = (f32x4*)(F.out + (size_t)m * D) + F.lane;
#pragma unroll
        for (int j = 0; j < 4; ++j) hr[64 * j] = hr[64 * j] * inv * g4[64 * j]; }
}

constexpr int PH_PER_LAYER = 9, N_PHASES = 2 + 2 * PH_PER_LAYER;
__global__ void __launch_bounds__(NT, 2) mk_fwd(Args args) {
#ifdef CPU_EMU
    unsigned char* lds = emu_lds_base();
#else
    extern __shared__ __attribute__((aligned(16))) unsigned char lds_[];
    LAS unsigned char* lds = (LAS unsigned char*)lds_;
#endif
    Frame F; F.lds = lds; F.tid = threadIdx.x; F.lane = F.tid & 63;
#ifdef CPU_EMU
    F.wave = F.tid >> 6;
#else
    F.wave = __builtin_amdgcn_readfirstlane(F.tid >> 6);
#endif
    F.G = gridDim.x; F.gtid = blockIdx.x * NT + F.tid; F.gsize = F.G * NT; F.gw = blockIdx.x * NWAVES + F.wave; F.ngw = F.G * NWAVES;
    #ifdef CPU_EMU
    F.ap = &args;
#else
    F.ap = (KARG_PTR)__builtin_amdgcn_kernarg_segment_ptr();
#endif
    F.out = args.out; F.ws = args.ws;
#ifndef CPU_EMU
    volatile LAS unsigned* MISC = (volatile LAS unsigned*)(lds + MISC_OFF);
    if (F.tid < 32) MISC[F.tid] = 0u;
    __syncthreads();
    XcdBarrier bar = xcd_barrier_post((unsigned*)(args.ws + WS_CTL) + CW_BAR, MISC + 8);
#define GRID_BAR() xcd_barrier(bar)
#else
#define GRID_BAR() do {} while (0)
#endif
    const int lo = args.ph_lo, hi = args.ph_hi;
#define IN(k) (lo <= (k) && (k) < hi)
#define SEAM(k) do { if (IN(k) && IN((k) + 1)) GRID_BAR(); } while (0)
#define P_SSQ ((float*)(F.ws + WS_SSQ))
#define P_HB ((bf16*)(F.ws + WS_HB))
#define P_PROJ ((bf16*)(F.ws + WS_PROJ))
#define P_YMIX ((bf16*)(F.ws + WS_YMIX))
#define P_G ((bf16*)(F.ws + WS_G))
#define P_YG ((bf16*)(F.ws + WS_YG))
    { int l0 = 0; if (IN(0)) { LAUNDER(F, l0); p_prologue(F); } }
    SEAM(0);
    for (int lq = 0; lq < 2; ++lq) {
        int l = lq; const int p0 = 1 + lq * PH_PER_LAYER;
        if (IN(p0 + 0)) { LAUNDER(F, l); p_hid2(F, l);
            pg8::Gemm g{P_HB, (const bf16*)(F.ws + WS_WIN + l * SZ_WIN), D}; pg8::StaticOrder S; S.init(M / 256, NINP / 256, F.G, (int)blockIdx.x);
            pg8::EpiIn E{P_PROJ, P_SSQ};
            pg8::gemm_phase<pg8::EpiIn, pg8::StaticOrder, true, true>(lds, F.tid, g, S, E); }
        SEAM(p0 + 0);
        if (IN(p0 + 1)) { LAUNDER(F, l); p_mix1(F, l); }
        SEAM(p0 + 1);
        if (IN(p0 + 2)) { LAUNDER(F, l); p_mix2(F, l); }
        SEAM(p0 + 2);
        if (IN(p0 + 3)) { LAUNDER(F, l); p_mix3(F, l); }
        SEAM(p0 + 3);
        if (IN(p0 + 4)) { LAUNDER(F, l); p_glu(F, l); }
        SEAM(p0 + 4);
        if (IN(p0 + 5)) { LAUNDER(F, l); p_mixnorm(F); }
        SEAM(p0 + 5);
        if (IN(p0 + 6)) { LAUNDER(F, l); pg8::Gemm g{P_YMIX, (const bf16*)(F.ws + WS_WOUT + l * SZ_WOUT), D}; pg8::StaticOrder S; S.init(M / 256, D / 256, F.G, (int)blockIdx.x);
            pg8::EpiRes E{F.out, P_HB, P_SSQ};
            pg8::gemm_phase<pg8::EpiRes, pg8::StaticOrder, true, true>(lds, F.tid, g, S, E); }
        SEAM(p0 + 6);
        if (IN(p0 + 7)) { LAUNDER(F, l); pg8::Gemm g{P_HB, (const bf16*)(F.ws + WS_WUP + l * SZ_WUP), D}; pg8::UpOrder S; S.init(Bn * NQ, FF2 / 256, F.G, (int)blockIdx.x);
            pg8::EpiUp E{P_G, P_SSQ, FIN(34) + (size_t)l * 3 * FF2, FIN(35) + (size_t)l * FF2};
            pg8::gemm_phase<pg8::EpiUp, pg8::UpOrder, true, true>(lds, F.tid, g, S, E); }
        SEAM(p0 + 7);
        if (IN(p0 + 8)) { LAUNDER(F, l); pg8::Gemm g{P_G, (const bf16*)(F.ws + WS_WDN + l * SZ_WDN), FF}; pg8::StaticOrder S; S.init(M / 256, D / 256, F.G, (int)blockIdx.x);
            pg8::EpiRes E{F.out, P_HB, P_SSQ};
            pg8::gemm_phase<pg8::EpiRes, pg8::StaticOrder, true, true>(lds, F.tid, g, S, E); }
        SEAM(p0 + 8);
    }
    { int l0 = 0; if (IN(N_PHASES - 1)) { LAUNDER(F, l0); p_final(F); } }
#undef IN
#undef SEAM
}

#ifndef MK_N_LAUNCHES
#define MK_N_LAUNCHES 1
#endif
extern "C" void kernel_launch(void* const* d_in, const int* in_sizes, int n_in, void* d_out, int out_size, void* d_ws, size_t ws_size, hipStream_t stream) {
    Args a{};
    for (int i = 0; i < 38; ++i) a.in[i] = (const float*)d_in[i];
    a.out = (float*)d_out; a.ws = (unsigned char*)d_ws;
#ifdef CPU_EMU
    const int grid = EMU_GRID;
    for (int ph = 0; ph < N_PHASES; ++ph) { a.ph_lo = ph; a.ph_hi = ph + 1; LAUNCH(mk_fwd, dim3(grid), dim3(NT), LDS_BYTES, stream, a); emu_phase_hook(ph, a); }
#else
    static int grid = 0;
    if (grid == 0) {
        if (n_in != 38 || out_size != M * D || ws_size < WS_END) { fprintf(stderr, "kernel_launch: unexpected shapes (n_in %d out %d ws %zu need %zu)\n", n_in, out_size, ws_size, (size_t)WS_END); grid = -1; return; }
        int dev = 0, cus = 0, per_cu = 0;
        if (hipGetDevice(&dev) != hipSuccess || hipDeviceGetAttribute(&cus, hipDeviceAttributeMultiprocessorCount, dev) != hipSuccess) { grid = -1; return; }
        if (hipFuncSetAttribute((const void*)mk_fwd, hipFuncAttributeMaxDynamicSharedMemorySize, LDS_BYTES) != hipSuccess) { fprintf(stderr, "kernel_launch: hipFuncSetAttribute failed\n"); grid = -1; return; }
        if (hipOccupancyMaxActiveBlocksPerMultiprocessor(&per_cu, (const void*)mk_fwd, NT, LDS_BYTES) != hipSuccess || per_cu < 1) { fprintf(stderr, "kernel_launch: occupancy query says %d\n", per_cu); (void)hipGetLastError(); per_cu = 1; }
        grid = cus;
    }
    if (grid < 0) return;
    (void)hipMemsetAsync((char*)d_ws + WS_CTL, 0, CTL_BYTES, stream);
#if MK_N_LAUNCHES == 1
    a.ph_lo = 0; a.ph_hi = N_PHASES;
    hipLaunchKernelGGL(mk_fwd, dim3(grid), dim3(NT), LDS_BYTES, stream, a);
#else
    for (int ph = 0; ph < N_PHASES; ++ph) { a.ph_lo = ph; a.ph_hi = ph + 1; hipLaunchKernelGGL(mk_fwd, dim3(grid), dim3(NT), LDS_BYTES, stream, a); }
#endif
#endif
}
```

```cpp
#ifdef CPU_EMU
#include "emu.h"
#define LAS
#define GAS
#define DEVFN static inline
#define MEMFN inline
#define WAVE_LDS_FENCE() emu::wave_sync()
#define OPAQUE16(x) do {} while (0)
#define FRESH(x) do {} while (0)
#define MFMA_GUARD(...) do {} while (0)
#define KV(x) 0
#define ACC1(a) 0
#define ACC2(a, b) 0
#define ACC3(a, b, c) 0
#define ACC4(a, b, c, d) 0
#else
#include <hip/hip_runtime.h>
#include <cstdio>
#include <cstdint>
#define LAS __attribute__((address_space(3)))
#define GAS __attribute__((address_space(1)))
#define DEVFN __device__ __forceinline__
#define MEMFN __device__ __forceinline__
#define WAVE_LDS_FENCE() do { asm volatile("s_waitcnt lgkmcnt(0)" ::: "memory"); } while (0)
#define OPAQUE16(x) asm volatile("" : "+v"(x))
#define FRESH(x) asm volatile("s_nop 1" : "+v"(x))
#define KV(x) "v"(x)
#define KA(x) "+v"(x)
#define MFMA_GUARD(accs, ...) asm volatile("s_nop 7\n\ts_nop 7\n\ts_nop 7\n\ts_nop 7" : accs : __VA_ARGS__)
#define ACC1(a) KA(a)
#define ACC2(a, b) KA(a), KA(b)
#define ACC3(a, b, c) KA(a), KA(b), KA(c)
#define ACC4(a, b, c, d) KA(a), KA(b), KA(c), KA(d)
typedef short bf16x8 __attribute__((ext_vector_type(8)));
typedef float f32x4 __attribute__((ext_vector_type(4)));
typedef float f32x2 __attribute__((ext_vector_type(2)));
typedef float f32x16 __attribute__((ext_vector_type(16)));
typedef unsigned u32x4 __attribute__((ext_vector_type(4)));
typedef unsigned u32x2 __attribute__((ext_vector_type(2)));
typedef __bf16 bf16x2_t __attribute__((ext_vector_type(2)));
DEVFN void sync_block() { __syncthreads(); }
DEVFN int lane_id() { int l; asm volatile("v_mbcnt_lo_u32_b32 %0, -1, 0\n\tv_mbcnt_hi_u32_b32 %0, -1, %0" : "=v"(l)); return l; }
DEVFN f32x16 mfma32(bf16x8 a, bf16x8 b, f32x16 c) { return __builtin_amdgcn_mfma_f32_32x32x16_bf16(a, b, c, 0, 0, 0); }
DEVFN f32x4 mfma16(bf16x8 a, bf16x8 b, f32x4 c) { return __builtin_amdgcn_mfma_f32_16x16x32_bf16(a, b, c, 0, 0, 0); }
DEVFN float shfl_f32(float v, int src) { return __builtin_bit_cast(float, __builtin_amdgcn_ds_bpermute(src << 2, __builtin_bit_cast(int, v))); }
DEVFN float shfl_xor_f32(float v, int m) { return shfl_f32(v, lane_id() ^ m); }
DEVFN float dpp_row_shr1(float old, float src) { return __builtin_bit_cast(float, __builtin_amdgcn_update_dpp(__builtin_bit_cast(int, old), __builtin_bit_cast(int, src), 0x111, 0xf, 0xf, false)); }
DEVFN float dpp_row_shl1(float old, float src) { return __builtin_bit_cast(float, __builtin_amdgcn_update_dpp(__builtin_bit_cast(int, old), __builtin_bit_cast(int, src), 0x101, 0xf, 0xf, false)); }
DEVFN float dpp_row_ror1(float src) { return __builtin_bit_cast(float, __builtin_amdgcn_update_dpp(0, __builtin_bit_cast(int, src), 0x121, 0xf, 0xf, false)); }
DEVFN float dpp_row_ror15(float src) { return __builtin_bit_cast(float, __builtin_amdgcn_update_dpp(0, __builtin_bit_cast(int, src), 0x12f, 0xf, 0xf, false)); }
DEVFN unsigned pk_bf16(float lo, float hi) { f32x2 v = {lo, hi}; bf16x2_t b = __builtin_convertvector(v, bf16x2_t); return __builtin_bit_cast(unsigned, b); }
DEVFN float bf_lo(unsigned u) { return __builtin_bit_cast(float, u << 16); }
DEVFN float bf_hi(unsigned u) { return __builtin_bit_cast(float, u & 0xffff0000u); }
DEVFN float fast_rcp(float x) { return __builtin_amdgcn_rcpf(x); }
DEVFN float fast_exp2(float x) { return __builtin_amdgcn_exp2f(x); }
#endif

#ifndef BATCH
#define BATCH 4
#endif
#ifndef SEQ
#define SEQ 4096
#endif
typedef unsigned short bf16;
constexpr int Bn = BATCH, L = SEQ, M = Bn * L, D = 1024, NIN = 1920, NINP = 2048, RGW = 384, S5W = 384, HYW = 256, FF = 2816, FF2 = 5632, GLUP = 512;
constexpr int NWAVES = 8, NT = NWAVES * 64;
constexpr int UPS = 254, NQ = (L + UPS - 1) / UPS;

constexpr size_t al256(size_t x) { return (x + 255) & ~(size_t)255; }
constexpr size_t WS_CTL = 0, CTL_BYTES = 1u << 20;
constexpr size_t SZ_WIN = (size_t)NINP * D * 2, SZ_WOUT = (size_t)D * D * 2, SZ_WUP = (size_t)FF2 * D * 2, SZ_WDN = (size_t)D * FF * 2, SZ_WGLU = (size_t)GLUP * S5W * 2;
constexpr size_t WS_WIN = WS_CTL + CTL_BYTES, WS_WOUT = WS_WIN + 2 * SZ_WIN, WS_WUP = WS_WOUT + 2 * SZ_WOUT, WS_WDN = WS_WUP + 2 * SZ_WUP, WS_WGLU = WS_WDN + 2 * SZ_WDN;
constexpr size_t WS_HBPAD = WS_WGLU + 2 * SZ_WGLU, HB_FRONT = (size_t)256 * D * 2, WS_HB = WS_HBPAD + HB_FRONT, SZ_HBPAD = (size_t)(M + 768) * D * 2;
constexpr size_t WS_SSQ = WS_HBPAD + SZ_HBPAD, SZ_SSQ = (size_t)M * 16 * 4;
constexpr size_t WS_PROJ = WS_SSQ + SZ_SSQ, SZ_PROJ = (size_t)M * NINP * 2;
constexpr size_t WS_YMIX = WS_PROJ + SZ_PROJ, SZ_YMIX = (size_t)M * D * 2;
constexpr size_t WS_G = WS_PROJ;
constexpr size_t WS_T0 = WS_YMIX + SZ_YMIX, SZ_T0 = (size_t)M * 384 * 4;
constexpr size_t WS_YG = WS_T0;
constexpr size_t WS_THF = WS_T0 + SZ_T0, SZ_THF = (size_t)M * 384 * 2;
constexpr size_t WS_T1 = WS_THF + SZ_THF, SZ_T1 = (size_t)(M / 16) * 2 * 1536 * 8;
constexpr size_t WS_KFB = WS_T1 + SZ_T1, SZ_KFB = (size_t)L * 512 * 4;
constexpr size_t WS_HID = WS_KFB + SZ_KFB, SZ_HID = (size_t)4 * L * 64 * 4;
constexpr size_t WS_S5A = WS_HID + SZ_HID, SZ_S5A = (size_t)2 * 2 * 24 * 64 * 8;
constexpr size_t WS_S5A16 = WS_S5A + SZ_S5A;
constexpr size_t WS_S5BT = WS_S5A16 + SZ_S5A, SZ_S5BT = (size_t)2 * 2 * 24 * 2 * 64 * 16 * 2;
constexpr size_t WS_S5CT = WS_S5BT + SZ_S5BT, SZ_S5CT = (size_t)2 * 2 * 24 * 16 * 128 * 2;
constexpr size_t WS_S5T = WS_S5A, SZ_S5T = 2 * SZ_S5A + SZ_S5BT + SZ_S5CT;
constexpr size_t WS_S5S = WS_T1;
static_assert((size_t)(M / 16) * 2 * 1536 * 8 <= SZ_T1 + SZ_KFB || true, "s5 state buffer");
constexpr size_t WS_SSQB = WS_S5T + SZ_S5T, SZ_SSQB = (size_t)M * 8 * 4;
constexpr size_t WS_RGSP = WS_SSQB + SZ_SSQB, SZ_RGSP = al256((size_t)2 * 2 * 384 * 4);
constexpr size_t WS_END = WS_RGSP + SZ_RGSP;
constexpr size_t WS_Z = WS_HB, WS_X0C = WS_HB + (size_t)M * 256 * 4;
static_assert(SZ_PROJ + SZ_YMIX >= (size_t)M * FF * 2, "g overlay");
static_assert((size_t)2 * M * 256 * 4 <= (size_t)M * D * 2, "z/x0c overlay");
static_assert(BATCH != 4 || SEQ != 4096 || WS_END <= ((size_t)256 << 20), "workspace over 256 MiB");

DEVFN float gelu_f(float x) { const float y = 1.5957691216057308f * (x + 0.044715f * x * x * x); return x * fast_rcp(1.0f + fast_exp2(-1.4426950408889634f * y)); }
DEVFN float sigmoid_f(float x) { return fast_rcp(1.0f + fast_exp2(-1.4426950408889634f * x)); }
DEVFN float softplus_f(float x) { return x > 0.f ? x + log1pf(expf(-x)) : log1pf(expf(x)); }
DEVFN float exp_f(float x) { return fast_exp2(1.4426950408889634f * x); }
DEVFN float expm1_f(float x) {
    const float p = x * (1.0f + x * (0.5f + x * (0.16666667f + x * (0.041666668f + x * (0.008333334f + x * 0.0013888889f)))));
    return fabsf(x) < 0.25f ? p : exp_f(x) - 1.0f; }
DEVFN float bf2f_(bf16 h) { return bf_lo((unsigned)h); }
DEVFN bf16 f2bf_(float f) { return (bf16)(pk_bf16(f, 0.f) & 0xffffu); }

namespace pg8 {
constexpr int BM = 256, BK = 64, HALF = 128, HTB = HALF * BK * 2, STAGE_BYTES = 8 * HTB, NXCD = 8, WGM = 8;
__host__ __device__ __forceinline__ int lds_byte(int r, int c) { const int st = (r >> 4) * 2 + (c >> 5), rr = r & 15, cc = c & 31, ob = rr * 64 + cc * 2; return st * 1024 + (ob ^ (((ob >> 9) & 1) << 5)); }
__host__ __device__ __forceinline__ void stage_rc(int b, int& R, int& C) { const int st = b / 1024, sb = b % 1024, swz = sb ^ (((sb >> 9) & 1) << 5); R = (st >> 1) * 16 + swz / 64; C = (st & 1) * 32 + (swz % 64) / 2; }
__host__ __device__ __forceinline__ int perm32(int rho) { const int n = rho >> 4, i = rho & 15; return 8 * (i >> 2) + 4 * n + (i & 3); }

struct Unit { int pm, pn; int arow; };
struct Gemm { const bf16* A; const bf16* Bt; int K; };

struct StaticOrder {
    int nM, nN, nwg, G, c;
    __host__ __device__ void init(int nM_, int nN_, int G_, int c_) { nM = nM_; nN = nN_; nwg = nM * nN; G = G_; c = c_; }
    __host__ __device__ bool next(int i, Unit& u) const {
        const long Lx = (long)i * G + c; if (Lx >= nwg) return false;
        int wgid = (int)Lx; { const int q = nwg / NXCD, r = nwg % NXCD, xcd = wgid % NXCD, off = wgid / NXCD; wgid = (xcd < r ? xcd * (q + 1) : r * (q + 1) + (xcd - r) * q) + off; }
        const int nig = WGM * nN, gid = wgid / nig, fm = gid * WGM, gsz = (nM - fm) < WGM ? (nM - fm) : WGM;
        u.pm = fm + ((wgid % nig) % gsz); u.pn = (wgid % nig) / gsz; u.arow = u.pm * BM; return true;
    }
};
struct UpOrder : StaticOrder {
    __host__ __device__ bool next(int i, Unit& u) const { if (!StaticOrder::next(i, u)) return false; const int b = u.pm / NQ, q = u.pm % NQ; u.arow = b * L + UPS * q - 1; return true; }
};

#ifndef CPU_EMU
#define PG8_LAS __attribute__((address_space(3)))
template <class Epi, class Sched, bool ALIGN_EPI = false, bool SP2 = false>
__device__ __forceinline__ void gemm_phase(PG8_LAS unsigned char* lds, const int tid, const Gemm g, const Sched& S, const Epi& E) {
    const int wid = __builtin_amdgcn_readfirstlane(tid >> 6), lane = tid & 63, wr = wid >> 2, wc = wid & 3, fr = lane & 15, fq = lane >> 4;
    const int K = g.K, nt = K / BK;
    unsigned voffA[2], voffB[2];
#pragma unroll
    for (int i = 0; i < 2; ++i) { int R, C; stage_rc(tid * 16 + i * 8192, R, C); const int Rb = Epi::PERM ? ((R & ~31) + perm32(R & 31)) : R;
        voffA[i] = (unsigned)(R * K + C) * 2u; voffB[i] = (unsigned)(Rb * K + C) * 2u; }
    const size_t kstep = (size_t)(BK * 2);
    const size_t hstep = (size_t)HALF * K * 2;
    const size_t tstep = 2 * hstep;
    const size_t rstep = (size_t)K * 2;
    const unsigned ldsw = (unsigned)wid * 1024u;
    const int aoff = lds_byte(wr * 64 + fr, fq * 8), boff = lds_byte(wc * 32 + fr, fq * 8);
#define PG8_SA(b, h) (((b) * 2 + (h)) * HTB)
#define PG8_SB(b, h) ((4 + (b) * 2 + (h)) * HTB)
#define PG8_STAGE(bufoff, gbase, voff) do { _Pragma("unroll") for (int _i = 0; _i < 2; ++_i) \
        __builtin_amdgcn_global_load_lds((const unsigned*)((const char*)(gbase) + (voff)[_i]), (PG8_LAS unsigned*)(lds + (bufoff) + ldsw + _i * 8192), 16, 0, 0); } while (0)
#define PG8_LDA(dst, b, h) do { _Pragma("unroll") for (int m = 0; m < 4; ++m) _Pragma("unroll") for (int k = 0; k < 2; ++k) dst[m][k] = *(const PG8_LAS bf16x8*)(lds + PG8_SA(b, h) + aoff + m * 2048 + k * 1024); } while (0)
#define PG8_LDB(dst, b, h) do { _Pragma("unroll") for (int n = 0; n < 2; ++n) _Pragma("unroll") for (int k = 0; k < 2; ++k) dst[n][k] = *(const PG8_LAS bf16x8*)(lds + PG8_SB(b, h) + boff + n * 2048 + k * 1024); } while (0)
#define PG8_MMA(ai, bj, At, Bt) do { __builtin_amdgcn_s_setprio(1); _Pragma("unroll") for (int m = 0; m < 4; ++m) _Pragma("unroll") for (int n = 0; n < 2; ++n) _Pragma("unroll") for (int k = 0; k < 2; ++k) \
        acc[ai][bj][m][n] = __builtin_amdgcn_mfma_f32_16x16x32_bf16(Bt[n][k], At[m][k], acc[ai][bj][m][n], 0, 0, 0); __builtin_amdgcn_s_setprio(0); } while (0)
#define PG8_WAIT_V(n) asm volatile("s_waitcnt vmcnt(" #n ")" ::: "memory")
#define PG8_WAIT_L(n) asm volatile("s_waitcnt lgkmcnt(" #n ")" ::: "memory")
#define PG8_BAR __builtin_amdgcn_s_barrier()
#define PG8_SCHED __builtin_amdgcn_sched_barrier(0)
    Unit cur, nxt; int ui = 0;
    if (!S.next(0, cur)) return;
    f32x4 acc[2][2][4][2];
#pragma unroll
    for (int a = 0; a < 2; ++a)
#pragma unroll
        for (int b = 0; b < 2; ++b)
#pragma unroll
            for (int m = 0; m < 4; ++m)
#pragma unroll
                for (int n = 0; n < 2; ++n) acc[a][b][m][n] = (f32x4){0.f, 0.f, 0.f, 0.f};
    bf16x8 At[4][2], B0[2][2], B1[2][2];
    const char* cA = (const char*)g.A + (long)cur.arow * (long)rstep; const char* cB = (const char*)g.Bt + (size_t)cur.pn * tstep;
    if constexpr (SP2) {
        PG8_STAGE(PG8_SB(0, 0), cB, voffB); PG8_STAGE(PG8_SB(0, 1), cB + hstep, voffB); PG8_STAGE(PG8_SA(0, 0), cA, voffA); PG8_STAGE(PG8_SA(0, 1), cA + hstep, voffA);
        if (wr == 1) PG8_BAR;
        PG8_WAIT_V(2); PG8_BAR;
        PG8_STAGE(PG8_SB(1, 0), cB + kstep, voffB); PG8_STAGE(PG8_SA(1, 0), cA + kstep, voffA); PG8_STAGE(PG8_SB(1, 1), cB + hstep + kstep, voffB);
        PG8_WAIT_V(6); PG8_BAR;
    } else {
        PG8_STAGE(PG8_SB(0, 0), cB, voffB); PG8_STAGE(PG8_SA(0, 0), cA, voffA); PG8_STAGE(PG8_SB(0, 1), cB + hstep, voffB); PG8_STAGE(PG8_SA(0, 1), cA + hstep, voffA);
        if (wr == 1) PG8_BAR;
        PG8_WAIT_V(4); PG8_BAR;
        PG8_STAGE(PG8_SB(1, 0), cB + kstep, voffB); PG8_STAGE(PG8_SA(1, 0), cA + kstep, voffA); PG8_STAGE(PG8_SB(1, 1), cB + hstep + kstep, voffB);
        PG8_WAIT_V(6); PG8_BAR;
    }
    for (;;) {
        const bool has_next = S.next(ui + 1, nxt);
        const char* nA = has_next ? (const char*)g.A + (long)nxt.arow * (long)rstep : cA; const char* nB = has_next ? (const char*)g.Bt + (size_t)nxt.pn * tstep : cB;
        for (int t = 0; t < nt; t += 2) {
            const bool last = (t == nt - 2);
            const char* a1 = cA + (size_t)(t + 1) * kstep;
            const char* a2 = last ? nA : cA + (size_t)(t + 2) * kstep; const char* b2 = last ? nB : cB + (size_t)(t + 2) * kstep;
            const char* a3 = a2 + kstep; const char* b3 = b2 + kstep;
            if constexpr (SP2) {
            PG8_LDB(B0, 0, 0); PG8_LDB(B1, 0, 1); PG8_SCHED; PG8_LDA(At, 0, 0); PG8_STAGE(PG8_SA(1, 1), a1 + hstep, voffA);
            PG8_WAIT_V(8); PG8_WAIT_L(0); PG8_BAR; PG8_MMA(0, 0, At, B0); PG8_MMA(0, 1, At, B1); PG8_BAR; PG8_SCHED;
            PG8_LDA(At, 0, 1); PG8_STAGE(PG8_SB(0, 0), b2, voffB); PG8_STAGE(PG8_SB(0, 1), b2 + hstep, voffB); PG8_STAGE(PG8_SA(0, 0), a2, voffA);
            PG8_WAIT_V(8); PG8_WAIT_L(0); PG8_BAR; PG8_MMA(1, 0, At, B0); PG8_MMA(1, 1, At, B1); PG8_BAR; PG8_SCHED;
            PG8_LDB(B0, 1, 0); PG8_LDB(B1, 1, 1); PG8_SCHED; PG8_LDA(At, 1, 0); PG8_STAGE(PG8_SA(0, 1), a2 + hstep, voffA);
            PG8_WAIT_V(8); PG8_WAIT_L(0); PG8_BAR; PG8_MMA(0, 0, At, B0); PG8_MMA(0, 1, At, B1); PG8_BAR; PG8_SCHED;
            PG8_LDA(At, 1, 1); PG8_STAGE(PG8_SB(1, 0), b3, voffB); PG8_STAGE(PG8_SB(1, 1), b3 + hstep, voffB); PG8_STAGE(PG8_SA(1, 0), a3, voffA);
            PG8_WAIT_V(8); PG8_WAIT_L(0); PG8_BAR; PG8_MMA(1, 0, At, B0); PG8_MMA(1, 1, At, B1); PG8_BAR; PG8_SCHED;
            } else {
            PG8_LDB(B0, 0, 0); PG8_SCHED; PG8_LDA(At, 0, 0); PG8_STAGE(PG8_SA(1, 1), a1 + hstep, voffA);
            PG8_WAIT_L(8); PG8_BAR; PG8_WAIT_L(0); PG8_MMA(0, 0, At, B0); PG8_BAR; PG8_SCHED;
            PG8_LDB(B1, 0, 1); PG8_STAGE(PG8_SB(0, 0), b2, voffB);
            PG8_BAR; PG8_WAIT_L(0); PG8_MMA(0, 1, At, B1); PG8_BAR;
            PG8_LDA(At, 0, 1); PG8_STAGE(PG8_SA(0, 0), a2, voffA);
            PG8_BAR; PG8_WAIT_L(0); PG8_MMA(1, 0, At, B0); PG8_BAR; PG8_SCHED;
            PG8_STAGE(PG8_SB(0, 1), b2 + hstep, voffB);
            PG8_WAIT_V(6); PG8_BAR; PG8_MMA(1, 1, At, B1); PG8_BAR;
            PG8_LDB(B0, 1, 0); PG8_SCHED; PG8_LDA(At, 1, 0); PG8_STAGE(PG8_SA(0, 1), a2 + hstep, voffA);
            PG8_WAIT_L(8); PG8_BAR; PG8_WAIT_L(0); PG8_MMA(0, 0, At, B0); PG8_BAR; PG8_SCHED;
            PG8_LDB(B1, 1, 1); PG8_STAGE(PG8_SB(1, 0), b3, voffB);
            PG8_BAR; PG8_WAIT_L(0); PG8_MMA(0, 1, At, B1); PG8_BAR;
            PG8_LDA(At, 1, 1); PG8_STAGE(PG8_SA(1, 0), a3, voffA);
            PG8_BAR; PG8_WAIT_L(0); PG8_MMA(1, 0, At, B0); PG8_BAR; PG8_SCHED;
            PG8_STAGE(PG8_SB(1, 1), b3 + hstep, voffB);
            PG8_WAIT_V(6); PG8_BAR; PG8_MMA(1, 1, At, B1); PG8_BAR;
            }
        }
        if constexpr (ALIGN_EPI) { if (wr == 0) PG8_BAR; }
        { int t_ = tid; asm volatile("" : "+v"(t_));
          E(acc, cur, wr, wc, t_ & 15, (t_ >> 4) & 3, lds + STAGE_BYTES); }
        if (!has_next) break;
#pragma unroll
        for (int a = 0; a < 2; ++a)
#pragma unroll
            for (int b = 0; b < 2; ++b)
#pragma unroll
                for (int m = 0; m < 4; ++m)
#pragma unroll
                    for (int n = 0; n < 2; ++n) acc[a][b][m][n] = (f32x4){0.f, 0.f, 0.f, 0.f};
        cur = nxt; cA = nA; cB = nB; ++ui;
        if constexpr (ALIGN_EPI) { if (wr == 1) PG8_BAR; }
    }
    PG8_WAIT_V(0);
    if constexpr (!ALIGN_EPI) { if (wr == 0) PG8_BAR; }
    PG8_BAR;
#undef PG8_SA
#undef PG8_SB
#undef PG8_STAGE
#undef PG8_LDA
#undef PG8_LDB
#undef PG8_MMA
#undef PG8_WAIT_V
#undef PG8_WAIT_L
#undef PG8_BAR
#undef PG8_SCHED
}
#else
template <class Epi, class Sched, bool ALIGN_EPI = false, bool SP2 = false>
static inline void gemm_phase(unsigned char* lds, const int tid, const Gemm g, const Sched& S, const Epi& E) {
    const int wid = tid >> 6, lane = tid & 63, wr = wid >> 2, wc = wid & 3, fr = lane & 15, fq = lane >> 4;
    static thread_local std::vector<float> Af, Bf;
    Unit cur;
    for (int ui = 0; S.next(ui, cur); ++ui) {
        const int K = g.K;
        sync_block();
        if (tid == 0) { Af.resize((size_t)256 * K); Bf.resize((size_t)256 * K);
            for (int r = 0; r < 256; ++r) for (int k = 0; k < K; ++k) { Af[(size_t)r * K + k] = bf2f_(g.A[((long)cur.arow + r) * K + k]); Bf[(size_t)r * K + k] = bf2f_(g.Bt[((size_t)cur.pn * 256 + r) * K + k]); } }
        sync_block();
        f32x4 acc[2][2][4][2];
        for (int ai = 0; ai < 2; ++ai) for (int bj = 0; bj < 2; ++bj) for (int m = 0; m < 4; ++m) for (int n = 0; n < 2; ++n) for (int e = 0; e < 4; ++e) {
            const int r = 128 * ai + 64 * wr + 16 * m + fr, c = 128 * bj + 32 * wc + (Epi::PERM ? 8 * fq + 4 * n + e : 16 * n + 4 * fq + e);
            const float* a = &Af[(size_t)r * K]; const float* b = &Bf[(size_t)c * K]; float s = 0.f;
            for (int k = 0; k < K; ++k) s += a[k] * b[k];
            acc[ai][bj][m][n][e] = s; }
        E(acc, cur, wr, wc, fr, fq, lds + STAGE_BYTES);
    }
    sync_block();
}
#endif

DEVFN float row_inv(const float* ssq, int row) {
    const f32x4* p = (const f32x4*)(ssq + (size_t)row * 16); const f32x4 a = p[0], b = p[1], c = p[2], d = p[3];
    const float s = ((a[0] + a[1]) + (a[2] + a[3])) + ((b[0] + b[1]) + (b[2] + b[3])) + ((c[0] + c[1]) + (c[2] + c[3])) + ((d[0] + d[1]) + (d[2] + d[3]));
    return 1.0f / sqrtf(s * (1.0f / D) + 1e-6f);
}
struct EpiIn {
    static constexpr bool PERM = true;
    bf16* O; const float* ssq;
    MEMFN void operator()(const f32x4 (&acc)[2][2][4][2], const Unit& u, int wr, int wc, int fr, int fq, LAS unsigned char*) const {
        const int row0 = u.pm * BM + wr * 64 + fr, col0 = u.pn * BM + wc * 32 + 8 * fq;
#pragma unroll
        for (int ai = 0; ai < 2; ++ai)
#pragma unroll
            for (int m = 0; m < 4; ++m) { const int row = row0 + ai * HALF + m * 16; const float sc = row_inv(ssq, row); bf16* rowp = O + (size_t)row * NINP + col0;
#pragma unroll
                for (int bj = 0; bj < 2; ++bj) { const f32x4 v0 = acc[ai][bj][m][0] * sc, v1 = acc[ai][bj][m][1] * sc;
                    u32x4 w; w.x = pk_bf16(v0[0], v0[1]); w.y = pk_bf16(v0[2], v0[3]); w.z = pk_bf16(v1[0], v1[1]); w.w = pk_bf16(v1[2], v1[3]);
                    *(u32x4*)(rowp + bj * HALF) = w; } }
    }
};
struct EpiRes {
    static constexpr bool PERM = false;
    float* H; bf16* HB; float* ssq;
    MEMFN void operator()(const f32x4 (&acc)[2][2][4][2], const Unit& u, int wr, int wc, int fr, int fq, LAS unsigned char*) const {
        const int row0 = u.pm * BM + wr * 64 + fr, col0 = u.pn * BM + wc * 32 + 4 * fq;
#pragma unroll
        for (int ai = 0; ai < 2; ++ai)
#pragma unroll
            for (int m = 0; m < 4; ++m) { const int row = row0 + ai * HALF + m * 16; const size_t off = (size_t)row * D + col0; float s = 0.f;
#pragma unroll
                for (int bj = 0; bj < 2; ++bj)
#pragma unroll
                    for (int n = 0; n < 2; ++n) { float* hp = H + off + bj * HALF + n * 16; const f32x4 h = *(const f32x4*)hp + acc[ai][bj][m][n]; *(f32x4*)hp = h;
                        u32x2 w; w.x = pk_bf16(h[0], h[1]); w.y = pk_bf16(h[2], h[3]); *(u32x2*)(HB + off + bj * HALF + n * 16) = w;
                        s += (h[0] * h[0] + h[1] * h[1]) + (h[2] * h[2] + h[3] * h[3]); }
                s += shfl_xor_f32(s, 16); s += shfl_xor_f32(s, 32);
                if (fq == 0) ssq[(size_t)row * 16 + u.pn * 4 + wc] = s;
                if (m & 1) asm volatile("" ::: "memory"); }
    }
};
struct EpiGlu {
    static constexpr bool PERM = true;
    const bf16* YG; const float* bias; bf16* YM;
    MEMFN void operator()(const f32x4 (&acc)[2][2][4][2], const Unit& u, int wr, int wc, int fr, int fq, LAS unsigned char*) const {
        const int row0 = u.pm * BM + wr * 64 + fr, col0 = u.pn * BM + wc * 32 + 8 * fq;
#pragma unroll
        for (int bj = 0; bj < 2; ++bj) { const int col = col0 + bj * HALF; if (u.pn == 1 && bj == 1) continue;
            const f32x4 b0 = *(const f32x4*)(bias + col), b1 = *(const f32x4*)(bias + col + 4);
#pragma unroll
            for (int ai = 0; ai < 2; ++ai)
#pragma unroll
                for (int m = 0; m < 4; ++m) { const int row = row0 + ai * HALF + m * 16;
                    const u32x4 y = *(const u32x4*)(YG + (size_t)row * S5W + col); const f32x4 a0 = acc[ai][bj][m][0] + b0, a1 = acc[ai][bj][m][1] + b1;
                    u32x4 w; w.x = pk_bf16(bf_lo(y.x) * sigmoid_f(a0[0]), bf_hi(y.x) * sigmoid_f(a0[1])); w.y = pk_bf16(bf_lo(y.y) * sigmoid_f(a0[2]), bf_hi(y.y) * sigmoid_f(a0[3]));
                    w.z = pk_bf16(bf_lo(y.z) * sigmoid_f(a1[0]), bf_hi(y.z) * sigmoid_f(a1[1])); w.w = pk_bf16(bf_lo(y.w) * sigmoid_f(a1[2]), bf_hi(y.w) * sigmoid_f(a1[3]));
                    *(u32x4*)(YM + (size_t)row * D + RGW + col) = w;
                    if (m & 1) asm volatile("" ::: "memory"); } }
    }
};
struct EpiUp {
    static constexpr bool PERM = true;
    bf16* G; const float* ssq; const float* cw; const float* cb;
    MEMFN void operator()(f32x4 (&acc)[2][2][4][2], const Unit& u, int wr, int wc, int fr, int fq, LAS unsigned char* xl) const {
        const int b = u.pm / NQ, q = u.pm % NQ, t0 = UPS * q - 1;
        LAS float* XB = (LAS float*)xl;
        const int cs = wc * 32 + 8 * fq;
#pragma unroll
        for (int ai = 0; ai < 2; ++ai)
#pragma unroll
            for (int m = 0; m < 4; ++m) { const int lr = 128 * ai + 64 * wr + 16 * m + fr, t = t0 + lr; const bool ok = (t >= 0) && (t < L);
                const float sc = ok ? row_inv(ssq, b * L + t) : 0.f;
#pragma unroll
                for (int bj = 0; bj < 2; ++bj)
#pragma unroll
                    for (int n = 0; n < 2; ++n)
#pragma unroll
                        for (int e = 0; e < 4; ++e) acc[ai][bj][m][n][e] = ok ? acc[ai][bj][m][n][e] * sc : 0.f; }
#pragma unroll
        for (int ai = 0; ai < 2; ++ai) { const int s = 2 * ai + wr;
            if (fr == 0) {
#pragma unroll
                for (int bj = 0; bj < 2; ++bj)
#pragma unroll
                    for (int n = 0; n < 2; ++n) *(LAS f32x4*)(XB + (2 * s) * 256 + bj * 128 + cs + 4 * n) = acc[ai][bj][0][n]; }
            if (fr == 15) {
#pragma unroll
                for (int bj = 0; bj < 2; ++bj)
#pragma unroll
                    for (int n = 0; n < 2; ++n) *(LAS f32x4*)(XB + (2 * s + 1) * 256 + bj * 128 + cs + 4 * n) = acc[ai][bj][3][n]; } }
#ifdef CPU_EMU
        sync_block();
#else
        asm volatile("s_waitcnt lgkmcnt(0)" ::: "memory"); __builtin_amdgcn_s_barrier(); asm volatile("" ::: "memory");
#endif
        const int j0 = u.pn * 128 + cs;
#pragma unroll
        for (int n = 0; n < 2; ++n) {
            f32x4 wa[3], wv[3]; const f32x4 ba = *(const f32x4*)(cb + j0 + 4 * n), bv = *(const f32x4*)(cb + FF + j0 + 4 * n);
#pragma unroll
            for (int k = 0; k < 3; ++k) { wa[k] = *(const f32x4*)(cw + k * FF2 + j0 + 4 * n); wv[k] = *(const f32x4*)(cw + k * FF2 + FF + j0 + 4 * n); }
#pragma unroll
            for (int ai = 0; ai < 2; ++ai) { const int s = 2 * ai + wr;
#pragma unroll
                for (int m = 0; m < 4; ++m) { const int lr = 64 * s + 16 * m + fr, t = t0 + lr;
                    f32x4 up[2], dn[2];
#pragma unroll
                    for (int bj = 0; bj < 2; ++bj) {
                        f32x4 pu, pd;
                        if (m > 0) { const f32x4 p = acc[ai][bj][m > 0 ? m - 1 : 0][n]; pu = (f32x4){dpp_row_ror1(p[0]), dpp_row_ror1(p[1]), dpp_row_ror1(p[2]), dpp_row_ror1(p[3])}; }
                        else if (s > 0) pu = *(const LAS f32x4*)(XB + (2 * (s - 1) + 1) * 256 + bj * 128 + cs + 4 * n);
                        else pu = (f32x4){0.f, 0.f, 0.f, 0.f};
                        if (m < 3) { const f32x4 p = acc[ai][bj][m < 3 ? m + 1 : 3][n]; pd = (f32x4){dpp_row_ror15(p[0]), dpp_row_ror15(p[1]), dpp_row_ror15(p[2]), dpp_row_ror15(p[3])}; }
                        else if (s < 3) pd = *(const LAS f32x4*)(XB + (2 * (s + 1)) * 256 + bj * 128 + cs + 4 * n);
                        else pd = (f32x4){0.f, 0.f, 0.f, 0.f};
                        const f32x4 x = acc[ai][bj][m][n];
#pragma unroll
                        for (int e = 0; e < 4; ++e) { up[bj][e] = dpp_row_shr1(pu[e], x[e]); dn[bj][e] = dpp_row_shl1(pd[e], x[e]); }
                    }
                    const f32x4 a = ba + wa[0] * up[0] + wa[1] * acc[ai][0][m][n] + wa[2] * dn[0];
                    const f32x4 v = bv + wv[0] * up[1] + wv[1] * acc[ai][1][m][n] + wv[2] * dn[1];
                    if (lr >= 1 && lr <= UPS && t < L) { u32x2 w; w.x = pk_bf16(gelu_f(a[0]) * v[0], gelu_f(a[1]) * v[1]); w.y = pk_bf16(gelu_f(a[2]) * v[2], gelu_f(a[3]) * v[3]);
                        *(u32x2*)(G + (size_t)(b * L + t) * FF + j0 + 4 * n) = w; }
                } } }
    }
};
}

constexpr int RING_BYTES = 131072, XCH_OFF = RING_BYTES, XCH_BYTES = 8192, MISC_OFF = XCH_OFF + XCH_BYTES, LDS_BYTES = 147456;
constexpr int CW_TMO = 0, CW_BAR = 4096;
#ifndef CPU_EMU
typedef GAS unsigned gu32;
#define XB_TMO      128
#define XB_XCNT(j)  (256  + 64 * (j))
#define XB_XSUB(j)  (1280 + 64 * (j))
#define XB_XGEN(j)  (2304 + 64 * (j))
#define XB_TOP      3328
#define XB_TOPGEN   3392
#define XCD_BAR_WORDS 3456
#define XB_SPIN_CAP (1u << 22)
__device__ __forceinline__ unsigned xb_ld(unsigned* p)              { return __hip_atomic_load(p, __ATOMIC_RELAXED, __HIP_MEMORY_SCOPE_AGENT); }
__device__ __forceinline__ unsigned xb_add(unsigned* p, unsigned v) { return __hip_atomic_fetch_add(p, v, __ATOMIC_RELAXED, __HIP_MEMORY_SCOPE_AGENT); }
__device__ __forceinline__ unsigned xb_xcc_id() { return (unsigned)__builtin_amdgcn_s_getreg((3 << 11) | 20) & 0xFu; }
#define XB_SPIN(cond, bar) do { unsigned _sp = 0; while (cond) { __builtin_amdgcn_s_sleep(1); \
    if ((++_sp & 255u) == 0u) { if (xb_ld(&(bar)[XB_TMO])) break; if (_sp > XB_SPIN_CAP) { atomicAdd(&(bar)[XB_TMO], 1u); break; } } } } while (0)
struct XcdBarrier { unsigned* bar; unsigned x; volatile LAS unsigned* st; };
__device__ __forceinline__ XcdBarrier xcd_barrier_post(unsigned* bar, volatile LAS unsigned* st) {
    XcdBarrier b; b.bar = bar; b.x = xb_xcc_id(); b.st = st;
    if (threadIdx.x == 0) (void)xb_add(&bar[XB_XCNT(b.x)], 1u);
    return b;
}
__device__ __forceinline__ void xcd_barrier_complete(unsigned* bar, unsigned x, unsigned& nloc, unsigned& nx) {
    const unsigned G = gridDim.x * gridDim.y * gridDim.z;
    unsigned sum, cnt, mine, sp = 0u;
    for (;;) {
        sum = 0u; cnt = 0u; mine = 0u;
#pragma unroll
        for (unsigned j = 0; j < 16; ++j) { const unsigned c = xb_ld(&bar[XB_XCNT(j)]); sum += c; cnt += (c > 0u) ? 1u : 0u; mine = (j == x) ? c : mine; }
        if (sum == G) break;
        __builtin_amdgcn_s_sleep(1);
        if ((++sp & 255u) == 0u) { if (xb_ld(&bar[XB_TMO])) break; if (sp > XB_SPIN_CAP) { atomicAdd(&bar[XB_TMO], 1u); break; } }
    }
    nloc = mine > 0u ? mine : 1u; nx = cnt > 0u ? cnt : 1u;
}
__device__ __forceinline__ void xcd_barrier(const XcdBarrier& b) {
    asm volatile("s_waitcnt vmcnt(0)" ::: "memory");
    __syncthreads();
    if (threadIdx.x == 0) {
        unsigned* bar = b.bar;
        __builtin_amdgcn_s_waitcnt(0);
        unsigned nloc = b.st[0], nx = b.st[1];
        if (nloc == 0u) { xcd_barrier_complete(bar, b.x, nloc, nx); b.st[0] = nloc; b.st[1] = nx; }
        const unsigned old = xb_add(&bar[XB_XSUB(b.x)], 1u);
        const unsigned gen = old / nloc;
        if (old + 1u == (gen + 1u) * nloc) {
            __builtin_amdgcn_fence(__ATOMIC_RELEASE, "agent");
            asm volatile("s_waitcnt vmcnt(0)" ::: "memory");
            const unsigned og = xb_add(&bar[XB_TOP], 1u);
            const unsigned tg = og / nx;
            if (og + 1u == (tg + 1u) * nx) xb_add(&bar[XB_TOPGEN], 1u);
            else XB_SPIN(xb_ld(&bar[XB_TOPGEN]) == tg, bar);
            __builtin_amdgcn_fence(__ATOMIC_ACQUIRE, "agent");
            xb_add(&bar[XB_XGEN(b.x)], 1u);
            asm volatile("s_waitcnt vmcnt(0)" ::: "memory");
        } else {
            XB_SPIN(xb_ld(&bar[XB_XGEN(b.x)]) == gen, bar);
            __builtin_amdgcn_fence(__ATOMIC_ACQUIRE, "agent");
            asm volatile("s_waitcnt vmcnt(0)" ::: "memory");
        }
    }
    __syncthreads();
}
#endif

#ifdef CPU_EMU
struct Args; static void emu_phase_hook(int ph, const Args& a);
#endif
struct Args { const float* in[38]; float* out; unsigned char* ws; int ph_lo, ph_hi; };
#ifdef CPU_EMU
typedef const Args* KARG_PTR;
#else
typedef const __attribute__((address_space(4))) Args* KARG_PTR;
#endif
struct Frame {
    LAS unsigned char* lds; int tid, lane, wave, G, gtid, gsize, gw, ngw;
    KARG_PTR ap; float* out; unsigned char* ws;
};
#define FIN(i) (F.ap->in[i])
#ifdef CPU_EMU
#define LAUNDER(F, l) do {} while (0)
#else
#define LAUNDER(F, l) do { size_t z_ = 0; asm volatile("" : "+s"(z_), "+s"(F.ap), "+s"(l), "+v"(F.tid)); F.ws = args.ws + z_; F.out = args.out + z_; F.lane = F.tid & 63; F.wave = __builtin_amdgcn_readfirstlane(F.tid >> 6); \
    F.gtid = blockIdx.x * NT + F.tid; F.gw = blockIdx.x * NWAVES + F.wave; } while (0)
#endif

DEVFN void transpose_item(const float* W, int ldw, int K, bf16* WT, int src_col0, int dst_row0, int k0, const float* sc, LAS float* scr, int lane) {
#pragma unroll 8
    for (int i = 0; i < 32; ++i) { const int kk = 2 * i + (lane >> 5); float v = W[(size_t)(k0 + kk) * ldw + src_col0 + (lane & 31)]; if (sc) v *= sc[k0 + kk]; scr[kk * 33 + (lane & 31)] = v; }
    WAVE_LDS_FENCE();
    const int c = lane & 7;
#pragma unroll
    for (int j = 0; j < 4; ++j) { const int n = (lane >> 3) + 8 * j; const LAS float* s = scr + (8 * c) * 33 + n;
        u32x4 o; o.x = pk_bf16(s[0 * 33], s[1 * 33]); o.y = pk_bf16(s[2 * 33], s[3 * 33]); o.z = pk_bf16(s[4 * 33], s[5 * 33]); o.w = pk_bf16(s[6 * 33], s[7 * 33]);
        *(u32x4*)(WT + (size_t)(dst_row0 + n) * K + k0 + 8 * c) = o; }
    WAVE_LDS_FENCE();
}
DEVFN float wave_sum(float v) {
#pragma unroll
    for (int o = 1; o < 64; o <<= 1) v += shfl_xor_f32(v, o);
    return v;
}
DEVFN void p_prologue(Frame& F) {
    LAS float* scr = (LAS float*)(F.lds + F.wave * 16384);
    constexpr int I_IN = 16 * 60, I_OUT = 16 * 32, I_UP = 16 * 176, I_DN = 44 * 32, I_GLU = 6 * 12, I_L = I_IN + I_OUT + I_UP + I_DN + I_GLU;
    for (int it = F.gw; it < 2 * I_L; it += F.ngw) {
        const int l = it / I_L; int r = it % I_L;
        if (r < I_IN) { const int kb = r / 60, nb = r % 60; transpose_item(FIN(2) + (size_t)l * D * NIN, NIN, D, (bf16*)(F.ws + WS_WIN + l * SZ_WIN), 32 * nb, 32 * nb, 64 * kb, FIN(1) + l * D, scr, F.lane); continue; } r -= I_IN;
        if (r < I_OUT) { const int kb = r / 32, nb = r % 32; transpose_item(FIN(31) + (size_t)l * D * D, D, D, (bf16*)(F.ws + WS_WOUT + l * SZ_WOUT), 32 * nb, 32 * nb, 64 * kb, FIN(30) + l * D, scr, F.lane); continue; } r -= I_OUT;
        if (r < I_UP) { const int kb = r / 176, nb = r % 176, sc0 = 32 * nb, half = sc0 / FF, jj = sc0 % FF, pn = jj / 128;
            transpose_item(FIN(33) + (size_t)l * D * FF2, FF2, D, (bf16*)(F.ws + WS_WUP + l * SZ_WUP), sc0, 256 * pn + 128 * half + (jj % 128), 64 * kb, FIN(32) + l * D, scr, F.lane); continue; } r -= I_UP;
        if (r < I_DN) { const int kb = r / 32, nb = r % 32; transpose_item(FIN(36) + (size_t)l * FF * D, D, FF, (bf16*)(F.ws + WS_WDN + l * SZ_WDN), 32 * nb, 32 * nb, 64 * kb, nullptr, scr, F.lane); continue; } r -= I_DN;
        { const int kb = r / 12, nb = r % 12; transpose_item(FIN(18) + (size_t)l * S5W * S5W, S5W, S5W, (bf16*)(F.ws + WS_WGLU + l * SZ_WGLU), 32 * nb, 32 * nb, 64 * kb, nullptr, scr, F.lane); }
    }
    for (int i = F.gtid; i < 2 * (128 * D / 8); i += F.gsize) { const int l = i / (128 * D / 8), r = i % (128 * D / 8); ((u32x4*)(F.ws + WS_WIN + l * SZ_WIN + (size_t)NIN * D * 2))[r] = (u32x4){0u, 0u, 0u, 0u}; }
    for (int i = F.gtid; i < 2 * (128 * S5W / 8); i += F.gsize) { const int l = i / (128 * S5W / 8), r = i % (128 * S5W / 8); ((u32x4*)(F.ws + WS_WGLU + l * SZ_WGLU + (size_t)S5W * S5W * 2))[r] = (u32x4){0u, 0u, 0u, 0u}; }
    float* ssq = (float*)(F.ws + WS_SSQ); bf16* hb = (bf16*)(F.ws + WS_HB);
    for (int m = F.gw; m < M; m += F.ngw) {
        const f32x4* xr = (const f32x4*)(FIN(0) + (size_t)m * D) + F.lane; f32x4* hr = (f32x4*)(F.out + (size_t)m * D) + F.lane; u32x2* br = (u32x2*)(hb + (size_t)m * D) + F.lane; float s = 0.f;
#pragma unroll
        for (int j = 0; j < 4; ++j) { const f32x4 v = xr[64 * j]; hr[64 * j] = v; u32x2 w; w.x = pk_bf16(v[0], v[1]); w.y = pk_bf16(v[2], v[3]); br[64 * j] = w; s += (v[0] * v[0] + v[1] * v[1]) + (v[2] * v[2] + v[3] * v[3]); }
        s = wave_sum(s);
        if (F.lane < 16) ssq[(size_t)m * 16 + F.lane] = F.lane == 0 ? s : 0.f;
    }
    for (int i = F.gtid; i < 2 * 3072; i += F.gsize) { const int l = i / 3072, r = i % 3072, dg = r / 64, p = r % 64;
        const float lr = FIN(10)[i], li = FIN(11)[i], dt = expf(FIN(12)[l * 48 + dg]);
        const float mag = expf(lr * dt), ar = mag * cosf(li * dt), ai = mag * sinf(li * dt);
        const float den = lr * lr + li * li, nr = ar - 1.0f, ni = ai, cr = (nr * lr + ni * li) / den, ci = (ni * lr - nr * li) / den;
        ((f32x2*)(F.ws + WS_S5A))[i] = (f32x2){ar, ai};
        const float m16 = expf(16.0f * lr * dt); ((f32x2*)(F.ws + WS_S5A16))[i] = (f32x2){m16 * cosf(16.0f * li * dt), m16 * sinf(16.0f * li * dt)};
        bf16* bt = (bf16*)(F.ws + WS_S5BT) + ((size_t)(l * 48 + dg) * 2) * 64 * 16; bf16* ct = (bf16*)(F.ws + WS_S5CT) + (size_t)(l * 48 + dg) * 16 * 128;
        for (int c = 0; c < 16; ++c) { const float br = FIN(13)[(size_t)i * 16 + c], bi = FIN(14)[(size_t)i * 16 + c];
            bt[(size_t)p * 16 + c] = f2bf_(cr * br - ci * bi); bt[(size_t)(64 + p) * 16 + c] = f2bf_(cr * bi + ci * br);
            const size_t ci_ = ((size_t)(l * 48 + dg) * 16 + c) * 64 + p;
            ct[(size_t)c * 128 + 2 * p] = f2bf_(FIN(15)[ci_]); ct[(size_t)c * 128 + 2 * p + 1] = f2bf_(-FIN(16)[ci_]); } }
    for (int i = F.gtid; i < 2 * 2 * RGW; i += F.gsize) ((float*)(F.ws + WS_RGSP))[i] = 8.0f * softplus_f(-FIN(9)[i]);
    for (int i = F.gtid; i < 2 * L * 64; i += F.gsize) { const int l = i / (L * 64), r = i % (L * 64), pos = r / 64, mm = r % 64;
        const float* w1 = FIN(22) + l * 33 * 64; const float t = (float)pos / (float)(L - 1 > 1 ? L - 1 : 1), w = (6.283185307179586f / (float)L) * (float)pos;
        float acc = FIN(23)[l * 64 + mm] + t * w1[mm];
        for (int q = 0; q < 16; ++q) { const float band = 1e-4f + (float)q * ((15.0f - 1e-4f) / 15.0f), ang = w * band; acc += cosf(ang) * w1[(1 + q) * 64 + mm] - sinf(ang) * w1[(17 + q) * 64 + mm]; }
        ((float*)(F.ws + WS_HID))[i] = sinf(FIN(24)[l * 64 + mm] * acc); }
}
DEVFN void p_hid2(Frame& F, int l) {
    const float* hid1 = (const float*)(F.ws + WS_HID) + (size_t)l * L * 64; float* hid2 = (float*)(F.ws + WS_HID) + (size_t)(2 + l) * L * 64;
    for (int i = F.gtid; i < L * 64; i += F.gsize) { const int pos = i / 64, mm = i % 64; float acc = FIN(26)[l * 64 + mm];
        for (int q = 0; q < 64; ++q) acc += hid1[pos * 64 + q] * FIN(25)[l * 4096 + q * 64 + mm];
        hid2[i] = sinf(FIN(27)[l * 64 + mm] * acc); }
}

DEVFN float ldproj(const bf16* proj, size_t m, int col) { return bf2f_(proj[m * NINP + col]); }
DEVFN void p_mix1(Frame& F, int l) {
    const bf16* proj = (const bf16*)(F.ws + WS_PROJ);
    { float* u = (float*)(F.ws + WS_T0); const float* cw = FIN(3) + l * 4 * RGW; const float* cb = FIN(4) + l * RGW;
      for (int i = F.gtid; i < M * RGW; i += F.gsize) { const int m = i / RGW, c = i % RGW, t = m % L; float s = cb[c];
#pragma unroll
          for (int k = 0; k < 4; ++k) { const int tt = t + k - 1; if (tt >= 0 && tt < L) s += cw[k * RGW + c] * ldproj(proj, m + k - 1, c); }
          u[i] = s; } }
    { float* z = (float*)(F.ws + WS_Z); float* x0c = (float*)(F.ws + WS_X0C); const float* cw = FIN(20) + l * 3 * 768; const float* cb = FIN(21) + l * 768;
      for (int i = F.gtid; i < M * HYW; i += F.gsize) { const int m = i / HYW, c = i % HYW, t = m % L; float q[3];
#pragma unroll
          for (int part = 0; part < 3; ++part) { const int col = part * HYW + c; float s = cb[col];
#pragma unroll
              for (int k = 0; k < 3; ++k) { const int tt = t + k - 1; if (tt >= 0 && tt < L) s += cw[k * 768 + col] * ldproj(proj, m + k - 1, 3 * RGW + col); }
              q[part] = s; }
          z[i] = q[2] * q[1]; x0c[i] = q[0]; } }
    { const float* hid2 = (const float*)(F.ws + WS_HID) + (size_t)(2 + l) * L * 64; const float* w3 = FIN(28) + (size_t)l * 64 * 512; float* kfb = (float*)(F.ws + WS_KFB);
      const float maxd = logf(1e-2f) / 0.3f, mind = logf(1e-2f) / 1.5f;
      for (int i = F.gtid; i < L * 512; i += F.gsize) { const int pos = i / 512, c2 = i % 512, c = c2 % 256; float acc = 0.f;
          for (int q = 0; q < 64; ++q) acc += hid2[pos * 64 + q] * w3[q * 512 + c2];
          const float delta = fabsf(mind + (float)c * ((maxd - mind) / 255.0f)), t = (float)pos / (float)(L - 1 > 1 ? L - 1 : 1);
          kfb[i] = acc * expf(-t * delta); } }
}
DEVFN void p_mix2(Frame& F, int l) {
    const bf16* proj = (const bf16*)(F.ws + WS_PROJ); bf16* ymix = (bf16*)(F.ws + WS_YMIX);
    if (F.gtid < Bn * RGW) { const int i = F.gtid, b = i / RGW, c = i % RGW, hd = c / 64, j = c % 64;
        const float* u = (const float*)(F.ws + WS_T0); bf16* hf = (bf16*)(F.ws + WS_THF);
        const float* wa = FIN(5) + (size_t)l * 2 * 6 * 4096; const float* wx = FIN(7) + (size_t)l * 2 * 6 * 4096;
        for (int d = 0; d < 2; ++d) {
            const float sp8 = ((const float*)(F.ws + WS_RGSP))[l * 2 * RGW + d * RGW + c];
            const float* Wa = wa + ((size_t)(d * 6 + hd) * 64) * 64 + j; const float* Wx = wx + ((size_t)(d * 6 + hd) * 64) * 64 + j;
            const float bra = FIN(6)[l * 2 * RGW + d * RGW + c], brx = FIN(8)[l * 2 * RGW + d * RGW + c];
            float h = 0.f;
            for (int s = 0; s < L; ++s) { const int t = d == 0 ? s : L - 1 - s; const size_t m = (size_t)b * L + t;
                const float* ur = u + m * RGW + hd * 64; float ar = bra, ax = brx;
                for (int q = 0; q < 64; ++q) { const float uu = ur[q]; ar += uu * Wa[q * 64]; ax += uu * Wx[q * 64]; }
                const float r = sigmoid_f(ar), ig = sigmoid_f(ax);
                const float la = -r * sp8, a = exp_f(la), mult = sqrtf(-expm1_f(2.0f * la));
                h = a * h + mult * (ig * ur[j]);
                if (d == 0) hf[m * RGW + c] = f2bf_(h); else ymix[m * D + c] = f2bf_((bf2f_(hf[m * RGW + c]) + h) * gelu_f(ldproj(proj, m, RGW + c))); } } }
    { const float* z = (const float*)(F.ws + WS_Z); const float* x0c = (const float*)(F.ws + WS_X0C); const float* kfb = (const float*)(F.ws + WS_KFB); const float* bias = FIN(29) + l * HYW;
      for (int i = F.gtid; i < M * HYW; i += F.gsize) { const int m = i / HYW, c = i % HYW, t = m % L, b = m / L;
          const float* zb = z + (size_t)b * L * HYW + c; float acc = 0.f;
          for (int s = 0; s <= t; ++s) acc += kfb[(size_t)(t - s) * 512 + c] * zb[(size_t)s * HYW];
          for (int s = t; s < L; ++s) acc += kfb[(size_t)(s - t) * 512 + 256 + c] * zb[(size_t)s * HYW];
          ymix[(size_t)m * D + RGW + S5W + c] = f2bf_((acc + z[i] * bias[c]) * x0c[i]); } }
}
constexpr int NG16 = L / 16, NT32 = M / 32, S5_HS = 272  , S5_YS = 784  ;
DEVFN int tau32(int rho) { return 16 * ((rho >> 2) & 1) + (rho & 3) + 4 * (rho >> 3); }
DEVFN void s5_tile(Frame& F, int l, int tile, const bool stage3) {
    const int lane = F.lane, w = F.wave, hh = lane >> 5, pl = lane & 31, m0 = tile * 32, b = m0 / L, grp = (m0 % L) / 16 + hh;
    const bf16* proj = (const bf16*)(F.ws + WS_PROJ); const bf16* BT = (const bf16*)(F.ws + WS_S5BT); const bf16* CT = (const bf16*)(F.ws + WS_S5CT);
    const f32x2* SA = (const f32x2*)(F.ws + WS_S5A); f32x2* SS = (f32x2*)(F.ws + WS_S5S);
    LAS unsigned char* Hw = F.lds + w * (32 * S5_HS); LAS unsigned char* YT = F.lds + 8 * 32 * S5_HS;
    const f32x16 z16 = {0.f, 0.f, 0.f, 0.f, 0.f, 0.f, 0.f, 0.f, 0.f, 0.f, 0.f, 0.f, 0.f, 0.f, 0.f, 0.f};
#pragma unroll 1
    for (int gi = 0; gi < 3; ++gi) { const int g = w + 8 * gi;
        const bf16x8 ua = *(const bf16x8*)(proj + (size_t)(m0 + tau32(pl)) * NINP + 2 * RGW + 16 * g + 8 * hh);
        f32x4 yacc[2] = {(f32x4){0.f, 0.f, 0.f, 0.f}, (f32x4){0.f, 0.f, 0.f, 0.f}};
#pragma unroll
        for (int d = 0; d < 2; ++d) { const size_t dg = (size_t)(l * 2 + d) * 24 + g;
            f32x16 acc[2][2];
            bf16x8 bb[2][2];
#pragma unroll
            for (int ri = 0; ri < 2; ++ri)
#pragma unroll
                for (int ph = 0; ph < 2; ++ph) bb[ri][ph] = *(const bf16x8*)(BT + ((dg * 2 + ri) * 64 + 32 * ph + pl) * 16 + 8 * hh);
            { bf16x8 ub = ua; FRESH(ub); FRESH(bb[0][0]); FRESH(bb[0][1]); FRESH(bb[1][0]); FRESH(bb[1][1]);
#pragma unroll
            for (int ri = 0; ri < 2; ++ri)
#pragma unroll
                for (int ph = 0; ph < 2; ++ph) { f32x16 zz = z16; OPAQUE16(zz); acc[ri][ph] = mfma32(ub, bb[ri][ph], zz); }
            MFMA_GUARD(ACC4(acc[0][0], acc[0][1], acc[1][0], acc[1][1]), KV(ub), KV(bb[0][0]), KV(bb[0][1]), KV(bb[1][0]), KV(bb[1][1])); }
#pragma unroll
            for (int ph = 0; ph < 2; ++ph) { const f32x2 A = SA[dg * 64 + 32 * ph + pl]; const size_t sidx = (((size_t)b * NG16 + grp) * 2 + d) * 1536 + g * 64 + 32 * ph + pl;
                float hr = 0.f, hi = 0.f; if (stage3) { const f32x2 c = SS[sidx]; hr = c[0]; hi = c[1]; }
#pragma unroll
                for (int q = 0; q < 16; ++q) { const int reg = d == 0 ? q : 15 - q; const float nr = A[0] * hr - A[1] * hi + acc[0][ph][reg], ni = A[0] * hi + A[1] * hr + acc[1][ph][reg];
                    hr = nr; hi = ni; acc[0][ph][reg] = nr; acc[1][ph][reg] = ni; }
                if (!stage3) SS[sidx] = (f32x2){hr, hi};
                else {
#pragma unroll
                    for (int reg = 0; reg < 16; ++reg) *(LAS unsigned*)(Hw + (16 * hh + reg) * S5_HS + 4 * (32 * ph + pl)) = pk_bf16(acc[0][ph][reg], acc[1][ph][reg]); } }
            if (stage3) { WAVE_LDS_FENCE();
#pragma unroll
                for (int rt = 0; rt < 2; ++rt) { bf16x8 a2[4], b2[4];
#pragma unroll
                    for (int ks = 0; ks < 4; ++ks) { a2[ks] = *(const LAS bf16x8*)(Hw + (16 * rt + (lane & 15)) * S5_HS + (32 * ks + 8 * (lane >> 4)) * 2);
                        b2[ks] = *(const bf16x8*)(CT + (dg * 16 + (lane & 15)) * 128 + 32 * ks + 8 * (lane >> 4)); }
                    FRESH(b2[0]); FRESH(b2[1]); FRESH(b2[2]); FRESH(b2[3]); FRESH(a2[0]); FRESH(a2[1]); FRESH(a2[2]); FRESH(a2[3]);
#pragma unroll
                    for (int ks = 0; ks < 4; ++ks) yacc[rt] = mfma16(a2[ks], b2[ks], yacc[rt]);
                    MFMA_GUARD(ACC1(yacc[rt]), KV(a2[0]), KV(a2[1]), KV(a2[2]), KV(a2[3]), KV(b2[0]), KV(b2[1]), KV(b2[2]), KV(b2[3])); }
                WAVE_LDS_FENCE(); } }
        if (stage3) { const int c = lane & 15; const float dsk = FIN(17)[l * S5W + 16 * g + c];
#pragma unroll
            for (int rt = 0; rt < 2; ++rt)
#pragma unroll
                for (int reg = 0; reg < 4; ++reg) { const int t = 16 * rt + 4 * (lane >> 4) + reg; const float u = bf2f_(proj[(size_t)(m0 + t) * NINP + 2 * RGW + 16 * g + c]);
                    *(LAS bf16*)(YT + t * S5_YS + (16 * g + c) * 2) = f2bf_(gelu_f(yacc[rt][reg] + dsk * u)); } } }
    if (stage3) { sync_block();
        if (w < 4) {
            const bf16* WG = (const bf16*)(F.ws + WS_WGLU + l * SZ_WGLU); bf16* ymix = (bf16*)(F.ws + WS_YMIX);
            f32x16 ga[3] = {z16, z16, z16};
#pragma unroll 2
            for (int ks = 0; ks < 24; ++ks) { const bf16x8 a = *(const LAS bf16x8*)(YT + pl * S5_YS + (16 * ks + 8 * hh) * 2); bf16x8 bq[3];
#pragma unroll
                for (int j = 0; j < 3; ++j) bq[j] = *(const bf16x8*)(WG + (size_t)(32 * (w + 4 * j) + pl) * S5W + 16 * ks + 8 * hh);
                FRESH(bq[0]); FRESH(bq[1]); FRESH(bq[2]);
#pragma unroll
                for (int j = 0; j < 3; ++j) ga[j] = mfma32(a, bq[j], ga[j]);
                MFMA_GUARD(ACC3(ga[0], ga[1], ga[2]), KV(a), KV(bq[0]), KV(bq[1]), KV(bq[2])); }
#pragma unroll
            for (int j = 0; j < 3; ++j) { const int n = 32 * (w + 4 * j) + pl; const float bias = FIN(19)[l * S5W + n];
#pragma unroll
                for (int reg = 0; reg < 16; ++reg) { const int t = (reg & 3) + 8 * (reg >> 2) + 4 * hh; const float y = bf2f_(*(const LAS bf16*)(YT + t * S5_YS + n * 2));
                    ymix[(size_t)(m0 + t) * D + RGW + n] = f2bf_(y * sigmoid_f(ga[j][reg] + bias)); } } }
        sync_block(); }
}
DEVFN void p_s5_stage(Frame& F, int l, const bool stage3) { for (int tile = blockIdx.x; tile < NT32; tile += F.G) s5_tile(F, l, tile, stage3); }
DEVFN void p_s5_carry(Frame& F, int l) {
    f32x2* SS = (f32x2*)(F.ws + WS_S5S); const f32x2* A16 = (const f32x2*)(F.ws + WS_S5A16);
    for (int i = F.gtid; i < Bn * 2 * 1536; i += F.gsize) { const int gp = i % 1536, d = (i / 1536) % 2, b = i / 3072; const f32x2 A = A16[(size_t)(l * 2 + d) * 1536 + gp];
        float cr = 0.f, ci = 0.f;
        for (int q = 0; q < NG16; ++q) { const int j = d == 0 ? q : NG16 - 1 - q; f32x2* sp = SS + (((size_t)b * NG16 + j) * 2 + d) * 1536 + gp; const f32x2 s = *sp; *sp = (f32x2){cr, ci};
            const float nr = A[0] * cr - A[1] * ci + s[0], ni = A[0] * ci + A[1] * cr + s[1]; cr = nr; ci = ni; } }
}
DEVFN void p_mixnorm(Frame& F) {
    bf16* ymix = (bf16*)(F.ws + WS_YMIX);
    for (int m = F.gw; m < M; m += F.ngw) { u32x4* row = (u32x4*)(ymix + (size_t)m * D);
        u32x4 v[2]; float s[2];
#pragma unroll
        for (int j = 0; j < 2; ++j) { v[j] = row[F.lane + 64 * j]; const float a0 = bf_lo(v[j].x), a1 = bf_hi(v[j].x), a2 = bf_lo(v[j].y), a3 = bf_hi(v[j].y), a4 = bf_lo(v[j].z), a5 = bf_hi(v[j].z), a6 = bf_lo(v[j].w), a7 = bf_hi(v[j].w);
            s[j] = ((a0 * a0 + a1 * a1) + (a2 * a2 + a3 * a3)) + ((a4 * a4 + a5 * a5) + (a6 * a6 + a7 * a7)); }
        const float sa = wave_sum(F.lane < 48 ? s[0] : 0.f), sb = wave_sum((F.lane >= 48 ? s[0] : 0.f) + (F.lane < 32 ? s[1] : 0.f)), sc = wave_sum(F.lane >= 32 ? s[1] : 0.f);
        const float ia = 1.0f / sqrtf(sa * (1.0f / RGW) + 1e-6f), ib = 1.0f / sqrtf(sb * (1.0f / S5W) + 1e-6f), ic = 1.0f / sqrtf(sc * (1.0f / HYW) + 1e-6f);
#pragma unroll
        for (int j = 0; j < 2; ++j) { const int ch = F.lane + 64 * j; const float f = ch < 48 ? ia : (ch < 96 ? ib : ic); u32x4 o;
            o.x = pk_bf16(bf_lo(v[j].x) * f, bf_hi(v[j].x) * f); o.y = pk_bf16(bf_lo(v[j].y) * f, bf_hi(v[j].y) * f); o.z = pk_bf16(bf_lo(v[j].z) * f, bf_hi(v[j].z) * f); o.w = pk_bf16(bf_lo(v[j].w) * f, bf_hi(v[j].w) * f);
            row[ch] = o; } }
}
DEVFN void p_final(Frame& F) {
    const float* ssq = (const float*)(F.ws + WS_SSQ); const f32x4* g4 = (const f32x4*)FIN(37) + F.lane;
    for (int m = F.gw; m < M; m += F.ngw) { const float inv = pg8::row_inv(ssq, m); f32x4* hr = (f32x4*)(F.out + (size_t)m * D) + F.lane;
#pragma unroll
        for (int j = 0; j < 4; ++j) hr[64 * j] = hr[64 * j] * inv * g4[64 * j]; }
}

constexpr int PH_PER_LAYER = 9, N_PHASES = 2 + 2 * PH_PER_LAYER;
__global__ void __launch_bounds__(NT, 2) mk_fwd(Args args) {
#ifdef CPU_EMU
    unsigned char* lds = emu_lds_base();
#else
    extern __shared__ __attribute__((aligned(16))) unsigned char lds_[];
    LAS unsigned char* lds = (LAS unsigned char*)lds_;
#endif
    Frame F; F.lds = lds; F.tid = threadIdx.x; F.lane = F.tid & 63;
#ifdef CPU_EMU
    F.wave = F.tid >> 6;
#else
    F.wave = __builtin_amdgcn_readfirstlane(F.tid >> 6);
#endif
    F.G = gridDim.x; F.gtid = blockIdx.x * NT + F.tid; F.gsize = F.G * NT; F.gw = blockIdx.x * NWAVES + F.wave; F.ngw = F.G * NWAVES;
    #ifdef CPU_EMU
    F.ap = &args;
#else
    F.ap = (KARG_PTR)__builtin_amdgcn_kernarg_segment_ptr();
#endif
    F.out = args.out; F.ws = args.ws;
#ifndef CPU_EMU
    volatile LAS unsigned* MISC = (volatile LAS unsigned*)(lds + MISC_OFF);
    if (F.tid < 32) MISC[F.tid] = 0u;
    __syncthreads();
    XcdBarrier bar = xcd_barrier_post((unsigned*)(args.ws + WS_CTL) + CW_BAR, MISC + 8);
#define GRID_BAR() xcd_barrier(bar)
#else
#define GRID_BAR() do {} while (0)
#endif
    const int lo = args.ph_lo, hi = args.ph_hi;
#define IN(k) (lo <= (k) && (k) < hi)
#define SEAM(k) do { if (IN(k) && IN((k) + 1)) GRID_BAR(); } while (0)
#define P_SSQ ((float*)(F.ws + WS_SSQ))
#define P_HB ((bf16*)(F.ws + WS_HB))
#define P_PROJ ((bf16*)(F.ws + WS_PROJ))
#define P_YMIX ((bf16*)(F.ws + WS_YMIX))
#define P_G ((bf16*)(F.ws + WS_G))
#define P_YG ((bf16*)(F.ws + WS_YG))
    { int l0 = 0; if (IN(0)) { LAUNDER(F, l0); p_prologue(F); } }
    SEAM(0);
    for (int lq = 0; lq < 2; ++lq) {
        int l = lq; const int p0 = 1 + lq * PH_PER_LAYER;
        if (IN(p0 + 0)) { LAUNDER(F, l); p_hid2(F, l);
            pg8::Gemm g{P_HB, (const bf16*)(F.ws + WS_WIN + l * SZ_WIN), D}; pg8::StaticOrder S; S.init(M / 256, NINP / 256, F.G, (int)blockIdx.x);
            pg8::EpiIn E{P_PROJ, P_SSQ};
            pg8::gemm_phase<pg8::EpiIn, pg8::StaticOrder, true, true>(lds, F.tid, g, S, E); }
        SEAM(p0 + 0);
        if (IN(p0 + 1)) { LAUNDER(F, l); p_mix1(F, l); p_s5_stage(F, l, false); }
        SEAM(p0 + 1);
        if (IN(p0 + 2)) { LAUNDER(F, l); p_s5_carry(F, l); p_mix2(F, l); }
        SEAM(p0 + 2);
        if (IN(p0 + 3)) { LAUNDER(F, l); p_s5_stage(F, l, true); }
        SEAM(p0 + 3);
        SEAM(p0 + 4);
        if (IN(p0 + 5)) { LAUNDER(F, l); p_mixnorm(F); }
        SEAM(p0 + 5);
        if (IN(p0 + 6)) { LAUNDER(F, l); pg8::Gemm g{P_YMIX, (const bf16*)(F.ws + WS_WOUT + l * SZ_WOUT), D}; pg8::StaticOrder S; S.init(M / 256, D / 256, F.G, (int)blockIdx.x);
            pg8::EpiRes E{F.out, P_HB, P_SSQ};
            pg8::gemm_phase<pg8::EpiRes, pg8::StaticOrder, true, true>(lds, F.tid, g, S, E); }
        SEAM(p0 + 6);
        if (IN(p0 + 7)) { LAUNDER(F, l); pg8::Gemm g{P_HB, (const bf16*)(F.ws + WS_WUP + l * SZ_WUP), D}; pg8::UpOrder S; S.init(Bn * NQ, FF2 / 256, F.G, (int)blockIdx.x);
            pg8::EpiUp E{P_G, P_SSQ, FIN(34) + (size_t)l * 3 * FF2, FIN(35) + (size_t)l * FF2};
            pg8::gemm_phase<pg8::EpiUp, pg8::UpOrder, true, true>(lds, F.tid, g, S, E); }
        SEAM(p0 + 7);
        if (IN(p0 + 8)) { LAUNDER(F, l); pg8::Gemm g{P_G, (const bf16*)(F.ws + WS_WDN + l * SZ_WDN), FF}; pg8::StaticOrder S; S.init(M / 256, D / 256, F.G, (int)blockIdx.x);
            pg8::EpiRes E{F.out, P_HB, P_SSQ};
            pg8::gemm_phase<pg8::EpiRes, pg8::StaticOrder, true, true>(lds, F.tid, g, S, E); }
        SEAM(p0 + 8);
    }
    { int l0 = 0; if (IN(N_PHASES - 1)) { LAUNDER(F, l0); p_final(F); } }
#undef IN
#undef SEAM
}

#ifndef MK_N_LAUNCHES
#define MK_N_LAUNCHES 1
#endif
extern "C" void kernel_launch(void* const* d_in, const int* in_sizes, int n_in, void* d_out, int out_size, void* d_ws, size_t ws_size, hipStream_t stream) {
    Args a{};
    for (int i = 0; i < 38; ++i) a.in[i] = (const float*)d_in[i];
    a.out = (float*)d_out; a.ws = (unsigned char*)d_ws;
#ifdef CPU_EMU
    const int grid = EMU_GRID;
    for (int ph = 0; ph < N_PHASES; ++ph) { a.ph_lo = ph; a.ph_hi = ph + 1; LAUNCH(mk_fwd, dim3(grid), dim3(NT), LDS_BYTES, stream, a); emu_phase_hook(ph, a); }
#else
    static int grid = 0;
    if (grid == 0) {
        if (n_in != 38 || out_size != M * D || ws_size < WS_END) { fprintf(stderr, "kernel_launch: unexpected shapes (n_in %d out %d ws %zu need %zu)\n", n_in, out_size, ws_size, (size_t)WS_END); grid = -1; return; }
        int dev = 0, cus = 0, per_cu = 0;
        if (hipGetDevice(&dev) != hipSuccess || hipDeviceGetAttribute(&cus, hipDeviceAttributeMultiprocessorCount, dev) != hipSuccess) { grid = -1; return; }
        if (hipFuncSetAttribute((const void*)mk_fwd, hipFuncAttributeMaxDynamicSharedMemorySize, LDS_BYTES) != hipSuccess) { fprintf(stderr, "kernel_launch: hipFuncSetAttribute failed\n"); grid = -1; return; }
        if (hipOccupancyMaxActiveBlocksPerMultiprocessor(&per_cu, (const void*)mk_fwd, NT, LDS_BYTES) != hipSuccess || per_cu < 1) { fprintf(stderr, "kernel_launch: occupancy query says %d\n", per_cu); (void)hipGetLastError(); per_cu = 1; }
        grid = cus;
    }
    if (grid < 0) return;
    (void)hipMemsetAsync((char*)d_ws + WS_CTL, 0, CTL_BYTES, stream);
#if MK_N_LAUNCHES == 1
    a.ph_lo = 0; a.ph_hi = N_PHASES;
    hipLaunchKernelGGL(mk_fwd, dim3(grid), dim3(NT), LDS_BYTES, stream, a);
#else
    for (int ph = 0; ph < N_PHASES; ++ph) { a.ph_lo = ph; a.ph_hi = ph + 1; hipLaunchKernelGGL(mk_fwd, dim3(grid), dim3(NT), LDS_BYTES, stream, a); }
#endif
#endif
}
```

```cpp
#ifdef CPU_EMU
#include "emu.h"
#define LAS
#define GAS
#define DEVFN static inline
#define MEMFN inline
#define WAVE_LDS_FENCE() emu::wave_sync()
#define OPAQUE16(x) do {} while (0)
#define OPAQUE_V(x) do {} while (0)
#define FRESH(x) do {} while (0)
#define MFMA_GUARD(...) do {} while (0)
#define KV(x) 0
#define ACC1(a) 0
#define ACC2(a, b) 0
#define ACC3(a, b, c) 0
#define ACC4(a, b, c, d) 0
#else
#include <hip/hip_runtime.h>
#include <cstdio>
#include <cstdint>
#define LAS __attribute__((address_space(3)))
#define GAS __attribute__((address_space(1)))
#define DEVFN __device__ __forceinline__
#define MEMFN __device__ __forceinline__
#define WAVE_LDS_FENCE() do { asm volatile("s_waitcnt lgkmcnt(0)" ::: "memory"); } while (0)
#define OPAQUE16(x) asm volatile("" : "+v"(x))
#define OPAQUE_V(x) asm volatile("" : "+v"(x))
#define FRESH(x) asm volatile("s_nop 3" : "+v"(x))
#define KV(x) "v"(x)
#define KA(x) "+v"(x)
#define MFMA_GUARD(accs, ...) asm volatile("s_nop 7\n\ts_nop 7\n\ts_nop 7\n\ts_nop 7" : accs : __VA_ARGS__)
#define ACC1(a) KA(a)
#define ACC2(a, b) KA(a), KA(b)
#define ACC3(a, b, c) KA(a), KA(b), KA(c)
#define ACC4(a, b, c, d) KA(a), KA(b), KA(c), KA(d)
typedef short bf16x8 __attribute__((ext_vector_type(8)));
typedef float f32x4 __attribute__((ext_vector_type(4)));
typedef float f32x2 __attribute__((ext_vector_type(2)));
typedef float f32x16 __attribute__((ext_vector_type(16)));
typedef unsigned u32x4 __attribute__((ext_vector_type(4)));
typedef unsigned u32x2 __attribute__((ext_vector_type(2)));
typedef __bf16 bf16x2_t __attribute__((ext_vector_type(2)));
DEVFN void sync_block() { __syncthreads(); }
DEVFN int lane_id() { int l; asm volatile("v_mbcnt_lo_u32_b32 %0, -1, 0\n\tv_mbcnt_hi_u32_b32 %0, -1, %0" : "=v"(l)); return l; }
DEVFN f32x16 mfma32(bf16x8 a, bf16x8 b, f32x16 c) { return __builtin_amdgcn_mfma_f32_32x32x16_bf16(a, b, c, 0, 0, 0); }
DEVFN f32x4 mfma16(bf16x8 a, bf16x8 b, f32x4 c) { return __builtin_amdgcn_mfma_f32_16x16x32_bf16(a, b, c, 0, 0, 0); }
DEVFN float shfl_f32(float v, int src) { return __builtin_bit_cast(float, __builtin_amdgcn_ds_bpermute(src << 2, __builtin_bit_cast(int, v))); }
DEVFN float shfl_xor_f32(float v, int m) { return shfl_f32(v, lane_id() ^ m); }
DEVFN float dpp_row_shr1(float old, float src) { return __builtin_bit_cast(float, __builtin_amdgcn_update_dpp(__builtin_bit_cast(int, old), __builtin_bit_cast(int, src), 0x111, 0xf, 0xf, false)); }
DEVFN float dpp_row_shl1(float old, float src) { return __builtin_bit_cast(float, __builtin_amdgcn_update_dpp(__builtin_bit_cast(int, old), __builtin_bit_cast(int, src), 0x101, 0xf, 0xf, false)); }
DEVFN float dpp_row_ror1(float src) { return __builtin_bit_cast(float, __builtin_amdgcn_update_dpp(0, __builtin_bit_cast(int, src), 0x121, 0xf, 0xf, false)); }
DEVFN float dpp_row_ror15(float src) { return __builtin_bit_cast(float, __builtin_amdgcn_update_dpp(0, __builtin_bit_cast(int, src), 0x12f, 0xf, 0xf, false)); }
DEVFN unsigned pk_bf16(float lo, float hi) { f32x2 v = {lo, hi}; bf16x2_t b = __builtin_convertvector(v, bf16x2_t); return __builtin_bit_cast(unsigned, b); }
DEVFN float bf_lo(unsigned u) { return __builtin_bit_cast(float, u << 16); }
DEVFN float bf_hi(unsigned u) { return __builtin_bit_cast(float, u & 0xffff0000u); }
DEVFN float fast_rcp(float x) { return __builtin_amdgcn_rcpf(x); }
DEVFN float fast_exp2(float x) { return __builtin_amdgcn_exp2f(x); }
#endif

#ifndef BATCH
#define BATCH 4
#endif
#ifndef SEQ
#define SEQ 4096
#endif
typedef unsigned short bf16;
constexpr int Bn = BATCH, L = SEQ, M = Bn * L, D = 1024, NIN = 1920, NINP = 2048, RGW = 384, S5W = 384, HYW = 256, FF = 2816, FF2 = 5632, GLUP = 512;
constexpr int NWAVES = 8, NT = NWAVES * 64;
constexpr int UPS = 254, NQ = (L + UPS - 1) / UPS;

constexpr size_t al256(size_t x) { return (x + 255) & ~(size_t)255; }
constexpr size_t WS_CTL = 0, CTL_BYTES = 1u << 20;
constexpr size_t WS_SSQ = WS_CTL + CTL_BYTES, SZ_SSQ = (size_t)M * 16 * 4;
constexpr size_t WS_S5A = WS_SSQ + SZ_SSQ, SZ_S5A = (size_t)2 * 2 * 24 * 64 * 8;
constexpr size_t WS_S5A16 = WS_S5A + SZ_S5A;
constexpr size_t WS_S5BT = WS_S5A16 + SZ_S5A, SZ_S5BT = (size_t)2 * 2 * 24 * 2 * 64 * 16 * 2;
constexpr size_t WS_S5CT = WS_S5BT + SZ_S5BT, SZ_S5CT = (size_t)2 * 2 * 24 * 16 * 128 * 2;
constexpr size_t WS_RGSP = WS_S5CT + SZ_S5CT, SZ_RGSP = al256((size_t)2 * 2 * 384 * 4);
constexpr size_t WS_RGWT = WS_RGSP + SZ_RGSP, SZ_RGWT = (size_t)2 * 2 * 2 * 6 * 64 * 64 * 2;
constexpr size_t WS_RGAG = WS_RGWT + SZ_RGWT, SZ_RGAG = (size_t)(M / 16) * 2 * RGW * 8;
constexpr size_t WS_RGCI = WS_RGAG + SZ_RGAG, SZ_RGCI = (size_t)(M / 16) * 2 * RGW * 4;
constexpr size_t WS_HID = WS_RGCI + SZ_RGCI, SZ_HID = (size_t)4 * L * 64 * 4;
constexpr size_t WS_T1 = WS_HID + SZ_HID, SZ_T1 = (size_t)(M / 16) * 2 * 1536 * 8;
constexpr size_t WS_S5S = WS_T1;
constexpr size_t WS_S5CI = WS_T1 + SZ_T1, SZ_S5CI = SZ_T1;
constexpr size_t WS_KFB = WS_S5CI + SZ_S5CI, SZ_KFB = (size_t)L * 512 * 4;
constexpr size_t SZ_WIN = (size_t)NINP * D * 2, SZ_WOUT = (size_t)D * D * 2, SZ_WUP = (size_t)FF2 * D * 2, SZ_WDN = (size_t)D * FF * 2, SZ_WGLU = (size_t)GLUP * S5W * 2;
constexpr size_t WS_WIN = WS_KFB + SZ_KFB, WS_WOUT = WS_WIN + 2 * SZ_WIN, WS_WUP = WS_WOUT + 2 * SZ_WOUT, WS_WDN = WS_WUP + 2 * SZ_WUP, WS_WGLU = WS_WDN + 2 * SZ_WDN;
constexpr size_t WS_HBPAD = WS_WGLU + 2 * SZ_WGLU, HB_FRONT = (size_t)256 * D * 2, WS_HB = WS_HBPAD + HB_FRONT, SZ_HBPAD = (size_t)(M + 768) * D * 2;
constexpr size_t WS_PROJ = WS_HBPAD + SZ_HBPAD, SZ_PROJ = (size_t)M * NINP * 2;
constexpr size_t WS_YMIX = WS_PROJ + SZ_PROJ, SZ_YMIX = (size_t)M * D * 2;
constexpr size_t WS_G = WS_PROJ;
constexpr size_t WS_END = WS_YMIX + SZ_YMIX;
constexpr size_t WS_Z = WS_HB, WS_X0C = WS_HB + (size_t)M * 256 * 4;
static_assert(SZ_PROJ + SZ_YMIX >= (size_t)M * FF * 2, "g overlay");
static_assert((size_t)2 * M * 256 * 4 <= (size_t)M * D * 2, "z/x0c overlay");
static_assert(BATCH != 4 || SEQ != 4096 || WS_END <= ((size_t)256 << 20), "workspace over 256 MiB");

DEVFN float gelu_f(float x) { const float y = 1.5957691216057308f * (x + 0.044715f * x * x * x); return x * fast_rcp(1.0f + fast_exp2(-1.4426950408889634f * y)); }
DEVFN float sigmoid_f(float x) { return fast_rcp(1.0f + fast_exp2(-1.4426950408889634f * x)); }
DEVFN float softplus_f(float x) { return x > 0.f ? x + log1pf(expf(-x)) : log1pf(expf(x)); }
DEVFN float exp_f(float x) { return fast_exp2(1.4426950408889634f * x); }
DEVFN float expm1_f(float x) {
    const float p = x * (1.0f + x * (0.5f + x * (0.16666667f + x * (0.041666668f + x * (0.008333334f + x * 0.0013888889f)))));
    return fabsf(x) < 0.25f ? p : exp_f(x) - 1.0f; }
DEVFN float bf2f_(bf16 h) { return bf_lo((unsigned)h); }
DEVFN bf16 f2bf_(float f) { return (bf16)(pk_bf16(f, 0.f) & 0xffffu); }

namespace pg8 {
constexpr int BM = 256, BK = 64, HALF = 128, HTB = HALF * BK * 2, STAGE_BYTES = 8 * HTB, NXCD = 8, WGM = 8;
__host__ __device__ __forceinline__ int lds_byte(int r, int c) { const int st = (r >> 4) * 2 + (c >> 5), rr = r & 15, cc = c & 31, ob = rr * 64 + cc * 2; return st * 1024 + (ob ^ (((ob >> 9) & 1) << 5)); }
__host__ __device__ __forceinline__ void stage_rc(int b, int& R, int& C) { const int st = b / 1024, sb = b % 1024, swz = sb ^ (((sb >> 9) & 1) << 5); R = (st >> 1) * 16 + swz / 64; C = (st & 1) * 32 + (swz % 64) / 2; }
__host__ __device__ __forceinline__ int perm32(int rho) { const int n = rho >> 4, i = rho & 15; return 8 * (i >> 2) + 4 * n + (i & 3); }

struct Unit { int pm, pn; int arow; };
struct Gemm { const bf16* A; const bf16* Bt; int K; };

struct StaticOrder {
    int nM, nN, nwg, G, c;
    __host__ __device__ void init(int nM_, int nN_, int G_, int c_) { nM = nM_; nN = nN_; nwg = nM * nN; G = G_; c = c_; }
    __host__ __device__ bool next(int i, Unit& u) const {
        const long Lx = (long)i * G + c; if (Lx >= nwg) return false;
        int wgid = (int)Lx; { const int q = nwg / NXCD, r = nwg % NXCD, xcd = wgid % NXCD, off = wgid / NXCD; wgid = (xcd < r ? xcd * (q + 1) : r * (q + 1) + (xcd - r) * q) + off; }
        const int nig = WGM * nN, gid = wgid / nig, fm = gid * WGM, gsz = (nM - fm) < WGM ? (nM - fm) : WGM;
        u.pm = fm + ((wgid % nig) % gsz); u.pn = (wgid % nig) / gsz; u.arow = u.pm * BM; return true;
    }
};
struct UpOrder : StaticOrder {
    __host__ __device__ bool next(int i, Unit& u) const { if (!StaticOrder::next(i, u)) return false; const int b = u.pm / NQ, q = u.pm % NQ; u.arow = b * L + UPS * q - 1; return true; }
};

#ifndef CPU_EMU
#define PG8_LAS __attribute__((address_space(3)))
template <class Epi, class Sched, bool ALIGN_EPI = false, bool SP2 = false>
__device__ __forceinline__ void gemm_phase(PG8_LAS unsigned char* lds, const int tid, const Gemm g, const Sched& S, const Epi& E) {
    const int wid = __builtin_amdgcn_readfirstlane(tid >> 6), lane = tid & 63, wr = wid >> 2, wc = wid & 3, fr = lane & 15, fq = lane >> 4;
    const int K = g.K, nt = K / BK;
    unsigned voffA[2], voffB[2];
#pragma unroll
    for (int i = 0; i < 2; ++i) { int R, C; stage_rc(tid * 16 + i * 8192, R, C); const int Rb = Epi::PERM ? ((R & ~31) + perm32(R & 31)) : R;
        voffA[i] = (unsigned)(R * K + C) * 2u; voffB[i] = (unsigned)(Rb * K + C) * 2u; }
    const size_t kstep = (size_t)(BK * 2);
    const size_t hstep = (size_t)HALF * K * 2;
    const size_t tstep = 2 * hstep;
    const size_t rstep = (size_t)K * 2;
    const unsigned ldsw = (unsigned)wid * 1024u;
    const int aoff = lds_byte(wr * 64 + fr, fq * 8), boff = lds_byte(wc * 32 + fr, fq * 8);
#define PG8_SA(b, h) (((b) * 2 + (h)) * HTB)
#define PG8_SB(b, h) ((4 + (b) * 2 + (h)) * HTB)
#define PG8_STAGE(bufoff, gbase, voff) do { _Pragma("unroll") for (int _i = 0; _i < 2; ++_i) \
        __builtin_amdgcn_global_load_lds((const unsigned*)((const char*)(gbase) + (voff)[_i]), (PG8_LAS unsigned*)(lds + (bufoff) + ldsw + _i * 8192), 16, 0, 0); } while (0)
#define PG8_LDA(dst, b, h) do { _Pragma("unroll") for (int m = 0; m < 4; ++m) _Pragma("unroll") for (int k = 0; k < 2; ++k) dst[m][k] = *(const PG8_LAS bf16x8*)(lds + PG8_SA(b, h) + aoff + m * 2048 + k * 1024); } while (0)
#define PG8_LDB(dst, b, h) do { _Pragma("unroll") for (int n = 0; n < 2; ++n) _Pragma("unroll") for (int k = 0; k < 2; ++k) dst[n][k] = *(const PG8_LAS bf16x8*)(lds + PG8_SB(b, h) + boff + n * 2048 + k * 1024); } while (0)
#define PG8_MMA(ai, bj, At, Bt) do { __builtin_amdgcn_s_setprio(1); _Pragma("unroll") for (int m = 0; m < 4; ++m) _Pragma("unroll") for (int n = 0; n < 2; ++n) _Pragma("unroll") for (int k = 0; k < 2; ++k) \
        acc[ai][bj][m][n] = __builtin_amdgcn_mfma_f32_16x16x32_bf16(Bt[n][k], At[m][k], acc[ai][bj][m][n], 0, 0, 0); __builtin_amdgcn_s_setprio(0); } while (0)
#define PG8_WAIT_V(n) asm volatile("s_waitcnt vmcnt(" #n ")" ::: "memory")
#define PG8_WAIT_L(n) asm volatile("s_waitcnt lgkmcnt(" #n ")" ::: "memory")
#define PG8_BAR __builtin_amdgcn_s_barrier()
#define PG8_SCHED __builtin_amdgcn_sched_barrier(0)
    Unit cur, nxt; int ui = 0;
    if (!S.next(0, cur)) return;
    f32x4 acc[2][2][4][2];
#pragma unroll
    for (int a = 0; a < 2; ++a)
#pragma unroll
        for (int b = 0; b < 2; ++b)
#pragma unroll
            for (int m = 0; m < 4; ++m)
#pragma unroll
                for (int n = 0; n < 2; ++n) acc[a][b][m][n] = (f32x4){0.f, 0.f, 0.f, 0.f};
    bf16x8 At[4][2], B0[2][2], B1[2][2];
    const char* cA = (const char*)g.A + (long)cur.arow * (long)rstep; const char* cB = (const char*)g.Bt + (size_t)cur.pn * tstep;
    if constexpr (SP2) {
        PG8_STAGE(PG8_SB(0, 0), cB, voffB); PG8_STAGE(PG8_SB(0, 1), cB + hstep, voffB); PG8_STAGE(PG8_SA(0, 0), cA, voffA); PG8_STAGE(PG8_SA(0, 1), cA + hstep, voffA);
        if (wr == 1) PG8_BAR;
        PG8_WAIT_V(2); PG8_BAR;
        PG8_STAGE(PG8_SB(1, 0), cB + kstep, voffB); PG8_STAGE(PG8_SA(1, 0), cA + kstep, voffA); PG8_STAGE(PG8_SB(1, 1), cB + hstep + kstep, voffB);
        PG8_WAIT_V(6); PG8_BAR;
    } else {
        PG8_STAGE(PG8_SB(0, 0), cB, voffB); PG8_STAGE(PG8_SA(0, 0), cA, voffA); PG8_STAGE(PG8_SB(0, 1), cB + hstep, voffB); PG8_STAGE(PG8_SA(0, 1), cA + hstep, voffA);
        if (wr == 1) PG8_BAR;
        PG8_WAIT_V(4); PG8_BAR;
        PG8_STAGE(PG8_SB(1, 0), cB + kstep, voffB); PG8_STAGE(PG8_SA(1, 0), cA + kstep, voffA); PG8_STAGE(PG8_SB(1, 1), cB + hstep + kstep, voffB);
        PG8_WAIT_V(6); PG8_BAR;
    }
    for (;;) {
        const bool has_next = S.next(ui + 1, nxt);
        const char* nA = has_next ? (const char*)g.A + (long)nxt.arow * (long)rstep : cA; const char* nB = has_next ? (const char*)g.Bt + (size_t)nxt.pn * tstep : cB;
        for (int t = 0; t < nt; t += 2) {
            const bool last = (t == nt - 2);
            const char* a1 = cA + (size_t)(t + 1) * kstep;
            const char* a2 = last ? nA : cA + (size_t)(t + 2) * kstep; const char* b2 = last ? nB : cB + (size_t)(t + 2) * kstep;
            const char* a3 = a2 + kstep; const char* b3 = b2 + kstep;
            if constexpr (SP2) {
            PG8_LDB(B0, 0, 0); PG8_LDB(B1, 0, 1); PG8_SCHED; PG8_LDA(At, 0, 0); PG8_STAGE(PG8_SA(1, 1), a1 + hstep, voffA);
            PG8_WAIT_V(8); PG8_WAIT_L(0); PG8_BAR; PG8_MMA(0, 0, At, B0); PG8_MMA(0, 1, At, B1); PG8_BAR; PG8_SCHED;
            PG8_LDA(At, 0, 1); PG8_STAGE(PG8_SB(0, 0), b2, voffB); PG8_STAGE(PG8_SB(0, 1), b2 + hstep, voffB); PG8_STAGE(PG8_SA(0, 0), a2, voffA);
            PG8_WAIT_V(8); PG8_WAIT_L(0); PG8_BAR; PG8_MMA(1, 0, At, B0); PG8_MMA(1, 1, At, B1); PG8_BAR; PG8_SCHED;
            PG8_LDB(B0, 1, 0); PG8_LDB(B1, 1, 1); PG8_SCHED; PG8_LDA(At, 1, 0); PG8_STAGE(PG8_SA(0, 1), a2 + hstep, voffA);
            PG8_WAIT_V(8); PG8_WAIT_L(0); PG8_BAR; PG8_MMA(0, 0, At, B0); PG8_MMA(0, 1, At, B1); PG8_BAR; PG8_SCHED;
            PG8_LDA(At, 1, 1); PG8_STAGE(PG8_SB(1, 0), b3, voffB); PG8_STAGE(PG8_SB(1, 1), b3 + hstep, voffB); PG8_STAGE(PG8_SA(1, 0), a3, voffA);
            PG8_WAIT_V(8); PG8_WAIT_L(0); PG8_BAR; PG8_MMA(1, 0, At, B0); PG8_MMA(1, 1, At, B1); PG8_BAR; PG8_SCHED;
            } else {
            PG8_LDB(B0, 0, 0); PG8_SCHED; PG8_LDA(At, 0, 0); PG8_STAGE(PG8_SA(1, 1), a1 + hstep, voffA);
            PG8_WAIT_L(8); PG8_BAR; PG8_WAIT_L(0); PG8_MMA(0, 0, At, B0); PG8_BAR; PG8_SCHED;
            PG8_LDB(B1, 0, 1); PG8_STAGE(PG8_SB(0, 0), b2, voffB);
            PG8_BAR; PG8_WAIT_L(0); PG8_MMA(0, 1, At, B1); PG8_BAR;
            PG8_LDA(At, 0, 1); PG8_STAGE(PG8_SA(0, 0), a2, voffA);
            PG8_BAR; PG8_WAIT_L(0); PG8_MMA(1, 0, At, B0); PG8_BAR; PG8_SCHED;
            PG8_STAGE(PG8_SB(0, 1), b2 + hstep, voffB);
            PG8_WAIT_V(6); PG8_BAR; PG8_MMA(1, 1, At, B1); PG8_BAR;
            PG8_LDB(B0, 1, 0); PG8_SCHED; PG8_LDA(At, 1, 0); PG8_STAGE(PG8_SA(0, 1), a2 + hstep, voffA);
            PG8_WAIT_L(8); PG8_BAR; PG8_WAIT_L(0); PG8_MMA(0, 0, At, B0); PG8_BAR; PG8_SCHED;
            PG8_LDB(B1, 1, 1); PG8_STAGE(PG8_SB(1, 0), b3, voffB);
            PG8_BAR; PG8_WAIT_L(0); PG8_MMA(0, 1, At, B1); PG8_BAR;
            PG8_LDA(At, 1, 1); PG8_STAGE(PG8_SA(1, 0), a3, voffA);
            PG8_BAR; PG8_WAIT_L(0); PG8_MMA(1, 0, At, B0); PG8_BAR; PG8_SCHED;
            PG8_STAGE(PG8_SB(1, 1), b3 + hstep, voffB);
            PG8_WAIT_V(6); PG8_BAR; PG8_MMA(1, 1, At, B1); PG8_BAR;
            }
        }
        if constexpr (ALIGN_EPI) { if (wr == 0) PG8_BAR; }
        { int t_ = tid; asm volatile("" : "+v"(t_));
          E(acc, cur, wr, wc, t_ & 15, (t_ >> 4) & 3, lds + STAGE_BYTES); }
        if (!has_next) break;
#pragma unroll
        for (int a = 0; a < 2; ++a)
#pragma unroll
            for (int b = 0; b < 2; ++b)
#pragma unroll
                for (int m = 0; m < 4; ++m)
#pragma unroll
                    for (int n = 0; n < 2; ++n) acc[a][b][m][n] = (f32x4){0.f, 0.f, 0.f, 0.f};
        cur = nxt; cA = nA; cB = nB; ++ui;
        if constexpr (ALIGN_EPI) { if (wr == 1) PG8_BAR; }
    }
    PG8_WAIT_V(0);
    if constexpr (!ALIGN_EPI) { if (wr == 0) PG8_BAR; }
    PG8_BAR;
#undef PG8_SA
#undef PG8_SB
#undef PG8_STAGE
#undef PG8_LDA
#undef PG8_LDB
#undef PG8_MMA
#undef PG8_WAIT_V
#undef PG8_WAIT_L
#undef PG8_BAR
#undef PG8_SCHED
}
#else
template <class Epi, class Sched, bool ALIGN_EPI = false, bool SP2 = false>
static inline void gemm_phase(unsigned char* lds, const int tid, const Gemm g, const Sched& S, const Epi& E) {
    const int wid = tid >> 6, lane = tid & 63, wr = wid >> 2, wc = wid & 3, fr = lane & 15, fq = lane >> 4;
    static thread_local std::vector<float> Af, Bf;
    Unit cur;
    for (int ui = 0; S.next(ui, cur); ++ui) {
        const int K = g.K;
        sync_block();
        if (tid == 0) { Af.resize((size_t)256 * K); Bf.resize((size_t)256 * K);
            for (int r = 0; r < 256; ++r) for (int k = 0; k < K; ++k) { Af[(size_t)r * K + k] = bf2f_(g.A[((long)cur.arow + r) * K + k]); Bf[(size_t)r * K + k] = bf2f_(g.Bt[((size_t)cur.pn * 256 + r) * K + k]); } }
        sync_block();
        f32x4 acc[2][2][4][2];
        for (int ai = 0; ai < 2; ++ai) for (int bj = 0; bj < 2; ++bj) for (int m = 0; m < 4; ++m) for (int n = 0; n < 2; ++n) for (int e = 0; e < 4; ++e) {
            const int r = 128 * ai + 64 * wr + 16 * m + fr, c = 128 * bj + 32 * wc + (Epi::PERM ? 8 * fq + 4 * n + e : 16 * n + 4 * fq + e);
            const float* a = &Af[(size_t)r * K]; const float* b = &Bf[(size_t)c * K]; float s = 0.f;
            for (int k = 0; k < K; ++k) s += a[k] * b[k];
            acc[ai][bj][m][n][e] = s; }
        E(acc, cur, wr, wc, fr, fq, lds + STAGE_BYTES);
    }
    sync_block();
}
#endif

DEVFN float row_inv(const float* ssq, int row) {
    const f32x4* p = (const f32x4*)(ssq + (size_t)row * 16); const f32x4 a = p[0], b = p[1], c = p[2], d = p[3];
    const float s = ((a[0] + a[1]) + (a[2] + a[3])) + ((b[0] + b[1]) + (b[2] + b[3])) + ((c[0] + c[1]) + (c[2] + c[3])) + ((d[0] + d[1]) + (d[2] + d[3]));
    return 1.0f / sqrtf(s * (1.0f / D) + 1e-6f);
}
struct EpiIn {
    static constexpr bool PERM = true;
    bf16* O; const float* ssq;
    MEMFN void operator()(const f32x4 (&acc)[2][2][4][2], const Unit& u, int wr, int wc, int fr, int fq, LAS unsigned char*) const {
        const int row0 = u.pm * BM + wr * 64 + fr, col0 = u.pn * BM + wc * 32 + 8 * fq;
#pragma unroll
        for (int ai = 0; ai < 2; ++ai)
#pragma unroll
            for (int m = 0; m < 4; ++m) { const int row = row0 + ai * HALF + m * 16; const float sc = row_inv(ssq, row); bf16* rowp = O + (size_t)row * NINP + col0;
#pragma unroll
                for (int bj = 0; bj < 2; ++bj) { const f32x4 v0 = acc[ai][bj][m][0] * sc, v1 = acc[ai][bj][m][1] * sc;
                    u32x4 w; w.x = pk_bf16(v0[0], v0[1]); w.y = pk_bf16(v0[2], v0[3]); w.z = pk_bf16(v1[0], v1[1]); w.w = pk_bf16(v1[2], v1[3]);
                    *(u32x4*)(rowp + bj * HALF) = w; } }
    }
};
struct EpiRes {
    static constexpr bool PERM = false;
    float* H; bf16* HB; float* ssq;
    MEMFN void operator()(const f32x4 (&acc)[2][2][4][2], const Unit& u, int wr, int wc, int fr, int fq, LAS unsigned char*) const {
        const int row0 = u.pm * BM + wr * 64 + fr, col0 = u.pn * BM + wc * 32 + 4 * fq;
#pragma unroll
        for (int ai = 0; ai < 2; ++ai)
#pragma unroll
            for (int m = 0; m < 4; ++m) { const int row = row0 + ai * HALF + m * 16; const size_t off = (size_t)row * D + col0; float s = 0.f;
#pragma unroll
                for (int bj = 0; bj < 2; ++bj)
#pragma unroll
                    for (int n = 0; n < 2; ++n) { float* hp = H + off + bj * HALF + n * 16; const f32x4 h = *(const f32x4*)hp + acc[ai][bj][m][n]; *(f32x4*)hp = h;
                        u32x2 w; w.x = pk_bf16(h[0], h[1]); w.y = pk_bf16(h[2], h[3]); *(u32x2*)(HB + off + bj * HALF + n * 16) = w;
                        s += (h[0] * h[0] + h[1] * h[1]) + (h[2] * h[2] + h[3] * h[3]); }
                s += shfl_xor_f32(s, 16); s += shfl_xor_f32(s, 32);
                if (fq == 0) ssq[(size_t)row * 16 + u.pn * 4 + wc] = s;
                if (m & 1) asm volatile("" ::: "memory"); }
    }
};
struct EpiGlu {
    static constexpr bool PERM = true;
    const bf16* YG; const float* bias; bf16* YM;
    MEMFN void operator()(const f32x4 (&acc)[2][2][4][2], const Unit& u, int wr, int wc, int fr, int fq, LAS unsigned char*) const {
        const int row0 = u.pm * BM + wr * 64 + fr, col0 = u.pn * BM + wc * 32 + 8 * fq;
#pragma unroll
        for (int bj = 0; bj < 2; ++bj) { const int col = col0 + bj * HALF; if (u.pn == 1 && bj == 1) continue;
            const f32x4 b0 = *(const f32x4*)(bias + col), b1 = *(const f32x4*)(bias + col + 4);
#pragma unroll
            for (int ai = 0; ai < 2; ++ai)
#pragma unroll
                for (int m = 0; m < 4; ++m) { const int row = row0 + ai * HALF + m * 16;
                    const u32x4 y = *(const u32x4*)(YG + (size_t)row * S5W + col); const f32x4 a0 = acc[ai][bj][m][0] + b0, a1 = acc[ai][bj][m][1] + b1;
                    u32x4 w; w.x = pk_bf16(bf_lo(y.x) * sigmoid_f(a0[0]), bf_hi(y.x) * sigmoid_f(a0[1])); w.y = pk_bf16(bf_lo(y.y) * sigmoid_f(a0[2]), bf_hi(y.y) * sigmoid_f(a0[3]));
                    w.z = pk_bf16(bf_lo(y.z) * sigmoid_f(a1[0]), bf_hi(y.z) * sigmoid_f(a1[1])); w.w = pk_bf16(bf_lo(y.w) * sigmoid_f(a1[2]), bf_hi(y.w) * sigmoid_f(a1[3]));
                    *(u32x4*)(YM + (size_t)row * D + RGW + col) = w;
                    if (m & 1) asm volatile("" ::: "memory"); } }
    }
};
struct EpiUp {
    static constexpr bool PERM = true;
    bf16* G; const float* ssq; const float* cw; const float* cb;
    MEMFN void operator()(f32x4 (&acc)[2][2][4][2], const Unit& u, int wr, int wc, int fr, int fq, LAS unsigned char* xl) const {
        const int b = u.pm / NQ, q = u.pm % NQ, t0 = UPS * q - 1;
        LAS float* XB = (LAS float*)xl;
        const int cs = wc * 32 + 8 * fq;
#pragma unroll
        for (int ai = 0; ai < 2; ++ai)
#pragma unroll
            for (int m = 0; m < 4; ++m) { const int lr = 128 * ai + 64 * wr + 16 * m + fr, t = t0 + lr; const bool ok = (t >= 0) && (t < L);
                const float sc = ok ? row_inv(ssq, b * L + t) : 0.f;
#pragma unroll
                for (int bj = 0; bj < 2; ++bj)
#pragma unroll
                    for (int n = 0; n < 2; ++n)
#pragma unroll
                        for (int e = 0; e < 4; ++e) acc[ai][bj][m][n][e] = ok ? acc[ai][bj][m][n][e] * sc : 0.f; }
#pragma unroll
        for (int ai = 0; ai < 2; ++ai) { const int s = 2 * ai + wr;
            if (fr == 0) {
#pragma unroll
                for (int bj = 0; bj < 2; ++bj)
#pragma unroll
                    for (int n = 0; n < 2; ++n) *(LAS f32x4*)(XB + (2 * s) * 256 + bj * 128 + cs + 4 * n) = acc[ai][bj][0][n]; }
            if (fr == 15) {
#pragma unroll
                for (int bj = 0; bj < 2; ++bj)
#pragma unroll
                    for (int n = 0; n < 2; ++n) *(LAS f32x4*)(XB + (2 * s + 1) * 256 + bj * 128 + cs + 4 * n) = acc[ai][bj][3][n]; } }
#ifdef CPU_EMU
        sync_block();
#else
        asm volatile("s_waitcnt lgkmcnt(0)" ::: "memory"); __builtin_amdgcn_s_barrier(); asm volatile("" ::: "memory");
#endif
        const int j0 = u.pn * 128 + cs;
#pragma unroll
        for (int n = 0; n < 2; ++n) {
            f32x4 wa[3], wv[3]; const f32x4 ba = *(const f32x4*)(cb + j0 + 4 * n), bv = *(const f32x4*)(cb + FF + j0 + 4 * n);
#pragma unroll
            for (int k = 0; k < 3; ++k) { wa[k] = *(const f32x4*)(cw + k * FF2 + j0 + 4 * n); wv[k] = *(const f32x4*)(cw + k * FF2 + FF + j0 + 4 * n); }
#pragma unroll
            for (int ai = 0; ai < 2; ++ai) { const int s = 2 * ai + wr;
#pragma unroll
                for (int m = 0; m < 4; ++m) { const int lr = 64 * s + 16 * m + fr, t = t0 + lr;
                    f32x4 up[2], dn[2];
#pragma unroll
                    for (int bj = 0; bj < 2; ++bj) {
                        f32x4 pu, pd;
                        if (m > 0) { const f32x4 p = acc[ai][bj][m > 0 ? m - 1 : 0][n]; pu = (f32x4){dpp_row_ror1(p[0]), dpp_row_ror1(p[1]), dpp_row_ror1(p[2]), dpp_row_ror1(p[3])}; }
                        else if (s > 0) pu = *(const LAS f32x4*)(XB + (2 * (s - 1) + 1) * 256 + bj * 128 + cs + 4 * n);
                        else pu = (f32x4){0.f, 0.f, 0.f, 0.f};
                        if (m < 3) { const f32x4 p = acc[ai][bj][m < 3 ? m + 1 : 3][n]; pd = (f32x4){dpp_row_ror15(p[0]), dpp_row_ror15(p[1]), dpp_row_ror15(p[2]), dpp_row_ror15(p[3])}; }
                        else if (s < 3) pd = *(const LAS f32x4*)(XB + (2 * (s + 1)) * 256 + bj * 128 + cs + 4 * n);
                        else pd = (f32x4){0.f, 0.f, 0.f, 0.f};
                        const f32x4 x = acc[ai][bj][m][n];
#pragma unroll
                        for (int e = 0; e < 4; ++e) { up[bj][e] = dpp_row_shr1(pu[e], x[e]); dn[bj][e] = dpp_row_shl1(pd[e], x[e]); }
                    }
                    const f32x4 a = ba + wa[0] * up[0] + wa[1] * acc[ai][0][m][n] + wa[2] * dn[0];
                    const f32x4 v = bv + wv[0] * up[1] + wv[1] * acc[ai][1][m][n] + wv[2] * dn[1];
                    if (lr >= 1 && lr <= UPS && t < L) { u32x2 w; w.x = pk_bf16(gelu_f(a[0]) * v[0], gelu_f(a[1]) * v[1]); w.y = pk_bf16(gelu_f(a[2]) * v[2], gelu_f(a[3]) * v[3]);
                        *(u32x2*)(G + (size_t)(b * L + t) * FF + j0 + 4 * n) = w; }
                } } }
    }
};
}

constexpr int RING_BYTES = 131072, XCH_OFF = RING_BYTES, XCH_BYTES = 8192, MISC_OFF = XCH_OFF + XCH_BYTES, LDS_BYTES = 147456;
constexpr int CW_TMO = 0, CW_BAR = 4096;
#ifndef CPU_EMU
typedef GAS unsigned gu32;
#define XB_TMO      128
#define XB_XCNT(j)  (256  + 64 * (j))
#define XB_XSUB(j)  (1280 + 64 * (j))
#define XB_XGEN(j)  (2304 + 64 * (j))
#define XB_TOP      3328
#define XB_TOPGEN   3392
#define XCD_BAR_WORDS 3456
#define XB_SPIN_CAP (1u << 22)
__device__ __forceinline__ unsigned xb_ld(unsigned* p)              { return __hip_atomic_load(p, __ATOMIC_RELAXED, __HIP_MEMORY_SCOPE_AGENT); }
__device__ __forceinline__ unsigned xb_add(unsigned* p, unsigned v) { return __hip_atomic_fetch_add(p, v, __ATOMIC_RELAXED, __HIP_MEMORY_SCOPE_AGENT); }
__device__ __forceinline__ unsigned xb_xcc_id() { return (unsigned)__builtin_amdgcn_s_getreg((3 << 11) | 20) & 0xFu; }
#define XB_SPIN(cond, bar) do { unsigned _sp = 0; while (cond) { __builtin_amdgcn_s_sleep(1); \
    if ((++_sp & 255u) == 0u) { if (xb_ld(&(bar)[XB_TMO])) break; if (_sp > XB_SPIN_CAP) { atomicAdd(&(bar)[XB_TMO], 1u); break; } } } } while (0)
struct XcdBarrier { unsigned* bar; unsigned x; volatile LAS unsigned* st; };
__device__ __forceinline__ XcdBarrier xcd_barrier_post(unsigned* bar, volatile LAS unsigned* st) {
    XcdBarrier b; b.bar = bar; b.x = xb_xcc_id(); b.st = st;
    if (threadIdx.x == 0) (void)xb_add(&bar[XB_XCNT(b.x)], 1u);
    return b;
}
__device__ __forceinline__ void xcd_barrier_complete(unsigned* bar, unsigned x, unsigned& nloc, unsigned& nx) {
    const unsigned G = gridDim.x * gridDim.y * gridDim.z;
    unsigned sum, cnt, mine, sp = 0u;
    for (;;) {
        sum = 0u; cnt = 0u; mine = 0u;
#pragma unroll
        for (unsigned j = 0; j < 16; ++j) { const unsigned c = xb_ld(&bar[XB_XCNT(j)]); sum += c; cnt += (c > 0u) ? 1u : 0u; mine = (j == x) ? c : mine; }
        if (sum == G) break;
        __builtin_amdgcn_s_sleep(1);
        if ((++sp & 255u) == 0u) { if (xb_ld(&bar[XB_TMO])) break; if (sp > XB_SPIN_CAP) { atomicAdd(&bar[XB_TMO], 1u); break; } }
    }
    nloc = mine > 0u ? mine : 1u; nx = cnt > 0u ? cnt : 1u;
}
__device__ __forceinline__ void xcd_barrier(const XcdBarrier& b) {
    __builtin_amdgcn_fence(__ATOMIC_RELEASE, "agent");
    asm volatile("s_waitcnt vmcnt(0)" ::: "memory");
    __syncthreads();
    if (threadIdx.x == 0) {
        unsigned* bar = b.bar;
        __builtin_amdgcn_s_waitcnt(0);
        unsigned nloc = b.st[0], nx = b.st[1];
        if (nloc == 0u) { xcd_barrier_complete(bar, b.x, nloc, nx); b.st[0] = nloc; b.st[1] = nx; }
        const unsigned old = xb_add(&bar[XB_XSUB(b.x)], 1u);
        const unsigned gen = old / nloc;
        if (old + 1u == (gen + 1u) * nloc) {
            __builtin_amdgcn_fence(__ATOMIC_RELEASE, "agent");
            asm volatile("s_waitcnt vmcnt(0)" ::: "memory");
            const unsigned og = xb_add(&bar[XB_TOP], 1u);
            const unsigned tg = og / nx;
            if (og + 1u == (tg + 1u) * nx) xb_add(&bar[XB_TOPGEN], 1u);
            else XB_SPIN(xb_ld(&bar[XB_TOPGEN]) == tg, bar);
            __builtin_amdgcn_fence(__ATOMIC_ACQUIRE, "agent");
            xb_add(&bar[XB_XGEN(b.x)], 1u);
            asm volatile("s_waitcnt vmcnt(0)" ::: "memory");
        } else {
            XB_SPIN(xb_ld(&bar[XB_XGEN(b.x)]) == gen, bar);
            __builtin_amdgcn_fence(__ATOMIC_ACQUIRE, "agent");
            asm volatile("s_waitcnt vmcnt(0)" ::: "memory");
        }
    }
    __syncthreads();
}
#endif

#ifdef CPU_EMU
struct Args; static void emu_phase_hook(int ph, const Args& a);
#endif
struct Args { const float* in[38]; float* out; unsigned char* ws; int ph_lo, ph_hi; };
#ifdef CPU_EMU
typedef const Args* KARG_PTR;
#else
typedef const __attribute__((address_space(4))) Args* KARG_PTR;
#endif
struct Frame {
    LAS unsigned char* lds; int tid, lane, wave, G, gtid, gsize, gw, ngw;
    KARG_PTR ap; float* out; unsigned char* ws;
};
#define FIN(i) (F.ap->in[i])
#ifdef CPU_EMU
#define LAUNDER(F, l) do {} while (0)
#else
#define LAUNDER(F, l) do { size_t z_ = 0; asm volatile("" : "+s"(z_), "+s"(F.ap), "+s"(l), "+s"(F.wave)); F.ws = args.ws + z_; F.out = args.out + z_; F.lane = lane_id(); F.tid = (F.wave << 6) | F.lane; \
    F.gtid = blockIdx.x * NT + F.tid; F.gw = blockIdx.x * NWAVES + F.wave; } while (0)
#endif

DEVFN void transpose_item(const float* W, int ldw, int K, bf16* WT, int src_col0, int dst_row0, int k0, const float* sc, LAS float* scr, int lane) {
#pragma unroll 8
    for (int i = 0; i < 32; ++i) { const int kk = 2 * i + (lane >> 5); float v = W[(size_t)(k0 + kk) * ldw + src_col0 + (lane & 31)]; if (sc) v *= sc[k0 + kk]; scr[kk * 33 + (lane & 31)] = v; }
    WAVE_LDS_FENCE();
    const int c = lane & 7;
#pragma unroll
    for (int j = 0; j < 4; ++j) { const int n = (lane >> 3) + 8 * j; const LAS float* s = scr + (8 * c) * 33 + n;
        u32x4 o; o.x = pk_bf16(s[0 * 33], s[1 * 33]); o.y = pk_bf16(s[2 * 33], s[3 * 33]); o.z = pk_bf16(s[4 * 33], s[5 * 33]); o.w = pk_bf16(s[6 * 33], s[7 * 33]);
        *(u32x4*)(WT + (size_t)(dst_row0 + n) * K + k0 + 8 * c) = o; }
    WAVE_LDS_FENCE();
}
DEVFN float wave_sum(float v) {
#pragma unroll
    for (int o = 1; o < 64; o <<= 1) v += shfl_xor_f32(v, o);
    return v;
}
DEVFN void p_prologue(Frame& F) {
    LAS float* scr = (LAS float*)(F.lds + F.wave * 16384);
    constexpr int I_IN = 16 * 60, I_OUT = 16 * 32, I_UP = 16 * 176, I_DN = 44 * 32, I_GLU = 6 * 12, I_L = I_IN + I_OUT + I_UP + I_DN + I_GLU;
    for (int it = F.gw; it < 2 * I_L; it += F.ngw) {
        const int l = it / I_L; int r = it % I_L;
        if (r < I_IN) { const int kb = r / 60, nb = r % 60; transpose_item(FIN(2) + (size_t)l * D * NIN, NIN, D, (bf16*)(F.ws + WS_WIN + l * SZ_WIN), 32 * nb, 32 * nb, 64 * kb, FIN(1) + l * D, scr, F.lane); continue; } r -= I_IN;
        if (r < I_OUT) { const int kb = r / 32, nb = r % 32; transpose_item(FIN(31) + (size_t)l * D * D, D, D, (bf16*)(F.ws + WS_WOUT + l * SZ_WOUT), 32 * nb, 32 * nb, 64 * kb, FIN(30) + l * D, scr, F.lane); continue; } r -= I_OUT;
        if (r < I_UP) { const int kb = r / 176, nb = r % 176, sc0 = 32 * nb, half = sc0 / FF, jj = sc0 % FF, pn = jj / 128;
            transpose_item(FIN(33) + (size_t)l * D * FF2, FF2, D, (bf16*)(F.ws + WS_WUP + l * SZ_WUP), sc0, 256 * pn + 128 * half + (jj % 128), 64 * kb, FIN(32) + l * D, scr, F.lane); continue; } r -= I_UP;
        if (r < I_DN) { const int kb = r / 32, nb = r % 32; transpose_item(FIN(36) + (size_t)l * FF * D, D, FF, (bf16*)(F.ws + WS_WDN + l * SZ_WDN), 32 * nb, 32 * nb, 64 * kb, nullptr, scr, F.lane); continue; } r -= I_DN;
        { const int kb = r / 12, nb = r % 12; transpose_item(FIN(18) + (size_t)l * S5W * S5W, S5W, S5W, (bf16*)(F.ws + WS_WGLU + l * SZ_WGLU), 32 * nb, 32 * nb, 64 * kb, nullptr, scr, F.lane); }
    }
    for (int i = F.gtid; i < 2 * (128 * D / 8); i += F.gsize) { const int l = i / (128 * D / 8), r = i % (128 * D / 8); ((u32x4*)(F.ws + WS_WIN + l * SZ_WIN + (size_t)NIN * D * 2))[r] = (u32x4){0u, 0u, 0u, 0u}; }
    for (int i = F.gtid; i < 2 * (128 * S5W / 8); i += F.gsize) { const int l = i / (128 * S5W / 8), r = i % (128 * S5W / 8); ((u32x4*)(F.ws + WS_WGLU + l * SZ_WGLU + (size_t)S5W * S5W * 2))[r] = (u32x4){0u, 0u, 0u, 0u}; }
    float* ssq = (float*)(F.ws + WS_SSQ); bf16* hb = (bf16*)(F.ws + WS_HB);
    for (int m = F.gw; m < M; m += F.ngw) {
        const f32x4* xr = (const f32x4*)(FIN(0) + (size_t)m * D) + F.lane; f32x4* hr = (f32x4*)(F.out + (size_t)m * D) + F.lane; u32x2* br = (u32x2*)(hb + (size_t)m * D) + F.lane; float s = 0.f;
#pragma unroll
        for (int j = 0; j < 4; ++j) { const f32x4 v = xr[64 * j]; hr[64 * j] = v; u32x2 w; w.x = pk_bf16(v[0], v[1]); w.y = pk_bf16(v[2], v[3]); br[64 * j] = w; s += (v[0] * v[0] + v[1] * v[1]) + (v[2] * v[2] + v[3] * v[3]); }
        s = wave_sum(s);
        if (F.lane < 16) ssq[(size_t)m * 16 + F.lane] = F.lane == 0 ? s : 0.f;
    }
    for (int i = F.gtid; i < 2 * 3072; i += F.gsize) { const int l = i / 3072, r = i % 3072, dg = r / 64, p = r % 64;
        const float lr = FIN(10)[i], li = FIN(11)[i], dt = expf(FIN(12)[l * 48 + dg]);
        const float mag = expf(lr * dt), ar = mag * cosf(li * dt), ai = mag * sinf(li * dt);
        const float den = lr * lr + li * li, nr = ar - 1.0f, ni = ai, cr = (nr * lr + ni * li) / den, ci = (ni * lr - nr * li) / den;
        ((f32x2*)(F.ws + WS_S5A))[i] = (f32x2){ar, ai};
        const float m16 = expf(16.0f * lr * dt); ((f32x2*)(F.ws + WS_S5A16))[i] = (f32x2){m16 * cosf(16.0f * li * dt), m16 * sinf(16.0f * li * dt)};
        bf16* bt = (bf16*)(F.ws + WS_S5BT) + ((size_t)(l * 48 + dg) * 2) * 64 * 16; bf16* ct = (bf16*)(F.ws + WS_S5CT) + (size_t)(l * 48 + dg) * 16 * 128;
        for (int c = 0; c < 16; ++c) { const float br = FIN(13)[(size_t)i * 16 + c], bi = FIN(14)[(size_t)i * 16 + c];
            bt[(size_t)p * 16 + c] = f2bf_(cr * br - ci * bi); bt[(size_t)(64 + p) * 16 + c] = f2bf_(cr * bi + ci * br);
            const size_t ci_ = ((size_t)(l * 48 + dg) * 16 + c) * 64 + p;
            ct[(size_t)c * 128 + 2 * p] = f2bf_(FIN(15)[ci_]); ct[(size_t)c * 128 + 2 * p + 1] = f2bf_(-FIN(16)[ci_]); } }
    for (int i = F.gtid; i < 2 * 2 * RGW; i += F.gsize) ((float*)(F.ws + WS_RGSP))[i] = 8.0f * softplus_f(-FIN(9)[i]);
    for (int i = F.gtid; i < 2 * 2 * 2 * 6 * 4096; i += F.gsize) { const int k = i % 64, n = (i / 64) % 64, hd = (i / 4096) % 6, mat = (i / 24576) % 2, ld = i / 49152;
        const float* src = (mat == 0 ? FIN(5) : FIN(7)) + ((size_t)ld * 6 + hd) * 4096; ((bf16*)(F.ws + WS_RGWT))[i] = f2bf_(src[k * 64 + n]); }
    for (int i = F.gtid; i < 2 * L * 64; i += F.gsize) { const int l = i / (L * 64), r = i % (L * 64), pos = r / 64, mm = r % 64;
        const float* w1 = FIN(22) + l * 33 * 64; const float t = (float)pos / (float)(L - 1 > 1 ? L - 1 : 1), w = (6.283185307179586f / (float)L) * (float)pos;
        float acc = FIN(23)[l * 64 + mm] + t * w1[mm];
        for (int q = 0; q < 16; ++q) { const float band = 1e-4f + (float)q * ((15.0f - 1e-4f) / 15.0f), ang = w * band; acc += cosf(ang) * w1[(1 + q) * 64 + mm] - sinf(ang) * w1[(17 + q) * 64 + mm]; }
        ((float*)(F.ws + WS_HID))[i] = sinf(FIN(24)[l * 64 + mm] * acc); }
}
DEVFN void p_hid2(Frame& F, int l) {
    const float* hid1 = (const float*)(F.ws + WS_HID) + (size_t)l * L * 64; float* hid2 = (float*)(F.ws + WS_HID) + (size_t)(2 + l) * L * 64;
    for (int i = F.gtid; i < L * 64; i += F.gsize) { const int pos = i / 64, mm = i % 64; float acc = FIN(26)[l * 64 + mm];
        for (int q = 0; q < 64; ++q) acc += hid1[pos * 64 + q] * FIN(25)[l * 4096 + q * 64 + mm];
        hid2[i] = sinf(FIN(27)[l * 64 + mm] * acc); }
}

DEVFN float ldproj(const bf16* proj, size_t m, int col) { return bf2f_(proj[m * NINP + col]); }
DEVFN void p_mix1(Frame& F, int l) {
    const bf16* proj = (const bf16*)(F.ws + WS_PROJ);
    { float* z = (float*)(F.ws + WS_Z); float* x0c = (float*)(F.ws + WS_X0C); const float* cw = FIN(20) + l * 3 * 768; const float* cb = FIN(21) + l * 768;
      for (int i = F.gtid; i < M * HYW; i += F.gsize) { const int m = i / HYW, c = i % HYW, t = m % L; float q[3];
#pragma unroll
          for (int part = 0; part < 3; ++part) { const int col = part * HYW + c; float s = cb[col];
#pragma unroll
              for (int k = 0; k < 3; ++k) { const int tt = t + k - 1; if (tt >= 0 && tt < L) s += cw[k * 768 + col] * ldproj(proj, m + k - 1, 3 * RGW + col); }
              q[part] = s; }
          z[i] = q[2] * q[1]; x0c[i] = q[0]; } }
    { const float* hid2 = (const float*)(F.ws + WS_HID) + (size_t)(2 + l) * L * 64; const float* w3 = FIN(28) + (size_t)l * 64 * 512; float* kfb = (float*)(F.ws + WS_KFB);
      const float maxd = logf(1e-2f) / 0.3f, mind = logf(1e-2f) / 1.5f;
      for (int i = F.gtid; i < L * 512; i += F.gsize) { const int pos = i / 512, c2 = i % 512, c = c2 % 256; float acc = 0.f;
          for (int q = 0; q < 64; ++q) acc += hid2[pos * 64 + q] * w3[q * 512 + c2];
          const float delta = fabsf(mind + (float)c * ((maxd - mind) / 255.0f)), t = (float)pos / (float)(L - 1 > 1 ? L - 1 : 1);
          kfb[i] = acc * expf(-t * delta); } }
}
DEVFN void p_mix2(Frame& F, int l) {
    const bf16* proj = (const bf16*)(F.ws + WS_PROJ); bf16* ymix = (bf16*)(F.ws + WS_YMIX);
    { const float* z = (const float*)(F.ws + WS_Z); const float* x0c = (const float*)(F.ws + WS_X0C); const float* kfb = (const float*)(F.ws + WS_KFB); const float* bias = FIN(29) + l * HYW;
      for (int i = F.gtid; i < M * HYW; i += F.gsize) { const int m = i / HYW, c = i % HYW, t = m % L, b = m / L;
          const float* zb = z + (size_t)b * L * HYW + c; float acc = 0.f;
          for (int s = 0; s <= t; ++s) acc += kfb[(size_t)(t - s) * 512 + c] * zb[(size_t)s * HYW];
          for (int s = t; s < L; ++s) acc += kfb[(size_t)(s - t) * 512 + 256 + c] * zb[(size_t)s * HYW];
          ymix[(size_t)m * D + RGW + S5W + c] = f2bf_((acc + z[i] * bias[c]) * x0c[i]); } }
}
constexpr int NG16 = L / 16, NT32 = M / 32;
DEVFN int tau32(int rho) { return 16 * ((rho >> 2) & 1) + (rho & 3) + 4 * (rho >> 3); }
DEVFN bf16x8 pack8(const f32x4 a, const f32x4 b) { u32x4 w; w.x = pk_bf16(a[0], a[1]); w.y = pk_bf16(a[2], a[3]); w.z = pk_bf16(b[0], b[1]); w.w = pk_bf16(b[2], b[3]); return __builtin_bit_cast(bf16x8, w); }
DEVFN void rg_item(Frame& F, int l, int tile, int hd, const bool stage3) {
    const int lane = lane_id(), hh = lane >> 5, pl = lane & 31, m0 = tile * 32, b = m0 / L, t0 = m0 % L, grp = t0 / 16 + hh;
    const bf16* proj = (const bf16*)(F.ws + WS_PROJ); const float* cw = FIN(3) + l * 4 * RGW; const float* cb = FIN(4) + l * RGW;
    const f32x16 z16 = {0.f, 0.f, 0.f, 0.f, 0.f, 0.f, 0.f, 0.f, 0.f, 0.f, 0.f, 0.f, 0.f, 0.f, 0.f, 0.f};
    const int tt = t0 + tau32(pl); bf16x8 uf[4];
#pragma unroll
    for (int ks = 0; ks < 4; ++ks) { const int c0 = 64 * hd + 16 * ks + 8 * hh; f32x4 s0 = *(const f32x4*)(cb + c0), s1 = *(const f32x4*)(cb + c0 + 4);
#pragma unroll
        for (int k = 0; k < 4; ++k) { const int tk = tt + k - 1; const bool ok = (tk >= 0) && (tk < L);
            u32x4 x = {0u, 0u, 0u, 0u}; if (ok) x = *(const u32x4*)(proj + (size_t)(b * L + tk) * NINP + c0);
            const f32x4 w0 = *(const f32x4*)(cw + k * RGW + c0), w1 = *(const f32x4*)(cw + k * RGW + c0 + 4);
            s0 += w0 * (f32x4){bf_lo(x.x), bf_hi(x.x), bf_lo(x.y), bf_hi(x.y)}; s1 += w1 * (f32x4){bf_lo(x.z), bf_hi(x.z), bf_lo(x.w), bf_hi(x.w)}; }
        uf[ks] = pack8(s0, s1); }
    FRESH(uf[0]); FRESH(uf[1]); FRESH(uf[2]); FRESH(uf[3]);
    const bf16* WT = (const bf16*)(F.ws + WS_RGWT); f32x2* AG = (f32x2*)(F.ws + WS_RGAG); const int pl_o = pl, hh_o = hh;
#pragma unroll 1
    for (int nt = 0; nt < 2; ++nt) { int pl_ = pl_o, hh_ = hh_o; OPAQUE_V(pl_); OPAQUE_V(hh_); const int pl = pl_, hh = hh_;
        const int c = 64 * hd + 32 * nt + pl;
        f32x16 uacc; { f32x16 zz = z16; OPAQUE16(zz); uacc = zz; }
        { bf16x8 idf[2];
#pragma unroll
          for (int q = 0; q < 2; ++q) { const int kk = pl - 16 * q - 8 * hh; u32x4 w;
              w.x = (kk >> 1) == 0 ? ((kk & 1) ? 0x3F800000u : 0x3F80u) : 0u; w.y = (kk >> 1) == 1 ? ((kk & 1) ? 0x3F800000u : 0x3F80u) : 0u;
              w.z = (kk >> 1) == 2 ? ((kk & 1) ? 0x3F800000u : 0x3F80u) : 0u; w.w = (kk >> 1) == 3 ? ((kk & 1) ? 0x3F800000u : 0x3F80u) : 0u;
              if (kk < 0 || kk > 7) w = (u32x4){0u, 0u, 0u, 0u};
              idf[q] = __builtin_bit_cast(bf16x8, w); }
          FRESH(idf[0]); FRESH(idf[1]);
          if (nt == 0) { uacc = mfma32(uf[0], idf[0], uacc); uacc = mfma32(uf[1], idf[1], uacc); MFMA_GUARD(ACC1(uacc), KV(uf[0]), KV(uf[1]), KV(idf[0]), KV(idf[1])); }
          else { uacc = mfma32(uf[2], idf[0], uacc); uacc = mfma32(uf[3], idf[1], uacc); MFMA_GUARD(ACC1(uacc), KV(uf[2]), KV(uf[3]), KV(idf[0]), KV(idf[1])); } }
        f32x16 hs = z16;
#pragma unroll
        for (int d = 0; d < 2; ++d) {
            f32x16 ga, gx; { f32x16 zz = z16; OPAQUE16(zz); ga = zz; f32x16 z2 = z16; OPAQUE16(z2); gx = z2; }
            bf16x8 wa[4], wx[4];
#pragma unroll
            for (int ks = 0; ks < 4; ++ks) { const size_t o = ((((size_t)(l * 2 + d) * 2) * 6 + hd) * 64 + 32 * nt + pl) * 64 + 16 * ks + 8 * hh;
                wa[ks] = *(const bf16x8*)(WT + o); wx[ks] = *(const bf16x8*)(WT + o + (size_t)6 * 4096); }
#pragma unroll
            for (int ks = 0; ks < 4; ++ks) { FRESH(wa[ks]); FRESH(wx[ks]); }
#pragma unroll
            for (int ks = 0; ks < 4; ++ks) { ga = mfma32(uf[ks], wa[ks], ga); gx = mfma32(uf[ks], wx[ks], gx); }
            MFMA_GUARD(ACC2(ga, gx), KV(uf[0]), KV(uf[1]), KV(uf[2]), KV(uf[3]), KV(wa[0]), KV(wa[1]), KV(wa[2]), KV(wa[3]), KV(wx[0]), KV(wx[1]), KV(wx[2]), KV(wx[3]));
            const float bav = FIN(6)[l * 2 * RGW + d * RGW + c], bxv = FIN(8)[l * 2 * RGW + d * RGW + c], sp8 = ((const float*)(F.ws + WS_RGSP))[l * 2 * RGW + d * RGW + c];
#pragma unroll
            for (int reg = 0; reg < 16; ++reg) { const float r = sigmoid_f(ga[reg] + bav), ig = sigmoid_f(gx[reg] + bxv), la = -r * sp8;
                ga[reg] = exp_f(la); gx[reg] = sqrtf(-expm1_f(2.0f * la)) * (ig * uacc[reg]); }
            const size_t aidx = (((size_t)b * NG16 + grp) * 2 + d) * RGW + c;
            if (!stage3) { float P = 1.f, H = 0.f;
#pragma unroll
                for (int q = 0; q < 16; ++q) { const int reg = d == 0 ? q : 15 - q; H = ga[reg] * H + gx[reg]; P *= ga[reg]; }
                AG[aidx] = (f32x2){P, H}; }
            else { float h = ((const float*)(F.ws + WS_RGCI))[aidx];
#pragma unroll
                for (int q = 0; q < 16; ++q) { const int reg = d == 0 ? q : 15 - q; h = ga[reg] * h + gx[reg]; hs[reg] += h; } } }
        if (stage3) { bf16* ymix = (bf16*)(F.ws + WS_YMIX);
#pragma unroll
            for (int reg = 0; reg < 16; ++reg) { const size_t m = (size_t)(m0 + 16 * hh + reg); ymix[m * D + c] = f2bf_(hs[reg] * gelu_f(bf2f_(proj[m * NINP + RGW + c]))); } } }
}
DEVFN void p_rg_stage(Frame& F, int l, const bool stage3) { for (int it = F.gw; it < NT32 * 6; it += F.ngw) rg_item(F, l, it / 6, it % 6, stage3); }
DEVFN void p_rg_carry(Frame& F) {
    f32x2* AG = (f32x2*)(F.ws + WS_RGAG);
    for (int i = F.gtid; i < Bn * 2 * RGW; i += F.gsize) { const int c = i % RGW, d = (i / RGW) % 2, b = i / (2 * RGW); float H = 0.f;
        for (int q = 0; q < NG16; ++q) { const int j = d == 0 ? q : NG16 - 1 - q; const size_t o_ = (((size_t)b * NG16 + j) * 2 + d) * RGW + c; const f32x2 s = AG[o_]; ((float*)(F.ws + WS_RGCI))[o_] = H; H = s[0] * H + s[1]; } }
}
constexpr int S5_HS = 272  , S5_YS = 784  ;
DEVFN void s5_tile(Frame& F, int l, int tile, const bool stage3) {
    const int lane = lane_id(), w = F.wave, hh = lane >> 5, pl = lane & 31, m0 = tile * 32, b = m0 / L, grp = (m0 % L) / 16 + hh;
    const bf16* proj = (const bf16*)(F.ws + WS_PROJ); const bf16* BT = (const bf16*)(F.ws + WS_S5BT); const bf16* CT = (const bf16*)(F.ws + WS_S5CT);
    const f32x2* SA = (const f32x2*)(F.ws + WS_S5A); f32x2* SS = (f32x2*)(F.ws + WS_S5S);
    LAS unsigned char* Hw = F.lds + w * (32 * S5_HS); LAS unsigned char* YT = F.lds + 8 * 32 * S5_HS;
    const f32x16 z16 = {0.f, 0.f, 0.f, 0.f, 0.f, 0.f, 0.f, 0.f, 0.f, 0.f, 0.f, 0.f, 0.f, 0.f, 0.f, 0.f};
#pragma unroll 1
    for (int gi = 0; gi < 3; ++gi) { const int g = w + 8 * gi;
        const bf16x8 ua = *(const bf16x8*)(proj + (size_t)(m0 + tau32(pl)) * NINP + 2 * RGW + 16 * g + 8 * hh);
        f32x4 yacc[2] = {(f32x4){0.f, 0.f, 0.f, 0.f}, (f32x4){0.f, 0.f, 0.f, 0.f}};
#pragma unroll
        for (int d = 0; d < 2; ++d) { const size_t dg = (size_t)(l * 2 + d) * 24 + g;
            f32x16 acc[2][2];
            bf16x8 bb[2][2];
#pragma unroll
            for (int ri = 0; ri < 2; ++ri)
#pragma unroll
                for (int ph = 0; ph < 2; ++ph) bb[ri][ph] = *(const bf16x8*)(BT + ((dg * 2 + ri) * 64 + 32 * ph + pl) * 16 + 8 * hh);
            { bf16x8 ub = ua; FRESH(ub); FRESH(bb[0][0]); FRESH(bb[0][1]); FRESH(bb[1][0]); FRESH(bb[1][1]);
#pragma unroll
            for (int ri = 0; ri < 2; ++ri)
#pragma unroll
                for (int ph = 0; ph < 2; ++ph) { f32x16 zz = z16; OPAQUE16(zz); acc[ri][ph] = mfma32(ub, bb[ri][ph], zz); }
            MFMA_GUARD(ACC4(acc[0][0], acc[0][1], acc[1][0], acc[1][1]), KV(ub), KV(bb[0][0]), KV(bb[0][1]), KV(bb[1][0]), KV(bb[1][1])); }
#pragma unroll
            for (int ph = 0; ph < 2; ++ph) { const f32x2 A = SA[dg * 64 + 32 * ph + pl]; const size_t sidx = (((size_t)b * NG16 + grp) * 2 + d) * 1536 + g * 64 + 32 * ph + pl;
                float hr = 0.f, hi = 0.f; if (stage3) { const f32x2 c = ((const f32x2*)(F.ws + WS_S5CI))[sidx]; hr = c[0]; hi = c[1]; }
#pragma unroll
                for (int q = 0; q < 16; ++q) { const int reg = d == 0 ? q : 15 - q; const float nr = A[0] * hr - A[1] * hi + acc[0][ph][reg], ni = A[0] * hi + A[1] * hr + acc[1][ph][reg];
                    hr = nr; hi = ni; acc[0][ph][reg] = nr; acc[1][ph][reg] = ni; }
                if (!stage3) SS[sidx] = (f32x2){hr, hi};
                else {
#pragma unroll
                    for (int reg = 0; reg < 16; ++reg) *(LAS unsigned*)(Hw + (16 * hh + reg) * S5_HS + 4 * (32 * ph + pl)) = pk_bf16(acc[0][ph][reg], acc[1][ph][reg]); } }
            if (stage3) { WAVE_LDS_FENCE();
#pragma unroll
                for (int rt = 0; rt < 2; ++rt) { bf16x8 a2[4], b2[4];
#pragma unroll
                    for (int ks = 0; ks < 4; ++ks) { a2[ks] = *(const LAS bf16x8*)(Hw + (16 * rt + (lane & 15)) * S5_HS + (32 * ks + 8 * (lane >> 4)) * 2);
                        b2[ks] = *(const bf16x8*)(CT + (dg * 16 + (lane & 15)) * 128 + 32 * ks + 8 * (lane >> 4)); }
                    FRESH(b2[0]); FRESH(b2[1]); FRESH(b2[2]); FRESH(b2[3]); FRESH(a2[0]); FRESH(a2[1]); FRESH(a2[2]); FRESH(a2[3]);
#pragma unroll
                    for (int ks = 0; ks < 4; ++ks) yacc[rt] = mfma16(a2[ks], b2[ks], yacc[rt]);
                    MFMA_GUARD(ACC1(yacc[rt]), KV(a2[0]), KV(a2[1]), KV(a2[2]), KV(a2[3]), KV(b2[0]), KV(b2[1]), KV(b2[2]), KV(b2[3])); }
                WAVE_LDS_FENCE(); } }
        if (stage3) { const int c = lane & 15; const float dsk = FIN(17)[l * S5W + 16 * g + c];
#pragma unroll
            for (int rt = 0; rt < 2; ++rt)
#pragma unroll
                for (int reg = 0; reg < 4; ++reg) { const int t = 16 * rt + 4 * (lane >> 4) + reg; const float u = bf2f_(proj[(size_t)(m0 + t) * NINP + 2 * RGW + 16 * g + c]);
                    *(LAS bf16*)(YT + t * S5_YS + (16 * g + c) * 2) = f2bf_(gelu_f(yacc[rt][reg] + dsk * u)); } } }
    if (stage3) { sync_block();
        if (w < 4) {
            const bf16* WG = (const bf16*)(F.ws + WS_WGLU + l * SZ_WGLU); bf16* ymix = (bf16*)(F.ws + WS_YMIX);
            f32x16 ga[3] = {z16, z16, z16};
#pragma unroll 2
            for (int ks = 0; ks < 24; ++ks) { const bf16x8 a = *(const LAS bf16x8*)(YT + pl * S5_YS + (16 * ks + 8 * hh) * 2); bf16x8 bq[3];
#pragma unroll
                for (int j = 0; j < 3; ++j) bq[j] = *(const bf16x8*)(WG + (size_t)(32 * (w + 4 * j) + pl) * S5W + 16 * ks + 8 * hh);
                FRESH(bq[0]); FRESH(bq[1]); FRESH(bq[2]); bf16x8 aq = a; FRESH(aq);
#pragma unroll
                for (int j = 0; j < 3; ++j) ga[j] = mfma32(aq, bq[j], ga[j]);
                MFMA_GUARD(ACC3(ga[0], ga[1], ga[2]), KV(aq), KV(bq[0]), KV(bq[1]), KV(bq[2])); }
#pragma unroll
            for (int j = 0; j < 3; ++j) { const int n = 32 * (w + 4 * j) + pl; const float bias = FIN(19)[l * S5W + n];
#pragma unroll
                for (int reg = 0; reg < 16; ++reg) { const int t = (reg & 3) + 8 * (reg >> 2) + 4 * hh; const float y = bf2f_(*(const LAS bf16*)(YT + t * S5_YS + n * 2));
                    ymix[(size_t)(m0 + t) * D + RGW + n] = f2bf_(y * sigmoid_f(ga[j][reg] + bias)); } } }
        sync_block(); }
}
DEVFN void p_s5_stage(Frame& F, int l, const bool stage3) { for (int tile = blockIdx.x; tile < NT32; tile += F.G) s5_tile(F, l, tile, stage3); }
DEVFN void p_s5_carry(Frame& F, int l) {
    f32x2* SS = (f32x2*)(F.ws + WS_S5S); const f32x2* A16 = (const f32x2*)(F.ws + WS_S5A16);
    for (int i = F.gtid; i < Bn * 2 * 1536; i += F.gsize) { const int gp = i % 1536, d = (i / 1536) % 2, b = i / 3072; const f32x2 A = A16[(size_t)(l * 2 + d) * 1536 + gp];
        float cr = 0.f, ci = 0.f;
        for (int q = 0; q < NG16; ++q) { const int j = d == 0 ? q : NG16 - 1 - q; const size_t o_ = (((size_t)b * NG16 + j) * 2 + d) * 1536 + gp; const f32x2 s = SS[o_]; ((f32x2*)(F.ws + WS_S5CI))[o_] = (f32x2){cr, ci};
            const float nr = A[0] * cr - A[1] * ci + s[0], ni = A[0] * ci + A[1] * cr + s[1]; cr = nr; ci = ni; } }
}
DEVFN void p_mixnorm(Frame& F) {
    bf16* ymix = (bf16*)(F.ws + WS_YMIX);
    for (int m = F.gw; m < M; m += F.ngw) { u32x4* row = (u32x4*)(ymix + (size_t)m * D);
        u32x4 v[2]; float s[2];
#pragma unroll
        for (int j = 0; j < 2; ++j) { v[j] = row[F.lane + 64 * j]; const float a0 = bf_lo(v[j].x), a1 = bf_hi(v[j].x), a2 = bf_lo(v[j].y), a3 = bf_hi(v[j].y), a4 = bf_lo(v[j].z), a5 = bf_hi(v[j].z), a6 = bf_lo(v[j].w), a7 = bf_hi(v[j].w);
            s[j] = ((a0 * a0 + a1 * a1) + (a2 * a2 + a3 * a3)) + ((a4 * a4 + a5 * a5) + (a6 * a6 + a7 * a7)); }
        const float sa = wave_sum(F.lane < 48 ? s[0] : 0.f), sb = wave_sum((F.lane >= 48 ? s[0] : 0.f) + (F.lane < 32 ? s[1] : 0.f)), sc = wave_sum(F.lane >= 32 ? s[1] : 0.f);
        const float ia = 1.0f / sqrtf(sa * (1.0f / RGW) + 1e-6f), ib = 1.0f / sqrtf(sb * (1.0f / S5W) + 1e-6f), ic = 1.0f / sqrtf(sc * (1.0f / HYW) + 1e-6f);
#pragma unroll
        for (int j = 0; j < 2; ++j) { const int ch = F.lane + 64 * j; const float f = ch < 48 ? ia : (ch < 96 ? ib : ic); u32x4 o;
            o.x = pk_bf16(bf_lo(v[j].x) * f, bf_hi(v[j].x) * f); o.y = pk_bf16(bf_lo(v[j].y) * f, bf_hi(v[j].y) * f); o.z = pk_bf16(bf_lo(v[j].z) * f, bf_hi(v[j].z) * f); o.w = pk_bf16(bf_lo(v[j].w) * f, bf_hi(v[j].w) * f);
            row[ch] = o; } }
}
DEVFN void p_final(Frame& F) {
    const float* ssq = (const float*)(F.ws + WS_SSQ); const f32x4* g4 = (const f32x4*)FIN(37) + F.lane;
    for (int m = F.gw; m < M; m += F.ngw) { const float inv = pg8::row_inv(ssq, m); f32x4* hr = (f32x4*)(F.out + (size_t)m * D) + F.lane;
#pragma unroll
        for (int j = 0; j < 4; ++j) hr[64 * j] = hr[64 * j] * inv * g4[64 * j]; }
}

constexpr int PH_PER_LAYER = 9, N_PHASES = 2 + 2 * PH_PER_LAYER;
__global__ void __launch_bounds__(NT, 2) mk_fwd(Args args) {
#ifdef CPU_EMU
    unsigned char* lds = emu_lds_base();
#else
    extern __shared__ __attribute__((aligned(16))) unsigned char lds_[];
    LAS unsigned char* lds = (LAS unsigned char*)lds_;
#endif
    Frame F; F.lds = lds; F.tid = threadIdx.x; F.lane = F.tid & 63;
#ifdef CPU_EMU
    F.wave = F.tid >> 6;
#else
    F.wave = __builtin_amdgcn_readfirstlane(F.tid >> 6);
#endif
    F.G = gridDim.x; F.gtid = blockIdx.x * NT + F.tid; F.gsize = F.G * NT; F.gw = blockIdx.x * NWAVES + F.wave; F.ngw = F.G * NWAVES;
    #ifdef CPU_EMU
    F.ap = &args;
#else
    F.ap = (KARG_PTR)__builtin_amdgcn_kernarg_segment_ptr();
#endif
    F.out = args.out; F.ws = args.ws;
#ifndef CPU_EMU
    volatile LAS unsigned* MISC = (volatile LAS unsigned*)(lds + MISC_OFF);
    if (F.tid < 32) MISC[F.tid] = 0u;
    __syncthreads();
    XcdBarrier bar = xcd_barrier_post((unsigned*)(args.ws + WS_CTL) + CW_BAR, MISC + 8);
#define GRID_BAR() xcd_barrier(bar)
#else
#define GRID_BAR() do {} while (0)
#endif
    const int lo = args.ph_lo, hi = args.ph_hi;
#define IN(k) (lo <= (k) && (k) < hi)
#define SEAM(k) do { if (IN(k) && IN((k) + 1)) GRID_BAR(); } while (0)
#define P_SSQ ((float*)(F.ws + WS_SSQ))
#define P_HB ((bf16*)(F.ws + WS_HB))
#define P_PROJ ((bf16*)(F.ws + WS_PROJ))
#define P_YMIX ((bf16*)(F.ws + WS_YMIX))
#define P_G ((bf16*)(F.ws + WS_G))
    { int l0 = 0; if (IN(0)) { LAUNDER(F, l0); p_prologue(F); } }
    SEAM(0);
    for (int lq = 0; lq < 2; ++lq) {
        int l = lq; const int p0 = 1 + lq * PH_PER_LAYER;
        if (IN(p0 + 0)) { LAUNDER(F, l); p_hid2(F, l);
            pg8::Gemm g{P_HB, (const bf16*)(F.ws + WS_WIN + l * SZ_WIN), D}; pg8::StaticOrder S; S.init(M / 256, NINP / 256, F.G, (int)blockIdx.x);
            pg8::EpiIn E{P_PROJ, P_SSQ};
            pg8::gemm_phase<pg8::EpiIn, pg8::StaticOrder, true, true>(lds, F.tid, g, S, E); }
        SEAM(p0 + 0);
        if (IN(p0 + 1)) { LAUNDER(F, l); p_mix1(F, l); p_rg_stage(F, l, false); p_s5_stage(F, l, false); }
        SEAM(p0 + 1);
        if (IN(p0 + 2)) { LAUNDER(F, l); p_s5_carry(F, l); p_rg_carry(F); p_mix2(F, l); }
        SEAM(p0 + 2);
        if (IN(p0 + 3)) { LAUNDER(F, l); p_rg_stage(F, l, true); p_s5_stage(F, l, true); }
        SEAM(p0 + 3);
        SEAM(p0 + 4);
        if (IN(p0 + 5)) { LAUNDER(F, l); p_mixnorm(F); }
        SEAM(p0 + 5);
        if (IN(p0 + 6)) { LAUNDER(F, l); pg8::Gemm g{P_YMIX, (const bf16*)(F.ws + WS_WOUT + l * SZ_WOUT), D}; pg8::StaticOrder S; S.init(M / 256, D / 256, F.G, (int)blockIdx.x);
            pg8::EpiRes E{F.out, P_HB, P_SSQ};
            pg8::gemm_phase<pg8::EpiRes, pg8::StaticOrder, true, true>(lds, F.tid, g, S, E); }
        SEAM(p0 + 6);
        if (IN(p0 + 7)) { LAUNDER(F, l); pg8::Gemm g{P_HB, (const bf16*)(F.ws + WS_WUP + l * SZ_WUP), D}; pg8::UpOrder S; S.init(Bn * NQ, FF2 / 256, F.G, (int)blockIdx.x);
            pg8::EpiUp E{P_G, P_SSQ, FIN(34) + (size_t)l * 3 * FF2, FIN(35) + (size_t)l * FF2};
            pg8::gemm_phase<pg8::EpiUp, pg8::UpOrder, true, true>(lds, F.tid, g, S, E); }
        SEAM(p0 + 7);
        if (IN(p0 + 8)) { LAUNDER(F, l); pg8::Gemm g{P_G, (const bf16*)(F.ws + WS_WDN + l * SZ_WDN), FF}; pg8::StaticOrder S; S.init(M / 256, D / 256, F.G, (int)blockIdx.x);
            pg8::EpiRes E{F.out, P_HB, P_SSQ};
            pg8::gemm_phase<pg8::EpiRes, pg8::StaticOrder, true, true>(lds, F.tid, g, S, E); }
        SEAM(p0 + 8);
    }
    { int l0 = 0; if (IN(N_PHASES - 1)) { LAUNDER(F, l0); p_final(F); } }
#undef IN
#undef SEAM
}

#ifndef MK_N_LAUNCHES
#define MK_N_LAUNCHES 1
#endif
extern "C" void kernel_launch(void* const* d_in, const int* in_sizes, int n_in, void* d_out, int out_size, void* d_ws, size_t ws_size, hipStream_t stream) {
    Args a{};
    for (int i = 0; i < 38; ++i) a.in[i] = (const float*)d_in[i];
    a.out = (float*)d_out; a.ws = (unsigned char*)d_ws;
#ifdef CPU_EMU
    const int grid = EMU_GRID;
    for (int ph = 0; ph < N_PHASES; ++ph) { a.ph_lo = ph; a.ph_hi = ph + 1; LAUNCH(mk_fwd, dim3(grid), dim3(NT), LDS_BYTES, stream, a); emu_phase_hook(ph, a); }
#else
    static int grid = 0;
    if (grid == 0) {
        if (n_in != 38 || out_size != M * D || ws_size < WS_END) { fprintf(stderr, "kernel_launch: unexpected shapes (n_in %d out %d ws %zu need %zu)\n", n_in, out_size, ws_size, (size_t)WS_END); grid = -1; return; }
        int dev = 0, cus = 0, per_cu = 0;
        if (hipGetDevice(&dev) != hipSuccess || hipDeviceGetAttribute(&cus, hipDeviceAttributeMultiprocessorCount, dev) != hipSuccess) { grid = -1; return; }
        if (hipFuncSetAttribute((const void*)mk_fwd, hipFuncAttributeMaxDynamicSharedMemorySize, LDS_BYTES) != hipSuccess) { fprintf(stderr, "kernel_launch: hipFuncSetAttribute failed\n"); grid = -1; return; }
        if (hipOccupancyMaxActiveBlocksPerMultiprocessor(&per_cu, (const void*)mk_fwd, NT, LDS_BYTES) != hipSuccess || per_cu < 1) { fprintf(stderr, "kernel_launch: occupancy query says %d\n", per_cu); (void)hipGetLastError(); per_cu = 1; }
        grid = cus;
    }
    if (grid < 0) return;
    (void)hipMemsetAsync((char*)d_ws + WS_CTL, 0, CTL_BYTES, stream);
#if MK_N_LAUNCHES == 1
    a.ph_lo = 0; a.ph_hi = N_PHASES;
    hipLaunchKernelGGL(mk_fwd, dim3(grid), dim3(NT), LDS_BYTES, stream, a);
#else
    for (int ph = 0; ph < N_PHASES; ++ph) { a.ph_lo = ph; a.ph_hi = ph + 1; hipLaunchKernelGGL(mk_fwd, dim3(grid), dim3(NT), LDS_BYTES, stream, a); }
#endif
#endif
}
```

```cpp
#ifdef CPU_EMU
#include "emu.h"
#define LAS
#define GAS
#define DEVFN static inline
#define MEMFN inline
#define WAVE_LDS_FENCE() emu::wave_sync()
#define OPAQUE16(x) do {} while (0)
#define OPAQUE_V(x) do {} while (0)
#define FRESH(x) do {} while (0)
#define MFMA_GUARD(...) do {} while (0)
#define KV(x) 0
#define ACC1(a) 0
#define ACC2(a, b) 0
#define ACC3(a, b, c) 0
#define ACC4(a, b, c, d) 0
#else
#include <hip/hip_runtime.h>
#include <cstdio>
#include <cstdint>
#define LAS __attribute__((address_space(3)))
#define GAS __attribute__((address_space(1)))
#define DEVFN __device__ __forceinline__
#define MEMFN __device__ __forceinline__
#define WAVE_LDS_FENCE() do { asm volatile("s_waitcnt lgkmcnt(0)" ::: "memory"); } while (0)
#define OPAQUE16(x) asm volatile("" : "+v"(x))
#define OPAQUE_V(x) asm volatile("" : "+v"(x))
#define FRESH(x) asm volatile("s_nop 3" : "+v"(x))
#define KV(x) "v"(x)
#define KA(x) "+v"(x)
#define MFMA_GUARD(accs, ...) asm volatile("s_nop 7\n\ts_nop 7\n\ts_nop 7\n\ts_nop 7" : accs : __VA_ARGS__)
#define ACC1(a) KA(a)
#define ACC2(a, b) KA(a), KA(b)
#define ACC3(a, b, c) KA(a), KA(b), KA(c)
#define ACC4(a, b, c, d) KA(a), KA(b), KA(c), KA(d)
typedef short bf16x8 __attribute__((ext_vector_type(8)));
typedef float f32x4 __attribute__((ext_vector_type(4)));
typedef float f32x2 __attribute__((ext_vector_type(2)));
typedef float f32x16 __attribute__((ext_vector_type(16)));
typedef unsigned u32x4 __attribute__((ext_vector_type(4)));
typedef unsigned u32x2 __attribute__((ext_vector_type(2)));
typedef __bf16 bf16x2_t __attribute__((ext_vector_type(2)));
DEVFN void sync_block() { __syncthreads(); }
DEVFN int lane_id() { int l; asm volatile("v_mbcnt_lo_u32_b32 %0, -1, 0\n\tv_mbcnt_hi_u32_b32 %0, -1, %0" : "=v"(l)); return l; }
DEVFN f32x16 mfma32(bf16x8 a, bf16x8 b, f32x16 c) { return __builtin_amdgcn_mfma_f32_32x32x16_bf16(a, b, c, 0, 0, 0); }
DEVFN f32x4 mfma16(bf16x8 a, bf16x8 b, f32x4 c) { return __builtin_amdgcn_mfma_f32_16x16x32_bf16(a, b, c, 0, 0, 0); }
DEVFN float shfl_f32(float v, int src) { return __builtin_bit_cast(float, __builtin_amdgcn_ds_bpermute(src << 2, __builtin_bit_cast(int, v))); }
DEVFN float shfl_xor_f32(float v, int m) { return shfl_f32(v, lane_id() ^ m); }
DEVFN float dpp_row_shr1(float old, float src) { return __builtin_bit_cast(float, __builtin_amdgcn_update_dpp(__builtin_bit_cast(int, old), __builtin_bit_cast(int, src), 0x111, 0xf, 0xf, false)); }
DEVFN float dpp_row_shl1(float old, float src) { return __builtin_bit_cast(float, __builtin_amdgcn_update_dpp(__builtin_bit_cast(int, old), __builtin_bit_cast(int, src), 0x101, 0xf, 0xf, false)); }
DEVFN float dpp_row_ror1(float src) { return __builtin_bit_cast(float, __builtin_amdgcn_update_dpp(0, __builtin_bit_cast(int, src), 0x121, 0xf, 0xf, false)); }
DEVFN float dpp_row_ror15(float src) { return __builtin_bit_cast(float, __builtin_amdgcn_update_dpp(0, __builtin_bit_cast(int, src), 0x12f, 0xf, 0xf, false)); }
DEVFN unsigned pk_bf16(float lo, float hi) { f32x2 v = {lo, hi}; bf16x2_t b = __builtin_convertvector(v, bf16x2_t); return __builtin_bit_cast(unsigned, b); }
DEVFN float bf_lo(unsigned u) { return __builtin_bit_cast(float, u << 16); }
DEVFN float bf_hi(unsigned u) { return __builtin_bit_cast(float, u & 0xffff0000u); }
DEVFN float fast_rcp(float x) { return __builtin_amdgcn_rcpf(x); }
DEVFN float fast_exp2(float x) { return __builtin_amdgcn_exp2f(x); }
#endif

#ifndef BATCH
#define BATCH 4
#endif
#ifndef SEQ
#define SEQ 4096
#endif
typedef unsigned short bf16;
constexpr int Bn = BATCH, L = SEQ, M = Bn * L, D = 1024, NIN = 1920, NINP = 2048, RGW = 384, S5W = 384, HYW = 256, FF = 2816, FF2 = 5632, GLUP = 512;
constexpr int NWAVES = 8, NT = NWAVES * 64;
constexpr int UPS = 254, NQ = (L + UPS - 1) / UPS;

constexpr size_t al256(size_t x) { return (x + 255) & ~(size_t)255; }
constexpr size_t WS_CTL = 0, CTL_BYTES = 1u << 20;
constexpr size_t WS_SSQ = WS_CTL + CTL_BYTES, SZ_SSQ = (size_t)M * 16 * 4;
constexpr size_t WS_S5A = WS_SSQ + SZ_SSQ, SZ_S5A = (size_t)2 * 2 * 24 * 64 * 8;
constexpr size_t WS_S5A16 = WS_S5A + SZ_S5A;
constexpr size_t WS_S5BT = WS_S5A16 + SZ_S5A, SZ_S5BT = (size_t)2 * 2 * 24 * 2 * 64 * 16 * 2;
constexpr size_t WS_S5CT = WS_S5BT + SZ_S5BT, SZ_S5CT = (size_t)2 * 2 * 24 * 16 * 128 * 2;
constexpr size_t WS_RGSP = WS_S5CT + SZ_S5CT, SZ_RGSP = al256((size_t)2 * 2 * 384 * 4);
constexpr size_t WS_RGWT = WS_RGSP + SZ_RGSP, SZ_RGWT = (size_t)2 * 2 * 2 * 6 * 64 * 64 * 2;
constexpr size_t WS_RGAG = WS_RGWT + SZ_RGWT, SZ_RGAG = (size_t)(M / 16) * 2 * RGW * 8;
constexpr size_t WS_RGCI = WS_RGAG + SZ_RGAG, SZ_RGCI = (size_t)(M / 16) * 2 * RGW * 4;
constexpr size_t WS_HID = WS_RGCI + SZ_RGCI, SZ_HID = (size_t)4 * L * 64 * 4;
constexpr size_t WS_T1 = WS_HID + SZ_HID, SZ_T1 = (size_t)(M / 16) * 2 * 1536 * 8;
constexpr size_t WS_S5S = WS_T1;
constexpr size_t WS_S5CI = WS_T1 + SZ_T1, SZ_S5CI = SZ_T1;
constexpr size_t WS_KFB = WS_S5CI + SZ_S5CI, SZ_KFB = (size_t)L * 512 * 4;
constexpr size_t SZ_WIN = (size_t)NINP * D * 2, SZ_WOUT = (size_t)D * D * 2, SZ_WUP = (size_t)FF2 * D * 2, SZ_WDN = (size_t)D * FF * 2, SZ_WGLU = (size_t)GLUP * S5W * 2;
constexpr size_t WS_WIN = WS_KFB + SZ_KFB, WS_WOUT = WS_WIN + 2 * SZ_WIN, WS_WUP = WS_WOUT + 2 * SZ_WOUT, WS_WDN = WS_WUP + 2 * SZ_WUP, WS_WGLU = WS_WDN + 2 * SZ_WDN;
constexpr size_t WS_HBPAD = WS_WGLU + 2 * SZ_WGLU, HB_FRONT = (size_t)256 * D * 2, WS_HB = WS_HBPAD + HB_FRONT, SZ_HBPAD = (size_t)(M + 768) * D * 2;
constexpr size_t WS_PROJ = WS_HBPAD + SZ_HBPAD, SZ_PROJ = (size_t)M * NINP * 2;
constexpr size_t WS_YMIX = WS_PROJ + SZ_PROJ, SZ_YMIX = (size_t)M * D * 2;
constexpr size_t WS_G = WS_PROJ;
constexpr size_t WS_END = WS_YMIX + SZ_YMIX;
constexpr size_t WS_ZT = WS_HB, WS_YT = WS_HB + (size_t)M * 256 * 2;
static_assert(SZ_PROJ + SZ_YMIX >= (size_t)M * FF * 2, "g overlay");
static_assert((size_t)M * 256 * 6 <= (size_t)M * D * 2, "zT/yT overlay");
static_assert(BATCH != 4 || SEQ != 4096 || WS_END <= ((size_t)256 << 20), "workspace over 256 MiB");

DEVFN float gelu_f(float x) { const float y = 1.5957691216057308f * (x + 0.044715f * x * x * x); return x * fast_rcp(1.0f + fast_exp2(-1.4426950408889634f * y)); }
DEVFN float sigmoid_f(float x) { return fast_rcp(1.0f + fast_exp2(-1.4426950408889634f * x)); }
DEVFN float softplus_f(float x) { return x > 0.f ? x + log1pf(expf(-x)) : log1pf(expf(x)); }
DEVFN float exp_f(float x) { return fast_exp2(1.4426950408889634f * x); }
DEVFN float expm1_f(float x) {
    const float p = x * (1.0f + x * (0.5f + x * (0.16666667f + x * (0.041666668f + x * (0.008333334f + x * 0.0013888889f)))));
    return fabsf(x) < 0.25f ? p : exp_f(x) - 1.0f; }
DEVFN float bf2f_(bf16 h) { return bf_lo((unsigned)h); }
DEVFN bf16 f2bf_(float f) { return (bf16)(pk_bf16(f, 0.f) & 0xffffu); }

namespace pg8 {
constexpr int BM = 256, BK = 64, HALF = 128, HTB = HALF * BK * 2, STAGE_BYTES = 8 * HTB, NXCD = 8, WGM = 8;
__host__ __device__ __forceinline__ int lds_byte(int r, int c) { const int st = (r >> 4) * 2 + (c >> 5), rr = r & 15, cc = c & 31, ob = rr * 64 + cc * 2; return st * 1024 + (ob ^ (((ob >> 9) & 1) << 5)); }
__host__ __device__ __forceinline__ void stage_rc(int b, int& R, int& C) { const int st = b / 1024, sb = b % 1024, swz = sb ^ (((sb >> 9) & 1) << 5); R = (st >> 1) * 16 + swz / 64; C = (st & 1) * 32 + (swz % 64) / 2; }
__host__ __device__ __forceinline__ int perm32(int rho) { const int n = rho >> 4, i = rho & 15; return 8 * (i >> 2) + 4 * n + (i & 3); }

struct Unit { int pm, pn; int arow; };
struct Gemm { const bf16* A; const bf16* Bt; int K; };

struct StaticOrder {
    int nM, nN, nwg, G, c;
    __host__ __device__ void init(int nM_, int nN_, int G_, int c_) { nM = nM_; nN = nN_; nwg = nM * nN; G = G_; c = c_; }
    __host__ __device__ bool next(int i, Unit& u) const {
        const long Lx = (long)i * G + c; if (Lx >= nwg) return false;
        int wgid = (int)Lx; { const int q = nwg / NXCD, r = nwg % NXCD, xcd = wgid % NXCD, off = wgid / NXCD; wgid = (xcd < r ? xcd * (q + 1) : r * (q + 1) + (xcd - r) * q) + off; }
        const int nig = WGM * nN, gid = wgid / nig, fm = gid * WGM, gsz = (nM - fm) < WGM ? (nM - fm) : WGM;
        u.pm = fm + ((wgid % nig) % gsz); u.pn = (wgid % nig) / gsz; u.arow = u.pm * BM; return true;
    }
};
struct UpOrder : StaticOrder {
    __host__ __device__ bool next(int i, Unit& u) const { if (!StaticOrder::next(i, u)) return false; const int b = u.pm / NQ, q = u.pm % NQ; u.arow = b * L + UPS * q - 1; return true; }
};

#ifndef CPU_EMU
#define PG8_LAS __attribute__((address_space(3)))
template <class Epi, class Sched, bool ALIGN_EPI = false, bool SP2 = false>
__device__ __forceinline__ void gemm_phase(PG8_LAS unsigned char* lds, const int tid, const Gemm g, const Sched& S, const Epi& E) {
    const int wid = __builtin_amdgcn_readfirstlane(tid >> 6), lane = tid & 63, wr = wid >> 2, wc = wid & 3, fr = lane & 15, fq = lane >> 4;
    const int K = g.K, nt = K / BK;
    unsigned voffA[2], voffB[2];
#pragma unroll
    for (int i = 0; i < 2; ++i) { int R, C; stage_rc(tid * 16 + i * 8192, R, C); const int Rb = Epi::PERM ? ((R & ~31) + perm32(R & 31)) : R;
        voffA[i] = (unsigned)(R * K + C) * 2u; voffB[i] = (unsigned)(Rb * K + C) * 2u; }
    const size_t kstep = (size_t)(BK * 2);
    const size_t hstep = (size_t)HALF * K * 2;
    const size_t tstep = 2 * hstep;
    const size_t rstep = (size_t)K * 2;
    const unsigned ldsw = (unsigned)wid * 1024u;
    const int aoff = lds_byte(wr * 64 + fr, fq * 8), boff = lds_byte(wc * 32 + fr, fq * 8);
#define PG8_SA(b, h) (((b) * 2 + (h)) * HTB)
#define PG8_SB(b, h) ((4 + (b) * 2 + (h)) * HTB)
#define PG8_STAGE(bufoff, gbase, voff) do { _Pragma("unroll") for (int _i = 0; _i < 2; ++_i) \
        __builtin_amdgcn_global_load_lds((const unsigned*)((const char*)(gbase) + (voff)[_i]), (PG8_LAS unsigned*)(lds + (bufoff) + ldsw + _i * 8192), 16, 0, 0); } while (0)
#define PG8_LDA(dst, b, h) do { _Pragma("unroll") for (int m = 0; m < 4; ++m) _Pragma("unroll") for (int k = 0; k < 2; ++k) dst[m][k] = *(const PG8_LAS bf16x8*)(lds + PG8_SA(b, h) + aoff + m * 2048 + k * 1024); } while (0)
#define PG8_LDB(dst, b, h) do { _Pragma("unroll") for (int n = 0; n < 2; ++n) _Pragma("unroll") for (int k = 0; k < 2; ++k) dst[n][k] = *(const PG8_LAS bf16x8*)(lds + PG8_SB(b, h) + boff + n * 2048 + k * 1024); } while (0)
#define PG8_MMA(ai, bj, At, Bt) do { __builtin_amdgcn_s_setprio(1); _Pragma("unroll") for (int m = 0; m < 4; ++m) _Pragma("unroll") for (int n = 0; n < 2; ++n) _Pragma("unroll") for (int k = 0; k < 2; ++k) \
        acc[ai][bj][m][n] = __builtin_amdgcn_mfma_f32_16x16x32_bf16(Bt[n][k], At[m][k], acc[ai][bj][m][n], 0, 0, 0); __builtin_amdgcn_s_setprio(0); } while (0)
#define PG8_WAIT_V(n) asm volatile("s_waitcnt vmcnt(" #n ")" ::: "memory")
#define PG8_WAIT_L(n) asm volatile("s_waitcnt lgkmcnt(" #n ")" ::: "memory")
#define PG8_BAR __builtin_amdgcn_s_barrier()
#define PG8_SCHED __builtin_amdgcn_sched_barrier(0)
    Unit cur, nxt; int ui = 0;
    if (!S.next(0, cur)) return;
    f32x4 acc[2][2][4][2];
#pragma unroll
    for (int a = 0; a < 2; ++a)
#pragma unroll
        for (int b = 0; b < 2; ++b)
#pragma unroll
            for (int m = 0; m < 4; ++m)
#pragma unroll
                for (int n = 0; n < 2; ++n) acc[a][b][m][n] = (f32x4){0.f, 0.f, 0.f, 0.f};
    bf16x8 At[4][2], B0[2][2], B1[2][2];
    const char* cA = (const char*)g.A + (long)cur.arow * (long)rstep; const char* cB = (const char*)g.Bt + (size_t)cur.pn * tstep;
    if constexpr (SP2) {
        PG8_STAGE(PG8_SB(0, 0), cB, voffB); PG8_STAGE(PG8_SB(0, 1), cB + hstep, voffB); PG8_STAGE(PG8_SA(0, 0), cA, voffA); PG8_STAGE(PG8_SA(0, 1), cA + hstep, voffA);
        if (wr == 1) PG8_BAR;
        PG8_WAIT_V(2); PG8_BAR;
        PG8_STAGE(PG8_SB(1, 0), cB + kstep, voffB); PG8_STAGE(PG8_SA(1, 0), cA + kstep, voffA); PG8_STAGE(PG8_SB(1, 1), cB + hstep + kstep, voffB);
        PG8_WAIT_V(6); PG8_BAR;
    } else {
        PG8_STAGE(PG8_SB(0, 0), cB, voffB); PG8_STAGE(PG8_SA(0, 0), cA, voffA); PG8_STAGE(PG8_SB(0, 1), cB + hstep, voffB); PG8_STAGE(PG8_SA(0, 1), cA + hstep, voffA);
        if (wr == 1) PG8_BAR;
        PG8_WAIT_V(4); PG8_BAR;
        PG8_STAGE(PG8_SB(1, 0), cB + kstep, voffB); PG8_STAGE(PG8_SA(1, 0), cA + kstep, voffA); PG8_STAGE(PG8_SB(1, 1), cB + hstep + kstep, voffB);
        PG8_WAIT_V(6); PG8_BAR;
    }
    for (;;) {
        const bool has_next = S.next(ui + 1, nxt);
        const char* nA = has_next ? (const char*)g.A + (long)nxt.arow * (long)rstep : cA; const char* nB = has_next ? (const char*)g.Bt + (size_t)nxt.pn * tstep : cB;
        for (int t = 0; t < nt; t += 2) {
            const bool last = (t == nt - 2);
            const char* a1 = cA + (size_t)(t + 1) * kstep;
            const char* a2 = last ? nA : cA + (size_t)(t + 2) * kstep; const char* b2 = last ? nB : cB + (size_t)(t + 2) * kstep;
            const char* a3 = a2 + kstep; const char* b3 = b2 + kstep;
            if constexpr (SP2) {
            PG8_LDB(B0, 0, 0); PG8_LDB(B1, 0, 1); PG8_SCHED; PG8_LDA(At, 0, 0); PG8_STAGE(PG8_SA(1, 1), a1 + hstep, voffA);
            PG8_WAIT_V(8); PG8_WAIT_L(0); PG8_BAR; PG8_MMA(0, 0, At, B0); PG8_MMA(0, 1, At, B1); PG8_BAR; PG8_SCHED;
            PG8_LDA(At, 0, 1); PG8_STAGE(PG8_SB(0, 0), b2, voffB); PG8_STAGE(PG8_SB(0, 1), b2 + hstep, voffB); PG8_STAGE(PG8_SA(0, 0), a2, voffA);
            PG8_WAIT_V(8); PG8_WAIT_L(0); PG8_BAR; PG8_MMA(1, 0, At, B0); PG8_MMA(1, 1, At, B1); PG8_BAR; PG8_SCHED;
            PG8_LDB(B0, 1, 0); PG8_LDB(B1, 1, 1); PG8_SCHED; PG8_LDA(At, 1, 0); PG8_STAGE(PG8_SA(0, 1), a2 + hstep, voffA);
            PG8_WAIT_V(8); PG8_WAIT_L(0); PG8_BAR; PG8_MMA(0, 0, At, B0); PG8_MMA(0, 1, At, B1); PG8_BAR; PG8_SCHED;
            PG8_LDA(At, 1, 1); PG8_STAGE(PG8_SB(1, 0), b3, voffB); PG8_STAGE(PG8_SB(1, 1), b3 + hstep, voffB); PG8_STAGE(PG8_SA(1, 0), a3, voffA);
            PG8_WAIT_V(8); PG8_WAIT_L(0); PG8_BAR; PG8_MMA(1, 0, At, B0); PG8_MMA(1, 1, At, B1); PG8_BAR; PG8_SCHED;
            } else {
            PG8_LDB(B0, 0, 0); PG8_SCHED; PG8_LDA(At, 0, 0); PG8_STAGE(PG8_SA(1, 1), a1 + hstep, voffA);
            PG8_WAIT_L(8); PG8_BAR; PG8_WAIT_L(0); PG8_MMA(0, 0, At, B0); PG8_BAR; PG8_SCHED;
            PG8_LDB(B1, 0, 1); PG8_STAGE(PG8_SB(0, 0), b2, voffB);
            PG8_BAR; PG8_WAIT_L(0); PG8_MMA(0, 1, At, B1); PG8_BAR;
            PG8_LDA(At, 0, 1); PG8_STAGE(PG8_SA(0, 0), a2, voffA);
            PG8_BAR; PG8_WAIT_L(0); PG8_MMA(1, 0, At, B0); PG8_BAR; PG8_SCHED;
            PG8_STAGE(PG8_SB(0, 1), b2 + hstep, voffB);
            PG8_WAIT_V(6); PG8_BAR; PG8_MMA(1, 1, At, B1); PG8_BAR;
            PG8_LDB(B0, 1, 0); PG8_SCHED; PG8_LDA(At, 1, 0); PG8_STAGE(PG8_SA(0, 1), a2 + hstep, voffA);
            PG8_WAIT_L(8); PG8_BAR; PG8_WAIT_L(0); PG8_MMA(0, 0, At, B0); PG8_BAR; PG8_SCHED;
            PG8_LDB(B1, 1, 1); PG8_STAGE(PG8_SB(1, 0), b3, voffB);
            PG8_BAR; PG8_WAIT_L(0); PG8_MMA(0, 1, At, B1); PG8_BAR;
            PG8_LDA(At, 1, 1); PG8_STAGE(PG8_SA(1, 0), a3, voffA);
            PG8_BAR; PG8_WAIT_L(0); PG8_MMA(1, 0, At, B0); PG8_BAR; PG8_SCHED;
            PG8_STAGE(PG8_SB(1, 1), b3 + hstep, voffB);
            PG8_WAIT_V(6); PG8_BAR; PG8_MMA(1, 1, At, B1); PG8_BAR;
            }
        }
        if constexpr (ALIGN_EPI) { if (wr == 0) PG8_BAR; }
        { int t_ = tid; asm volatile("" : "+v"(t_));
          E(acc, cur, wr, wc, t_ & 15, (t_ >> 4) & 3, lds + STAGE_BYTES); }
        if (!has_next) break;
#pragma unroll
        for (int a = 0; a < 2; ++a)
#pragma unroll
            for (int b = 0; b < 2; ++b)
#pragma unroll
                for (int m = 0; m < 4; ++m)
#pragma unroll
                    for (int n = 0; n < 2; ++n) acc[a][b][m][n] = (f32x4){0.f, 0.f, 0.f, 0.f};
        cur = nxt; cA = nA; cB = nB; ++ui;
        if constexpr (ALIGN_EPI) { if (wr == 1) PG8_BAR; }
    }
    PG8_WAIT_V(0);
    if constexpr (!ALIGN_EPI) { if (wr == 0) PG8_BAR; }
    PG8_BAR;
#undef PG8_SA
#undef PG8_SB
#undef PG8_STAGE
#undef PG8_LDA
#undef PG8_LDB
#undef PG8_MMA
#undef PG8_WAIT_V
#undef PG8_WAIT_L
#undef PG8_BAR
#undef PG8_SCHED
}
#else
template <class Epi, class Sched, bool ALIGN_EPI = false, bool SP2 = false>
static inline void gemm_phase(unsigned char* lds, const int tid, const Gemm g, const Sched& S, const Epi& E) {
    const int wid = tid >> 6, lane = tid & 63, wr = wid >> 2, wc = wid & 3, fr = lane & 15, fq = lane >> 4;
    static thread_local std::vector<float> Af, Bf;
    Unit cur;
    for (int ui = 0; S.next(ui, cur); ++ui) {
        const int K = g.K;
        sync_block();
        if (tid == 0) { Af.resize((size_t)256 * K); Bf.resize((size_t)256 * K);
            for (int r = 0; r < 256; ++r) for (int k = 0; k < K; ++k) { Af[(size_t)r * K + k] = bf2f_(g.A[((long)cur.arow + r) * K + k]); Bf[(size_t)r * K + k] = bf2f_(g.Bt[((size_t)cur.pn * 256 + r) * K + k]); } }
        sync_block();
        f32x4 acc[2][2][4][2];
        for (int ai = 0; ai < 2; ++ai) for (int bj = 0; bj < 2; ++bj) for (int m = 0; m < 4; ++m) for (int n = 0; n < 2; ++n) for (int e = 0; e < 4; ++e) {
            const int r = 128 * ai + 64 * wr + 16 * m + fr, c = 128 * bj + 32 * wc + (Epi::PERM ? 8 * fq + 4 * n + e : 16 * n + 4 * fq + e);
            const float* a = &Af[(size_t)r * K]; const float* b = &Bf[(size_t)c * K]; float s = 0.f;
            for (int k = 0; k < K; ++k) s += a[k] * b[k];
            acc[ai][bj][m][n][e] = s; }
        E(acc, cur, wr, wc, fr, fq, lds + STAGE_BYTES);
    }
    sync_block();
}
#endif

DEVFN float row_inv(const float* ssq, int row) {
    const f32x4* p = (const f32x4*)(ssq + (size_t)row * 16); const f32x4 a = p[0], b = p[1], c = p[2], d = p[3];
    const float s = ((a[0] + a[1]) + (a[2] + a[3])) + ((b[0] + b[1]) + (b[2] + b[3])) + ((c[0] + c[1]) + (c[2] + c[3])) + ((d[0] + d[1]) + (d[2] + d[3]));
    return 1.0f / sqrtf(s * (1.0f / D) + 1e-6f);
}
struct EpiIn {
    static constexpr bool PERM = true;
    bf16* O; const float* ssq;
    MEMFN void operator()(const f32x4 (&acc)[2][2][4][2], const Unit& u, int wr, int wc, int fr, int fq, LAS unsigned char*) const {
        const int row0 = u.pm * BM + wr * 64 + fr, col0 = u.pn * BM + wc * 32 + 8 * fq;
#pragma unroll
        for (int ai = 0; ai < 2; ++ai)
#pragma unroll
            for (int m = 0; m < 4; ++m) { const int row = row0 + ai * HALF + m * 16; const float sc = row_inv(ssq, row); bf16* rowp = O + (size_t)row * NINP + col0;
#pragma unroll
                for (int bj = 0; bj < 2; ++bj) { const f32x4 v0 = acc[ai][bj][m][0] * sc, v1 = acc[ai][bj][m][1] * sc;
                    u32x4 w; w.x = pk_bf16(v0[0], v0[1]); w.y = pk_bf16(v0[2], v0[3]); w.z = pk_bf16(v1[0], v1[1]); w.w = pk_bf16(v1[2], v1[3]);
                    *(u32x4*)(rowp + bj * HALF) = w; } }
    }
};
struct EpiRes {
    static constexpr bool PERM = false;
    float* H; bf16* HB; float* ssq;
    MEMFN void operator()(const f32x4 (&acc)[2][2][4][2], const Unit& u, int wr, int wc, int fr, int fq, LAS unsigned char*) const {
        const int row0 = u.pm * BM + wr * 64 + fr, col0 = u.pn * BM + wc * 32 + 4 * fq;
#pragma unroll
        for (int ai = 0; ai < 2; ++ai)
#pragma unroll
            for (int m = 0; m < 4; ++m) { const int row = row0 + ai * HALF + m * 16; const size_t off = (size_t)row * D + col0; float s = 0.f;
#pragma unroll
                for (int bj = 0; bj < 2; ++bj)
#pragma unroll
                    for (int n = 0; n < 2; ++n) { float* hp = H + off + bj * HALF + n * 16; const f32x4 h = *(const f32x4*)hp + acc[ai][bj][m][n]; *(f32x4*)hp = h;
                        u32x2 w; w.x = pk_bf16(h[0], h[1]); w.y = pk_bf16(h[2], h[3]); *(u32x2*)(HB + off + bj * HALF + n * 16) = w;
                        s += (h[0] * h[0] + h[1] * h[1]) + (h[2] * h[2] + h[3] * h[3]); }
                s += shfl_xor_f32(s, 16); s += shfl_xor_f32(s, 32);
                if (fq == 0) ssq[(size_t)row * 16 + u.pn * 4 + wc] = s;
                if (m & 1) asm volatile("" ::: "memory"); }
    }
};
struct EpiGlu {
    static constexpr bool PERM = true;
    const bf16* YG; const float* bias; bf16* YM;
    MEMFN void operator()(const f32x4 (&acc)[2][2][4][2], const Unit& u, int wr, int wc, int fr, int fq, LAS unsigned char*) const {
        const int row0 = u.pm * BM + wr * 64 + fr, col0 = u.pn * BM + wc * 32 + 8 * fq;
#pragma unroll
        for (int bj = 0; bj < 2; ++bj) { const int col = col0 + bj * HALF; if (u.pn == 1 && bj == 1) continue;
            const f32x4 b0 = *(const f32x4*)(bias + col), b1 = *(const f32x4*)(bias + col + 4);
#pragma unroll
            for (int ai = 0; ai < 2; ++ai)
#pragma unroll
                for (int m = 0; m < 4; ++m) { const int row = row0 + ai * HALF + m * 16;
                    const u32x4 y = *(const u32x4*)(YG + (size_t)row * S5W + col); const f32x4 a0 = acc[ai][bj][m][0] + b0, a1 = acc[ai][bj][m][1] + b1;
                    u32x4 w; w.x = pk_bf16(bf_lo(y.x) * sigmoid_f(a0[0]), bf_hi(y.x) * sigmoid_f(a0[1])); w.y = pk_bf16(bf_lo(y.y) * sigmoid_f(a0[2]), bf_hi(y.y) * sigmoid_f(a0[3]));
                    w.z = pk_bf16(bf_lo(y.z) * sigmoid_f(a1[0]), bf_hi(y.z) * sigmoid_f(a1[1])); w.w = pk_bf16(bf_lo(y.w) * sigmoid_f(a1[2]), bf_hi(y.w) * sigmoid_f(a1[3]));
                    *(u32x4*)(YM + (size_t)row * D + RGW + col) = w;
                    if (m & 1) asm volatile("" ::: "memory"); } }
    }
};
struct EpiUp {
    static constexpr bool PERM = true;
    bf16* G; const float* ssq; const float* cw; const float* cb;
    MEMFN void operator()(f32x4 (&acc)[2][2][4][2], const Unit& u, int wr, int wc, int fr, int fq, LAS unsigned char* xl) const {
        const int b = u.pm / NQ, q = u.pm % NQ, t0 = UPS * q - 1;
        LAS float* XB = (LAS float*)xl;
        const int cs = wc * 32 + 8 * fq;
#pragma unroll
        for (int ai = 0; ai < 2; ++ai)
#pragma unroll
            for (int m = 0; m < 4; ++m) { const int lr = 128 * ai + 64 * wr + 16 * m + fr, t = t0 + lr; const bool ok = (t >= 0) && (t < L);
                const float sc = ok ? row_inv(ssq, b * L + t) : 0.f;
#pragma unroll
                for (int bj = 0; bj < 2; ++bj)
#pragma unroll
                    for (int n = 0; n < 2; ++n)
#pragma unroll
                        for (int e = 0; e < 4; ++e) acc[ai][bj][m][n][e] = ok ? acc[ai][bj][m][n][e] * sc : 0.f; }
#pragma unroll
        for (int ai = 0; ai < 2; ++ai) { const int s = 2 * ai + wr;
            if (fr == 0) {
#pragma unroll
                for (int bj = 0; bj < 2; ++bj)
#pragma unroll
                    for (int n = 0; n < 2; ++n) *(LAS f32x4*)(XB + (2 * s) * 256 + bj * 128 + cs + 4 * n) = acc[ai][bj][0][n]; }
            if (fr == 15) {
#pragma unroll
                for (int bj = 0; bj < 2; ++bj)
#pragma unroll
                    for (int n = 0; n < 2; ++n) *(LAS f32x4*)(XB + (2 * s + 1) * 256 + bj * 128 + cs + 4 * n) = acc[ai][bj][3][n]; } }
#ifdef CPU_EMU
        sync_block();
#else
        asm volatile("s_waitcnt lgkmcnt(0)" ::: "memory"); __builtin_amdgcn_s_barrier(); asm volatile("" ::: "memory");
#endif
        const int j0 = u.pn * 128 + cs;
#pragma unroll
        for (int n = 0; n < 2; ++n) {
            f32x4 wa[3], wv[3]; const f32x4 ba = *(const f32x4*)(cb + j0 + 4 * n), bv = *(const f32x4*)(cb + FF + j0 + 4 * n);
#pragma unroll
            for (int k = 0; k < 3; ++k) { wa[k] = *(const f32x4*)(cw + k * FF2 + j0 + 4 * n); wv[k] = *(const f32x4*)(cw + k * FF2 + FF + j0 + 4 * n); }
#pragma unroll
            for (int ai = 0; ai < 2; ++ai) { const int s = 2 * ai + wr;
#pragma unroll
                for (int m = 0; m < 4; ++m) { const int lr = 64 * s + 16 * m + fr, t = t0 + lr;
                    f32x4 up[2], dn[2];
#pragma unroll
                    for (int bj = 0; bj < 2; ++bj) {
                        f32x4 pu, pd;
                        if (m > 0) { const f32x4 p = acc[ai][bj][m > 0 ? m - 1 : 0][n]; pu = (f32x4){dpp_row_ror1(p[0]), dpp_row_ror1(p[1]), dpp_row_ror1(p[2]), dpp_row_ror1(p[3])}; }
                        else if (s > 0) pu = *(const LAS f32x4*)(XB + (2 * (s - 1) + 1) * 256 + bj * 128 + cs + 4 * n);
                        else pu = (f32x4){0.f, 0.f, 0.f, 0.f};
                        if (m < 3) { const f32x4 p = acc[ai][bj][m < 3 ? m + 1 : 3][n]; pd = (f32x4){dpp_row_ror15(p[0]), dpp_row_ror15(p[1]), dpp_row_ror15(p[2]), dpp_row_ror15(p[3])}; }
                        else if (s < 3) pd = *(const LAS f32x4*)(XB + (2 * (s + 1)) * 256 + bj * 128 + cs + 4 * n);
                        else pd = (f32x4){0.f, 0.f, 0.f, 0.f};
                        const f32x4 x = acc[ai][bj][m][n];
#pragma unroll
                        for (int e = 0; e < 4; ++e) { up[bj][e] = dpp_row_shr1(pu[e], x[e]); dn[bj][e] = dpp_row_shl1(pd[e], x[e]); }
                    }
                    const f32x4 a = ba + wa[0] * up[0] + wa[1] * acc[ai][0][m][n] + wa[2] * dn[0];
                    const f32x4 v = bv + wv[0] * up[1] + wv[1] * acc[ai][1][m][n] + wv[2] * dn[1];
                    if (lr >= 1 && lr <= UPS && t < L) { u32x2 w; w.x = pk_bf16(gelu_f(a[0]) * v[0], gelu_f(a[1]) * v[1]); w.y = pk_bf16(gelu_f(a[2]) * v[2], gelu_f(a[3]) * v[3]);
                        *(u32x2*)(G + (size_t)(b * L + t) * FF + j0 + 4 * n) = w; }
                } } }
    }
};
}

constexpr int RING_BYTES = 131072, XCH_OFF = RING_BYTES, XCH_BYTES = 8192, MISC_OFF = XCH_OFF + XCH_BYTES, LDS_BYTES = 147456;
constexpr int CW_TMO = 0, CW_BAR = 4096;
#ifndef CPU_EMU
typedef GAS unsigned gu32;
#define XB_TMO      128
#define XB_XCNT(j)  (256  + 64 * (j))
#define XB_XSUB(j)  (1280 + 64 * (j))
#define XB_XGEN(j)  (2304 + 64 * (j))
#define XB_TOP      3328
#define XB_TOPGEN   3392
#define XCD_BAR_WORDS 3456
#define XB_SPIN_CAP (1u << 22)
__device__ __forceinline__ unsigned xb_ld(unsigned* p)              { return __hip_atomic_load(p, __ATOMIC_RELAXED, __HIP_MEMORY_SCOPE_AGENT); }
__device__ __forceinline__ unsigned xb_add(unsigned* p, unsigned v) { return __hip_atomic_fetch_add(p, v, __ATOMIC_RELAXED, __HIP_MEMORY_SCOPE_AGENT); }
__device__ __forceinline__ unsigned xb_xcc_id() { return (unsigned)__builtin_amdgcn_s_getreg((3 << 11) | 20) & 0xFu; }
#define XB_SPIN(cond, bar) do { unsigned _sp = 0; while (cond) { __builtin_amdgcn_s_sleep(1); \
    if ((++_sp & 255u) == 0u) { if (xb_ld(&(bar)[XB_TMO])) break; if (_sp > XB_SPIN_CAP) { atomicAdd(&(bar)[XB_TMO], 1u); break; } } } } while (0)
struct XcdBarrier { unsigned* bar; unsigned x; volatile LAS unsigned* st; };
__device__ __forceinline__ XcdBarrier xcd_barrier_post(unsigned* bar, volatile LAS unsigned* st) {
    XcdBarrier b; b.bar = bar; b.x = xb_xcc_id(); b.st = st;
    if (threadIdx.x == 0) (void)xb_add(&bar[XB_XCNT(b.x)], 1u);
    return b;
}
__device__ __forceinline__ void xcd_barrier_complete(unsigned* bar, unsigned x, unsigned& nloc, unsigned& nx) {
    const unsigned G = gridDim.x * gridDim.y * gridDim.z;
    unsigned sum, cnt, mine, sp = 0u;
    for (;;) {
        sum = 0u; cnt = 0u; mine = 0u;
#pragma unroll
        for (unsigned j = 0; j < 16; ++j) { const unsigned c = xb_ld(&bar[XB_XCNT(j)]); sum += c; cnt += (c > 0u) ? 1u : 0u; mine = (j == x) ? c : mine; }
        if (sum == G) break;
        __builtin_amdgcn_s_sleep(1);
        if ((++sp & 255u) == 0u) { if (xb_ld(&bar[XB_TMO])) break; if (sp > XB_SPIN_CAP) { atomicAdd(&bar[XB_TMO], 1u); break; } }
    }
    nloc = mine > 0u ? mine : 1u; nx = cnt > 0u ? cnt : 1u;
}
__device__ __forceinline__ void xcd_barrier(const XcdBarrier& b) {
    __builtin_amdgcn_fence(__ATOMIC_RELEASE, "agent");
    asm volatile("s_waitcnt vmcnt(0)" ::: "memory");
    __syncthreads();
    if (threadIdx.x == 0) {
        unsigned* bar = b.bar;
        __builtin_amdgcn_s_waitcnt(0);
        unsigned nloc = b.st[0], nx = b.st[1];
        if (nloc == 0u) { xcd_barrier_complete(bar, b.x, nloc, nx); b.st[0] = nloc; b.st[1] = nx; }
        const unsigned old = xb_add(&bar[XB_XSUB(b.x)], 1u);
        const unsigned gen = old / nloc;
        if (old + 1u == (gen + 1u) * nloc) {
            __builtin_amdgcn_fence(__ATOMIC_RELEASE, "agent");
            asm volatile("s_waitcnt vmcnt(0)" ::: "memory");
            const unsigned og = xb_add(&bar[XB_TOP], 1u);
            const unsigned tg = og / nx;
            if (og + 1u == (tg + 1u) * nx) xb_add(&bar[XB_TOPGEN], 1u);
            else XB_SPIN(xb_ld(&bar[XB_TOPGEN]) == tg, bar);
            __builtin_amdgcn_fence(__ATOMIC_ACQUIRE, "agent");
            xb_add(&bar[XB_XGEN(b.x)], 1u);
            asm volatile("s_waitcnt vmcnt(0)" ::: "memory");
        } else {
            XB_SPIN(xb_ld(&bar[XB_XGEN(b.x)]) == gen, bar);
            __builtin_amdgcn_fence(__ATOMIC_ACQUIRE, "agent");
            asm volatile("s_waitcnt vmcnt(0)" ::: "memory");
        }
    }
    __syncthreads();
}
#endif

#ifdef CPU_EMU
struct Args; static void emu_phase_hook(int ph, const Args& a);
#endif
struct Args { const float* in[38]; float* out; unsigned char* ws; int ph_lo, ph_hi; };
#ifdef CPU_EMU
typedef const Args* KARG_PTR;
#else
typedef const __attribute__((address_space(4))) Args* KARG_PTR;
#endif
struct Frame {
    LAS unsigned char* lds; int tid, lane, wave, G, gtid, gsize, gw, ngw;
    KARG_PTR ap; float* out; unsigned char* ws;
};
#define FIN(i) (F.ap->in[i])
#ifdef CPU_EMU
#define LAUNDER(F, l) do {} while (0)
#else
#define LAUNDER(F, l) do { size_t z_ = 0; asm volatile("" : "+s"(z_), "+s"(F.ap), "+s"(l), "+s"(F.wave)); F.ws = args.ws + z_; F.out = args.out + z_; F.lane = lane_id(); F.tid = (F.wave << 6) | F.lane; \
    F.gtid = blockIdx.x * NT + F.tid; F.gw = blockIdx.x * NWAVES + F.wave; } while (0)
#endif

DEVFN void transpose_item(const float* W, int ldw, int K, bf16* WT, int src_col0, int dst_row0, int k0, const float* sc, LAS float* scr, int lane) {
#pragma unroll 8
    for (int i = 0; i < 32; ++i) { const int kk = 2 * i + (lane >> 5); float v = W[(size_t)(k0 + kk) * ldw + src_col0 + (lane & 31)]; if (sc) v *= sc[k0 + kk]; scr[kk * 33 + (lane & 31)] = v; }
    WAVE_LDS_FENCE();
    const int c = lane & 7;
#pragma unroll
    for (int j = 0; j < 4; ++j) { const int n = (lane >> 3) + 8 * j; const LAS float* s = scr + (8 * c) * 33 + n;
        u32x4 o; o.x = pk_bf16(s[0 * 33], s[1 * 33]); o.y = pk_bf16(s[2 * 33], s[3 * 33]); o.z = pk_bf16(s[4 * 33], s[5 * 33]); o.w = pk_bf16(s[6 * 33], s[7 * 33]);
        *(u32x4*)(WT + (size_t)(dst_row0 + n) * K + k0 + 8 * c) = o; }
    WAVE_LDS_FENCE();
}
DEVFN float wave_sum(float v) {
#pragma unroll
    for (int o = 1; o < 64; o <<= 1) v += shfl_xor_f32(v, o);
    return v;
}
DEVFN void p_prologue(Frame& F) {
    LAS float* scr = (LAS float*)(F.lds + F.wave * 16384);
    constexpr int I_IN = 16 * 60, I_OUT = 16 * 32, I_UP = 16 * 176, I_DN = 44 * 32, I_GLU = 6 * 12, I_L = I_IN + I_OUT + I_UP + I_DN + I_GLU;
    for (int it = F.gw; it < 2 * I_L; it += F.ngw) {
        const int l = it / I_L; int r = it % I_L;
        if (r < I_IN) { const int kb = r / 60, nb = r % 60; transpose_item(FIN(2) + (size_t)l * D * NIN, NIN, D, (bf16*)(F.ws + WS_WIN + l * SZ_WIN), 32 * nb, 32 * nb, 64 * kb, FIN(1) + l * D, scr, F.lane); continue; } r -= I_IN;
        if (r < I_OUT) { const int kb = r / 32, nb = r % 32; transpose_item(FIN(31) + (size_t)l * D * D, D, D, (bf16*)(F.ws + WS_WOUT + l * SZ_WOUT), 32 * nb, 32 * nb, 64 * kb, FIN(30) + l * D, scr, F.lane); continue; } r -= I_OUT;
        if (r < I_UP) { const int kb = r / 176, nb = r % 176, sc0 = 32 * nb, half = sc0 / FF, jj = sc0 % FF, pn = jj / 128;
            transpose_item(FIN(33) + (size_t)l * D * FF2, FF2, D, (bf16*)(F.ws + WS_WUP + l * SZ_WUP), sc0, 256 * pn + 128 * half + (jj % 128), 64 * kb, FIN(32) + l * D, scr, F.lane); continue; } r -= I_UP;
        if (r < I_DN) { const int kb = r / 32, nb = r % 32; transpose_item(FIN(36) + (size_t)l * FF * D, D, FF, (bf16*)(F.ws + WS_WDN + l * SZ_WDN), 32 * nb, 32 * nb, 64 * kb, nullptr, scr, F.lane); continue; } r -= I_DN;
        { const int kb = r / 12, nb = r % 12; transpose_item(FIN(18) + (size_t)l * S5W * S5W, S5W, S5W, (bf16*)(F.ws + WS_WGLU + l * SZ_WGLU), 32 * nb, 32 * nb, 64 * kb, nullptr, scr, F.lane); }
    }
    for (int i = F.gtid; i < 2 * (128 * D / 8); i += F.gsize) { const int l = i / (128 * D / 8), r = i % (128 * D / 8); ((u32x4*)(F.ws + WS_WIN + l * SZ_WIN + (size_t)NIN * D * 2))[r] = (u32x4){0u, 0u, 0u, 0u}; }
    for (int i = F.gtid; i < 2 * (128 * S5W / 8); i += F.gsize) { const int l = i / (128 * S5W / 8), r = i % (128 * S5W / 8); ((u32x4*)(F.ws + WS_WGLU + l * SZ_WGLU + (size_t)S5W * S5W * 2))[r] = (u32x4){0u, 0u, 0u, 0u}; }
    float* ssq = (float*)(F.ws + WS_SSQ); bf16* hb = (bf16*)(F.ws + WS_HB);
    for (int m = F.gw; m < M; m += F.ngw) {
        const f32x4* xr = (const f32x4*)(FIN(0) + (size_t)m * D) + F.lane; f32x4* hr = (f32x4*)(F.out + (size_t)m * D) + F.lane; u32x2* br = (u32x2*)(hb + (size_t)m * D) + F.lane; float s = 0.f;
#pragma unroll
        for (int j = 0; j < 4; ++j) { const f32x4 v = xr[64 * j]; hr[64 * j] = v; u32x2 w; w.x = pk_bf16(v[0], v[1]); w.y = pk_bf16(v[2], v[3]); br[64 * j] = w; s += (v[0] * v[0] + v[1] * v[1]) + (v[2] * v[2] + v[3] * v[3]); }
        s = wave_sum(s);
        if (F.lane < 16) ssq[(size_t)m * 16 + F.lane] = F.lane == 0 ? s : 0.f;
    }
    for (int i = F.gtid; i < 2 * 3072; i += F.gsize) { const int l = i / 3072, r = i % 3072, dg = r / 64, p = r % 64;
        const float lr = FIN(10)[i], li = FIN(11)[i], dt = expf(FIN(12)[l * 48 + dg]);
        const float mag = expf(lr * dt), ar = mag * cosf(li * dt), ai = mag * sinf(li * dt);
        const float den = lr * lr + li * li, nr = ar - 1.0f, ni = ai, cr = (nr * lr + ni * li) / den, ci = (ni * lr - nr * li) / den;
        ((f32x2*)(F.ws + WS_S5A))[i] = (f32x2){ar, ai};
        const float m16 = expf(16.0f * lr * dt); ((f32x2*)(F.ws + WS_S5A16))[i] = (f32x2){m16 * cosf(16.0f * li * dt), m16 * sinf(16.0f * li * dt)};
        bf16* bt = (bf16*)(F.ws + WS_S5BT) + ((size_t)(l * 48 + dg) * 2) * 64 * 16; bf16* ct = (bf16*)(F.ws + WS_S5CT) + (size_t)(l * 48 + dg) * 16 * 128;
        for (int c = 0; c < 16; ++c) { const float br = FIN(13)[(size_t)i * 16 + c], bi = FIN(14)[(size_t)i * 16 + c];
            bt[(size_t)p * 16 + c] = f2bf_(cr * br - ci * bi); bt[(size_t)(64 + p) * 16 + c] = f2bf_(cr * bi + ci * br);
            const size_t ci_ = ((size_t)(l * 48 + dg) * 16 + c) * 64 + p;
            ct[(size_t)c * 128 + 2 * p] = f2bf_(FIN(15)[ci_]); ct[(size_t)c * 128 + 2 * p + 1] = f2bf_(-FIN(16)[ci_]); } }
    for (int i = F.gtid; i < 2 * 2 * RGW; i += F.gsize) ((float*)(F.ws + WS_RGSP))[i] = 8.0f * softplus_f(-FIN(9)[i]);
    for (int i = F.gtid; i < 2 * 2 * 2 * 6 * 4096; i += F.gsize) { const int k = i % 64, n = (i / 64) % 64, hd = (i / 4096) % 6, mat = (i / 24576) % 2, ld = i / 49152;
        const float* src = (mat == 0 ? FIN(5) : FIN(7)) + ((size_t)ld * 6 + hd) * 4096; ((bf16*)(F.ws + WS_RGWT))[i] = f2bf_(src[k * 64 + n]); }
    for (int i = F.gtid; i < 2 * L * 64; i += F.gsize) { const int l = i / (L * 64), r = i % (L * 64), pos = r / 64, mm = r % 64;
        const float* w1 = FIN(22) + l * 33 * 64; const float t = (float)pos / (float)(L - 1 > 1 ? L - 1 : 1), w = (6.283185307179586f / (float)L) * (float)pos;
        float acc = FIN(23)[l * 64 + mm] + t * w1[mm];
        for (int q = 0; q < 16; ++q) { const float band = 1e-4f + (float)q * ((15.0f - 1e-4f) / 15.0f), ang = w * band; acc += cosf(ang) * w1[(1 + q) * 64 + mm] - sinf(ang) * w1[(17 + q) * 64 + mm]; }
        ((float*)(F.ws + WS_HID))[i] = sinf(FIN(24)[l * 64 + mm] * acc); }
}
DEVFN void p_hid2(Frame& F, int l) {
    const float* hid1 = (const float*)(F.ws + WS_HID) + (size_t)l * L * 64; float* hid2 = (float*)(F.ws + WS_HID) + (size_t)(2 + l) * L * 64;
    for (int i = F.gtid; i < L * 64; i += F.gsize) { const int pos = i / 64, mm = i % 64; float acc = FIN(26)[l * 64 + mm];
        for (int q = 0; q < 64; ++q) acc += hid1[pos * 64 + q] * FIN(25)[l * 4096 + q * 64 + mm];
        hid2[i] = sinf(FIN(27)[l * 64 + mm] * acc); }
}

constexpr int RING_BYTES_C = 131072;
constexpr int HY_NA = L / 32;
constexpr int HY_TA = HY_NA < 32 ? HY_NA : 32;
constexpr int HY_TB = 32 / HY_TA, HY_NBLK = HY_NA + 2 * (HY_TA - 1), HY_NTILE = (HY_NA / HY_TA) * ((Bn + HY_TB - 1) / HY_TB);
constexpr int HY_CPY = 2 * L * 2 + 64;
constexpr int HY_FI = 0, HY_ZI = 4 * HY_CPY, HY_LDS = HY_ZI + Bn * HY_NBLK * 80;
static_assert(HY_LDS <= RING_BYTES_C, "hyena LDS");
DEVFN void p_hy_filter(Frame& F, int l) {
    const float* hid2 = (const float*)(F.ws + WS_HID) + (size_t)(2 + l) * L * 64; const float* w3 = FIN(28) + (size_t)l * 64 * 512; float* kfbT = (float*)(F.ws + WS_KFB);
    const float maxd = logf(1e-2f) / 0.3f, mind = logf(1e-2f) / 1.5f;
    for (int i = F.gtid; i < L * 512; i += F.gsize) { const int pos = i % L, c2 = i / L, c = c2 % 256; float acc = 0.f;
        for (int q = 0; q < 64; ++q) acc += hid2[pos * 64 + q] * w3[q * 512 + c2];
        const float delta = fabsf(mind + (float)c * ((maxd - mind) / 255.0f)), t = (float)pos / (float)(L - 1 > 1 ? L - 1 : 1);
        kfbT[i] = acc * expf(-t * delta); }
}
DEVFN void p_hy_pre(Frame& F, int l) {
    const bf16* proj = (const bf16*)(F.ws + WS_PROJ); bf16* zT = (bf16*)(F.ws + WS_ZT); const float* cw = FIN(20) + l * 3 * 768; const float* cb = FIN(21) + l * 768;
    for (int i = F.gtid; i < 256 * (M / 32); i += F.gsize) { const int c = i % 256, m0 = (i / 256) * 32, t0 = m0 % L;
        const float w1[3] = {cw[256 + c], cw[768 + 256 + c], cw[1536 + 256 + c]}, wv[3] = {cw[512 + c], cw[768 + 512 + c], cw[1536 + 512 + c]}; const float b1 = cb[256 + c], bv = cb[512 + c];
        float p1 = 0.f, pv = 0.f, c1 = 0.f, cv = 0.f;
        if (t0 > 0) { p1 = bf2f_(proj[(size_t)(m0 - 1) * NINP + 3 * RGW + 256 + c]); pv = bf2f_(proj[(size_t)(m0 - 1) * NINP + 3 * RGW + 512 + c]); }
        c1 = bf2f_(proj[(size_t)m0 * NINP + 3 * RGW + 256 + c]); cv = bf2f_(proj[(size_t)m0 * NINP + 3 * RGW + 512 + c]);
        unsigned pk[16];
#pragma unroll
        for (int j = 0; j < 32; ++j) { float n1 = 0.f, nv = 0.f;
            if (t0 + j + 1 < L) { n1 = bf2f_(proj[(size_t)(m0 + j + 1) * NINP + 3 * RGW + 256 + c]); nv = bf2f_(proj[(size_t)(m0 + j + 1) * NINP + 3 * RGW + 512 + c]); }
            const float zz = (bv + wv[0] * pv + wv[1] * cv + wv[2] * nv) * (b1 + w1[0] * p1 + w1[1] * c1 + w1[2] * n1);
            if (j & 1) pk[j >> 1] = pk_bf16(bf_lo(pk[j >> 1]), zz); else pk[j >> 1] = pk_bf16(zz, 0.f);
            p1 = c1; c1 = n1; pv = cv; cv = nv; }
        u32x4* dst = (u32x4*)(zT + (size_t)c * M + m0);
#pragma unroll
        for (int j = 0; j < 4; ++j) dst[j] = (u32x4){pk[4 * j], pk[4 * j + 1], pk[4 * j + 2], pk[4 * j + 3]}; }
}
DEVFN void hy_channel(Frame& F, int l, int c) {
    const int lane = lane_id(), w = F.wave, tid = F.tid, h = lane >> 5, r = lane & 31;
    LAS unsigned char* FI = F.lds + HY_FI; LAS unsigned char* ZI = F.lds + HY_ZI;
    const float* kf = (const float*)(F.ws + WS_KFB) + (size_t)c * L; const float* kb = (const float*)(F.ws + WS_KFB) + (size_t)(256 + c) * L; const float bias = FIN(29)[l * HYW + c];
    for (int i = tid; i < 4 * L; i += NT) { const int sg = i / L, u = 2 * (i % L); float v[2];
#pragma unroll
        for (int e = 0; e < 2; ++e) { const int m = L - (u + e) - sg; float x = 0.f;
            if (m > 0 && m < L) x = kf[m]; else if (m < 0 && m > -L) x = kb[-m]; else if (m == 0) x = kf[0] + kb[0] + bias;
            v[e] = x; }
        *(LAS unsigned*)(FI + sg * HY_CPY + u * 2) = pk_bf16(v[0], v[1]); }
    for (int i = tid; i < Bn * HY_NBLK * 5; i += NT) *(LAS u32x4*)(ZI + i * 16) = (u32x4){0u, 0u, 0u, 0u};
    sync_block();
    { const bf16* zT = (const bf16*)(F.ws + WS_ZT) + (size_t)c * M;
      for (int i = tid; i < Bn * HY_NA * 4; i += NT) { const int j = i & 3, a = (i >> 2) % HY_NA, b = (i >> 2) / HY_NA;
          *(LAS u32x4*)(ZI + ((b * HY_NBLK + a + HY_TA - 1) * 80 + 16 * j)) = *(const u32x4*)(zT + (size_t)b * L + 32 * a + 8 * j); } }
    sync_block();
    float* yT = (float*)(F.ws + WS_YT) + (size_t)c * M;
    const int sgm = (4 - (r & 3)) & 3;
    const f32x16 z16 = {0.f, 0.f, 0.f, 0.f, 0.f, 0.f, 0.f, 0.f, 0.f, 0.f, 0.f, 0.f, 0.f, 0.f, 0.f, 0.f};
    for (int tl = w; tl < HY_NTILE; tl += NWAVES) { const int aq = tl % (HY_NA / HY_TA), bq = tl / (HY_NA / HY_TA);
        const int a = aq * HY_TA + (r % HY_TA), bb = bq * HY_TB + r / HY_TA; const bool bok = bb < Bn;
        const int dlo = aq * HY_TA - (HY_NA - 1), dhi = aq * HY_TA + HY_TA - 1;
        f32x16 acc = z16; OPAQUE16(acc);
        int fa = sgm * HY_CPY + 2 * ((8 * h - r - 32 * dlo) - sgm + L);
        int za = bok ? ((bb * HY_NBLK + a - dlo + HY_TA - 1) * 80 + 16 * h) : 0;
        for (int d = dlo; d <= dhi; ++d) {
#pragma unroll
            for (int ks = 0; ks < 2; ++ks) { typedef unsigned long long u64x2 __attribute__((ext_vector_type(2)));
                u64x2 av; av.x = *(const LAS unsigned long long*)(FI + fa + 32 * ks); av.y = *(const LAS unsigned long long*)(FI + fa + 32 * ks + 8);
                const bf16x8 bv = *(const LAS bf16x8*)(ZI + za + 32 * ks);
                acc = mfma32(__builtin_bit_cast(bf16x8, av), bv, acc); }
            fa -= 64; if (bok) za -= 80; }
        if (bok) {
#pragma unroll
            for (int q = 0; q < 4; ++q) *(f32x4*)(yT + (size_t)bb * L + 32 * a + 8 * q + 4 * h) = (f32x4){acc[4 * q], acc[4 * q + 1], acc[4 * q + 2], acc[4 * q + 3]}; } }
    sync_block();
}
DEVFN void p_hy_main(Frame& F, int l) { for (int c = blockIdx.x; c < HYW; c += F.G) hy_channel(F, l, c); }
DEVFN void p_hy_post(Frame& F, int l) {
    const bf16* proj = (const bf16*)(F.ws + WS_PROJ); const float* yT = (const float*)(F.ws + WS_YT); bf16* ymix = (bf16*)(F.ws + WS_YMIX); const float* cw = FIN(20) + l * 3 * 768; const float* cb = FIN(21) + l * 768;
    for (int i = F.gtid; i < 256 * (M / 32); i += F.gsize) { const int c = i % 256, m0 = (i / 256) * 32, t0 = m0 % L;
        const float w0[3] = {cw[c], cw[768 + c], cw[1536 + c]}; const float b0 = cb[c];
        float p0 = 0.f, c0 = bf2f_(proj[(size_t)m0 * NINP + 3 * RGW + c]); if (t0 > 0) p0 = bf2f_(proj[(size_t)(m0 - 1) * NINP + 3 * RGW + c]);
        const f32x4* ys = (const f32x4*)(yT + (size_t)c * M + m0);
#pragma unroll
        for (int j4 = 0; j4 < 8; ++j4) { const f32x4 y = ys[j4];
#pragma unroll
            for (int e = 0; e < 4; ++e) { const int j = 4 * j4 + e; float n0 = 0.f; if (t0 + j + 1 < L) n0 = bf2f_(proj[(size_t)(m0 + j + 1) * NINP + 3 * RGW + c]);
                ymix[(size_t)(m0 + j) * D + RGW + S5W + c] = f2bf_(y[e] * (b0 + w0[0] * p0 + w0[1] * c0 + w0[2] * n0)); p0 = c0; c0 = n0; } } }
}
constexpr int NG16 = L / 16, NT32 = M / 32;
DEVFN int tau32(int rho) { return 16 * ((rho >> 2) & 1) + (rho & 3) + 4 * (rho >> 3); }
DEVFN bf16x8 pack8(const f32x4 a, const f32x4 b) { u32x4 w; w.x = pk_bf16(a[0], a[1]); w.y = pk_bf16(a[2], a[3]); w.z = pk_bf16(b[0], b[1]); w.w = pk_bf16(b[2], b[3]); return __builtin_bit_cast(bf16x8, w); }
DEVFN void rg_item(Frame& F, int l, int tile, int hd, const bool stage3) {
    const int lane = lane_id(), hh = lane >> 5, pl = lane & 31, m0 = tile * 32, b = m0 / L, t0 = m0 % L, grp = t0 / 16 + hh;
    const bf16* proj = (const bf16*)(F.ws + WS_PROJ); const float* cw = FIN(3) + l * 4 * RGW; const float* cb = FIN(4) + l * RGW;
    const f32x16 z16 = {0.f, 0.f, 0.f, 0.f, 0.f, 0.f, 0.f, 0.f, 0.f, 0.f, 0.f, 0.f, 0.f, 0.f, 0.f, 0.f};
    const int tt = t0 + tau32(pl); bf16x8 uf[4];
#pragma unroll
    for (int ks = 0; ks < 4; ++ks) { const int c0 = 64 * hd + 16 * ks + 8 * hh; f32x4 s0 = *(const f32x4*)(cb + c0), s1 = *(const f32x4*)(cb + c0 + 4);
#pragma unroll
        for (int k = 0; k < 4; ++k) { const int tk = tt + k - 1; const bool ok = (tk >= 0) && (tk < L);
            u32x4 x = {0u, 0u, 0u, 0u}; if (ok) x = *(const u32x4*)(proj + (size_t)(b * L + tk) * NINP + c0);
            const f32x4 w0 = *(const f32x4*)(cw + k * RGW + c0), w1 = *(const f32x4*)(cw + k * RGW + c0 + 4);
            s0 += w0 * (f32x4){bf_lo(x.x), bf_hi(x.x), bf_lo(x.y), bf_hi(x.y)}; s1 += w1 * (f32x4){bf_lo(x.z), bf_hi(x.z), bf_lo(x.w), bf_hi(x.w)}; }
        uf[ks] = pack8(s0, s1); }
    FRESH(uf[0]); FRESH(uf[1]); FRESH(uf[2]); FRESH(uf[3]);
    const bf16* WT = (const bf16*)(F.ws + WS_RGWT); f32x2* AG = (f32x2*)(F.ws + WS_RGAG); const int pl_o = pl, hh_o = hh;
#pragma unroll 1
    for (int nt = 0; nt < 2; ++nt) { int pl_ = pl_o, hh_ = hh_o; OPAQUE_V(pl_); OPAQUE_V(hh_); const int pl = pl_, hh = hh_;
        const int c = 64 * hd + 32 * nt + pl;
        f32x16 uacc; { f32x16 zz = z16; OPAQUE16(zz); uacc = zz; }
        { bf16x8 idf[2];
#pragma unroll
          for (int q = 0; q < 2; ++q) { const int kk = pl - 16 * q - 8 * hh; u32x4 w;
              w.x = (kk >> 1) == 0 ? ((kk & 1) ? 0x3F800000u : 0x3F80u) : 0u; w.y = (kk >> 1) == 1 ? ((kk & 1) ? 0x3F800000u : 0x3F80u) : 0u;
              w.z = (kk >> 1) == 2 ? ((kk & 1) ? 0x3F800000u : 0x3F80u) : 0u; w.w = (kk >> 1) == 3 ? ((kk & 1) ? 0x3F800000u : 0x3F80u) : 0u;
              if (kk < 0 || kk > 7) w = (u32x4){0u, 0u, 0u, 0u};
              idf[q] = __builtin_bit_cast(bf16x8, w); }
          FRESH(idf[0]); FRESH(idf[1]);
          if (nt == 0) { uacc = mfma32(uf[0], idf[0], uacc); uacc = mfma32(uf[1], idf[1], uacc); MFMA_GUARD(ACC1(uacc), KV(uf[0]), KV(uf[1]), KV(idf[0]), KV(idf[1])); }
          else { uacc = mfma32(uf[2], idf[0], uacc); uacc = mfma32(uf[3], idf[1], uacc); MFMA_GUARD(ACC1(uacc), KV(uf[2]), KV(uf[3]), KV(idf[0]), KV(idf[1])); } }
        f32x16 hs = z16;
#pragma unroll
        for (int d = 0; d < 2; ++d) {
            f32x16 ga, gx; { f32x16 zz = z16; OPAQUE16(zz); ga = zz; f32x16 z2 = z16; OPAQUE16(z2); gx = z2; }
            bf16x8 wa[4], wx[4];
#pragma unroll
            for (int ks = 0; ks < 4; ++ks) { const size_t o = ((((size_t)(l * 2 + d) * 2) * 6 + hd) * 64 + 32 * nt + pl) * 64 + 16 * ks + 8 * hh;
                wa[ks] = *(const bf16x8*)(WT + o); wx[ks] = *(const bf16x8*)(WT + o + (size_t)6 * 4096); }
#pragma unroll
            for (int ks = 0; ks < 4; ++ks) { FRESH(wa[ks]); FRESH(wx[ks]); }
#pragma unroll
            for (int ks = 0; ks < 4; ++ks) { ga = mfma32(uf[ks], wa[ks], ga); gx = mfma32(uf[ks], wx[ks], gx); }
            MFMA_GUARD(ACC2(ga, gx), KV(uf[0]), KV(uf[1]), KV(uf[2]), KV(uf[3]), KV(wa[0]), KV(wa[1]), KV(wa[2]), KV(wa[3]), KV(wx[0]), KV(wx[1]), KV(wx[2]), KV(wx[3]));
            const float bav = FIN(6)[l * 2 * RGW + d * RGW + c], bxv = FIN(8)[l * 2 * RGW + d * RGW + c], sp8 = ((const float*)(F.ws + WS_RGSP))[l * 2 * RGW + d * RGW + c];
#pragma unroll
            for (int reg = 0; reg < 16; ++reg) { const float r = sigmoid_f(ga[reg] + bav), ig = sigmoid_f(gx[reg] + bxv), la = -r * sp8;
                ga[reg] = exp_f(la); gx[reg] = sqrtf(-expm1_f(2.0f * la)) * (ig * uacc[reg]); }
            const size_t aidx = (((size_t)b * NG16 + grp) * 2 + d) * RGW + c;
            if (!stage3) { float P = 1.f, H = 0.f;
#pragma unroll
                for (int q = 0; q < 16; ++q) { const int reg = d == 0 ? q : 15 - q; H = ga[reg] * H + gx[reg]; P *= ga[reg]; }
                AG[aidx] = (f32x2){P, H}; }
            else { float h = ((const float*)(F.ws + WS_RGCI))[aidx];
#pragma unroll
                for (int q = 0; q < 16; ++q) { const int reg = d == 0 ? q : 15 - q; h = ga[reg] * h + gx[reg]; hs[reg] += h; } } }
        if (stage3) { bf16* ymix = (bf16*)(F.ws + WS_YMIX);
#pragma unroll
            for (int reg = 0; reg < 16; ++reg) { const size_t m = (size_t)(m0 + 16 * hh + reg); ymix[m * D + c] = f2bf_(hs[reg] * gelu_f(bf2f_(proj[m * NINP + RGW + c]))); } } }
}
DEVFN void p_rg_stage(Frame& F, int l, const bool stage3) { for (int it = F.gw; it < NT32 * 6; it += F.ngw) rg_item(F, l, it / 6, it % 6, stage3); }
DEVFN void p_rg_carry(Frame& F) {
    f32x2* AG = (f32x2*)(F.ws + WS_RGAG);
    for (int i = F.gtid; i < Bn * 2 * RGW; i += F.gsize) { const int c = i % RGW, d = (i / RGW) % 2, b = i / (2 * RGW); float H = 0.f;
        for (int q = 0; q < NG16; ++q) { const int j = d == 0 ? q : NG16 - 1 - q; const size_t o_ = (((size_t)b * NG16 + j) * 2 + d) * RGW + c; const f32x2 s = AG[o_]; ((float*)(F.ws + WS_RGCI))[o_] = H; H = s[0] * H + s[1]; } }
}
constexpr int S5_HS = 272  , S5_YS = 784  ;
DEVFN void s5_tile(Frame& F, int l, int tile, const bool stage3) {
    const int lane = lane_id(), w = F.wave, hh = lane >> 5, pl = lane & 31, m0 = tile * 32, b = m0 / L, grp = (m0 % L) / 16 + hh;
    const bf16* proj = (const bf16*)(F.ws + WS_PROJ); const bf16* BT = (const bf16*)(F.ws + WS_S5BT); const bf16* CT = (const bf16*)(F.ws + WS_S5CT);
    const f32x2* SA = (const f32x2*)(F.ws + WS_S5A); f32x2* SS = (f32x2*)(F.ws + WS_S5S);
    LAS unsigned char* Hw = F.lds + w * (32 * S5_HS); LAS unsigned char* YT = F.lds + 8 * 32 * S5_HS;
    const f32x16 z16 = {0.f, 0.f, 0.f, 0.f, 0.f, 0.f, 0.f, 0.f, 0.f, 0.f, 0.f, 0.f, 0.f, 0.f, 0.f, 0.f};
#pragma unroll 1
    for (int gi = 0; gi < 3; ++gi) { const int g = w + 8 * gi;
        const bf16x8 ua = *(const bf16x8*)(proj + (size_t)(m0 + tau32(pl)) * NINP + 2 * RGW + 16 * g + 8 * hh);
        f32x4 yacc[2] = {(f32x4){0.f, 0.f, 0.f, 0.f}, (f32x4){0.f, 0.f, 0.f, 0.f}};
#pragma unroll
        for (int d = 0; d < 2; ++d) { const size_t dg = (size_t)(l * 2 + d) * 24 + g;
            f32x16 acc[2][2];
            bf16x8 bb[2][2];
#pragma unroll
            for (int ri = 0; ri < 2; ++ri)
#pragma unroll
                for (int ph = 0; ph < 2; ++ph) bb[ri][ph] = *(const bf16x8*)(BT + ((dg * 2 + ri) * 64 + 32 * ph + pl) * 16 + 8 * hh);
            { bf16x8 ub = ua; FRESH(ub); FRESH(bb[0][0]); FRESH(bb[0][1]); FRESH(bb[1][0]); FRESH(bb[1][1]);
#pragma unroll
            for (int ri = 0; ri < 2; ++ri)
#pragma unroll
                for (int ph = 0; ph < 2; ++ph) { f32x16 zz = z16; OPAQUE16(zz); acc[ri][ph] = mfma32(ub, bb[ri][ph], zz); }
            MFMA_GUARD(ACC4(acc[0][0], acc[0][1], acc[1][0], acc[1][1]), KV(ub), KV(bb[0][0]), KV(bb[0][1]), KV(bb[1][0]), KV(bb[1][1])); }
#pragma unroll
            for (int ph = 0; ph < 2; ++ph) { const f32x2 A = SA[dg * 64 + 32 * ph + pl]; const size_t sidx = (((size_t)b * NG16 + grp) * 2 + d) * 1536 + g * 64 + 32 * ph + pl;
                float hr = 0.f, hi = 0.f; if (stage3) { const f32x2 c = ((const f32x2*)(F.ws + WS_S5CI))[sidx]; hr = c[0]; hi = c[1]; }
#pragma unroll
                for (int q = 0; q < 16; ++q) { const int reg = d == 0 ? q : 15 - q; const float nr = A[0] * hr - A[1] * hi + acc[0][ph][reg], ni = A[0] * hi + A[1] * hr + acc[1][ph][reg];
                    hr = nr; hi = ni; acc[0][ph][reg] = nr; acc[1][ph][reg] = ni; }
                if (!stage3) SS[sidx] = (f32x2){hr, hi};
                else {
#pragma unroll
                    for (int reg = 0; reg < 16; ++reg) *(LAS unsigned*)(Hw + (16 * hh + reg) * S5_HS + 4 * (32 * ph + pl)) = pk_bf16(acc[0][ph][reg], acc[1][ph][reg]); } }
            if (stage3) { WAVE_LDS_FENCE();
#pragma unroll
                for (int rt = 0; rt < 2; ++rt) { bf16x8 a2[4], b2[4];
#pragma unroll
                    for (int ks = 0; ks < 4; ++ks) { a2[ks] = *(const LAS bf16x8*)(Hw + (16 * rt + (lane & 15)) * S5_HS + (32 * ks + 8 * (lane >> 4)) * 2);
                        b2[ks] = *(const bf16x8*)(CT + (dg * 16 + (lane & 15)) * 128 + 32 * ks + 8 * (lane >> 4)); }
                    FRESH(b2[0]); FRESH(b2[1]); FRESH(b2[2]); FRESH(b2[3]); FRESH(a2[0]); FRESH(a2[1]); FRESH(a2[2]); FRESH(a2[3]);
#pragma unroll
                    for (int ks = 0; ks < 4; ++ks) yacc[rt] = mfma16(a2[ks], b2[ks], yacc[rt]);
                    MFMA_GUARD(ACC1(yacc[rt]), KV(a2[0]), KV(a2[1]), KV(a2[2]), KV(a2[3]), KV(b2[0]), KV(b2[1]), KV(b2[2]), KV(b2[3])); }
                WAVE_LDS_FENCE(); } }
        if (stage3) { const int c = lane & 15; const float dsk = FIN(17)[l * S5W + 16 * g + c];
#pragma unroll
            for (int rt = 0; rt < 2; ++rt)
#pragma unroll
                for (int reg = 0; reg < 4; ++reg) { const int t = 16 * rt + 4 * (lane >> 4) + reg; const float u = bf2f_(proj[(size_t)(m0 + t) * NINP + 2 * RGW + 16 * g + c]);
                    *(LAS bf16*)(YT + t * S5_YS + (16 * g + c) * 2) = f2bf_(gelu_f(yacc[rt][reg] + dsk * u)); } } }
    if (stage3) { sync_block();
        if (w < 4) {
            const bf16* WG = (const bf16*)(F.ws + WS_WGLU + l * SZ_WGLU); bf16* ymix = (bf16*)(F.ws + WS_YMIX);
            f32x16 ga[3] = {z16, z16, z16};
#pragma unroll 2
            for (int ks = 0; ks < 24; ++ks) { const bf16x8 a = *(const LAS bf16x8*)(YT + pl * S5_YS + (16 * ks + 8 * hh) * 2); bf16x8 bq[3];
#pragma unroll
                for (int j = 0; j < 3; ++j) bq[j] = *(const bf16x8*)(WG + (size_t)(32 * (w + 4 * j) + pl) * S5W + 16 * ks + 8 * hh);
                FRESH(bq[0]); FRESH(bq[1]); FRESH(bq[2]); bf16x8 aq = a; FRESH(aq);
#pragma unroll
                for (int j = 0; j < 3; ++j) ga[j] = mfma32(aq, bq[j], ga[j]);
                MFMA_GUARD(ACC3(ga[0], ga[1], ga[2]), KV(aq), KV(bq[0]), KV(bq[1]), KV(bq[2])); }
#pragma unroll
            for (int j = 0; j < 3; ++j) { const int n = 32 * (w + 4 * j) + pl; const float bias = FIN(19)[l * S5W + n];
#pragma unroll
                for (int reg = 0; reg < 16; ++reg) { const int t = (reg & 3) + 8 * (reg >> 2) + 4 * hh; const float y = bf2f_(*(const LAS bf16*)(YT + t * S5_YS + n * 2));
                    ymix[(size_t)(m0 + t) * D + RGW + n] = f2bf_(y * sigmoid_f(ga[j][reg] + bias)); } } }
        sync_block(); }
}
DEVFN void p_s5_stage(Frame& F, int l, const bool stage3) { for (int tile = blockIdx.x; tile < NT32; tile += F.G) s5_tile(F, l, tile, stage3); }
DEVFN void p_s5_carry(Frame& F, int l) {
    f32x2* SS = (f32x2*)(F.ws + WS_S5S); const f32x2* A16 = (const f32x2*)(F.ws + WS_S5A16);
    for (int i = F.gtid; i < Bn * 2 * 1536; i += F.gsize) { const int gp = i % 1536, d = (i / 1536) % 2, b = i / 3072; const f32x2 A = A16[(size_t)(l * 2 + d) * 1536 + gp];
        float cr = 0.f, ci = 0.f;
        for (int q = 0; q < NG16; ++q) { const int j = d == 0 ? q : NG16 - 1 - q; const size_t o_ = (((size_t)b * NG16 + j) * 2 + d) * 1536 + gp; const f32x2 s = SS[o_]; ((f32x2*)(F.ws + WS_S5CI))[o_] = (f32x2){cr, ci};
            const float nr = A[0] * cr - A[1] * ci + s[0], ni = A[0] * ci + A[1] * cr + s[1]; cr = nr; ci = ni; } }
}
DEVFN void p_mixnorm(Frame& F) {
    bf16* ymix = (bf16*)(F.ws + WS_YMIX);
    for (int m = F.gw; m < M; m += F.ngw) { u32x4* row = (u32x4*)(ymix + (size_t)m * D);
        u32x4 v[2]; float s[2];
#pragma unroll
        for (int j = 0; j < 2; ++j) { v[j] = row[F.lane + 64 * j]; const float a0 = bf_lo(v[j].x), a1 = bf_hi(v[j].x), a2 = bf_lo(v[j].y), a3 = bf_hi(v[j].y), a4 = bf_lo(v[j].z), a5 = bf_hi(v[j].z), a6 = bf_lo(v[j].w), a7 = bf_hi(v[j].w);
            s[j] = ((a0 * a0 + a1 * a1) + (a2 * a2 + a3 * a3)) + ((a4 * a4 + a5 * a5) + (a6 * a6 + a7 * a7)); }
        const float sa = wave_sum(F.lane < 48 ? s[0] : 0.f), sb = wave_sum((F.lane >= 48 ? s[0] : 0.f) + (F.lane < 32 ? s[1] : 0.f)), sc = wave_sum(F.lane >= 32 ? s[1] : 0.f);
        const float ia = 1.0f / sqrtf(sa * (1.0f / RGW) + 1e-6f), ib = 1.0f / sqrtf(sb * (1.0f / S5W) + 1e-6f), ic = 1.0f / sqrtf(sc * (1.0f / HYW) + 1e-6f);
#pragma unroll
        for (int j = 0; j < 2; ++j) { const int ch = F.lane + 64 * j; const float f = ch < 48 ? ia : (ch < 96 ? ib : ic); u32x4 o;
            o.x = pk_bf16(bf_lo(v[j].x) * f, bf_hi(v[j].x) * f); o.y = pk_bf16(bf_lo(v[j].y) * f, bf_hi(v[j].y) * f); o.z = pk_bf16(bf_lo(v[j].z) * f, bf_hi(v[j].z) * f); o.w = pk_bf16(bf_lo(v[j].w) * f, bf_hi(v[j].w) * f);
            row[ch] = o; } }
}
DEVFN void p_final(Frame& F) {
    const float* ssq = (const float*)(F.ws + WS_SSQ); const f32x4* g4 = (const f32x4*)FIN(37) + F.lane;
    for (int m = F.gw; m < M; m += F.ngw) { const float inv = pg8::row_inv(ssq, m); f32x4* hr = (f32x4*)(F.out + (size_t)m * D) + F.lane;
#pragma unroll
        for (int j = 0; j < 4; ++j) hr[64 * j] = hr[64 * j] * inv * g4[64 * j]; }
}

constexpr int PH_PER_LAYER = 9, N_PHASES = 2 + 2 * PH_PER_LAYER;
__global__ void __launch_bounds__(NT, 2) mk_fwd(Args args) {
#ifdef CPU_EMU
    unsigned char* lds = emu_lds_base();
#else
    extern __shared__ __attribute__((aligned(16))) unsigned char lds_[];
    LAS unsigned char* lds = (LAS unsigned char*)lds_;
#endif
    Frame F; F.lds = lds; F.tid = threadIdx.x; F.lane = F.tid & 63;
#ifdef CPU_EMU
    F.wave = F.tid >> 6;
#else
    F.wave = __builtin_amdgcn_readfirstlane(F.tid >> 6);
#endif
    F.G = gridDim.x; F.gtid = blockIdx.x * NT + F.tid; F.gsize = F.G * NT; F.gw = blockIdx.x * NWAVES + F.wave; F.ngw = F.G * NWAVES;
    #ifdef CPU_EMU
    F.ap = &args;
#else
    F.ap = (KARG_PTR)__builtin_amdgcn_kernarg_segment_ptr();
#endif
    F.out = args.out; F.ws = args.ws;
#ifndef CPU_EMU
    volatile LAS unsigned* MISC = (volatile LAS unsigned*)(lds + MISC_OFF);
    if (F.tid < 32) MISC[F.tid] = 0u;
    __syncthreads();
    XcdBarrier bar = xcd_barrier_post((unsigned*)(args.ws + WS_CTL) + CW_BAR, MISC + 8);
#define GRID_BAR() xcd_barrier(bar)
#else
#define GRID_BAR() do {} while (0)
#endif
    const int lo = args.ph_lo, hi = args.ph_hi;
#define IN(k) (lo <= (k) && (k) < hi)
#define SEAM(k) do { if (IN(k) && IN((k) + 1)) GRID_BAR(); } while (0)
#define P_SSQ ((float*)(F.ws + WS_SSQ))
#define P_HB ((bf16*)(F.ws + WS_HB))
#define P_PROJ ((bf16*)(F.ws + WS_PROJ))
#define P_YMIX ((bf16*)(F.ws + WS_YMIX))
#define P_G ((bf16*)(F.ws + WS_G))
    { int l0 = 0; if (IN(0)) { LAUNDER(F, l0); p_prologue(F); } }
    SEAM(0);
    for (int lq = 0; lq < 2; ++lq) {
        int l = lq; const int p0 = 1 + lq * PH_PER_LAYER;
        if (IN(p0 + 0)) { LAUNDER(F, l); p_hid2(F, l);
            pg8::Gemm g{P_HB, (const bf16*)(F.ws + WS_WIN + l * SZ_WIN), D}; pg8::StaticOrder S; S.init(M / 256, NINP / 256, F.G, (int)blockIdx.x);
            pg8::EpiIn E{P_PROJ, P_SSQ};
            pg8::gemm_phase<pg8::EpiIn, pg8::StaticOrder, true, true>(lds, F.tid, g, S, E); }
        SEAM(p0 + 0);
        if (IN(p0 + 1)) { LAUNDER(F, l); p_hy_filter(F, l); p_hy_pre(F, l); p_rg_stage(F, l, false); p_s5_stage(F, l, false); }
        SEAM(p0 + 1);
        if (IN(p0 + 2)) { LAUNDER(F, l); p_s5_carry(F, l); p_rg_carry(F); p_hy_main(F, l); }
        SEAM(p0 + 2);
        if (IN(p0 + 3)) { LAUNDER(F, l); p_hy_post(F, l); p_rg_stage(F, l, true); p_s5_stage(F, l, true); }
        SEAM(p0 + 3);
        SEAM(p0 + 4);
        if (IN(p0 + 5)) { LAUNDER(F, l); p_mixnorm(F); }
        SEAM(p0 + 5);
        if (IN(p0 + 6)) { LAUNDER(F, l); pg8::Gemm g{P_YMIX, (const bf16*)(F.ws + WS_WOUT + l * SZ_WOUT), D}; pg8::StaticOrder S; S.init(M / 256, D / 256, F.G, (int)blockIdx.x);
            pg8::EpiRes E{F.out, P_HB, P_SSQ};
            pg8::gemm_phase<pg8::EpiRes, pg8::StaticOrder, true, true>(lds, F.tid, g, S, E); }
        SEAM(p0 + 6);
        if (IN(p0 + 7)) { LAUNDER(F, l); pg8::Gemm g{P_HB, (const bf16*)(F.ws + WS_WUP + l * SZ_WUP), D}; pg8::UpOrder S; S.init(Bn * NQ, FF2 / 256, F.G, (int)blockIdx.x);
            pg8::EpiUp E{P_G, P_SSQ, FIN(34) + (size_t)l * 3 * FF2, FIN(35) + (size_t)l * FF2};
            pg8::gemm_phase<pg8::EpiUp, pg8::UpOrder, true, true>(lds, F.tid, g, S, E); }
        SEAM(p0 + 7);
        if (IN(p0 + 8)) { LAUNDER(F, l); pg8::Gemm g{P_G, (const bf16*)(F.ws + WS_WDN + l * SZ_WDN), FF}; pg8::StaticOrder S; S.init(M / 256, D / 256, F.G, (int)blockIdx.x);
            pg8::EpiRes E{F.out, P_HB, P_SSQ};
            pg8::gemm_phase<pg8::EpiRes, pg8::StaticOrder, true, true>(lds, F.tid, g, S, E); }
        SEAM(p0 + 8);
    }
    { int l0 = 0; if (IN(N_PHASES - 1)) { LAUNDER(F, l0); p_final(F); } }
#undef IN
#undef SEAM
}

#ifndef MK_N_LAUNCHES
#define MK_N_LAUNCHES 1
#endif
extern "C" void kernel_launch(void* const* d_in, const int* in_sizes, int n_in, void* d_out, int out_size, void* d_ws, size_t ws_size, hipStream_t stream) {
    Args a{};
    for (int i = 0; i < 38; ++i) a.in[i] = (const float*)d_in[i];
    a.out = (float*)d_out; a.ws = (unsigned char*)d_ws;
#ifdef CPU_EMU
    const int grid = EMU_GRID;
    for (int ph = 0; ph < N_PHASES; ++ph) { a.ph_lo = ph; a.ph_hi = ph + 1; LAUNCH(mk_fwd, dim3(grid), dim3(NT), LDS_BYTES, stream, a); emu_phase_hook(ph, a); }
#else
    static int grid = 0;
    if (grid == 0) {
        if (n_in != 38 || out_size != M * D || ws_size < WS_END) { fprintf(stderr, "kernel_launch: unexpected shapes (n_in %d out %d ws %zu need %zu)\n", n_in, out_size, ws_size, (size_t)WS_END); grid = -1; return; }
        int dev = 0, cus = 0, per_cu = 0;
        if (hipGetDevice(&dev) != hipSuccess || hipDeviceGetAttribute(&cus, hipDeviceAttributeMultiprocessorCount, dev) != hipSuccess) { grid = -1; return; }
        if (hipFuncSetAttribute((const void*)mk_fwd, hipFuncAttributeMaxDynamicSharedMemorySize, LDS_BYTES) != hipSuccess) { fprintf(stderr, "kernel_launch: hipFuncSetAttribute failed\n"); grid = -1; return; }
        if (hipOccupancyMaxActiveBlocksPerMultiprocessor(&per_cu, (const void*)mk_fwd, NT, LDS_BYTES) != hipSuccess || per_cu < 1) { fprintf(stderr, "kernel_launch: occupancy query says %d\n", per_cu); (void)hipGetLastError(); per_cu = 1; }
        grid = cus;
    }
    if (grid < 0) return;
    (void)hipMemsetAsync((char*)d_ws + WS_CTL, 0, CTL_BYTES, stream);
#if MK_N_LAUNCHES == 1
    a.ph_lo = 0; a.ph_hi = N_PHASES;
    hipLaunchKernelGGL(mk_fwd, dim3(grid), dim3(NT), LDS_BYTES, stream, a);
#else
    for (int ph = 0; ph < N_PHASES; ++ph) { a.ph_lo = ph; a.ph_hi = ph + 1; hipLaunchKernelGGL(mk_fwd, dim3(grid), dim3(NT), LDS_BYTES, stream, a); }
#endif
#endif
}
```

```cpp
#ifdef CPU_EMU
#include "emu.h"
#define LAS
#define GAS
#define DEVFN static inline
#define MEMFN inline
#define WAVE_LDS_FENCE() emu::wave_sync()
#define OPAQUE16(x) do {} while (0)
#define OPAQUE_V(x) do {} while (0)
#define FRESH(x) do {} while (0)
#define MFMA_GUARD(...) do {} while (0)
#define KV(x) 0
#define ACC1(a) 0
#define ACC2(a, b) 0
#define ACC3(a, b, c) 0
#define ACC4(a, b, c, d) 0
#else
#include <hip/hip_runtime.h>
#include <cstdio>
#include <cstdint>
#define LAS __attribute__((address_space(3)))
#define GAS __attribute__((address_space(1)))
#define DEVFN __device__ __forceinline__
#define MEMFN __device__ __forceinline__
#define WAVE_LDS_FENCE() do { asm volatile("s_waitcnt lgkmcnt(0)" ::: "memory"); } while (0)
#define OPAQUE16(x) asm volatile("" : "+v"(x))
#define OPAQUE_V(x) asm volatile("" : "+v"(x))
#define FRESH(x) asm volatile("s_nop 3" : "+v"(x))
#define KV(x) "v"(x)
#define KA(x) "+v"(x)
#define MFMA_GUARD(accs, ...) asm volatile("s_nop 7\n\ts_nop 7\n\ts_nop 7\n\ts_nop 7" : accs : __VA_ARGS__)
#define ACC1(a) KA(a)
#define ACC2(a, b) KA(a), KA(b)
#define ACC3(a, b, c) KA(a), KA(b), KA(c)
#define ACC4(a, b, c, d) KA(a), KA(b), KA(c), KA(d)
typedef short bf16x8 __attribute__((ext_vector_type(8)));
typedef float f32x4 __attribute__((ext_vector_type(4)));
typedef float f32x2 __attribute__((ext_vector_type(2)));
typedef float f32x16 __attribute__((ext_vector_type(16)));
typedef unsigned u32x4 __attribute__((ext_vector_type(4)));
typedef unsigned u32x2 __attribute__((ext_vector_type(2)));
typedef __bf16 bf16x2_t __attribute__((ext_vector_type(2)));
DEVFN void sync_block() { __syncthreads(); }
DEVFN int lane_id() { int l; asm volatile("v_mbcnt_lo_u32_b32 %0, -1, 0\n\tv_mbcnt_hi_u32_b32 %0, -1, %0" : "=v"(l)); return l; }
DEVFN f32x16 mfma32(bf16x8 a, bf16x8 b, f32x16 c) { return __builtin_amdgcn_mfma_f32_32x32x16_bf16(a, b, c, 0, 0, 0); }
DEVFN f32x4 mfma16(bf16x8 a, bf16x8 b, f32x4 c) { return __builtin_amdgcn_mfma_f32_16x16x32_bf16(a, b, c, 0, 0, 0); }
DEVFN float shfl_f32(float v, int src) { return __builtin_bit_cast(float, __builtin_amdgcn_ds_bpermute(src << 2, __builtin_bit_cast(int, v))); }
DEVFN float shfl_xor_f32(float v, int m) { return shfl_f32(v, lane_id() ^ m); }
DEVFN float dpp_row_shr1(float old, float src) { return __builtin_bit_cast(float, __builtin_amdgcn_update_dpp(__builtin_bit_cast(int, old), __builtin_bit_cast(int, src), 0x111, 0xf, 0xf, false)); }
DEVFN float dpp_row_shl1(float old, float src) { return __builtin_bit_cast(float, __builtin_amdgcn_update_dpp(__builtin_bit_cast(int, old), __builtin_bit_cast(int, src), 0x101, 0xf, 0xf, false)); }
DEVFN float dpp_row_ror1(float src) { return __builtin_bit_cast(float, __builtin_amdgcn_update_dpp(0, __builtin_bit_cast(int, src), 0x121, 0xf, 0xf, false)); }
DEVFN float dpp_row_ror15(float src) { return __builtin_bit_cast(float, __builtin_amdgcn_update_dpp(0, __builtin_bit_cast(int, src), 0x12f, 0xf, 0xf, false)); }
DEVFN unsigned pk_bf16(float lo, float hi) { f32x2 v = {lo, hi}; bf16x2_t b = __builtin_convertvector(v, bf16x2_t); return __builtin_bit_cast(unsigned, b); }
DEVFN float bf_lo(unsigned u) { return __builtin_bit_cast(float, u << 16); }
DEVFN float bf_hi(unsigned u) { return __builtin_bit_cast(float, u & 0xffff0000u); }
DEVFN float fast_rcp(float x) { return __builtin_amdgcn_rcpf(x); }
DEVFN float fast_exp2(float x) { return __builtin_amdgcn_exp2f(x); }
#endif

#ifndef BATCH
#define BATCH 4
#endif
#ifndef SEQ
#define SEQ 4096
#endif
typedef unsigned short bf16;
constexpr int Bn = BATCH, L = SEQ, M = Bn * L, D = 1024, NIN = 1920, NINP = 2048, RGW = 384, S5W = 384, HYW = 256, FF = 2816, FF2 = 5632, GLUP = 512;
constexpr int NWAVES = 8, NT = NWAVES * 64;
constexpr int UPS = 254, NQ = (L + UPS - 1) / UPS;

constexpr size_t al256(size_t x) { return (x + 255) & ~(size_t)255; }
constexpr size_t WS_CTL = 0, CTL_BYTES = 1u << 20;
constexpr size_t WS_SSQ = WS_CTL + CTL_BYTES, SZ_SSQ = (size_t)M * 16 * 4;
constexpr size_t WS_S5A = WS_SSQ + SZ_SSQ, SZ_S5A = (size_t)2 * 2 * 24 * 64 * 8;
constexpr size_t WS_S5A16 = WS_S5A + SZ_S5A;
constexpr size_t WS_S5BT = WS_S5A16 + SZ_S5A, SZ_S5BT = (size_t)2 * 2 * 24 * 2 * 64 * 16 * 2;
constexpr size_t WS_S5CT = WS_S5BT + SZ_S5BT, SZ_S5CT = (size_t)2 * 2 * 24 * 16 * 128 * 2;
constexpr size_t WS_RGSP = WS_S5CT + SZ_S5CT, SZ_RGSP = al256((size_t)2 * 2 * 384 * 4);
constexpr size_t WS_RGWT = WS_RGSP + SZ_RGSP, SZ_RGWT = (size_t)2 * 2 * 2 * 6 * 64 * 64 * 2;
constexpr size_t WS_RGAG = WS_RGWT + SZ_RGWT, SZ_RGAG = (size_t)(M / 16) * 2 * RGW * 8;
constexpr size_t WS_RGCI = WS_RGAG + SZ_RGAG, SZ_RGCI = (size_t)(M / 16) * 2 * RGW * 4;
constexpr size_t WS_HID = WS_RGCI + SZ_RGCI, SZ_HID = (size_t)4 * L * 64 * 4;
constexpr size_t WS_T1 = WS_HID + SZ_HID, SZ_T1 = (size_t)(M / 16) * 2 * 1536 * 8;
constexpr size_t WS_S5S = WS_T1;
constexpr size_t WS_S5CI = WS_T1 + SZ_T1, SZ_S5CI = SZ_T1;
constexpr size_t WS_KFB = WS_S5CI + SZ_S5CI, SZ_KFB = (size_t)L * 512 * 4;
constexpr size_t SZ_WIN = (size_t)NINP * D * 2, SZ_WOUT = (size_t)D * D * 2, SZ_WUP = (size_t)FF2 * D * 2, SZ_WDN = (size_t)D * FF * 2, SZ_WGLU = (size_t)GLUP * S5W * 2;
constexpr size_t WS_WIN = WS_KFB + SZ_KFB, WS_WOUT = WS_WIN + 2 * SZ_WIN, WS_WUP = WS_WOUT + 2 * SZ_WOUT, WS_WDN = WS_WUP + 2 * SZ_WUP, WS_WGLU = WS_WDN + 2 * SZ_WDN;
constexpr size_t WS_HBPAD = WS_WGLU + 2 * SZ_WGLU, HB_FRONT = (size_t)256 * D * 2, WS_HB = WS_HBPAD + HB_FRONT, SZ_HBPAD = (size_t)(M + 768) * D * 2;
constexpr size_t WS_PROJ = WS_HBPAD + SZ_HBPAD, SZ_PROJ = (size_t)M * NINP * 2;
constexpr size_t WS_YMIX = WS_PROJ + SZ_PROJ, SZ_YMIX = (size_t)M * D * 2;
constexpr size_t WS_G = WS_PROJ;
constexpr size_t WS_END = WS_YMIX + SZ_YMIX;
constexpr size_t WS_ZT = WS_HB, WS_YT = WS_HB + (size_t)M * 256 * 2;
static_assert(SZ_PROJ + SZ_YMIX >= (size_t)M * FF * 2, "g overlay");
static_assert((size_t)M * 256 * 6 <= (size_t)M * D * 2, "zT/yT overlay");
static_assert(BATCH != 4 || SEQ != 4096 || WS_END <= ((size_t)256 << 20), "workspace over 256 MiB");

DEVFN float gelu_f(float x) { const float y = 1.5957691216057308f * (x + 0.044715f * x * x * x); return x * fast_rcp(1.0f + fast_exp2(-1.4426950408889634f * y)); }
DEVFN float sigmoid_f(float x) { return fast_rcp(1.0f + fast_exp2(-1.4426950408889634f * x)); }
DEVFN float softplus_f(float x) { return x > 0.f ? x + log1pf(expf(-x)) : log1pf(expf(x)); }
DEVFN float exp_f(float x) { return fast_exp2(1.4426950408889634f * x); }
DEVFN float expm1_f(float x) {
    const float p = x * (1.0f + x * (0.5f + x * (0.16666667f + x * (0.041666668f + x * (0.008333334f + x * 0.0013888889f)))));
    return fabsf(x) < 0.25f ? p : exp_f(x) - 1.0f; }
DEVFN float bf2f_(bf16 h) { return bf_lo((unsigned)h); }
DEVFN bf16 f2bf_(float f) { return (bf16)(pk_bf16(f, 0.f) & 0xffffu); }

namespace pg8 {
constexpr int BM = 256, BK = 64, HALF = 128, HTB = HALF * BK * 2, STAGE_BYTES = 8 * HTB, NXCD = 8, WGM = 8;
__host__ __device__ __forceinline__ int lds_byte(int r, int c) { const int st = (r >> 4) * 2 + (c >> 5), rr = r & 15, cc = c & 31, ob = rr * 64 + cc * 2; return st * 1024 + (ob ^ (((ob >> 9) & 1) << 5)); }
__host__ __device__ __forceinline__ void stage_rc(int b, int& R, int& C) { const int st = b / 1024, sb = b % 1024, swz = sb ^ (((sb >> 9) & 1) << 5); R = (st >> 1) * 16 + swz / 64; C = (st & 1) * 32 + (swz % 64) / 2; }
__host__ __device__ __forceinline__ int perm32(int rho) { const int n = rho >> 4, i = rho & 15; return 8 * (i >> 2) + 4 * n + (i & 3); }

struct Unit { int pm, pn; int arow; };
struct Gemm { const bf16* A; const bf16* Bt; int K; };

struct StaticOrder {
    int nM, nN, nwg, G, c;
    __host__ __device__ void init(int nM_, int nN_, int G_, int c_) { nM = nM_; nN = nN_; nwg = nM * nN; G = G_; c = c_; }
    __host__ __device__ bool next(int i, Unit& u) const {
        const long Lx = (long)i * G + c; if (Lx >= nwg) return false;
        int wgid = (int)Lx; { const int q = nwg / NXCD, r = nwg % NXCD, xcd = wgid % NXCD, off = wgid / NXCD; wgid = (xcd < r ? xcd * (q + 1) : r * (q + 1) + (xcd - r) * q) + off; }
        const int nig = WGM * nN, gid = wgid / nig, fm = gid * WGM, gsz = (nM - fm) < WGM ? (nM - fm) : WGM;
        u.pm = fm + ((wgid % nig) % gsz); u.pn = (wgid % nig) / gsz; u.arow = u.pm * BM; return true;
    }
};
struct UpOrder : StaticOrder {
    __host__ __device__ bool next(int i, Unit& u) const { if (!StaticOrder::next(i, u)) return false; const int b = u.pm / NQ, q = u.pm % NQ; u.arow = b * L + UPS * q - 1; return true; }
};

#ifndef CPU_EMU
#define PG8_LAS __attribute__((address_space(3)))
template <class Epi, class Sched, bool ALIGN_EPI = false, bool SP2 = false>
__device__ __forceinline__ void gemm_phase(PG8_LAS unsigned char* lds, const int tid, const Gemm g, const Sched& S, const Epi& E) {
    const int wid = __builtin_amdgcn_readfirstlane(tid >> 6), lane = tid & 63, wr = wid >> 2, wc = wid & 3, fr = lane & 15, fq = lane >> 4;
    const int K = g.K, nt = K / BK;
    unsigned voffA[2], voffB[2];
#pragma unroll
    for (int i = 0; i < 2; ++i) { int R, C; stage_rc(tid * 16 + i * 8192, R, C); const int Rb = Epi::PERM ? ((R & ~31) + perm32(R & 31)) : R;
        voffA[i] = (unsigned)(R * K + C) * 2u; voffB[i] = (unsigned)(Rb * K + C) * 2u; }
    const size_t kstep = (size_t)(BK * 2);
    const size_t hstep = (size_t)HALF * K * 2;
    const size_t tstep = 2 * hstep;
    const size_t rstep = (size_t)K * 2;
    const unsigned ldsw = (unsigned)wid * 1024u;
    const int aoff = lds_byte(wr * 64 + fr, fq * 8), boff = lds_byte(wc * 32 + fr, fq * 8);
#define PG8_SA(b, h) (((b) * 2 + (h)) * HTB)
#define PG8_SB(b, h) ((4 + (b) * 2 + (h)) * HTB)
#define PG8_STAGE(bufoff, gbase, voff) do { _Pragma("unroll") for (int _i = 0; _i < 2; ++_i) \
        __builtin_amdgcn_global_load_lds((const unsigned*)((const char*)(gbase) + (voff)[_i]), (PG8_LAS unsigned*)(lds + (bufoff) + ldsw + _i * 8192), 16, 0, 0); } while (0)
#define PG8_LDA(dst, b, h) do { _Pragma("unroll") for (int m = 0; m < 4; ++m) _Pragma("unroll") for (int k = 0; k < 2; ++k) dst[m][k] = *(const PG8_LAS bf16x8*)(lds + PG8_SA(b, h) + aoff + m * 2048 + k * 1024); } while (0)
#define PG8_LDB(dst, b, h) do { _Pragma("unroll") for (int n = 0; n < 2; ++n) _Pragma("unroll") for (int k = 0; k < 2; ++k) dst[n][k] = *(const PG8_LAS bf16x8*)(lds + PG8_SB(b, h) + boff + n * 2048 + k * 1024); } while (0)
#define PG8_MMA(ai, bj, At, Bt) do { __builtin_amdgcn_s_setprio(1); _Pragma("unroll") for (int m = 0; m < 4; ++m) _Pragma("unroll") for (int n = 0; n < 2; ++n) _Pragma("unroll") for (int k = 0; k < 2; ++k) \
        acc[ai][bj][m][n] = __builtin_amdgcn_mfma_f32_16x16x32_bf16(Bt[n][k], At[m][k], acc[ai][bj][m][n], 0, 0, 0); __builtin_amdgcn_s_setprio(0); } while (0)
#define PG8_WAIT_V(n) asm volatile("s_waitcnt vmcnt(" #n ")" ::: "memory")
#define PG8_WAIT_L(n) asm volatile("s_waitcnt lgkmcnt(" #n ")" ::: "memory")
#define PG8_BAR __builtin_amdgcn_s_barrier()
#define PG8_SCHED __builtin_amdgcn_sched_barrier(0)
    Unit cur, nxt; int ui = 0;
    if (!S.next(0, cur)) return;
    f32x4 acc[2][2][4][2];
#pragma unroll
    for (int a = 0; a < 2; ++a)
#pragma unroll
        for (int b = 0; b < 2; ++b)
#pragma unroll
            for (int m = 0; m < 4; ++m)
#pragma unroll
                for (int n = 0; n < 2; ++n) acc[a][b][m][n] = (f32x4){0.f, 0.f, 0.f, 0.f};
    bf16x8 At[4][2], B0[2][2], B1[2][2];
    const char* cA = (const char*)g.A + (long)cur.arow * (long)rstep; const char* cB = (const char*)g.Bt + (size_t)cur.pn * tstep;
    if constexpr (SP2) {
        PG8_STAGE(PG8_SB(0, 0), cB, voffB); PG8_STAGE(PG8_SB(0, 1), cB + hstep, voffB); PG8_STAGE(PG8_SA(0, 0), cA, voffA); PG8_STAGE(PG8_SA(0, 1), cA + hstep, voffA);
        if (wr == 1) PG8_BAR;
        PG8_WAIT_V(2); PG8_BAR;
        PG8_STAGE(PG8_SB(1, 0), cB + kstep, voffB); PG8_STAGE(PG8_SA(1, 0), cA + kstep, voffA); PG8_STAGE(PG8_SB(1, 1), cB + hstep + kstep, voffB);
        PG8_WAIT_V(6); PG8_BAR;
    } else {
        PG8_STAGE(PG8_SB(0, 0), cB, voffB); PG8_STAGE(PG8_SA(0, 0), cA, voffA); PG8_STAGE(PG8_SB(0, 1), cB + hstep, voffB); PG8_STAGE(PG8_SA(0, 1), cA + hstep, voffA);
        if (wr == 1) PG8_BAR;
        PG8_WAIT_V(4); PG8_BAR;
        PG8_STAGE(PG8_SB(1, 0), cB + kstep, voffB); PG8_STAGE(PG8_SA(1, 0), cA + kstep, voffA); PG8_STAGE(PG8_SB(1, 1), cB + hstep + kstep, voffB);
        PG8_WAIT_V(6); PG8_BAR;
    }
    for (;;) {
        const bool has_next = S.next(ui + 1, nxt);
        const char* nA = has_next ? (const char*)g.A + (long)nxt.arow * (long)rstep : cA; const char* nB = has_next ? (const char*)g.Bt + (size_t)nxt.pn * tstep : cB;
        for (int t = 0; t < nt; t += 2) {
            const bool last = (t == nt - 2);
            const char* a1 = cA + (size_t)(t + 1) * kstep;
            const char* a2 = last ? nA : cA + (size_t)(t + 2) * kstep; const char* b2 = last ? nB : cB + (size_t)(t + 2) * kstep;
            const char* a3 = a2 + kstep; const char* b3 = b2 + kstep;
            if constexpr (SP2) {
            PG8_LDB(B0, 0, 0); PG8_LDB(B1, 0, 1); PG8_SCHED; PG8_LDA(At, 0, 0); PG8_STAGE(PG8_SA(1, 1), a1 + hstep, voffA);
            PG8_WAIT_V(8); PG8_WAIT_L(0); PG8_BAR; PG8_MMA(0, 0, At, B0); PG8_MMA(0, 1, At, B1); PG8_BAR; PG8_SCHED;
            PG8_LDA(At, 0, 1); PG8_STAGE(PG8_SB(0, 0), b2, voffB); PG8_STAGE(PG8_SB(0, 1), b2 + hstep, voffB); PG8_STAGE(PG8_SA(0, 0), a2, voffA);
            PG8_WAIT_V(8); PG8_WAIT_L(0); PG8_BAR; PG8_MMA(1, 0, At, B0); PG8_MMA(1, 1, At, B1); PG8_BAR; PG8_SCHED;
            PG8_LDB(B0, 1, 0); PG8_LDB(B1, 1, 1); PG8_SCHED; PG8_LDA(At, 1, 0); PG8_STAGE(PG8_SA(0, 1), a2 + hstep, voffA);
            PG8_WAIT_V(8); PG8_WAIT_L(0); PG8_BAR; PG8_MMA(0, 0, At, B0); PG8_MMA(0, 1, At, B1); PG8_BAR; PG8_SCHED;
            PG8_LDA(At, 1, 1); PG8_STAGE(PG8_SB(1, 0), b3, voffB); PG8_STAGE(PG8_SB(1, 1), b3 + hstep, voffB); PG8_STAGE(PG8_SA(1, 0), a3, voffA);
            PG8_WAIT_V(8); PG8_WAIT_L(0); PG8_BAR; PG8_MMA(1, 0, At, B0); PG8_MMA(1, 1, At, B1); PG8_BAR; PG8_SCHED;
            } else {
            PG8_LDB(B0, 0, 0); PG8_SCHED; PG8_LDA(At, 0, 0); PG8_STAGE(PG8_SA(1, 1), a1 + hstep, voffA);
            PG8_WAIT_L(8); PG8_BAR; PG8_WAIT_L(0); PG8_MMA(0, 0, At, B0); PG8_BAR; PG8_SCHED;
            PG8_LDB(B1, 0, 1); PG8_STAGE(PG8_SB(0, 0), b2, voffB);
            PG8_BAR; PG8_WAIT_L(0); PG8_MMA(0, 1, At, B1); PG8_BAR;
            PG8_LDA(At, 0, 1); PG8_STAGE(PG8_SA(0, 0), a2, voffA);
            PG8_BAR; PG8_WAIT_L(0); PG8_MMA(1, 0, At, B0); PG8_BAR; PG8_SCHED;
            PG8_STAGE(PG8_SB(0, 1), b2 + hstep, voffB);
            PG8_WAIT_V(6); PG8_BAR; PG8_MMA(1, 1, At, B1); PG8_BAR;
            PG8_LDB(B0, 1, 0); PG8_SCHED; PG8_LDA(At, 1, 0); PG8_STAGE(PG8_SA(0, 1), a2 + hstep, voffA);
            PG8_WAIT_L(8); PG8_BAR; PG8_WAIT_L(0); PG8_MMA(0, 0, At, B0); PG8_BAR; PG8_SCHED;
            PG8_LDB(B1, 1, 1); PG8_STAGE(PG8_SB(1, 0), b3, voffB);
            PG8_BAR; PG8_WAIT_L(0); PG8_MMA(0, 1, At, B1); PG8_BAR;
            PG8_LDA(At, 1, 1); PG8_STAGE(PG8_SA(1, 0), a3, voffA);
            PG8_BAR; PG8_WAIT_L(0); PG8_MMA(1, 0, At, B0); PG8_BAR; PG8_SCHED;
            PG8_STAGE(PG8_SB(1, 1), b3 + hstep, voffB);
            PG8_WAIT_V(6); PG8_BAR; PG8_MMA(1, 1, At, B1); PG8_BAR;
            }
        }
        if constexpr (ALIGN_EPI) { if (wr == 0) PG8_BAR; }
        { int t_ = tid; asm volatile("" : "+v"(t_));
          E(acc, cur, wr, wc, t_ & 15, (t_ >> 4) & 3, lds + STAGE_BYTES); }
        if (!has_next) break;
#pragma unroll
        for (int a = 0; a < 2; ++a)
#pragma unroll
            for (int b = 0; b < 2; ++b)
#pragma unroll
                for (int m = 0; m < 4; ++m)
#pragma unroll
                    for (int n = 0; n < 2; ++n) acc[a][b][m][n] = (f32x4){0.f, 0.f, 0.f, 0.f};
        cur = nxt; cA = nA; cB = nB; ++ui;
        if constexpr (ALIGN_EPI) { if (wr == 1) PG8_BAR; }
    }
    PG8_WAIT_V(0);
    if constexpr (!ALIGN_EPI) { if (wr == 0) PG8_BAR; }
    PG8_BAR;
#undef PG8_SA
#undef PG8_SB
#undef PG8_STAGE
#undef PG8_LDA
#undef PG8_LDB
#undef PG8_MMA
#undef PG8_WAIT_V
#undef PG8_WAIT_L
#undef PG8_BAR
#undef PG8_SCHED
}
#else
template <class Epi, class Sched, bool ALIGN_EPI = false, bool SP2 = false>
static inline void gemm_phase(unsigned char* lds, const int tid, const Gemm g, const Sched& S, const Epi& E) {
    const int wid = tid >> 6, lane = tid & 63, wr = wid >> 2, wc = wid & 3, fr = lane & 15, fq = lane >> 4;
    static thread_local std::vector<float> Af, Bf;
    Unit cur;
    for (int ui = 0; S.next(ui, cur); ++ui) {
        const int K = g.K;
        sync_block();
        if (tid == 0) { Af.resize((size_t)256 * K); Bf.resize((size_t)256 * K);
            for (int r = 0; r < 256; ++r) for (int k = 0; k < K; ++k) { Af[(size_t)r * K + k] = bf2f_(g.A[((long)cur.arow + r) * K + k]); Bf[(size_t)r * K + k] = bf2f_(g.Bt[((size_t)cur.pn * 256 + r) * K + k]); } }
        sync_block();
        f32x4 acc[2][2][4][2];
        for (int ai = 0; ai < 2; ++ai) for (int bj = 0; bj < 2; ++bj) for (int m = 0; m < 4; ++m) for (int n = 0; n < 2; ++n) for (int e = 0; e < 4; ++e) {
            const int r = 128 * ai + 64 * wr + 16 * m + fr, c = 128 * bj + 32 * wc + (Epi::PERM ? 8 * fq + 4 * n + e : 16 * n + 4 * fq + e);
            const float* a = &Af[(size_t)r * K]; const float* b = &Bf[(size_t)c * K]; float s = 0.f;
            for (int k = 0; k < K; ++k) s += a[k] * b[k];
            acc[ai][bj][m][n][e] = s; }
        E(acc, cur, wr, wc, fr, fq, lds + STAGE_BYTES);
    }
    sync_block();
}
#endif

DEVFN float row_inv(const float* ssq, int row) {
    const f32x4* p = (const f32x4*)(ssq + (size_t)row * 16); const f32x4 a = p[0], b = p[1], c = p[2], d = p[3];
    const float s = ((a[0] + a[1]) + (a[2] + a[3])) + ((b[0] + b[1]) + (b[2] + b[3])) + ((c[0] + c[1]) + (c[2] + c[3])) + ((d[0] + d[1]) + (d[2] + d[3]));
    return 1.0f / sqrtf(s * (1.0f / D) + 1e-6f);
}
struct EpiIn {
    static constexpr bool PERM = true;
    bf16* O; const float* ssq;
    MEMFN void operator()(const f32x4 (&acc)[2][2][4][2], const Unit& u, int wr, int wc, int fr, int fq, LAS unsigned char*) const {
        const int row0 = u.pm * BM + wr * 64 + fr, col0 = u.pn * BM + wc * 32 + 8 * fq;
#pragma unroll
        for (int ai = 0; ai < 2; ++ai)
#pragma unroll
            for (int m = 0; m < 4; ++m) { const int row = row0 + ai * HALF + m * 16; const float sc = row_inv(ssq, row); bf16* rowp = O + (size_t)row * NINP + col0;
#pragma unroll
                for (int bj = 0; bj < 2; ++bj) { const f32x4 v0 = acc[ai][bj][m][0] * sc, v1 = acc[ai][bj][m][1] * sc;
                    u32x4 w; w.x = pk_bf16(v0[0], v0[1]); w.y = pk_bf16(v0[2], v0[3]); w.z = pk_bf16(v1[0], v1[1]); w.w = pk_bf16(v1[2], v1[3]);
                    *(u32x4*)(rowp + bj * HALF) = w; } }
    }
};
struct EpiRes {
    static constexpr bool PERM = false;
    float* H; bf16* HB; float* ssq;
    MEMFN void operator()(const f32x4 (&acc)[2][2][4][2], const Unit& u, int wr, int wc, int fr, int fq, LAS unsigned char*) const {
        const int row0 = u.pm * BM + wr * 64 + fr, col0 = u.pn * BM + wc * 32 + 4 * fq;
#pragma unroll
        for (int ai = 0; ai < 2; ++ai)
#pragma unroll
            for (int m = 0; m < 4; ++m) { const int row = row0 + ai * HALF + m * 16; const size_t off = (size_t)row * D + col0; float s = 0.f;
#pragma unroll
                for (int bj = 0; bj < 2; ++bj)
#pragma unroll
                    for (int n = 0; n < 2; ++n) { float* hp = H + off + bj * HALF + n * 16; const f32x4 h = *(const f32x4*)hp + acc[ai][bj][m][n]; *(f32x4*)hp = h;
                        u32x2 w; w.x = pk_bf16(h[0], h[1]); w.y = pk_bf16(h[2], h[3]); *(u32x2*)(HB + off + bj * HALF + n * 16) = w;
                        s += (h[0] * h[0] + h[1] * h[1]) + (h[2] * h[2] + h[3] * h[3]); }
                s += shfl_xor_f32(s, 16); s += shfl_xor_f32(s, 32);
                if (fq == 0) ssq[(size_t)row * 16 + u.pn * 4 + wc] = s;
                if (m & 1) asm volatile("" ::: "memory"); }
    }
};
struct EpiGlu {
    static constexpr bool PERM = true;
    const bf16* YG; const float* bias; bf16* YM;
    MEMFN void operator()(const f32x4 (&acc)[2][2][4][2], const Unit& u, int wr, int wc, int fr, int fq, LAS unsigned char*) const {
        const int row0 = u.pm * BM + wr * 64 + fr, col0 = u.pn * BM + wc * 32 + 8 * fq;
#pragma unroll
        for (int bj = 0; bj < 2; ++bj) { const int col = col0 + bj * HALF; if (u.pn == 1 && bj == 1) continue;
            const f32x4 b0 = *(const f32x4*)(bias + col), b1 = *(const f32x4*)(bias + col + 4);
#pragma unroll
            for (int ai = 0; ai < 2; ++ai)
#pragma unroll
                for (int m = 0; m < 4; ++m) { const int row = row0 + ai * HALF + m * 16;
                    const u32x4 y = *(const u32x4*)(YG + (size_t)row * S5W + col); const f32x4 a0 = acc[ai][bj][m][0] + b0, a1 = acc[ai][bj][m][1] + b1;
                    u32x4 w; w.x = pk_bf16(bf_lo(y.x) * sigmoid_f(a0[0]), bf_hi(y.x) * sigmoid_f(a0[1])); w.y = pk_bf16(bf_lo(y.y) * sigmoid_f(a0[2]), bf_hi(y.y) * sigmoid_f(a0[3]));
                    w.z = pk_bf16(bf_lo(y.z) * sigmoid_f(a1[0]), bf_hi(y.z) * sigmoid_f(a1[1])); w.w = pk_bf16(bf_lo(y.w) * sigmoid_f(a1[2]), bf_hi(y.w) * sigmoid_f(a1[3]));
                    *(u32x4*)(YM + (size_t)row * D + RGW + col) = w;
                    if (m & 1) asm volatile("" ::: "memory"); } }
    }
};
struct EpiUp {
    static constexpr bool PERM = true;
    bf16* G; const float* ssq; const float* cw; const float* cb;
    MEMFN void operator()(f32x4 (&acc)[2][2][4][2], const Unit& u, int wr, int wc, int fr, int fq, LAS unsigned char* xl) const {
        const int b = u.pm / NQ, q = u.pm % NQ, t0 = UPS * q - 1;
        LAS float* XB = (LAS float*)xl;
        const int cs = wc * 32 + 8 * fq;
#pragma unroll
        for (int ai = 0; ai < 2; ++ai)
#pragma unroll
            for (int m = 0; m < 4; ++m) { const int lr = 128 * ai + 64 * wr + 16 * m + fr, t = t0 + lr; const bool ok = (t >= 0) && (t < L);
                const float sc = ok ? row_inv(ssq, b * L + t) : 0.f;
#pragma unroll
                for (int bj = 0; bj < 2; ++bj)
#pragma unroll
                    for (int n = 0; n < 2; ++n)
#pragma unroll
                        for (int e = 0; e < 4; ++e) acc[ai][bj][m][n][e] = ok ? acc[ai][bj][m][n][e] * sc : 0.f; }
#pragma unroll
        for (int ai = 0; ai < 2; ++ai) { const int s = 2 * ai + wr;
            if (fr == 0) {
#pragma unroll
                for (int bj = 0; bj < 2; ++bj)
#pragma unroll
                    for (int n = 0; n < 2; ++n) *(LAS f32x4*)(XB + (2 * s) * 256 + bj * 128 + cs + 4 * n) = acc[ai][bj][0][n]; }
            if (fr == 15) {
#pragma unroll
                for (int bj = 0; bj < 2; ++bj)
#pragma unroll
                    for (int n = 0; n < 2; ++n) *(LAS f32x4*)(XB + (2 * s + 1) * 256 + bj * 128 + cs + 4 * n) = acc[ai][bj][3][n]; } }
#ifdef CPU_EMU
        sync_block();
#else
        asm volatile("s_waitcnt lgkmcnt(0)" ::: "memory"); __builtin_amdgcn_s_barrier(); asm volatile("" ::: "memory");
#endif
        const int j0 = u.pn * 128 + cs;
#pragma unroll
        for (int n = 0; n < 2; ++n) {
            f32x4 wa[3], wv[3]; const f32x4 ba = *(const f32x4*)(cb + j0 + 4 * n), bv = *(const f32x4*)(cb + FF + j0 + 4 * n);
#pragma unroll
            for (int k = 0; k < 3; ++k) { wa[k] = *(const f32x4*)(cw + k * FF2 + j0 + 4 * n); wv[k] = *(const f32x4*)(cw + k * FF2 + FF + j0 + 4 * n); }
#pragma unroll
            for (int ai = 0; ai < 2; ++ai) { const int s = 2 * ai + wr;
#pragma unroll
                for (int m = 0; m < 4; ++m) { const int lr = 64 * s + 16 * m + fr, t = t0 + lr;
                    f32x4 up[2], dn[2];
#pragma unroll
                    for (int bj = 0; bj < 2; ++bj) {
                        f32x4 pu, pd;
                        if (m > 0) { const f32x4 p = acc[ai][bj][m > 0 ? m - 1 : 0][n]; pu = (f32x4){dpp_row_ror1(p[0]), dpp_row_ror1(p[1]), dpp_row_ror1(p[2]), dpp_row_ror1(p[3])}; }
                        else if (s > 0) pu = *(const LAS f32x4*)(XB + (2 * (s - 1) + 1) * 256 + bj * 128 + cs + 4 * n);
                        else pu = (f32x4){0.f, 0.f, 0.f, 0.f};
                        if (m < 3) { const f32x4 p = acc[ai][bj][m < 3 ? m + 1 : 3][n]; pd = (f32x4){dpp_row_ror15(p[0]), dpp_row_ror15(p[1]), dpp_row_ror15(p[2]), dpp_row_ror15(p[3])}; }
                        else if (s < 3) pd = *(const LAS f32x4*)(XB + (2 * (s + 1)) * 256 + bj * 128 + cs + 4 * n);
                        else pd = (f32x4){0.f, 0.f, 0.f, 0.f};
                        const f32x4 x = acc[ai][bj][m][n];
#pragma unroll
                        for (int e = 0; e < 4; ++e) { up[bj][e] = dpp_row_shr1(pu[e], x[e]); dn[bj][e] = dpp_row_shl1(pd[e], x[e]); }
                    }
                    const f32x4 a = ba + wa[0] * up[0] + wa[1] * acc[ai][0][m][n] + wa[2] * dn[0];
                    const f32x4 v = bv + wv[0] * up[1] + wv[1] * acc[ai][1][m][n] + wv[2] * dn[1];
                    if (lr >= 1 && lr <= UPS && t < L) { u32x2 w; w.x = pk_bf16(gelu_f(a[0]) * v[0], gelu_f(a[1]) * v[1]); w.y = pk_bf16(gelu_f(a[2]) * v[2], gelu_f(a[3]) * v[3]);
                        *(u32x2*)(G + (size_t)(b * L + t) * FF + j0 + 4 * n) = w; }
                } } }
    }
};
}

constexpr int RING_BYTES = 131072, XCH_OFF = RING_BYTES, XCH_BYTES = 8192, MISC_OFF = XCH_OFF + XCH_BYTES, LDS_BYTES = 147456;
constexpr int CW_TMO = 0, CW_BAR = 4096;
#ifndef CPU_EMU
typedef GAS unsigned gu32;
#define XB_TMO      128
#define XB_XCNT(j)  (256  + 64 * (j))
#define XB_XSUB(j)  (1280 + 64 * (j))
#define XB_XGEN(j)  (2304 + 64 * (j))
#define XB_TOP      3328
#define XB_TOPGEN   3392
#define XCD_BAR_WORDS 3456
#define XB_SPIN_CAP (1u << 22)
__device__ __forceinline__ unsigned xb_ld(unsigned* p)              { return __hip_atomic_load(p, __ATOMIC_RELAXED, __HIP_MEMORY_SCOPE_AGENT); }
__device__ __forceinline__ unsigned xb_add(unsigned* p, unsigned v) { return __hip_atomic_fetch_add(p, v, __ATOMIC_RELAXED, __HIP_MEMORY_SCOPE_AGENT); }
__device__ __forceinline__ unsigned xb_xcc_id() { return (unsigned)__builtin_amdgcn_s_getreg((3 << 11) | 20) & 0xFu; }
#define XB_SPIN(cond, bar) do { unsigned _sp = 0; while (cond) { __builtin_amdgcn_s_sleep(1); \
    if ((++_sp & 255u) == 0u) { if (xb_ld(&(bar)[XB_TMO])) break; if (_sp > XB_SPIN_CAP) { atomicAdd(&(bar)[XB_TMO], 1u); break; } } } } while (0)
struct XcdBarrier { unsigned* bar; unsigned x; volatile LAS unsigned* st; };
__device__ __forceinline__ XcdBarrier xcd_barrier_post(unsigned* bar, volatile LAS unsigned* st) {
    XcdBarrier b; b.bar = bar; b.x = xb_xcc_id(); b.st = st;
    if (threadIdx.x == 0) (void)xb_add(&bar[XB_XCNT(b.x)], 1u);
    return b;
}
__device__ __forceinline__ void xcd_barrier_complete(unsigned* bar, unsigned x, unsigned& nloc, unsigned& nx) {
    const unsigned G = gridDim.x * gridDim.y * gridDim.z;
    unsigned sum, cnt, mine, sp = 0u;
    for (;;) {
        sum = 0u; cnt = 0u; mine = 0u;
#pragma unroll
        for (unsigned j = 0; j < 16; ++j) { const unsigned c = xb_ld(&bar[XB_XCNT(j)]); sum += c; cnt += (c > 0u) ? 1u : 0u; mine = (j == x) ? c : mine; }
        if (sum == G) break;
        __builtin_amdgcn_s_sleep(1);
        if ((++sp & 255u) == 0u) { if (xb_ld(&bar[XB_TMO])) break; if (sp > XB_SPIN_CAP) { atomicAdd(&bar[XB_TMO], 1u); break; } }
    }
    nloc = mine > 0u ? mine : 1u; nx = cnt > 0u ? cnt : 1u;
}
__device__ __forceinline__ void xcd_barrier(const XcdBarrier& b) {
    __builtin_amdgcn_fence(__ATOMIC_RELEASE, "agent");
    asm volatile("s_waitcnt vmcnt(0)" ::: "memory");
    __syncthreads();
    if (threadIdx.x == 0) {
        unsigned* bar = b.bar;
        __builtin_amdgcn_s_waitcnt(0);
        unsigned nloc = b.st[0], nx = b.st[1];
        if (nloc == 0u) { xcd_barrier_complete(bar, b.x, nloc, nx); b.st[0] = nloc; b.st[1] = nx; }
        const unsigned old = xb_add(&bar[XB_XSUB(b.x)], 1u);
        const unsigned gen = old / nloc;
        if (old + 1u == (gen + 1u) * nloc) {
            __builtin_amdgcn_fence(__ATOMIC_RELEASE, "agent");
            asm volatile("s_waitcnt vmcnt(0)" ::: "memory");
            const unsigned og = xb_add(&bar[XB_TOP], 1u);
            const unsigned tg = og / nx;
            if (og + 1u == (tg + 1u) * nx) xb_add(&bar[XB_TOPGEN], 1u);
            else XB_SPIN(xb_ld(&bar[XB_TOPGEN]) == tg, bar);
            __builtin_amdgcn_fence(__ATOMIC_ACQUIRE, "agent");
            xb_add(&bar[XB_XGEN(b.x)], 1u);
            asm volatile("s_waitcnt vmcnt(0)" ::: "memory");
        } else {
            XB_SPIN(xb_ld(&bar[XB_XGEN(b.x)]) == gen, bar);
            __builtin_amdgcn_fence(__ATOMIC_ACQUIRE, "agent");
            asm volatile("s_waitcnt vmcnt(0)" ::: "memory");
        }
    }
    __syncthreads();
}
#endif

#ifdef CPU_EMU
struct Args; static void emu_phase_hook(int ph, const Args& a);
#endif
struct Args { const float* in[38]; float* out; unsigned char* ws; int ph_lo, ph_hi; };
#ifdef CPU_EMU
typedef const Args* KARG_PTR;
#else
typedef const __attribute__((address_space(4))) Args* KARG_PTR;
#endif
struct Frame {
    LAS unsigned char* lds; int tid, lane, wave, G, gtid, gsize, gw, ngw;
    KARG_PTR ap; float* out; unsigned char* ws;
};
#define FIN(i) (F.ap->in[i])
#ifdef CPU_EMU
#define LAUNDER(F, l) do {} while (0)
#else
#define LAUNDER(F, l) do { size_t z_ = 0; asm volatile("" : "+s"(z_), "+s"(F.ap), "+s"(l), "+s"(F.wave)); F.ws = args.ws + z_; F.out = args.out + z_; F.lane = lane_id(); F.tid = (F.wave << 6) | F.lane; \
    F.gtid = blockIdx.x * NT + F.tid; F.gw = blockIdx.x * NWAVES + F.wave; } while (0)
#endif

DEVFN void transpose_item(const float* W, int ldw, int K, bf16* WT, int src_col0, int dst_row0, int k0, const float* sc, LAS float* scr, int lane) {
#pragma unroll 8
    for (int i = 0; i < 32; ++i) { const int kk = 2 * i + (lane >> 5); float v = W[(size_t)(k0 + kk) * ldw + src_col0 + (lane & 31)]; if (sc) v *= sc[k0 + kk]; scr[kk * 33 + (lane & 31)] = v; }
    WAVE_LDS_FENCE();
    const int c = lane & 7;
#pragma unroll
    for (int j = 0; j < 4; ++j) { const int n = (lane >> 3) + 8 * j; const LAS float* s = scr + (8 * c) * 33 + n;
        u32x4 o; o.x = pk_bf16(s[0 * 33], s[1 * 33]); o.y = pk_bf16(s[2 * 33], s[3 * 33]); o.z = pk_bf16(s[4 * 33], s[5 * 33]); o.w = pk_bf16(s[6 * 33], s[7 * 33]);
        *(u32x4*)(WT + (size_t)(dst_row0 + n) * K + k0 + 8 * c) = o; }
    WAVE_LDS_FENCE();
}
DEVFN float wave_sum(float v) {
#pragma unroll
    for (int o = 1; o < 64; o <<= 1) v += shfl_xor_f32(v, o);
    return v;
}
DEVFN void p_prologue(Frame& F) {
    LAS float* scr = (LAS float*)(F.lds + F.wave * 16384);
    constexpr int I_IN = 16 * 60, I_OUT = 16 * 32, I_UP = 16 * 176, I_DN = 44 * 32, I_GLU = 6 * 12, I_L = I_IN + I_OUT + I_UP + I_DN + I_GLU;
    for (int it = F.gw; it < 2 * I_L; it += F.ngw) {
        const int l = it / I_L; int r = it % I_L;
        if (r < I_IN) { const int kb = r / 60, nb = r % 60; transpose_item(FIN(2) + (size_t)l * D * NIN, NIN, D, (bf16*)(F.ws + WS_WIN + l * SZ_WIN), 32 * nb, 32 * nb, 64 * kb, FIN(1) + l * D, scr, F.lane); continue; } r -= I_IN;
        if (r < I_OUT) { const int kb = r / 32, nb = r % 32; transpose_item(FIN(31) + (size_t)l * D * D, D, D, (bf16*)(F.ws + WS_WOUT + l * SZ_WOUT), 32 * nb, 32 * nb, 64 * kb, FIN(30) + l * D, scr, F.lane); continue; } r -= I_OUT;
        if (r < I_UP) { const int kb = r / 176, nb = r % 176, sc0 = 32 * nb, half = sc0 / FF, jj = sc0 % FF, pn = jj / 128;
            transpose_item(FIN(33) + (size_t)l * D * FF2, FF2, D, (bf16*)(F.ws + WS_WUP + l * SZ_WUP), sc0, 256 * pn + 128 * half + (jj % 128), 64 * kb, FIN(32) + l * D, scr, F.lane); continue; } r -= I_UP;
        if (r < I_DN) { const int kb = r / 32, nb = r % 32; transpose_item(FIN(36) + (size_t)l * FF * D, D, FF, (bf16*)(F.ws + WS_WDN + l * SZ_WDN), 32 * nb, 32 * nb, 64 * kb, nullptr, scr, F.lane); continue; } r -= I_DN;
        { const int kb = r / 12, nb = r % 12; transpose_item(FIN(18) + (size_t)l * S5W * S5W, S5W, S5W, (bf16*)(F.ws + WS_WGLU + l * SZ_WGLU), 32 * nb, 32 * nb, 64 * kb, nullptr, scr, F.lane); }
    }
    for (int i = F.gtid; i < 2 * (128 * D / 8); i += F.gsize) { const int l = i / (128 * D / 8), r = i % (128 * D / 8); ((u32x4*)(F.ws + WS_WIN + l * SZ_WIN + (size_t)NIN * D * 2))[r] = (u32x4){0u, 0u, 0u, 0u}; }
    for (int i = F.gtid; i < 2 * (128 * S5W / 8); i += F.gsize) { const int l = i / (128 * S5W / 8), r = i % (128 * S5W / 8); ((u32x4*)(F.ws + WS_WGLU + l * SZ_WGLU + (size_t)S5W * S5W * 2))[r] = (u32x4){0u, 0u, 0u, 0u}; }
    float* ssq = (float*)(F.ws + WS_SSQ); bf16* hb = (bf16*)(F.ws + WS_HB);
    for (int m = F.gw; m < M; m += F.ngw) {
        const f32x4* xr = (const f32x4*)(FIN(0) + (size_t)m * D) + F.lane; f32x4* hr = (f32x4*)(F.out + (size_t)m * D) + F.lane; u32x2* br = (u32x2*)(hb + (size_t)m * D) + F.lane; float s = 0.f;
#pragma unroll
        for (int j = 0; j < 4; ++j) { const f32x4 v = xr[64 * j]; hr[64 * j] = v; u32x2 w; w.x = pk_bf16(v[0], v[1]); w.y = pk_bf16(v[2], v[3]); br[64 * j] = w; s += (v[0] * v[0] + v[1] * v[1]) + (v[2] * v[2] + v[3] * v[3]); }
        s = wave_sum(s);
        if (F.lane < 16) ssq[(size_t)m * 16 + F.lane] = F.lane == 0 ? s : 0.f;
    }
    for (int i = F.gtid; i < 2 * 3072; i += F.gsize) { const int l = i / 3072, r = i % 3072, dg = r / 64, p = r % 64;
        const float lr = FIN(10)[i], li = FIN(11)[i], dt = expf(FIN(12)[l * 48 + dg]);
        const float mag = expf(lr * dt), ar = mag * cosf(li * dt), ai = mag * sinf(li * dt);
        const float den = lr * lr + li * li, nr = ar - 1.0f, ni = ai, cr = (nr * lr + ni * li) / den, ci = (ni * lr - nr * li) / den;
        ((f32x2*)(F.ws + WS_S5A))[i] = (f32x2){ar, ai};
        const float m16 = expf(16.0f * lr * dt); ((f32x2*)(F.ws + WS_S5A16))[i] = (f32x2){m16 * cosf(16.0f * li * dt), m16 * sinf(16.0f * li * dt)};
        bf16* bt = (bf16*)(F.ws + WS_S5BT) + ((size_t)(l * 48 + dg) * 2) * 64 * 16; bf16* ct = (bf16*)(F.ws + WS_S5CT) + (size_t)(l * 48 + dg) * 16 * 128;
        for (int c = 0; c < 16; ++c) { const float br = FIN(13)[(size_t)i * 16 + c], bi = FIN(14)[(size_t)i * 16 + c];
            bt[(size_t)p * 16 + c] = f2bf_(cr * br - ci * bi); bt[(size_t)(64 + p) * 16 + c] = f2bf_(cr * bi + ci * br);
            const size_t ci_ = ((size_t)(l * 48 + dg) * 16 + c) * 64 + p;
            ct[(size_t)c * 128 + 2 * p] = f2bf_(FIN(15)[ci_]); ct[(size_t)c * 128 + 2 * p + 1] = f2bf_(-FIN(16)[ci_]); } }
    for (int i = F.gtid; i < 2 * 2 * RGW; i += F.gsize) ((float*)(F.ws + WS_RGSP))[i] = 8.0f * softplus_f(-FIN(9)[i]);
    for (int i = F.gtid; i < 2 * 2 * 2 * 6 * 4096; i += F.gsize) { const int k = i % 64, n = (i / 64) % 64, hd = (i / 4096) % 6, mat = (i / 24576) % 2, ld = i / 49152;
        const float* src = (mat == 0 ? FIN(5) : FIN(7)) + ((size_t)ld * 6 + hd) * 4096; ((bf16*)(F.ws + WS_RGWT))[i] = f2bf_(src[k * 64 + n]); }
    for (int i = F.gtid; i < 2 * L * 64; i += F.gsize) { const int l = i / (L * 64), r = i % (L * 64), pos = r / 64, mm = r % 64;
        const float* w1 = FIN(22) + l * 33 * 64; const float t = (float)pos / (float)(L - 1 > 1 ? L - 1 : 1), w = (6.283185307179586f / (float)L) * (float)pos;
        float acc = FIN(23)[l * 64 + mm] + t * w1[mm];
        for (int q = 0; q < 16; ++q) { const float band = 1e-4f + (float)q * ((15.0f - 1e-4f) / 15.0f), ang = w * band; acc += cosf(ang) * w1[(1 + q) * 64 + mm] - sinf(ang) * w1[(17 + q) * 64 + mm]; }
        ((float*)(F.ws + WS_HID))[i] = sinf(FIN(24)[l * 64 + mm] * acc); }
}
DEVFN void p_hid2(Frame& F, int l) {
    const float* hid1 = (const float*)(F.ws + WS_HID) + (size_t)l * L * 64; float* hid2 = (float*)(F.ws + WS_HID) + (size_t)(2 + l) * L * 64;
    for (int i = F.gtid; i < L * 64; i += F.gsize) { const int pos = i / 64, mm = i % 64; float acc = FIN(26)[l * 64 + mm];
        for (int q = 0; q < 64; ++q) acc += hid1[pos * 64 + q] * FIN(25)[l * 4096 + q * 64 + mm];
        hid2[i] = sinf(FIN(27)[l * 64 + mm] * acc); }
}

constexpr int RING_BYTES_C = 131072;
constexpr int HY_NA = L / 32;
constexpr int HY_TA = HY_NA < 32 ? HY_NA : 32;
constexpr int HY_TB = 32 / HY_TA, HY_NBLK = HY_NA + 2 * (HY_TA - 1), HY_NTILE = (HY_NA / HY_TA) * ((Bn + HY_TB - 1) / HY_TB);
constexpr int HY_CPY = 2 * L * 2 + 64;
constexpr int HY_FI = 0, HY_ZI = 4 * HY_CPY, HY_LDS = HY_ZI + Bn * HY_NBLK * 80;
static_assert(HY_LDS <= RING_BYTES_C, "hyena LDS");
DEVFN void p_hy_filter(Frame& F, int l) {
    const float* hid2 = (const float*)(F.ws + WS_HID) + (size_t)(2 + l) * L * 64; const float* w3 = FIN(28) + (size_t)l * 64 * 512; float* kfbT = (float*)(F.ws + WS_KFB);
    const float maxd = logf(1e-2f) / 0.3f, mind = logf(1e-2f) / 1.5f;
    for (int i = F.gtid; i < L * 512; i += F.gsize) { const int pos = i % L, c2 = i / L, c = c2 % 256; float acc = 0.f;
        for (int q = 0; q < 64; ++q) acc += hid2[pos * 64 + q] * w3[q * 512 + c2];
        const float delta = fabsf(mind + (float)c * ((maxd - mind) / 255.0f)), t = (float)pos / (float)(L - 1 > 1 ? L - 1 : 1);
        kfbT[i] = acc * expf(-t * delta); }
}
DEVFN void p_hy_pre(Frame& F, int l) {
    const bf16* proj = (const bf16*)(F.ws + WS_PROJ); bf16* zT = (bf16*)(F.ws + WS_ZT); const float* cw = FIN(20) + l * 3 * 768; const float* cb = FIN(21) + l * 768;
    for (int i = F.gtid; i < 256 * (M / 32); i += F.gsize) { const int c = i % 256, m0 = (i / 256) * 32, t0 = m0 % L;
        const float w1[3] = {cw[256 + c], cw[768 + 256 + c], cw[1536 + 256 + c]}, wv[3] = {cw[512 + c], cw[768 + 512 + c], cw[1536 + 512 + c]}; const float b1 = cb[256 + c], bv = cb[512 + c];
        float p1 = 0.f, pv = 0.f, c1 = 0.f, cv = 0.f;
        if (t0 > 0) { p1 = bf2f_(proj[(size_t)(m0 - 1) * NINP + 3 * RGW + 256 + c]); pv = bf2f_(proj[(size_t)(m0 - 1) * NINP + 3 * RGW + 512 + c]); }
        c1 = bf2f_(proj[(size_t)m0 * NINP + 3 * RGW + 256 + c]); cv = bf2f_(proj[(size_t)m0 * NINP + 3 * RGW + 512 + c]);
        unsigned pk[16];
#pragma unroll
        for (int j = 0; j < 32; ++j) { float n1 = 0.f, nv = 0.f;
            if (t0 + j + 1 < L) { n1 = bf2f_(proj[(size_t)(m0 + j + 1) * NINP + 3 * RGW + 256 + c]); nv = bf2f_(proj[(size_t)(m0 + j + 1) * NINP + 3 * RGW + 512 + c]); }
            const float zz = (bv + wv[0] * pv + wv[1] * cv + wv[2] * nv) * (b1 + w1[0] * p1 + w1[1] * c1 + w1[2] * n1);
            if (j & 1) pk[j >> 1] = pk_bf16(bf_lo(pk[j >> 1]), zz); else pk[j >> 1] = pk_bf16(zz, 0.f);
            p1 = c1; c1 = n1; pv = cv; cv = nv; }
        u32x4* dst = (u32x4*)(zT + (size_t)c * M + m0);
#pragma unroll
        for (int j = 0; j < 4; ++j) dst[j] = (u32x4){pk[4 * j], pk[4 * j + 1], pk[4 * j + 2], pk[4 * j + 3]}; }
}
DEVFN void hy_channel(Frame& F, int l, int c) {
    const int lane = lane_id(), w = F.wave, tid = F.tid, h = lane >> 5, r = lane & 31;
    LAS unsigned char* FI = F.lds + HY_FI; LAS unsigned char* ZI = F.lds + HY_ZI;
    { LAS float* KX = (LAS float*)ZI; LAS float* WC = KX + 2 * L;
      const float* hid2 = (const float*)(F.ws + WS_HID) + (size_t)(2 + l) * L * 64; const float* w3 = FIN(28) + (size_t)l * 64 * 512; const float bias = FIN(29)[l * HYW + c];
      if (tid < 128) WC[tid] = w3[(tid & 63) * 512 + (tid >> 6) * 256 + c];
      if (tid == 0) KX[0] = 0.f;
      sync_block();
      const float maxd = logf(1e-2f) / 0.3f, mind = logf(1e-2f) / 1.5f, delta = fabsf(mind + (float)c * ((maxd - mind) / 255.0f));
      for (int pos = tid; pos < L; pos += NT) { const f32x4* row = (const f32x4*)(hid2 + (size_t)pos * 64); float kfv = 0.f, kbv = 0.f;
#pragma unroll
          for (int q = 0; q < 16; ++q) { const f32x4 hv = row[q]; const f32x4 wf = *(const LAS f32x4*)(WC + 4 * q), wb = *(const LAS f32x4*)(WC + 64 + 4 * q);
              kfv += (hv[0] * wf[0] + hv[1] * wf[1]) + (hv[2] * wf[2] + hv[3] * wf[3]); kbv += (hv[0] * wb[0] + hv[1] * wb[1]) + (hv[2] * wb[2] + hv[3] * wb[3]); }
          const float dec = expf(-((float)pos / (float)(L - 1 > 1 ? L - 1 : 1)) * delta); kfv *= dec; kbv *= dec;
          if (pos == 0) KX[L] = kfv + kbv + bias; else { KX[L + pos] = kfv; KX[L - pos] = kbv; } }
      sync_block();
      for (int i = tid; i < 4 * L; i += NT) { const int sg = i / L, u = 2 * (i % L); float v[2];
#pragma unroll
          for (int e = 0; e < 2; ++e) { const int ix = 2 * L - (u + e) - sg; v[e] = (ix >= 1 && ix <= 2 * L - 1) ? KX[ix] : 0.f; }
          *(LAS unsigned*)(FI + sg * HY_CPY + u * 2) = pk_bf16(v[0], v[1]); }
      sync_block(); }
    for (int i = tid; i < Bn * HY_NBLK * 5; i += NT) *(LAS u32x4*)(ZI + i * 16) = (u32x4){0u, 0u, 0u, 0u};
    sync_block();
    { const bf16* zT = (const bf16*)(F.ws + WS_ZT) + (size_t)c * M;
      for (int i = tid; i < Bn * HY_NA * 4; i += NT) { const int j = i & 3, a = (i >> 2) % HY_NA, b = (i >> 2) / HY_NA;
          *(LAS u32x4*)(ZI + ((b * HY_NBLK + a + HY_TA - 1) * 80 + 16 * j)) = *(const u32x4*)(zT + (size_t)b * L + 32 * a + 8 * j); } }
    sync_block();
    float* yT = (float*)(F.ws + WS_YT) + (size_t)c * M;
    const int sgm = (4 - (r & 3)) & 3;
    const f32x16 z16 = {0.f, 0.f, 0.f, 0.f, 0.f, 0.f, 0.f, 0.f, 0.f, 0.f, 0.f, 0.f, 0.f, 0.f, 0.f, 0.f};
    for (int tl = w; tl < HY_NTILE; tl += NWAVES) { const int aq = tl % (HY_NA / HY_TA), bq = tl / (HY_NA / HY_TA);
        const int a = aq * HY_TA + (r % HY_TA), bb = bq * HY_TB + r / HY_TA; const bool bok = bb < Bn;
        const int dlo = aq * HY_TA - (HY_NA - 1), dhi = aq * HY_TA + HY_TA - 1;
        f32x16 acc = z16; OPAQUE16(acc);
        int fa = sgm * HY_CPY + 2 * ((8 * h - r - 32 * dlo) - sgm + L);
        int za = bok ? ((bb * HY_NBLK + a - dlo + HY_TA - 1) * 80 + 16 * h) : 0;
        typedef unsigned long long u64x2 __attribute__((ext_vector_type(2)));
        u64x2 av[2]; bf16x8 bv[2];
#define HY_LOAD(av_, bv_) do { _Pragma("unroll") for (int ks = 0; ks < 2; ++ks) { av_[ks].x = *(const LAS unsigned long long*)(FI + fa + 32 * ks); av_[ks].y = *(const LAS unsigned long long*)(FI + fa + 32 * ks + 8); \
            bv_[ks] = *(const LAS bf16x8*)(ZI + za + 32 * ks); } fa -= 64; if (bok) za -= 80; } while (0)
        HY_LOAD(av, bv);
        for (int d = dlo; d <= dhi; ++d) { u64x2 an[2]; bf16x8 bn[2];
            if (d < dhi) HY_LOAD(an, bn); else { an[0] = av[0]; an[1] = av[1]; bn[0] = bv[0]; bn[1] = bv[1]; }
            acc = mfma32(__builtin_bit_cast(bf16x8, av[0]), bv[0], acc); acc = mfma32(__builtin_bit_cast(bf16x8, av[1]), bv[1], acc);
            av[0] = an[0]; av[1] = an[1]; bv[0] = bn[0]; bv[1] = bn[1]; }
#undef HY_LOAD
        if (bok) {
#pragma unroll
            for (int q = 0; q < 4; ++q) *(f32x4*)(yT + (size_t)bb * L + 32 * a + 8 * q + 4 * h) = (f32x4){acc[4 * q], acc[4 * q + 1], acc[4 * q + 2], acc[4 * q + 3]}; } }
    sync_block();
}
DEVFN void p_hy_main(Frame& F, int l) { for (int c = blockIdx.x; c < HYW; c += F.G) hy_channel(F, l, c); }
DEVFN void p_hy_post(Frame& F, int l) {
    const bf16* proj = (const bf16*)(F.ws + WS_PROJ); const float* yT = (const float*)(F.ws + WS_YT); bf16* ymix = (bf16*)(F.ws + WS_YMIX); const float* cw = FIN(20) + l * 3 * 768; const float* cb = FIN(21) + l * 768;
    for (int i = F.gtid; i < 256 * (M / 32); i += F.gsize) { const int c = i % 256, m0 = (i / 256) * 32, t0 = m0 % L;
        const float w0[3] = {cw[c], cw[768 + c], cw[1536 + c]}; const float b0 = cb[c];
        float p0 = 0.f, c0 = bf2f_(proj[(size_t)m0 * NINP + 3 * RGW + c]); if (t0 > 0) p0 = bf2f_(proj[(size_t)(m0 - 1) * NINP + 3 * RGW + c]);
        const f32x4* ys = (const f32x4*)(yT + (size_t)c * M + m0);
#pragma unroll
        for (int j4 = 0; j4 < 8; ++j4) { const f32x4 y = ys[j4];
#pragma unroll
            for (int e = 0; e < 4; ++e) { const int j = 4 * j4 + e; float n0 = 0.f; if (t0 + j + 1 < L) n0 = bf2f_(proj[(size_t)(m0 + j + 1) * NINP + 3 * RGW + c]);
                ymix[(size_t)(m0 + j) * D + RGW + S5W + c] = f2bf_(y[e] * (b0 + w0[0] * p0 + w0[1] * c0 + w0[2] * n0)); p0 = c0; c0 = n0; } } }
}
constexpr int NG16 = L / 16, NT32 = M / 32, CARRY_B = NG16 < 16 ? NG16 : 16;
DEVFN int tau32(int rho) { return 16 * ((rho >> 2) & 1) + (rho & 3) + 4 * (rho >> 3); }
DEVFN bf16x8 pack8(const f32x4 a, const f32x4 b) { u32x4 w; w.x = pk_bf16(a[0], a[1]); w.y = pk_bf16(a[2], a[3]); w.z = pk_bf16(b[0], b[1]); w.w = pk_bf16(b[2], b[3]); return __builtin_bit_cast(bf16x8, w); }
DEVFN void rg_item(Frame& F, int l, int tile, int hd, const bool stage3) {
    const int lane = lane_id(), hh = lane >> 5, pl = lane & 31, m0 = tile * 32, b = m0 / L, t0 = m0 % L, grp = t0 / 16 + hh;
    const bf16* proj = (const bf16*)(F.ws + WS_PROJ); const float* cw = FIN(3) + l * 4 * RGW; const float* cb = FIN(4) + l * RGW;
    const f32x16 z16 = {0.f, 0.f, 0.f, 0.f, 0.f, 0.f, 0.f, 0.f, 0.f, 0.f, 0.f, 0.f, 0.f, 0.f, 0.f, 0.f};
    const int tt = t0 + tau32(pl); bf16x8 uf[4];
#pragma unroll
    for (int ks = 0; ks < 4; ++ks) { const int c0 = 64 * hd + 16 * ks + 8 * hh; f32x4 s0 = *(const f32x4*)(cb + c0), s1 = *(const f32x4*)(cb + c0 + 4);
#pragma unroll
        for (int k = 0; k < 4; ++k) { const int tk = tt + k - 1; const bool ok = (tk >= 0) && (tk < L);
            u32x4 x = {0u, 0u, 0u, 0u}; if (ok) x = *(const u32x4*)(proj + (size_t)(b * L + tk) * NINP + c0);
            const f32x4 w0 = *(const f32x4*)(cw + k * RGW + c0), w1 = *(const f32x4*)(cw + k * RGW + c0 + 4);
            s0 += w0 * (f32x4){bf_lo(x.x), bf_hi(x.x), bf_lo(x.y), bf_hi(x.y)}; s1 += w1 * (f32x4){bf_lo(x.z), bf_hi(x.z), bf_lo(x.w), bf_hi(x.w)}; }
        uf[ks] = pack8(s0, s1); }
    FRESH(uf[0]); FRESH(uf[1]); FRESH(uf[2]); FRESH(uf[3]);
    const bf16* WT = (const bf16*)(F.ws + WS_RGWT); f32x2* AG = (f32x2*)(F.ws + WS_RGAG); const int pl_o = pl, hh_o = hh;
#pragma unroll 1
    for (int nt = 0; nt < 2; ++nt) { int pl_ = pl_o, hh_ = hh_o; OPAQUE_V(pl_); OPAQUE_V(hh_); const int pl = pl_, hh = hh_;
        const int c = 64 * hd + 32 * nt + pl;
        f32x16 uacc; { f32x16 zz = z16; OPAQUE16(zz); uacc = zz; }
        { bf16x8 idf[2];
#pragma unroll
          for (int q = 0; q < 2; ++q) { const int kk = pl - 16 * q - 8 * hh; u32x4 w;
              w.x = (kk >> 1) == 0 ? ((kk & 1) ? 0x3F800000u : 0x3F80u) : 0u; w.y = (kk >> 1) == 1 ? ((kk & 1) ? 0x3F800000u : 0x3F80u) : 0u;
              w.z = (kk >> 1) == 2 ? ((kk & 1) ? 0x3F800000u : 0x3F80u) : 0u; w.w = (kk >> 1) == 3 ? ((kk & 1) ? 0x3F800000u : 0x3F80u) : 0u;
              if (kk < 0 || kk > 7) w = (u32x4){0u, 0u, 0u, 0u};
              idf[q] = __builtin_bit_cast(bf16x8, w); }
          FRESH(idf[0]); FRESH(idf[1]);
          if (nt == 0) { uacc = mfma32(uf[0], idf[0], uacc); uacc = mfma32(uf[1], idf[1], uacc); MFMA_GUARD(ACC1(uacc), KV(uf[0]), KV(uf[1]), KV(idf[0]), KV(idf[1])); }
          else { uacc = mfma32(uf[2], idf[0], uacc); uacc = mfma32(uf[3], idf[1], uacc); MFMA_GUARD(ACC1(uacc), KV(uf[2]), KV(uf[3]), KV(idf[0]), KV(idf[1])); } }
        f32x16 hs = z16;
#pragma unroll
        for (int d = 0; d < 2; ++d) {
            f32x16 ga, gx; { f32x16 zz = z16; OPAQUE16(zz); ga = zz; f32x16 z2 = z16; OPAQUE16(z2); gx = z2; }
            bf16x8 wa[4], wx[4];
#pragma unroll
            for (int ks = 0; ks < 4; ++ks) { const size_t o = ((((size_t)(l * 2 + d) * 2) * 6 + hd) * 64 + 32 * nt + pl) * 64 + 16 * ks + 8 * hh;
                wa[ks] = *(const bf16x8*)(WT + o); wx[ks] = *(const bf16x8*)(WT + o + (size_t)6 * 4096); }
#pragma unroll
            for (int ks = 0; ks < 4; ++ks) { FRESH(wa[ks]); FRESH(wx[ks]); }
#pragma unroll
            for (int ks = 0; ks < 4; ++ks) { ga = mfma32(uf[ks], wa[ks], ga); gx = mfma32(uf[ks], wx[ks], gx); }
            MFMA_GUARD(ACC2(ga, gx), KV(uf[0]), KV(uf[1]), KV(uf[2]), KV(uf[3]), KV(wa[0]), KV(wa[1]), KV(wa[2]), KV(wa[3]), KV(wx[0]), KV(wx[1]), KV(wx[2]), KV(wx[3]));
            const float bav = FIN(6)[l * 2 * RGW + d * RGW + c], bxv = FIN(8)[l * 2 * RGW + d * RGW + c], sp8 = ((const float*)(F.ws + WS_RGSP))[l * 2 * RGW + d * RGW + c];
#pragma unroll
            for (int reg = 0; reg < 16; ++reg) { const float r = sigmoid_f(ga[reg] + bav), ig = sigmoid_f(gx[reg] + bxv), la = -r * sp8;
                ga[reg] = exp_f(la); gx[reg] = sqrtf(-expm1_f(2.0f * la)) * (ig * uacc[reg]); }
            const size_t aidx = (((size_t)b * NG16 + grp) * 2 + d) * RGW + c;
            if (!stage3) { float P = 1.f, H = 0.f;
#pragma unroll
                for (int q = 0; q < 16; ++q) { const int reg = d == 0 ? q : 15 - q; H = ga[reg] * H + gx[reg]; P *= ga[reg]; }
                AG[aidx] = (f32x2){P, H}; }
            else { float h = ((const float*)(F.ws + WS_RGCI))[aidx];
#pragma unroll
                for (int q = 0; q < 16; ++q) { const int reg = d == 0 ? q : 15 - q; h = ga[reg] * h + gx[reg]; hs[reg] += h; } } }
        if (stage3) { bf16* ymix = (bf16*)(F.ws + WS_YMIX);
#pragma unroll
            for (int reg = 0; reg < 16; ++reg) { const size_t m = (size_t)(m0 + 16 * hh + reg); ymix[m * D + c] = f2bf_(hs[reg] * gelu_f(bf2f_(proj[m * NINP + RGW + c]))); } } }
}
DEVFN void p_rg_stage(Frame& F, int l, const bool stage3) { for (int it = F.gw; it < NT32 * 6; it += F.ngw) rg_item(F, l, it / 6, it % 6, stage3); }
DEVFN void p_rg_carry(Frame& F) {
    const f32x2* __restrict__ AG = (const f32x2*)(F.ws + WS_RGAG); float* __restrict__ CI = (float*)(F.ws + WS_RGCI);
    for (int i = F.gtid; i < Bn * 2 * RGW; i += F.gsize) { const int c = i % RGW, d = (i / RGW) % 2, b = i / (2 * RGW); float H = 0.f;
#pragma unroll 1
        for (int q0 = 0; q0 < NG16; q0 += CARRY_B) { f32x2 sv[CARRY_B];
#pragma unroll
            for (int e = 0; e < CARRY_B; ++e) { const int q = q0 + e, j = d == 0 ? q : NG16 - 1 - q; sv[e] = AG[(((size_t)b * NG16 + j) * 2 + d) * RGW + c]; }
#pragma unroll
            for (int e = 0; e < CARRY_B; ++e) { const int q = q0 + e, j = d == 0 ? q : NG16 - 1 - q; CI[(((size_t)b * NG16 + j) * 2 + d) * RGW + c] = H; H = sv[e][0] * H + sv[e][1]; } } }
}
constexpr int S5_HS = 272  , S5_YS = 784  ;
DEVFN void s5_tile(Frame& F, int l, int tile, const bool stage3) {
    const int lane = lane_id(), w = F.wave, hh = lane >> 5, pl = lane & 31, m0 = tile * 32, b = m0 / L, grp = (m0 % L) / 16 + hh;
    const bf16* proj = (const bf16*)(F.ws + WS_PROJ); const bf16* BT = (const bf16*)(F.ws + WS_S5BT); const bf16* CT = (const bf16*)(F.ws + WS_S5CT);
    const f32x2* SA = (const f32x2*)(F.ws + WS_S5A); f32x2* SS = (f32x2*)(F.ws + WS_S5S);
    LAS unsigned char* Hw = F.lds + w * (32 * S5_HS); LAS unsigned char* YT = F.lds + 8 * 32 * S5_HS;
    const f32x16 z16 = {0.f, 0.f, 0.f, 0.f, 0.f, 0.f, 0.f, 0.f, 0.f, 0.f, 0.f, 0.f, 0.f, 0.f, 0.f, 0.f};
#pragma unroll 1
    for (int gi = 0; gi < 3; ++gi) { const int g = w + 8 * gi;
        const bf16x8 ua = *(const bf16x8*)(proj + (size_t)(m0 + tau32(pl)) * NINP + 2 * RGW + 16 * g + 8 * hh);
        f32x4 yacc[2] = {(f32x4){0.f, 0.f, 0.f, 0.f}, (f32x4){0.f, 0.f, 0.f, 0.f}};
#pragma unroll
        for (int d = 0; d < 2; ++d) { const size_t dg = (size_t)(l * 2 + d) * 24 + g;
            f32x16 acc[2][2];
            bf16x8 bb[2][2];
#pragma unroll
            for (int ri = 0; ri < 2; ++ri)
#pragma unroll
                for (int ph = 0; ph < 2; ++ph) bb[ri][ph] = *(const bf16x8*)(BT + ((dg * 2 + ri) * 64 + 32 * ph + pl) * 16 + 8 * hh);
            { bf16x8 ub = ua; FRESH(ub); FRESH(bb[0][0]); FRESH(bb[0][1]); FRESH(bb[1][0]); FRESH(bb[1][1]);
#pragma unroll
            for (int ri = 0; ri < 2; ++ri)
#pragma unroll
                for (int ph = 0; ph < 2; ++ph) { f32x16 zz = z16; OPAQUE16(zz); acc[ri][ph] = mfma32(ub, bb[ri][ph], zz); }
            MFMA_GUARD(ACC4(acc[0][0], acc[0][1], acc[1][0], acc[1][1]), KV(ub), KV(bb[0][0]), KV(bb[0][1]), KV(bb[1][0]), KV(bb[1][1])); }
#pragma unroll
            for (int ph = 0; ph < 2; ++ph) { const f32x2 A = SA[dg * 64 + 32 * ph + pl]; const size_t sidx = (((size_t)b * NG16 + grp) * 2 + d) * 1536 + g * 64 + 32 * ph + pl;
                float hr = 0.f, hi = 0.f; if (stage3) { const f32x2 c = ((const f32x2*)(F.ws + WS_S5CI))[sidx]; hr = c[0]; hi = c[1]; }
#pragma unroll
                for (int q = 0; q < 16; ++q) { const int reg = d == 0 ? q : 15 - q; const float nr = A[0] * hr - A[1] * hi + acc[0][ph][reg], ni = A[0] * hi + A[1] * hr + acc[1][ph][reg];
                    hr = nr; hi = ni; acc[0][ph][reg] = nr; acc[1][ph][reg] = ni; }
                if (!stage3) SS[sidx] = (f32x2){hr, hi};
                else {
#pragma unroll
                    for (int reg = 0; reg < 16; ++reg) *(LAS unsigned*)(Hw + (16 * hh + reg) * S5_HS + 4 * (32 * ph + pl)) = pk_bf16(acc[0][ph][reg], acc[1][ph][reg]); } }
            if (stage3) { WAVE_LDS_FENCE();
#pragma unroll
                for (int rt = 0; rt < 2; ++rt) { bf16x8 a2[4], b2[4];
#pragma unroll
                    for (int ks = 0; ks < 4; ++ks) { a2[ks] = *(const LAS bf16x8*)(Hw + (16 * rt + (lane & 15)) * S5_HS + (32 * ks + 8 * (lane >> 4)) * 2);
                        b2[ks] = *(const bf16x8*)(CT + (dg * 16 + (lane & 15)) * 128 + 32 * ks + 8 * (lane >> 4)); }
                    FRESH(b2[0]); FRESH(b2[1]); FRESH(b2[2]); FRESH(b2[3]); FRESH(a2[0]); FRESH(a2[1]); FRESH(a2[2]); FRESH(a2[3]);
#pragma unroll
                    for (int ks = 0; ks < 4; ++ks) yacc[rt] = mfma16(a2[ks], b2[ks], yacc[rt]);
                    MFMA_GUARD(ACC1(yacc[rt]), KV(a2[0]), KV(a2[1]), KV(a2[2]), KV(a2[3]), KV(b2[0]), KV(b2[1]), KV(b2[2]), KV(b2[3])); }
                WAVE_LDS_FENCE(); } }
        if (stage3) { const int c = lane & 15; const float dsk = FIN(17)[l * S5W + 16 * g + c];
#pragma unroll
            for (int rt = 0; rt < 2; ++rt)
#pragma unroll
                for (int reg = 0; reg < 4; ++reg) { const int t = 16 * rt + 4 * (lane >> 4) + reg; const float u = bf2f_(proj[(size_t)(m0 + t) * NINP + 2 * RGW + 16 * g + c]);
                    *(LAS bf16*)(YT + t * S5_YS + (16 * g + c) * 2) = f2bf_(gelu_f(yacc[rt][reg] + dsk * u)); } } }
    if (stage3) { sync_block();
        if (w < 4) {
            const bf16* WG = (const bf16*)(F.ws + WS_WGLU + l * SZ_WGLU); bf16* ymix = (bf16*)(F.ws + WS_YMIX);
            f32x16 ga[3] = {z16, z16, z16};
#pragma unroll 2
            for (int ks = 0; ks < 24; ++ks) { const bf16x8 a = *(const LAS bf16x8*)(YT + pl * S5_YS + (16 * ks + 8 * hh) * 2); bf16x8 bq[3];
#pragma unroll
                for (int j = 0; j < 3; ++j) bq[j] = *(const bf16x8*)(WG + (size_t)(32 * (w + 4 * j) + pl) * S5W + 16 * ks + 8 * hh);
                FRESH(bq[0]); FRESH(bq[1]); FRESH(bq[2]); bf16x8 aq = a; FRESH(aq);
#pragma unroll
                for (int j = 0; j < 3; ++j) ga[j] = mfma32(aq, bq[j], ga[j]);
                MFMA_GUARD(ACC3(ga[0], ga[1], ga[2]), KV(aq), KV(bq[0]), KV(bq[1]), KV(bq[2])); }
#pragma unroll
            for (int j = 0; j < 3; ++j) { const int n = 32 * (w + 4 * j) + pl; const float bias = FIN(19)[l * S5W + n];
#pragma unroll
                for (int reg = 0; reg < 16; ++reg) { const int t = (reg & 3) + 8 * (reg >> 2) + 4 * hh; const float y = bf2f_(*(const LAS bf16*)(YT + t * S5_YS + n * 2));
                    ymix[(size_t)(m0 + t) * D + RGW + n] = f2bf_(y * sigmoid_f(ga[j][reg] + bias)); } } }
        sync_block(); }
}
DEVFN void p_s5_stage(Frame& F, int l, const bool stage3) { for (int tile = blockIdx.x; tile < NT32; tile += F.G) s5_tile(F, l, tile, stage3); }
DEVFN void p_s5_carry(Frame& F, int l) {
    const f32x2* __restrict__ SS = (const f32x2*)(F.ws + WS_S5S); f32x2* __restrict__ CI = (f32x2*)(F.ws + WS_S5CI); const f32x2* A16 = (const f32x2*)(F.ws + WS_S5A16);
    for (int i = F.gtid; i < Bn * 2 * 1536; i += F.gsize) { const int gp = i % 1536, d = (i / 1536) % 2, b = i / 3072; const f32x2 A = A16[(size_t)(l * 2 + d) * 1536 + gp];
        float cr = 0.f, ci = 0.f;
#pragma unroll 1
        for (int q0 = 0; q0 < NG16; q0 += CARRY_B) { f32x2 sv[CARRY_B];
#pragma unroll
            for (int e = 0; e < CARRY_B; ++e) { const int q = q0 + e, j = d == 0 ? q : NG16 - 1 - q; sv[e] = SS[(((size_t)b * NG16 + j) * 2 + d) * 1536 + gp]; }
#pragma unroll
            for (int e = 0; e < CARRY_B; ++e) { const int q = q0 + e, j = d == 0 ? q : NG16 - 1 - q; CI[(((size_t)b * NG16 + j) * 2 + d) * 1536 + gp] = (f32x2){cr, ci};
                const float nr = A[0] * cr - A[1] * ci + sv[e][0], ni = A[0] * ci + A[1] * cr + sv[e][1]; cr = nr; ci = ni; } } }
}
DEVFN void p_mixnorm(Frame& F) {
    bf16* ymix = (bf16*)(F.ws + WS_YMIX);
    for (int m = F.gw; m < M; m += F.ngw) { u32x4* row = (u32x4*)(ymix + (size_t)m * D);
        u32x4 v[2]; float s[2];
#pragma unroll
        for (int j = 0; j < 2; ++j) { v[j] = row[F.lane + 64 * j]; const float a0 = bf_lo(v[j].x), a1 = bf_hi(v[j].x), a2 = bf_lo(v[j].y), a3 = bf_hi(v[j].y), a4 = bf_lo(v[j].z), a5 = bf_hi(v[j].z), a6 = bf_lo(v[j].w), a7 = bf_hi(v[j].w);
            s[j] = ((a0 * a0 + a1 * a1) + (a2 * a2 + a3 * a3)) + ((a4 * a4 + a5 * a5) + (a6 * a6 + a7 * a7)); }
        const float sa = wave_sum(F.lane < 48 ? s[0] : 0.f), sb = wave_sum((F.lane >= 48 ? s[0] : 0.f) + (F.lane < 32 ? s[1] : 0.f)), sc = wave_sum(F.lane >= 32 ? s[1] : 0.f);
        const float ia = 1.0f / sqrtf(sa * (1.0f / RGW) + 1e-6f), ib = 1.0f / sqrtf(sb * (1.0f / S5W) + 1e-6f), ic = 1.0f / sqrtf(sc * (1.0f / HYW) + 1e-6f);
#pragma unroll
        for (int j = 0; j < 2; ++j) { const int ch = F.lane + 64 * j; const float f = ch < 48 ? ia : (ch < 96 ? ib : ic); u32x4 o;
            o.x = pk_bf16(bf_lo(v[j].x) * f, bf_hi(v[j].x) * f); o.y = pk_bf16(bf_lo(v[j].y) * f, bf_hi(v[j].y) * f); o.z = pk_bf16(bf_lo(v[j].z) * f, bf_hi(v[j].z) * f); o.w = pk_bf16(bf_lo(v[j].w) * f, bf_hi(v[j].w) * f);
            row[ch] = o; } }
}
DEVFN void p_final(Frame& F) {
    const float* ssq = (const float*)(F.ws + WS_SSQ); const f32x4* g4 = (const f32x4*)FIN(37) + F.lane;
    for (int m = F.gw; m < M; m += F.ngw) { const float inv = pg8::row_inv(ssq, m); f32x4* hr = (f32x4*)(F.out + (size_t)m * D) + F.lane;
#pragma unroll
        for (int j = 0; j < 4; ++j) hr[64 * j] = hr[64 * j] * inv * g4[64 * j]; }
}

constexpr int PH_PER_LAYER = 9, N_PHASES = 2 + 2 * PH_PER_LAYER;
__global__ void __launch_bounds__(NT, 2) mk_fwd(Args args) {
#ifdef CPU_EMU
    unsigned char* lds = emu_lds_base();
#else
    extern __shared__ __attribute__((aligned(16))) unsigned char lds_[];
    LAS unsigned char* lds = (LAS unsigned char*)lds_;
#endif
    Frame F; F.lds = lds; F.tid = threadIdx.x; F.lane = F.tid & 63;
#ifdef CPU_EMU
    F.wave = F.tid >> 6;
#else
    F.wave = __builtin_amdgcn_readfirstlane(F.tid >> 6);
#endif
    F.G = gridDim.x; F.gtid = blockIdx.x * NT + F.tid; F.gsize = F.G * NT; F.gw = blockIdx.x * NWAVES + F.wave; F.ngw = F.G * NWAVES;
    #ifdef CPU_EMU
    F.ap = &args;
#else
    F.ap = (KARG_PTR)__builtin_amdgcn_kernarg_segment_ptr();
#endif
    F.out = args.out; F.ws = args.ws;
#ifndef CPU_EMU
    volatile LAS unsigned* MISC = (volatile LAS unsigned*)(lds + MISC_OFF);
    if (F.tid < 32) MISC[F.tid] = 0u;
    __syncthreads();
    XcdBarrier bar = xcd_barrier_post((unsigned*)(args.ws + WS_CTL) + CW_BAR, MISC + 8);
#define GRID_BAR() do { xcd_barrier(bar); __builtin_amdgcn_fence(__ATOMIC_ACQUIRE, "agent"); asm volatile("s_waitcnt vmcnt(0)" ::: "memory"); } while (0)
#else
#define GRID_BAR() do {} while (0)
#endif
    const int lo = args.ph_lo, hi = args.ph_hi;
#define IN(k) (lo <= (k) && (k) < hi)
#define SEAM(k) do { if (IN(k) && IN((k) + 1)) GRID_BAR(); } while (0)
#define P_SSQ ((float*)(F.ws + WS_SSQ))
#define P_HB ((bf16*)(F.ws + WS_HB))
#define P_PROJ ((bf16*)(F.ws + WS_PROJ))
#define P_YMIX ((bf16*)(F.ws + WS_YMIX))
#define P_G ((bf16*)(F.ws + WS_G))
    { int l0 = 0; if (IN(0)) { LAUNDER(F, l0); p_prologue(F); } }
    SEAM(0);
    for (int lq = 0; lq < 2; ++lq) {
        int l = lq; const int p0 = 1 + lq * PH_PER_LAYER;
        if (IN(p0 + 0)) { LAUNDER(F, l); p_hid2(F, l);
            pg8::Gemm g{P_HB, (const bf16*)(F.ws + WS_WIN + l * SZ_WIN), D}; pg8::StaticOrder S; S.init(M / 256, NINP / 256, F.G, (int)blockIdx.x);
            pg8::EpiIn E{P_PROJ, P_SSQ};
            pg8::gemm_phase<pg8::EpiIn, pg8::StaticOrder, true, true>(lds, F.tid, g, S, E); }
        SEAM(p0 + 0);
        if (IN(p0 + 1)) { LAUNDER(F, l); p_hy_pre(F, l); p_rg_stage(F, l, false); p_s5_stage(F, l, false); }
        SEAM(p0 + 1);
        if (IN(p0 + 2)) { LAUNDER(F, l); p_s5_carry(F, l); p_rg_carry(F); p_hy_main(F, l); }
        SEAM(p0 + 2);
        if (IN(p0 + 3)) { LAUNDER(F, l); p_hy_post(F, l); p_rg_stage(F, l, true); p_s5_stage(F, l, true); }
        SEAM(p0 + 3);
        SEAM(p0 + 4);
        if (IN(p0 + 5)) { LAUNDER(F, l); p_mixnorm(F); }
        SEAM(p0 + 5);
        if (IN(p0 + 6)) { LAUNDER(F, l); pg8::Gemm g{P_YMIX, (const bf16*)(F.ws + WS_WOUT + l * SZ_WOUT), D}; pg8::StaticOrder S; S.init(M / 256, D / 256, F.G, (int)blockIdx.x);
            pg8::EpiRes E{F.out, P_HB, P_SSQ};
            pg8::gemm_phase<pg8::EpiRes, pg8::StaticOrder, true, true>(lds, F.tid, g, S, E); }
        SEAM(p0 + 6);
        if (IN(p0 + 7)) { LAUNDER(F, l); pg8::Gemm g{P_HB, (const bf16*)(F.ws + WS_WUP + l * SZ_WUP), D}; pg8::UpOrder S; S.init(Bn * NQ, FF2 / 256, F.G, (int)blockIdx.x);
            pg8::EpiUp E{P_G, P_SSQ, FIN(34) + (size_t)l * 3 * FF2, FIN(35) + (size_t)l * FF2};
            pg8::gemm_phase<pg8::EpiUp, pg8::UpOrder, true, true>(lds, F.tid, g, S, E); }
        SEAM(p0 + 7);
        if (IN(p0 + 8)) { LAUNDER(F, l); pg8::Gemm g{P_G, (const bf16*)(F.ws + WS_WDN + l * SZ_WDN), FF}; pg8::StaticOrder S; S.init(M / 256, D / 256, F.G, (int)blockIdx.x);
            pg8::EpiRes E{F.out, P_HB, P_SSQ};
            pg8::gemm_phase<pg8::EpiRes, pg8::StaticOrder, true, true>(lds, F.tid, g, S, E); }
        SEAM(p0 + 8);
    }
    { int l0 = 0; if (IN(N_PHASES - 1)) { LAUNDER(F, l0); p_final(F); } }
#undef IN
#undef SEAM
}

#ifndef MK_N_LAUNCHES
#define MK_N_LAUNCHES 1
#endif
extern "C" void kernel_launch(void* const* d_in, const int* in_sizes, int n_in, void* d_out, int out_size, void* d_ws, size_t ws_size, hipStream_t stream) {
    Args a{};
    for (int i = 0; i < 38; ++i) a.in[i] = (const float*)d_in[i];
    a.out = (float*)d_out; a.ws = (unsigned char*)d_ws;
#ifdef CPU_EMU
    const int grid = EMU_GRID;
    for (int ph = 0; ph < N_PHASES; ++ph) { a.ph_lo = ph; a.ph_hi = ph + 1; LAUNCH(mk_fwd, dim3(grid), dim3(NT), LDS_BYTES, stream, a); emu_phase_hook(ph, a); }
#else
    static int grid = 0;
    if (grid == 0) {
        if (n_in != 38 || out_size != M * D || ws_size < WS_END) { fprintf(stderr, "kernel_launch: unexpected shapes (n_in %d out %d ws %zu need %zu)\n", n_in, out_size, ws_size, (size_t)WS_END); grid = -1; return; }
        int dev = 0, cus = 0, per_cu = 0;
        if (hipGetDevice(&dev) != hipSuccess || hipDeviceGetAttribute(&cus, hipDeviceAttributeMultiprocessorCount, dev) != hipSuccess) { grid = -1; return; }
        if (hipFuncSetAttribute((const void*)mk_fwd, hipFuncAttributeMaxDynamicSharedMemorySize, LDS_BYTES) != hipSuccess) { fprintf(stderr, "kernel_launch: hipFuncSetAttribute failed\n"); grid = -1; return; }
        if (hipOccupancyMaxActiveBlocksPerMultiprocessor(&per_cu, (const void*)mk_fwd, NT, LDS_BYTES) != hipSuccess || per_cu < 1) { fprintf(stderr, "kernel_launch: occupancy query says %d\n", per_cu); (void)hipGetLastError(); per_cu = 1; }
        grid = cus;
    }
    if (grid < 0) return;
    (void)hipMemsetAsync((char*)d_ws + WS_CTL, 0, CTL_BYTES, stream);
#if MK_N_LAUNCHES == 1
    a.ph_lo = 0; a.ph_hi = N_PHASES;
    hipLaunchKernelGGL(mk_fwd, dim3(grid), dim3(NT), LDS_BYTES, stream, a);
#else
    for (int ph = 0; ph < N_PHASES; ++ph) { a.ph_lo = ph; a.ph_hi = ph + 1; hipLaunchKernelGGL(mk_fwd, dim3(grid), dim3(NT), LDS_BYTES, stream, a); }
#endif
#endif
}
```

```cpp
#ifdef CPU_EMU
#include "emu.h"
#define LAS
#define GAS
#define DEVFN static inline
#define MEMFN inline
#define WAVE_LDS_FENCE() emu::wave_sync()
#define OPAQUE16(x) do {} while (0)
#define OPAQUE_V(x) do {} while (0)
#define FRESH(x) do {} while (0)
#define MFMA_GUARD(...) do {} while (0)
#define KV(x) 0
#define ACC1(a) 0
#define ACC2(a, b) 0
#define ACC3(a, b, c) 0
#define ACC4(a, b, c, d) 0
#else
#include <hip/hip_runtime.h>
#include <cstdio>
#include <cstdint>
#define LAS __attribute__((address_space(3)))
#define GAS __attribute__((address_space(1)))
#define DEVFN __device__ __forceinline__
#define MEMFN __device__ __forceinline__
#define WAVE_LDS_FENCE() do { asm volatile("s_waitcnt lgkmcnt(0)" ::: "memory"); } while (0)
#define OPAQUE16(x) asm volatile("" : "+v"(x))
#define OPAQUE_V(x) asm volatile("" : "+v"(x))
#define FRESH(x) asm volatile("s_nop 1" : "+v"(x))
#define KV(x) "v"(x)
#define KA(x) "+v"(x)
#define MFMA_GUARD(accs, ...) asm volatile("s_nop 7\n\ts_nop 7\n\ts_nop 7\n\ts_nop 7" : accs : __VA_ARGS__)
#define ACC1(a) KA(a)
#define ACC2(a, b) KA(a), KA(b)
#define ACC3(a, b, c) KA(a), KA(b), KA(c)
#define ACC4(a, b, c, d) KA(a), KA(b), KA(c), KA(d)
typedef short bf16x8 __attribute__((ext_vector_type(8)));
typedef float f32x4 __attribute__((ext_vector_type(4)));
typedef float f32x2 __attribute__((ext_vector_type(2)));
typedef float f32x16 __attribute__((ext_vector_type(16)));
typedef unsigned u32x4 __attribute__((ext_vector_type(4)));
typedef unsigned u32x2 __attribute__((ext_vector_type(2)));
typedef __bf16 bf16x2_t __attribute__((ext_vector_type(2)));
DEVFN void sync_block() { __syncthreads(); }
DEVFN int lane_id() { int l; asm volatile("v_mbcnt_lo_u32_b32 %0, -1, 0\n\tv_mbcnt_hi_u32_b32 %0, -1, %0" : "=v"(l)); return l; }
DEVFN f32x16 mfma32(bf16x8 a, bf16x8 b, f32x16 c) { return __builtin_amdgcn_mfma_f32_32x32x16_bf16(a, b, c, 0, 0, 0); }
DEVFN f32x4 mfma16(bf16x8 a, bf16x8 b, f32x4 c) { return __builtin_amdgcn_mfma_f32_16x16x32_bf16(a, b, c, 0, 0, 0); }
DEVFN float shfl_f32(float v, int src) { return __builtin_bit_cast(float, __builtin_amdgcn_ds_bpermute(src << 2, __builtin_bit_cast(int, v))); }
DEVFN float shfl_xor_f32(float v, int m) { return shfl_f32(v, lane_id() ^ m); }
DEVFN float dpp_row_shr1(float old, float src) { return __builtin_bit_cast(float, __builtin_amdgcn_update_dpp(__builtin_bit_cast(int, old), __builtin_bit_cast(int, src), 0x111, 0xf, 0xf, false)); }
DEVFN float dpp_row_shl1(float old, float src) { return __builtin_bit_cast(float, __builtin_amdgcn_update_dpp(__builtin_bit_cast(int, old), __builtin_bit_cast(int, src), 0x101, 0xf, 0xf, false)); }
DEVFN float dpp_row_ror1(float src) { return __builtin_bit_cast(float, __builtin_amdgcn_update_dpp(0, __builtin_bit_cast(int, src), 0x121, 0xf, 0xf, false)); }
DEVFN float dpp_row_ror15(float src) { return __builtin_bit_cast(float, __builtin_amdgcn_update_dpp(0, __builtin_bit_cast(int, src), 0x12f, 0xf, 0xf, false)); }
DEVFN unsigned pk_bf16(float lo, float hi) { f32x2 v = {lo, hi}; bf16x2_t b = __builtin_convertvector(v, bf16x2_t); return __builtin_bit_cast(unsigned, b); }
DEVFN float bf_lo(unsigned u) { return __builtin_bit_cast(float, u << 16); }
DEVFN float bf_hi(unsigned u) { return __builtin_bit_cast(float, u & 0xffff0000u); }
DEVFN float fast_rcp(float x) { return __builtin_amdgcn_rcpf(x); }
DEVFN float fast_exp2(float x) { return __builtin_amdgcn_exp2f(x); }
#endif

#ifndef BATCH
#define BATCH 4
#endif
#ifndef SEQ
#define SEQ 4096
#endif
typedef unsigned short bf16;
constexpr int Bn = BATCH, L = SEQ, M = Bn * L, D = 1024, NIN = 1920, NINP = 2048, RGW = 384, S5W = 384, HYW = 256, FF = 2816, FF2 = 5632, GLUP = 512;
constexpr int NWAVES = 8, NT = NWAVES * 64;
constexpr int UPS = 254, NQ = (L + UPS - 1) / UPS;

constexpr size_t al256(size_t x) { return (x + 255) & ~(size_t)255; }
constexpr size_t WS_CTL = 0, CTL_BYTES = 1u << 20;
constexpr size_t WS_SSQ = WS_CTL + CTL_BYTES, SZ_SSQ = (size_t)M * 16 * 4;
constexpr size_t WS_S5A = WS_SSQ + SZ_SSQ, SZ_S5A = (size_t)2 * 2 * 24 * 64 * 8;
constexpr size_t WS_S5A16 = WS_S5A + SZ_S5A;
constexpr size_t WS_S5BT = WS_S5A16 + SZ_S5A, SZ_S5BT = (size_t)2 * 2 * 24 * 2 * 64 * 16 * 2;
constexpr size_t WS_S5CT = WS_S5BT + SZ_S5BT, SZ_S5CT = (size_t)2 * 2 * 24 * 16 * 128 * 2;
constexpr size_t WS_RGSP = WS_S5CT + SZ_S5CT, SZ_RGSP = al256((size_t)2 * 2 * 384 * 4);
constexpr size_t WS_RGWT = WS_RGSP + SZ_RGSP, SZ_RGWT = (size_t)2 * 2 * 2 * 6 * 64 * 64 * 2;
constexpr size_t WS_RGAG = WS_RGWT + SZ_RGWT, SZ_RGAG = (size_t)(M / 16) * 2 * RGW * 8;
constexpr size_t WS_RGCI = WS_RGAG + SZ_RGAG, SZ_RGCI = (size_t)(M / 16) * 2 * RGW * 4;
constexpr size_t WS_HID = WS_RGCI + SZ_RGCI, SZ_HID = (size_t)4 * L * 64 * 4;
constexpr size_t WS_T1 = WS_HID + SZ_HID, SZ_T1 = (size_t)(M / 16) * 2 * 1536 * 8;
constexpr size_t WS_S5S = WS_T1;
constexpr size_t WS_S5CI = WS_T1 + SZ_T1, SZ_S5CI = SZ_T1;
constexpr size_t WS_KFB = WS_S5CI + SZ_S5CI, SZ_KFB = (size_t)L * 512 * 4;
constexpr size_t SZ_WIN = (size_t)NINP * D * 2, SZ_WOUT = (size_t)D * D * 2, SZ_WUP = (size_t)FF2 * D * 2, SZ_WDN = (size_t)D * FF * 2, SZ_WGLU = (size_t)GLUP * S5W * 2;
constexpr size_t WS_WIN = WS_KFB + SZ_KFB, WS_WOUT = WS_WIN + 2 * SZ_WIN, WS_WUP = WS_WOUT + 2 * SZ_WOUT, WS_WDN = WS_WUP + 2 * SZ_WUP, WS_WGLU = WS_WDN + 2 * SZ_WDN;
constexpr size_t WS_HBPAD = WS_WGLU + 2 * SZ_WGLU, HB_FRONT = (size_t)256 * D * 2, WS_HB = WS_HBPAD + HB_FRONT, SZ_HBPAD = (size_t)(M + 768) * D * 2;
constexpr size_t WS_PROJ = WS_HBPAD + SZ_HBPAD, SZ_PROJ = (size_t)M * NINP * 2;
constexpr size_t WS_YMIX = WS_PROJ + SZ_PROJ, SZ_YMIX = (size_t)M * D * 2;
constexpr size_t WS_G = WS_PROJ;
constexpr size_t WS_END = WS_YMIX + SZ_YMIX;
constexpr size_t WS_ZT = WS_HB, WS_YT = WS_HB + (size_t)M * 256 * 2;
static_assert(SZ_PROJ + SZ_YMIX >= (size_t)M * FF * 2, "g overlay");
static_assert((size_t)M * 256 * 6 <= (size_t)M * D * 2, "zT/yT overlay");
static_assert(BATCH != 4 || SEQ != 4096 || WS_END <= ((size_t)256 << 20), "workspace over 256 MiB");

DEVFN float gelu_f(float x) { const float y = 1.5957691216057308f * (x + 0.044715f * x * x * x); return x * fast_rcp(1.0f + fast_exp2(-1.4426950408889634f * y)); }
DEVFN float sigmoid_f(float x) { return fast_rcp(1.0f + fast_exp2(-1.4426950408889634f * x)); }
DEVFN float softplus_f(float x) { return x > 0.f ? x + log1pf(expf(-x)) : log1pf(expf(x)); }
DEVFN float exp_f(float x) { return fast_exp2(1.4426950408889634f * x); }
DEVFN float expm1_f(float x) {
    const float p = x * (1.0f + x * (0.5f + x * (0.16666667f + x * (0.041666668f + x * (0.008333334f + x * 0.0013888889f)))));
    return fabsf(x) < 0.25f ? p : exp_f(x) - 1.0f; }
DEVFN float bf2f_(bf16 h) { return bf_lo((unsigned)h); }
DEVFN bf16 f2bf_(float f) { return (bf16)(pk_bf16(f, 0.f) & 0xffffu); }

namespace pg8 {
constexpr int BM = 256, BK = 64, HALF = 128, HTB = HALF * BK * 2, STAGE_BYTES = 8 * HTB, NXCD = 8, WGM = 8;
__host__ __device__ __forceinline__ int lds_byte(int r, int c) { const int st = (r >> 4) * 2 + (c >> 5), rr = r & 15, cc = c & 31, ob = rr * 64 + cc * 2; return st * 1024 + (ob ^ (((ob >> 9) & 1) << 5)); }
__host__ __device__ __forceinline__ void stage_rc(int b, int& R, int& C) { const int st = b / 1024, sb = b % 1024, swz = sb ^ (((sb >> 9) & 1) << 5); R = (st >> 1) * 16 + swz / 64; C = (st & 1) * 32 + (swz % 64) / 2; }
__host__ __device__ __forceinline__ int perm32(int rho) { const int n = rho >> 4, i = rho & 15; return 8 * (i >> 2) + 4 * n + (i & 3); }

struct Unit { int pm, pn; int arow; };
struct Gemm { const bf16* A; const bf16* Bt; int K; };

struct StaticOrder {
    int nM, nN, nwg, G, c;
    __host__ __device__ void init(int nM_, int nN_, int G_, int c_) { nM = nM_; nN = nN_; nwg = nM * nN; G = G_; c = c_; }
    __host__ __device__ bool next(int i, Unit& u) const {
        const long Lx = (long)i * G + c; if (Lx >= nwg) return false;
        int wgid = (int)Lx; { const int q = nwg / NXCD, r = nwg % NXCD, xcd = wgid % NXCD, off = wgid / NXCD; wgid = (xcd < r ? xcd * (q + 1) : r * (q + 1) + (xcd - r) * q) + off; }
        const int nig = WGM * nN, gid = wgid / nig, fm = gid * WGM, gsz = (nM - fm) < WGM ? (nM - fm) : WGM;
        u.pm = fm + ((wgid % nig) % gsz); u.pn = (wgid % nig) / gsz; u.arow = u.pm * BM; return true;
    }
};
struct UpOrder : StaticOrder {
    __host__ __device__ bool next(int i, Unit& u) const { if (!StaticOrder::next(i, u)) return false; const int b = u.pm / NQ, q = u.pm % NQ; u.arow = b * L + UPS * q - 1; return true; }
};

#ifndef CPU_EMU
#define PG8_LAS __attribute__((address_space(3)))
template <class Epi, class Sched, bool ALIGN_EPI = false, bool SP2 = false>
__device__ __forceinline__ void gemm_phase(PG8_LAS unsigned char* lds, const int tid, const Gemm g, const Sched& S, const Epi& E) {
    const int wid = __builtin_amdgcn_readfirstlane(tid >> 6), lane = tid & 63, wr = wid >> 2, wc = wid & 3, fr = lane & 15, fq = lane >> 4;
    const int K = g.K, nt = K / BK;
    unsigned voffA[2], voffB[2];
#pragma unroll
    for (int i = 0; i < 2; ++i) { int R, C; stage_rc(tid * 16 + i * 8192, R, C); const int Rb = Epi::PERM ? ((R & ~31) + perm32(R & 31)) : R;
        voffA[i] = (unsigned)(R * K + C) * 2u; voffB[i] = (unsigned)(Rb * K + C) * 2u; }
    const size_t kstep = (size_t)(BK * 2);
    const size_t hstep = (size_t)HALF * K * 2;
    const size_t tstep = 2 * hstep;
    const size_t rstep = (size_t)K * 2;
    const unsigned ldsw = (unsigned)wid * 1024u;
    const int aoff = lds_byte(wr * 64 + fr, fq * 8), boff = lds_byte(wc * 32 + fr, fq * 8);
#define PG8_SA(b, h) (((b) * 2 + (h)) * HTB)
#define PG8_SB(b, h) ((4 + (b) * 2 + (h)) * HTB)
#define PG8_STAGE(bufoff, gbase, voff) do { _Pragma("unroll") for (int _i = 0; _i < 2; ++_i) \
        __builtin_amdgcn_global_load_lds((const unsigned*)((const char*)(gbase) + (voff)[_i]), (PG8_LAS unsigned*)(lds + (bufoff) + ldsw + _i * 8192), 16, 0, 0); } while (0)
#define PG8_LDA(dst, b, h) do { _Pragma("unroll") for (int m = 0; m < 4; ++m) _Pragma("unroll") for (int k = 0; k < 2; ++k) dst[m][k] = *(const PG8_LAS bf16x8*)(lds + PG8_SA(b, h) + aoff + m * 2048 + k * 1024); } while (0)
#define PG8_LDB(dst, b, h) do { _Pragma("unroll") for (int n = 0; n < 2; ++n) _Pragma("unroll") for (int k = 0; k < 2; ++k) dst[n][k] = *(const PG8_LAS bf16x8*)(lds + PG8_SB(b, h) + boff + n * 2048 + k * 1024); } while (0)
#define PG8_MMA(ai, bj, At, Bt) do { __builtin_amdgcn_s_setprio(1); _Pragma("unroll") for (int m = 0; m < 4; ++m) _Pragma("unroll") for (int n = 0; n < 2; ++n) _Pragma("unroll") for (int k = 0; k < 2; ++k) \
        acc[ai][bj][m][n] = __builtin_amdgcn_mfma_f32_16x16x32_bf16(Bt[n][k], At[m][k], acc[ai][bj][m][n], 0, 0, 0); __builtin_amdgcn_s_setprio(0); } while (0)
#define PG8_WAIT_V(n) asm volatile("s_waitcnt vmcnt(" #n ")" ::: "memory")
#define PG8_WAIT_L(n) asm volatile("s_waitcnt lgkmcnt(" #n ")" ::: "memory")
#define PG8_BAR __builtin_amdgcn_s_barrier()
#define PG8_SCHED __builtin_amdgcn_sched_barrier(0)
    Unit cur, nxt; int ui = 0;
    if (!S.next(0, cur)) return;
    f32x4 acc[2][2][4][2];
#pragma unroll
    for (int a = 0; a < 2; ++a)
#pragma unroll
        for (int b = 0; b < 2; ++b)
#pragma unroll
            for (int m = 0; m < 4; ++m)
#pragma unroll
                for (int n = 0; n < 2; ++n) acc[a][b][m][n] = (f32x4){0.f, 0.f, 0.f, 0.f};
    bf16x8 At[4][2], B0[2][2], B1[2][2];
    const char* cA = (const char*)g.A + (long)cur.arow * (long)rstep; const char* cB = (const char*)g.Bt + (size_t)cur.pn * tstep;
    if constexpr (SP2) {
        PG8_STAGE(PG8_SB(0, 0), cB, voffB); PG8_STAGE(PG8_SB(0, 1), cB + hstep, voffB); PG8_STAGE(PG8_SA(0, 0), cA, voffA); PG8_STAGE(PG8_SA(0, 1), cA + hstep, voffA);
        if (wr == 1) PG8_BAR;
        PG8_WAIT_V(2); PG8_BAR;
        PG8_STAGE(PG8_SB(1, 0), cB + kstep, voffB); PG8_STAGE(PG8_SA(1, 0), cA + kstep, voffA); PG8_STAGE(PG8_SB(1, 1), cB + hstep + kstep, voffB);
        PG8_WAIT_V(6); PG8_BAR;
    } else {
        PG8_STAGE(PG8_SB(0, 0), cB, voffB); PG8_STAGE(PG8_SA(0, 0), cA, voffA); PG8_STAGE(PG8_SB(0, 1), cB + hstep, voffB); PG8_STAGE(PG8_SA(0, 1), cA + hstep, voffA);
        if (wr == 1) PG8_BAR;
        PG8_WAIT_V(4); PG8_BAR;
        PG8_STAGE(PG8_SB(1, 0), cB + kstep, voffB); PG8_STAGE(PG8_SA(1, 0), cA + kstep, voffA); PG8_STAGE(PG8_SB(1, 1), cB + hstep + kstep, voffB);
        PG8_WAIT_V(6); PG8_BAR;
    }
    for (;;) {
        const bool has_next = S.next(ui + 1, nxt);
        const char* nA = has_next ? (const char*)g.A + (long)nxt.arow * (long)rstep : cA; const char* nB = has_next ? (const char*)g.Bt + (size_t)nxt.pn * tstep : cB;
        for (int t = 0; t < nt; t += 2) {
            const bool last = (t == nt - 2);
            const char* a1 = cA + (size_t)(t + 1) * kstep;
            const char* a2 = last ? nA : cA + (size_t)(t + 2) * kstep; const char* b2 = last ? nB : cB + (size_t)(t + 2) * kstep;
            const char* a3 = a2 + kstep; const char* b3 = b2 + kstep;
            if constexpr (Epi::RESCALE) { if (t == Epi::T1 || t == Epi::T2) E.rescale(acc, t == Epi::T1 ? 0 : 1, wr, tid & 15, lds + STAGE_BYTES); }
            if constexpr (SP2) {
            PG8_LDB(B0, 0, 0); PG8_LDB(B1, 0, 1); PG8_SCHED; PG8_LDA(At, 0, 0); PG8_STAGE(PG8_SA(1, 1), a1 + hstep, voffA);
            PG8_WAIT_V(8); PG8_WAIT_L(0); PG8_BAR; PG8_MMA(0, 0, At, B0); PG8_MMA(0, 1, At, B1); PG8_BAR; PG8_SCHED;
            PG8_LDA(At, 0, 1); PG8_STAGE(PG8_SB(0, 0), b2, voffB); PG8_STAGE(PG8_SB(0, 1), b2 + hstep, voffB); PG8_STAGE(PG8_SA(0, 0), a2, voffA);
            PG8_WAIT_V(8); PG8_WAIT_L(0); PG8_BAR; PG8_MMA(1, 0, At, B0); PG8_MMA(1, 1, At, B1); PG8_BAR; PG8_SCHED;
            PG8_LDB(B0, 1, 0); PG8_LDB(B1, 1, 1); PG8_SCHED; PG8_LDA(At, 1, 0); PG8_STAGE(PG8_SA(0, 1), a2 + hstep, voffA);
            PG8_WAIT_V(8); PG8_WAIT_L(0); PG8_BAR; PG8_MMA(0, 0, At, B0); PG8_MMA(0, 1, At, B1); PG8_BAR; PG8_SCHED;
            PG8_LDA(At, 1, 1); PG8_STAGE(PG8_SB(1, 0), b3, voffB); PG8_STAGE(PG8_SB(1, 1), b3 + hstep, voffB); PG8_STAGE(PG8_SA(1, 0), a3, voffA);
            PG8_WAIT_V(8); PG8_WAIT_L(0); PG8_BAR; PG8_MMA(1, 0, At, B0); PG8_MMA(1, 1, At, B1); PG8_BAR; PG8_SCHED;
            } else {
            PG8_LDB(B0, 0, 0); PG8_SCHED; PG8_LDA(At, 0, 0); PG8_STAGE(PG8_SA(1, 1), a1 + hstep, voffA);
            PG8_WAIT_L(8); PG8_BAR; PG8_WAIT_L(0); PG8_MMA(0, 0, At, B0); PG8_BAR; PG8_SCHED;
            PG8_LDB(B1, 0, 1); PG8_STAGE(PG8_SB(0, 0), b2, voffB);
            PG8_BAR; PG8_WAIT_L(0); PG8_MMA(0, 1, At, B1); PG8_BAR;
            PG8_LDA(At, 0, 1); PG8_STAGE(PG8_SA(0, 0), a2, voffA);
            PG8_BAR; PG8_WAIT_L(0); PG8_MMA(1, 0, At, B0); PG8_BAR; PG8_SCHED;
            PG8_STAGE(PG8_SB(0, 1), b2 + hstep, voffB);
            PG8_WAIT_V(6); PG8_BAR; PG8_MMA(1, 1, At, B1); PG8_BAR;
            PG8_LDB(B0, 1, 0); PG8_SCHED; PG8_LDA(At, 1, 0); PG8_STAGE(PG8_SA(0, 1), a2 + hstep, voffA);
            PG8_WAIT_L(8); PG8_BAR; PG8_WAIT_L(0); PG8_MMA(0, 0, At, B0); PG8_BAR; PG8_SCHED;
            PG8_LDB(B1, 1, 1); PG8_STAGE(PG8_SB(1, 0), b3, voffB);
            PG8_BAR; PG8_WAIT_L(0); PG8_MMA(0, 1, At, B1); PG8_BAR;
            PG8_LDA(At, 1, 1); PG8_STAGE(PG8_SA(1, 0), a3, voffA);
            PG8_BAR; PG8_WAIT_L(0); PG8_MMA(1, 0, At, B0); PG8_BAR; PG8_SCHED;
            PG8_STAGE(PG8_SB(1, 1), b3 + hstep, voffB);
            PG8_WAIT_V(6); PG8_BAR; PG8_MMA(1, 1, At, B1); PG8_BAR;
            }
        }
        if constexpr (ALIGN_EPI) { if (wr == 0) PG8_BAR; }
        { int t_ = tid; asm volatile("" : "+v"(t_));
          E(acc, cur, wr, wc, t_ & 15, (t_ >> 4) & 3, lds + STAGE_BYTES); }
        if (!has_next) break;
#pragma unroll
        for (int a = 0; a < 2; ++a)
#pragma unroll
            for (int b = 0; b < 2; ++b)
#pragma unroll
                for (int m = 0; m < 4; ++m)
#pragma unroll
                    for (int n = 0; n < 2; ++n) acc[a][b][m][n] = (f32x4){0.f, 0.f, 0.f, 0.f};
        cur = nxt; cA = nA; cB = nB; ++ui;
        if constexpr (ALIGN_EPI) { if (wr == 1) PG8_BAR; }
    }
    PG8_WAIT_V(0);
    if constexpr (!ALIGN_EPI) { if (wr == 0) PG8_BAR; }
    PG8_BAR;
#undef PG8_SA
#undef PG8_SB
#undef PG8_STAGE
#undef PG8_LDA
#undef PG8_LDB
#undef PG8_MMA
#undef PG8_WAIT_V
#undef PG8_WAIT_L
#undef PG8_BAR
#undef PG8_SCHED
}
#else
template <class Epi, class Sched, bool ALIGN_EPI = false, bool SP2 = false>
static inline void gemm_phase(unsigned char* lds, const int tid, const Gemm g, const Sched& S, const Epi& E) {
    const int wid = tid >> 6, lane = tid & 63, wr = wid >> 2, wc = wid & 3, fr = lane & 15, fq = lane >> 4;
    static thread_local std::vector<float> Af, Bf;
    Unit cur;
    for (int ui = 0; S.next(ui, cur); ++ui) {
        const int K = g.K;
        sync_block();
        if (tid == 0) { Af.resize((size_t)256 * K); Bf.resize((size_t)256 * K);
            for (int r = 0; r < 256; ++r) for (int k = 0; k < K; ++k) { Af[(size_t)r * K + k] = bf2f_(g.A[((long)cur.arow + r) * K + k]); Bf[(size_t)r * K + k] = bf2f_(g.Bt[((size_t)cur.pn * 256 + r) * K + k]); } }
        sync_block();
        f32x4 acc[2][2][4][2];
        for (int ai = 0; ai < 2; ++ai) for (int bj = 0; bj < 2; ++bj) for (int m = 0; m < 4; ++m) for (int n = 0; n < 2; ++n) for (int e = 0; e < 4; ++e) {
            const int r = 128 * ai + 64 * wr + 16 * m + fr, c = 128 * bj + 32 * wc + (Epi::PERM ? 8 * fq + 4 * n + e : 16 * n + 4 * fq + e);
            const float* a = &Af[(size_t)r * K]; const float* b = &Bf[(size_t)c * K]; float s = 0.f;
            if constexpr (Epi::RESCALE) { const float* TS = (const float*)(lds + STAGE_BYTES) + r * 4;
                for (int k = 0; k < K; ++k) { if (k == 64 * Epi::T1) s *= TS[0]; if (k == 64 * Epi::T2) s *= TS[1]; s += a[k] * b[k]; } }
            else for (int k = 0; k < K; ++k) s += a[k] * b[k];
            acc[ai][bj][m][n][e] = s; }
        E(acc, cur, wr, wc, fr, fq, lds + STAGE_BYTES);
    }
    sync_block();
}
#endif

DEVFN float row_inv(const float* ssq, int row) {
    const f32x4* p = (const f32x4*)(ssq + (size_t)row * 16); const f32x4 a = p[0], b = p[1], c = p[2], d = p[3];
    const float s = ((a[0] + a[1]) + (a[2] + a[3])) + ((b[0] + b[1]) + (b[2] + b[3])) + ((c[0] + c[1]) + (c[2] + c[3])) + ((d[0] + d[1]) + (d[2] + d[3]));
    return 1.0f / sqrtf(s * (1.0f / D) + 1e-6f);
}
struct EpiIn {
    static constexpr bool PERM = true, RESCALE = false;
    bf16* O; const float* ssq;
    MEMFN void operator()(const f32x4 (&acc)[2][2][4][2], const Unit& u, int wr, int wc, int fr, int fq, LAS unsigned char*) const {
        const int row0 = u.pm * BM + wr * 64 + fr, col0 = u.pn * BM + wc * 32 + 8 * fq;
#pragma unroll
        for (int ai = 0; ai < 2; ++ai)
#pragma unroll
            for (int m = 0; m < 4; ++m) { const int row = row0 + ai * HALF + m * 16; const float sc = row_inv(ssq, row); bf16* rowp = O + (size_t)row * NINP + col0;
#pragma unroll
                for (int bj = 0; bj < 2; ++bj) { const f32x4 v0 = acc[ai][bj][m][0] * sc, v1 = acc[ai][bj][m][1] * sc;
                    u32x4 w; w.x = pk_bf16(v0[0], v0[1]); w.y = pk_bf16(v0[2], v0[3]); w.z = pk_bf16(v1[0], v1[1]); w.w = pk_bf16(v1[2], v1[3]);
                    *(u32x4*)(rowp + bj * HALF) = w; } }
    }
};
struct EpiRes {
    static constexpr bool PERM = false, RESCALE = false;
    float* H; bf16* HB; float* ssq;
    MEMFN void operator()(const f32x4 (&acc)[2][2][4][2], const Unit& u, int wr, int wc, int fr, int fq, LAS unsigned char*) const {
        const int row0 = u.pm * BM + wr * 64 + fr, col0 = u.pn * BM + wc * 32 + 4 * fq;
#pragma unroll
        for (int ai = 0; ai < 2; ++ai)
#pragma unroll
            for (int m = 0; m < 4; ++m) { const int row = row0 + ai * HALF + m * 16; const size_t off = (size_t)row * D + col0; float s = 0.f;
#pragma unroll
                for (int bj = 0; bj < 2; ++bj)
#pragma unroll
                    for (int n = 0; n < 2; ++n) { float* hp = H + off + bj * HALF + n * 16; const f32x4 h = *(const f32x4*)hp + acc[ai][bj][m][n]; *(f32x4*)hp = h;
                        u32x2 w; w.x = pk_bf16(h[0], h[1]); w.y = pk_bf16(h[2], h[3]); *(u32x2*)(HB + off + bj * HALF + n * 16) = w;
                        s += (h[0] * h[0] + h[1] * h[1]) + (h[2] * h[2] + h[3] * h[3]); }
                s += shfl_xor_f32(s, 16); s += shfl_xor_f32(s, 32);
                if (fq == 0) ssq[(size_t)row * 16 + u.pn * 4 + wc] = s;
                if (m & 1) asm volatile("" ::: "memory"); }
    }
};
struct EpiResMix {
    static constexpr bool PERM = false, RESCALE = true; static constexpr int T1 = 6, T2 = 12;
    float* H; bf16* HB; float* ssq;
    MEMFN void rescale(f32x4 (&acc)[2][2][4][2], int which, int wr, int fr, LAS unsigned char* xl) const {
        const LAS float* TS = (const LAS float*)xl;
#pragma unroll
        for (int ai = 0; ai < 2; ++ai)
#pragma unroll
            for (int m = 0; m < 4; ++m) { const float r = TS[(ai * HALF + wr * 64 + m * 16 + fr) * 4 + which];
#pragma unroll
                for (int bj = 0; bj < 2; ++bj)
#pragma unroll
                    for (int n = 0; n < 2; ++n) acc[ai][bj][m][n] = acc[ai][bj][m][n] * r; }
    }
    MEMFN void operator()(const f32x4 (&acc)[2][2][4][2], const Unit& u, int wr, int wc, int fr, int fq, LAS unsigned char* xl) const {
        const LAS float* TS = (const LAS float*)xl;
        const int row0 = u.pm * BM + wr * 64 + fr, col0 = u.pn * BM + wc * 32 + 4 * fq;
#pragma unroll
        for (int ai = 0; ai < 2; ++ai)
#pragma unroll
            for (int m = 0; m < 4; ++m) { const int row = row0 + ai * HALF + m * 16; const size_t off = (size_t)row * D + col0; float s = 0.f; const float r3 = TS[(ai * HALF + wr * 64 + m * 16 + fr) * 4 + 2];
#pragma unroll
                for (int bj = 0; bj < 2; ++bj)
#pragma unroll
                    for (int n = 0; n < 2; ++n) { float* hp = H + off + bj * HALF + n * 16; const f32x4 h = *(const f32x4*)hp + acc[ai][bj][m][n] * r3; *(f32x4*)hp = h;
                        u32x2 w; w.x = pk_bf16(h[0], h[1]); w.y = pk_bf16(h[2], h[3]); *(u32x2*)(HB + off + bj * HALF + n * 16) = w;
                        s += (h[0] * h[0] + h[1] * h[1]) + (h[2] * h[2] + h[3] * h[3]); }
                s += shfl_xor_f32(s, 16); s += shfl_xor_f32(s, 32);
                if (fq == 0) ssq[(size_t)row * 16 + u.pn * 4 + wc] = s;
                if (m & 1) asm volatile("" ::: "memory"); }
    }
};
struct EpiGlu {
    static constexpr bool PERM = true, RESCALE = false;
    const bf16* YG; const float* bias; bf16* YM;
    MEMFN void operator()(const f32x4 (&acc)[2][2][4][2], const Unit& u, int wr, int wc, int fr, int fq, LAS unsigned char*) const {
        const int row0 = u.pm * BM + wr * 64 + fr, col0 = u.pn * BM + wc * 32 + 8 * fq;
#pragma unroll
        for (int bj = 0; bj < 2; ++bj) { const int col = col0 + bj * HALF; if (u.pn == 1 && bj == 1) continue;
            const f32x4 b0 = *(const f32x4*)(bias + col), b1 = *(const f32x4*)(bias + col + 4);
#pragma unroll
            for (int ai = 0; ai < 2; ++ai)
#pragma unroll
                for (int m = 0; m < 4; ++m) { const int row = row0 + ai * HALF + m * 16;
                    const u32x4 y = *(const u32x4*)(YG + (size_t)row * S5W + col); const f32x4 a0 = acc[ai][bj][m][0] + b0, a1 = acc[ai][bj][m][1] + b1;
                    u32x4 w; w.x = pk_bf16(bf_lo(y.x) * sigmoid_f(a0[0]), bf_hi(y.x) * sigmoid_f(a0[1])); w.y = pk_bf16(bf_lo(y.y) * sigmoid_f(a0[2]), bf_hi(y.y) * sigmoid_f(a0[3]));
                    w.z = pk_bf16(bf_lo(y.z) * sigmoid_f(a1[0]), bf_hi(y.z) * sigmoid_f(a1[1])); w.w = pk_bf16(bf_lo(y.w) * sigmoid_f(a1[2]), bf_hi(y.w) * sigmoid_f(a1[3]));
                    *(u32x4*)(YM + (size_t)row * D + RGW + col) = w;
                    if (m & 1) asm volatile("" ::: "memory"); } }
    }
};
struct EpiUp {
    static constexpr bool PERM = true, RESCALE = false;
    bf16* G; const float* ssq; const float* cw; const float* cb;
    MEMFN void operator()(f32x4 (&acc)[2][2][4][2], const Unit& u, int wr, int wc, int fr, int fq, LAS unsigned char* xl) const {
        const int b = u.pm / NQ, q = u.pm % NQ, t0 = UPS * q - 1;
        LAS float* XB = (LAS float*)xl;
        const int cs = wc * 32 + 8 * fq;
#pragma unroll
        for (int ai = 0; ai < 2; ++ai)
#pragma unroll
            for (int m = 0; m < 4; ++m) { const int lr = 128 * ai + 64 * wr + 16 * m + fr, t = t0 + lr; const bool ok = (t >= 0) && (t < L);
                const float sc = ok ? row_inv(ssq, b * L + t) : 0.f;
#pragma unroll
                for (int bj = 0; bj < 2; ++bj)
#pragma unroll
                    for (int n = 0; n < 2; ++n)
#pragma unroll
                        for (int e = 0; e < 4; ++e) acc[ai][bj][m][n][e] = ok ? acc[ai][bj][m][n][e] * sc : 0.f; }
#pragma unroll
        for (int ai = 0; ai < 2; ++ai) { const int s = 2 * ai + wr;
            if (fr == 0) {
#pragma unroll
                for (int bj = 0; bj < 2; ++bj)
#pragma unroll
                    for (int n = 0; n < 2; ++n) *(LAS f32x4*)(XB + (2 * s) * 256 + bj * 128 + cs + 4 * n) = acc[ai][bj][0][n]; }
            if (fr == 15) {
#pragma unroll
                for (int bj = 0; bj < 2; ++bj)
#pragma unroll
                    for (int n = 0; n < 2; ++n) *(LAS f32x4*)(XB + (2 * s + 1) * 256 + bj * 128 + cs + 4 * n) = acc[ai][bj][3][n]; } }
#ifdef CPU_EMU
        sync_block();
#else
        asm volatile("s_waitcnt lgkmcnt(0)" ::: "memory"); __builtin_amdgcn_s_barrier(); asm volatile("" ::: "memory");
#endif
        const int j0 = u.pn * 128 + cs;
#pragma unroll
        for (int n = 0; n < 2; ++n) {
            f32x4 wa[3], wv[3]; const f32x4 ba = *(const f32x4*)(cb + j0 + 4 * n), bv = *(const f32x4*)(cb + FF + j0 + 4 * n);
#pragma unroll
            for (int k = 0; k < 3; ++k) { wa[k] = *(const f32x4*)(cw + k * FF2 + j0 + 4 * n); wv[k] = *(const f32x4*)(cw + k * FF2 + FF + j0 + 4 * n); }
#pragma unroll
            for (int ai = 0; ai < 2; ++ai) { const int s = 2 * ai + wr;
#pragma unroll
                for (int m = 0; m < 4; ++m) { const int lr = 64 * s + 16 * m + fr, t = t0 + lr;
                    f32x4 up[2], dn[2];
#pragma unroll
                    for (int bj = 0; bj < 2; ++bj) {
                        f32x4 pu, pd;
                        if (m > 0) { const f32x4 p = acc[ai][bj][m > 0 ? m - 1 : 0][n]; pu = (f32x4){dpp_row_ror1(p[0]), dpp_row_ror1(p[1]), dpp_row_ror1(p[2]), dpp_row_ror1(p[3])}; }
                        else if (s > 0) pu = *(const LAS f32x4*)(XB + (2 * (s - 1) + 1) * 256 + bj * 128 + cs + 4 * n);
                        else pu = (f32x4){0.f, 0.f, 0.f, 0.f};
                        if (m < 3) { const f32x4 p = acc[ai][bj][m < 3 ? m + 1 : 3][n]; pd = (f32x4){dpp_row_ror15(p[0]), dpp_row_ror15(p[1]), dpp_row_ror15(p[2]), dpp_row_ror15(p[3])}; }
                        else if (s < 3) pd = *(const LAS f32x4*)(XB + (2 * (s + 1)) * 256 + bj * 128 + cs + 4 * n);
                        else pd = (f32x4){0.f, 0.f, 0.f, 0.f};
                        const f32x4 x = acc[ai][bj][m][n];
#pragma unroll
                        for (int e = 0; e < 4; ++e) { up[bj][e] = dpp_row_shr1(pu[e], x[e]); dn[bj][e] = dpp_row_shl1(pd[e], x[e]); }
                    }
                    const f32x4 a = ba + wa[0] * up[0] + wa[1] * acc[ai][0][m][n] + wa[2] * dn[0];
                    const f32x4 v = bv + wv[0] * up[1] + wv[1] * acc[ai][1][m][n] + wv[2] * dn[1];
                    if (lr >= 1 && lr <= UPS && t < L) { u32x2 w; w.x = pk_bf16(gelu_f(a[0]) * v[0], gelu_f(a[1]) * v[1]); w.y = pk_bf16(gelu_f(a[2]) * v[2], gelu_f(a[3]) * v[3]);
                        *(u32x2*)(G + (size_t)(b * L + t) * FF + j0 + 4 * n) = w; }
                } } }
    }
};
}

constexpr int RING_BYTES = 131072, XCH_OFF = RING_BYTES, XCH_BYTES = 8192, MISC_OFF = XCH_OFF + XCH_BYTES, LDS_BYTES = 147456;
constexpr int CW_TMO = 0, CW_BAR = 4096;
#ifndef CPU_EMU
typedef GAS unsigned gu32;
#define XB_TMO      128
#define XB_XCNT(j)  (256  + 64 * (j))
#define XB_XSUB(j)  (1280 + 64 * (j))
#define XB_XGEN(j)  (2304 + 64 * (j))
#define XB_TOP      3328
#define XB_TOPGEN   3392
#define XCD_BAR_WORDS 3456
#define XB_SPIN_CAP (1u << 22)
__device__ __forceinline__ unsigned xb_ld(unsigned* p)              { return __hip_atomic_load(p, __ATOMIC_RELAXED, __HIP_MEMORY_SCOPE_AGENT); }
__device__ __forceinline__ unsigned xb_add(unsigned* p, unsigned v) { return __hip_atomic_fetch_add(p, v, __ATOMIC_RELAXED, __HIP_MEMORY_SCOPE_AGENT); }
__device__ __forceinline__ unsigned xb_xcc_id() { return (unsigned)__builtin_amdgcn_s_getreg((3 << 11) | 20) & 0xFu; }
#define XB_SPIN(cond, bar) do { unsigned _sp = 0; while (cond) { __builtin_amdgcn_s_sleep(1); \
    if ((++_sp & 255u) == 0u) { if (xb_ld(&(bar)[XB_TMO])) break; if (_sp > XB_SPIN_CAP) { atomicAdd(&(bar)[XB_TMO], 1u); break; } } } } while (0)
struct XcdBarrier { unsigned* bar; unsigned x; volatile LAS unsigned* st; };
__device__ __forceinline__ XcdBarrier xcd_barrier_post(unsigned* bar, volatile LAS unsigned* st) {
    XcdBarrier b; b.bar = bar; b.x = xb_xcc_id(); b.st = st;
    if (threadIdx.x == 0) (void)xb_add(&bar[XB_XCNT(b.x)], 1u);
    return b;
}
__device__ __forceinline__ void xcd_barrier_complete(unsigned* bar, unsigned x, unsigned& nloc, unsigned& nx) {
    const unsigned G = gridDim.x * gridDim.y * gridDim.z;
    unsigned sum, cnt, mine, sp = 0u;
    for (;;) {
        sum = 0u; cnt = 0u; mine = 0u;
#pragma unroll
        for (unsigned j = 0; j < 16; ++j) { const unsigned c = xb_ld(&bar[XB_XCNT(j)]); sum += c; cnt += (c > 0u) ? 1u : 0u; mine = (j == x) ? c : mine; }
        if (sum == G) break;
        __builtin_amdgcn_s_sleep(1);
        if ((++sp & 255u) == 0u) { if (xb_ld(&bar[XB_TMO])) break; if (sp > XB_SPIN_CAP) { atomicAdd(&bar[XB_TMO], 1u); break; } }
    }
    nloc = mine > 0u ? mine : 1u; nx = cnt > 0u ? cnt : 1u;
}
__device__ __forceinline__ void xcd_barrier(const XcdBarrier& b) {
    __builtin_amdgcn_fence(__ATOMIC_RELEASE, "agent");
    asm volatile("s_waitcnt vmcnt(0)" ::: "memory");
    __syncthreads();
    if (threadIdx.x == 0) {
        unsigned* bar = b.bar;
        __builtin_amdgcn_s_waitcnt(0);
        unsigned nloc = b.st[0], nx = b.st[1];
        if (nloc == 0u) { xcd_barrier_complete(bar, b.x, nloc, nx); b.st[0] = nloc; b.st[1] = nx; }
        const unsigned old = xb_add(&bar[XB_XSUB(b.x)], 1u);
        const unsigned gen = old / nloc;
        if (old + 1u == (gen + 1u) * nloc) {
            __builtin_amdgcn_fence(__ATOMIC_RELEASE, "agent");
            asm volatile("s_waitcnt vmcnt(0)" ::: "memory");
            const unsigned og = xb_add(&bar[XB_TOP], 1u);
            const unsigned tg = og / nx;
            if (og + 1u == (tg + 1u) * nx) xb_add(&bar[XB_TOPGEN], 1u);
            else XB_SPIN(xb_ld(&bar[XB_TOPGEN]) == tg, bar);
            __builtin_amdgcn_fence(__ATOMIC_ACQUIRE, "agent");
            xb_add(&bar[XB_XGEN(b.x)], 1u);
            asm volatile("s_waitcnt vmcnt(0)" ::: "memory");
        } else {
            XB_SPIN(xb_ld(&bar[XB_XGEN(b.x)]) == gen, bar);
            __builtin_amdgcn_fence(__ATOMIC_ACQUIRE, "agent");
            asm volatile("s_waitcnt vmcnt(0)" ::: "memory");
        }
    }
    __syncthreads();
}
#endif

#ifdef CPU_EMU
struct Args; static void emu_phase_hook(int ph, const Args& a);
#endif
struct Args { const float* in[38]; float* out; unsigned char* ws; int ph_lo, ph_hi; };
#ifdef CPU_EMU
typedef const Args* KARG_PTR;
#else
typedef const __attribute__((address_space(4))) Args* KARG_PTR;
#endif
struct Frame {
    LAS unsigned char* lds; int tid, lane, wave, G, gtid, gsize, gw, ngw;
    KARG_PTR ap; float* out; unsigned char* ws;
};
#define FIN(i) (F.ap->in[i])
#ifdef CPU_EMU
#define LAUNDER(F, l) do {} while (0)
#else
#define LAUNDER(F, l) do { size_t z_ = 0; asm volatile("" : "+s"(z_), "+s"(F.ap), "+s"(l), "+s"(F.wave)); F.ws = args.ws + z_; F.out = args.out + z_; F.lane = lane_id(); F.tid = (F.wave << 6) | F.lane; \
    F.gtid = blockIdx.x * NT + F.tid; F.gw = blockIdx.x * NWAVES + F.wave; } while (0)
#endif

DEVFN void transpose_item(const float* W, int ldw, int K, bf16* WT, int src_col0, int dst_row0, int k0, const float* sc, LAS float* scr, int lane) {
#pragma unroll 8
    for (int i = 0; i < 32; ++i) { const int kk = 2 * i + (lane >> 5); float v = W[(size_t)(k0 + kk) * ldw + src_col0 + (lane & 31)]; if (sc) v *= sc[k0 + kk]; scr[kk * 33 + (lane & 31)] = v; }
    WAVE_LDS_FENCE();
    const int c = lane & 7;
#pragma unroll
    for (int j = 0; j < 4; ++j) { const int n = (lane >> 3) + 8 * j; const LAS float* s = scr + (8 * c) * 33 + n;
        u32x4 o; o.x = pk_bf16(s[0 * 33], s[1 * 33]); o.y = pk_bf16(s[2 * 33], s[3 * 33]); o.z = pk_bf16(s[4 * 33], s[5 * 33]); o.w = pk_bf16(s[6 * 33], s[7 * 33]);
        *(u32x4*)(WT + (size_t)(dst_row0 + n) * K + k0 + 8 * c) = o; }
    WAVE_LDS_FENCE();
}
DEVFN float wave_sum(float v) {
#pragma unroll
    for (int o = 1; o < 64; o <<= 1) v += shfl_xor_f32(v, o);
    return v;
}
DEVFN void p_prologue(Frame& F) {
    LAS float* scr = (LAS float*)(F.lds + F.wave * 16384);
    constexpr int I_IN = 16 * 60, I_OUT = 16 * 32, I_UP = 16 * 176, I_DN = 44 * 32, I_GLU = 6 * 12, I_L = I_IN + I_OUT + I_UP + I_DN + I_GLU;
    for (int it = F.gw; it < 2 * I_L; it += F.ngw) {
        const int l = it / I_L; int r = it % I_L;
        if (r < I_IN) { const int kb = r / 60, nb = r % 60; transpose_item(FIN(2) + (size_t)l * D * NIN, NIN, D, (bf16*)(F.ws + WS_WIN + l * SZ_WIN), 32 * nb, 32 * nb, 64 * kb, FIN(1) + l * D, scr, F.lane); continue; } r -= I_IN;
        if (r < I_OUT) { const int kb = r / 32, nb = r % 32; transpose_item(FIN(31) + (size_t)l * D * D, D, D, (bf16*)(F.ws + WS_WOUT + l * SZ_WOUT), 32 * nb, 32 * nb, 64 * kb, FIN(30) + l * D, scr, F.lane); continue; } r -= I_OUT;
        if (r < I_UP) { const int kb = r / 176, nb = r % 176, sc0 = 32 * nb, half = sc0 / FF, jj = sc0 % FF, pn = jj / 128;
            transpose_item(FIN(33) + (size_t)l * D * FF2, FF2, D, (bf16*)(F.ws + WS_WUP + l * SZ_WUP), sc0, 256 * pn + 128 * half + (jj % 128), 64 * kb, FIN(32) + l * D, scr, F.lane); continue; } r -= I_UP;
        if (r < I_DN) { const int kb = r / 32, nb = r % 32; transpose_item(FIN(36) + (size_t)l * FF * D, D, FF, (bf16*)(F.ws + WS_WDN + l * SZ_WDN), 32 * nb, 32 * nb, 64 * kb, nullptr, scr, F.lane); continue; } r -= I_DN;
        { const int kb = r / 12, nb = r % 12; transpose_item(FIN(18) + (size_t)l * S5W * S5W, S5W, S5W, (bf16*)(F.ws + WS_WGLU + l * SZ_WGLU), 32 * nb, 32 * nb, 64 * kb, nullptr, scr, F.lane); }
    }
    for (int i = F.gtid; i < 2 * (128 * D / 8); i += F.gsize) { const int l = i / (128 * D / 8), r = i % (128 * D / 8); ((u32x4*)(F.ws + WS_WIN + l * SZ_WIN + (size_t)NIN * D * 2))[r] = (u32x4){0u, 0u, 0u, 0u}; }
    for (int i = F.gtid; i < 2 * (128 * S5W / 8); i += F.gsize) { const int l = i / (128 * S5W / 8), r = i % (128 * S5W / 8); ((u32x4*)(F.ws + WS_WGLU + l * SZ_WGLU + (size_t)S5W * S5W * 2))[r] = (u32x4){0u, 0u, 0u, 0u}; }
    float* ssq = (float*)(F.ws + WS_SSQ); bf16* hb = (bf16*)(F.ws + WS_HB);
    for (int m = F.gw; m < M; m += F.ngw) {
        const f32x4* xr = (const f32x4*)(FIN(0) + (size_t)m * D) + F.lane; f32x4* hr = (f32x4*)(F.out + (size_t)m * D) + F.lane; u32x2* br = (u32x2*)(hb + (size_t)m * D) + F.lane; float s = 0.f;
#pragma unroll
        for (int j = 0; j < 4; ++j) { const f32x4 v = xr[64 * j]; hr[64 * j] = v; u32x2 w; w.x = pk_bf16(v[0], v[1]); w.y = pk_bf16(v[2], v[3]); br[64 * j] = w; s += (v[0] * v[0] + v[1] * v[1]) + (v[2] * v[2] + v[3] * v[3]); }
        s = wave_sum(s);
        if (F.lane < 16) ssq[(size_t)m * 16 + F.lane] = F.lane == 0 ? s : 0.f;
    }
    for (int i = F.gtid; i < 2 * 3072; i += F.gsize) { const int l = i / 3072, r = i % 3072, dg = r / 64, p = r % 64;
        const float lr = FIN(10)[i], li = FIN(11)[i], dt = expf(FIN(12)[l * 48 + dg]);
        const float mag = expf(lr * dt), ar = mag * cosf(li * dt), ai = mag * sinf(li * dt);
        const float den = lr * lr + li * li, nr = ar - 1.0f, ni = ai, cr = (nr * lr + ni * li) / den, ci = (ni * lr - nr * li) / den;
        ((f32x2*)(F.ws + WS_S5A))[i] = (f32x2){ar, ai};
        const float m16 = expf(16.0f * lr * dt); ((f32x2*)(F.ws + WS_S5A16))[i] = (f32x2){m16 * cosf(16.0f * li * dt), m16 * sinf(16.0f * li * dt)};
        bf16* bt = (bf16*)(F.ws + WS_S5BT) + ((size_t)(l * 48 + dg) * 2) * 64 * 16; bf16* ct = (bf16*)(F.ws + WS_S5CT) + (size_t)(l * 48 + dg) * 16 * 128;
        for (int c = 0; c < 16; ++c) { const float br = FIN(13)[(size_t)i * 16 + c], bi = FIN(14)[(size_t)i * 16 + c];
            bt[(size_t)p * 16 + c] = f2bf_(cr * br - ci * bi); bt[(size_t)(64 + p) * 16 + c] = f2bf_(cr * bi + ci * br);
            const size_t ci_ = ((size_t)(l * 48 + dg) * 16 + c) * 64 + p;
            ct[(size_t)c * 128 + 2 * p] = f2bf_(FIN(15)[ci_]); ct[(size_t)c * 128 + 2 * p + 1] = f2bf_(-FIN(16)[ci_]); } }
    for (int i = F.gtid; i < 2 * 2 * RGW; i += F.gsize) ((float*)(F.ws + WS_RGSP))[i] = 8.0f * softplus_f(-FIN(9)[i]);
    for (int i = F.gtid; i < 2 * 2 * 2 * 6 * 4096; i += F.gsize) { const int k = i % 64, n = (i / 64) % 64, hd = (i / 4096) % 6, mat = (i / 24576) % 2, ld = i / 49152;
        const float* src = (mat == 0 ? FIN(5) : FIN(7)) + ((size_t)ld * 6 + hd) * 4096; ((bf16*)(F.ws + WS_RGWT))[i] = f2bf_(src[k * 64 + n]); }
    for (int i = F.gtid; i < 2 * L * 64; i += F.gsize) { const int l = i / (L * 64), r = i % (L * 64), pos = r / 64, mm = r % 64;
        const float* w1 = FIN(22) + l * 33 * 64; const float t = (float)pos / (float)(L - 1 > 1 ? L - 1 : 1), w = (6.283185307179586f / (float)L) * (float)pos;
        float acc = FIN(23)[l * 64 + mm] + t * w1[mm];
        for (int q = 0; q < 16; ++q) { const float band = 1e-4f + (float)q * ((15.0f - 1e-4f) / 15.0f), ang = w * band; acc += cosf(ang) * w1[(1 + q) * 64 + mm] - sinf(ang) * w1[(17 + q) * 64 + mm]; }
        ((float*)(F.ws + WS_HID))[i] = sinf(FIN(24)[l * 64 + mm] * acc); }
}
DEVFN void p_hid2(Frame& F, int l) {
    const float* hid1 = (const float*)(F.ws + WS_HID) + (size_t)l * L * 64; float* hid2 = (float*)(F.ws + WS_HID) + (size_t)(2 + l) * L * 64;
    for (int i = F.gtid; i < L * 64; i += F.gsize) { const int pos = i / 64, mm = i % 64; float acc = FIN(26)[l * 64 + mm];
        for (int q = 0; q < 64; ++q) acc += hid1[pos * 64 + q] * FIN(25)[l * 4096 + q * 64 + mm];
        hid2[i] = sinf(FIN(27)[l * 64 + mm] * acc); }
}

constexpr int RING_BYTES_C = 131072;
constexpr int HY_NA = L / 32;
constexpr int HY_TA = HY_NA < 32 ? HY_NA : 32;
constexpr int HY_TB = 32 / HY_TA, HY_NBLK = HY_NA + 2 * (HY_TA - 1), HY_NTILE = (HY_NA / HY_TA) * ((Bn + HY_TB - 1) / HY_TB);
constexpr int HY_CPY = 2 * L * 2 + 64;
constexpr int HY_FI = 0, HY_ZI = 4 * HY_CPY, HY_LDS = HY_ZI + Bn * HY_NBLK * 80;
static_assert(HY_LDS <= RING_BYTES_C, "hyena LDS");
DEVFN void p_hy_filter(Frame& F, int l) {
    const float* hid2 = (const float*)(F.ws + WS_HID) + (size_t)(2 + l) * L * 64; const float* w3 = FIN(28) + (size_t)l * 64 * 512; float* kfbT = (float*)(F.ws + WS_KFB);
    const float maxd = logf(1e-2f) / 0.3f, mind = logf(1e-2f) / 1.5f;
    for (int i = F.gtid; i < L * 512; i += F.gsize) { const int pos = i % L, c2 = i / L, c = c2 % 256; float acc = 0.f;
        for (int q = 0; q < 64; ++q) acc += hid2[pos * 64 + q] * w3[q * 512 + c2];
        const float delta = fabsf(mind + (float)c * ((maxd - mind) / 255.0f)), t = (float)pos / (float)(L - 1 > 1 ? L - 1 : 1);
        kfbT[i] = acc * expf(-t * delta); }
}
DEVFN void p_hy_pre(Frame& F, int l) {
    const bf16* proj = (const bf16*)(F.ws + WS_PROJ); bf16* zT = (bf16*)(F.ws + WS_ZT); const float* cw = FIN(20) + l * 3 * 768; const float* cb = FIN(21) + l * 768;
    for (int i = F.gtid; i < 256 * (M / 32); i += F.gsize) { const int c = i % 256, m0 = (i / 256) * 32, t0 = m0 % L;
        const float w1[3] = {cw[256 + c], cw[768 + 256 + c], cw[1536 + 256 + c]}, wv[3] = {cw[512 + c], cw[768 + 512 + c], cw[1536 + 512 + c]}; const float b1 = cb[256 + c], bv = cb[512 + c];
        float p1 = 0.f, pv = 0.f, c1 = 0.f, cv = 0.f;
        if (t0 > 0) { p1 = bf2f_(proj[(size_t)(m0 - 1) * NINP + 3 * RGW + 256 + c]); pv = bf2f_(proj[(size_t)(m0 - 1) * NINP + 3 * RGW + 512 + c]); }
        c1 = bf2f_(proj[(size_t)m0 * NINP + 3 * RGW + 256 + c]); cv = bf2f_(proj[(size_t)m0 * NINP + 3 * RGW + 512 + c]);
        unsigned pk[16];
#pragma unroll
        for (int j = 0; j < 32; ++j) { float n1 = 0.f, nv = 0.f;
            if (t0 + j + 1 < L) { n1 = bf2f_(proj[(size_t)(m0 + j + 1) * NINP + 3 * RGW + 256 + c]); nv = bf2f_(proj[(size_t)(m0 + j + 1) * NINP + 3 * RGW + 512 + c]); }
            const float zz = (bv + wv[0] * pv + wv[1] * cv + wv[2] * nv) * (b1 + w1[0] * p1 + w1[1] * c1 + w1[2] * n1);
            if (j & 1) pk[j >> 1] = pk_bf16(bf_lo(pk[j >> 1]), zz); else pk[j >> 1] = pk_bf16(zz, 0.f);
            p1 = c1; c1 = n1; pv = cv; cv = nv; }
        u32x4* dst = (u32x4*)(zT + (size_t)c * M + m0);
#pragma unroll
        for (int j = 0; j < 4; ++j) dst[j] = (u32x4){pk[4 * j], pk[4 * j + 1], pk[4 * j + 2], pk[4 * j + 3]}; }
}
DEVFN void hy_channel(Frame& F, int l, int c) {
    const int lane = lane_id(), w = F.wave, tid = F.tid, h = lane >> 5, r = lane & 31;
    LAS unsigned char* FI = F.lds + HY_FI; LAS unsigned char* ZI = F.lds + HY_ZI;
    { LAS float* KX = (LAS float*)ZI; LAS float* WC = KX + 2 * L;
      const float* hid2 = (const float*)(F.ws + WS_HID) + (size_t)(2 + l) * L * 64; const float* w3 = FIN(28) + (size_t)l * 64 * 512; const float bias = FIN(29)[l * HYW + c];
      if (tid < 128) WC[tid] = w3[(tid & 63) * 512 + (tid >> 6) * 256 + c];
      if (tid == 0) KX[0] = 0.f;
      sync_block();
      const float maxd = logf(1e-2f) / 0.3f, mind = logf(1e-2f) / 1.5f, delta = fabsf(mind + (float)c * ((maxd - mind) / 255.0f));
      for (int pos = tid; pos < L; pos += NT) { const f32x4* row = (const f32x4*)(hid2 + (size_t)pos * 64); float kfv = 0.f, kbv = 0.f;
#pragma unroll
          for (int q = 0; q < 16; ++q) { const f32x4 hv = row[q]; const f32x4 wf = *(const LAS f32x4*)(WC + 4 * q), wb = *(const LAS f32x4*)(WC + 64 + 4 * q);
              kfv += (hv[0] * wf[0] + hv[1] * wf[1]) + (hv[2] * wf[2] + hv[3] * wf[3]); kbv += (hv[0] * wb[0] + hv[1] * wb[1]) + (hv[2] * wb[2] + hv[3] * wb[3]); }
          const float dec = expf(-((float)pos / (float)(L - 1 > 1 ? L - 1 : 1)) * delta); kfv *= dec; kbv *= dec;
          if (pos == 0) KX[L] = kfv + kbv + bias; else { KX[L + pos] = kfv; KX[L - pos] = kbv; } }
      sync_block();
      for (int i = tid; i < 4 * L; i += NT) { const int sg = i / L, u = 2 * (i % L); float v[2];
#pragma unroll
          for (int e = 0; e < 2; ++e) { const int ix = 2 * L - (u + e) - sg; v[e] = (ix >= 1 && ix <= 2 * L - 1) ? KX[ix] : 0.f; }
          *(LAS unsigned*)(FI + sg * HY_CPY + u * 2) = pk_bf16(v[0], v[1]); }
      sync_block(); }
    for (int i = tid; i < Bn * HY_NBLK * 5; i += NT) *(LAS u32x4*)(ZI + i * 16) = (u32x4){0u, 0u, 0u, 0u};
    sync_block();
    { const bf16* zT = (const bf16*)(F.ws + WS_ZT) + (size_t)c * M;
      for (int i = tid; i < Bn * HY_NA * 4; i += NT) { const int j = i & 3, a = (i >> 2) % HY_NA, b = (i >> 2) / HY_NA;
          *(LAS u32x4*)(ZI + ((b * HY_NBLK + a + HY_TA - 1) * 80 + 16 * j)) = *(const u32x4*)(zT + (size_t)b * L + 32 * a + 8 * j); } }
    sync_block();
    float* yT = (float*)(F.ws + WS_YT) + (size_t)c * M;
    const int sgm = (4 - (r & 3)) & 3;
    const f32x16 z16 = {0.f, 0.f, 0.f, 0.f, 0.f, 0.f, 0.f, 0.f, 0.f, 0.f, 0.f, 0.f, 0.f, 0.f, 0.f, 0.f};
    for (int tl = w; tl < HY_NTILE; tl += NWAVES) { const int aq = tl % (HY_NA / HY_TA), bq = tl / (HY_NA / HY_TA);
        const int a = aq * HY_TA + (r % HY_TA), bb = bq * HY_TB + r / HY_TA; const bool bok = bb < Bn;
        const int dlo = aq * HY_TA - (HY_NA - 1), dhi = aq * HY_TA + HY_TA - 1;
        f32x16 acc = z16; OPAQUE16(acc);
        int fa = sgm * HY_CPY + 2 * ((8 * h - r - 32 * dlo) - sgm + L);
        int za = bok ? ((bb * HY_NBLK + a - dlo + HY_TA - 1) * 80 + 16 * h) : 0;
        typedef unsigned long long u64x2 __attribute__((ext_vector_type(2)));
        u64x2 av[2]; bf16x8 bv[2];
#define HY_LOAD(av_, bv_) do { _Pragma("unroll") for (int ks = 0; ks < 2; ++ks) { av_[ks].x = *(const LAS unsigned long long*)(FI + fa + 32 * ks); av_[ks].y = *(const LAS unsigned long long*)(FI + fa + 32 * ks + 8); \
            bv_[ks] = *(const LAS bf16x8*)(ZI + za + 32 * ks); } fa -= 64; if (bok) za -= 80; } while (0)
        HY_LOAD(av, bv);
        for (int d = dlo; d <= dhi; ++d) { u64x2 an[2]; bf16x8 bn[2];
            if (d < dhi) HY_LOAD(an, bn); else { an[0] = av[0]; an[1] = av[1]; bn[0] = bv[0]; bn[1] = bv[1]; }
            { bf16x8 a0 = __builtin_bit_cast(bf16x8, av[0]), a1 = __builtin_bit_cast(bf16x8, av[1]), b0 = bv[0], b1 = bv[1]; FRESH(a0); FRESH(a1); FRESH(b0); FRESH(b1);
              acc = mfma32(a0, b0, acc); acc = mfma32(a1, b1, acc); }
            av[0] = an[0]; av[1] = an[1]; bv[0] = bn[0]; bv[1] = bn[1]; }
#undef HY_LOAD
        if (bok) {
#pragma unroll
            for (int q = 0; q < 4; ++q) *(f32x4*)(yT + (size_t)bb * L + 32 * a + 8 * q + 4 * h) = (f32x4){acc[4 * q], acc[4 * q + 1], acc[4 * q + 2], acc[4 * q + 3]}; } }
    sync_block();
}
DEVFN void p_hy_main(Frame& F, int l) { for (int c = blockIdx.x; c < HYW; c += F.G) hy_channel(F, l, c); }
DEVFN void p_hy_post(Frame& F, int l) {
    const bf16* proj = (const bf16*)(F.ws + WS_PROJ); const float* yT = (const float*)(F.ws + WS_YT); bf16* ymix = (bf16*)(F.ws + WS_YMIX); const float* cw = FIN(20) + l * 3 * 768; const float* cb = FIN(21) + l * 768;
    for (int i = F.gtid; i < 256 * (M / 32); i += F.gsize) { const int c = i % 256, m0 = (i / 256) * 32, t0 = m0 % L;
        const float w0[3] = {cw[c], cw[768 + c], cw[1536 + c]}; const float b0 = cb[c];
        float p0 = 0.f, c0 = bf2f_(proj[(size_t)m0 * NINP + 3 * RGW + c]); if (t0 > 0) p0 = bf2f_(proj[(size_t)(m0 - 1) * NINP + 3 * RGW + c]);
        const f32x4* ys = (const f32x4*)(yT + (size_t)c * M + m0);
#pragma unroll
        for (int j4 = 0; j4 < 8; ++j4) { const f32x4 y = ys[j4];
#pragma unroll
            for (int e = 0; e < 4; ++e) { const int j = 4 * j4 + e; float n0 = 0.f; if (t0 + j + 1 < L) n0 = bf2f_(proj[(size_t)(m0 + j + 1) * NINP + 3 * RGW + c]);
                ymix[(size_t)(m0 + j) * D + RGW + S5W + c] = f2bf_(y[e] * (b0 + w0[0] * p0 + w0[1] * c0 + w0[2] * n0)); p0 = c0; c0 = n0; } } }
}
constexpr int NG16 = L / 16, NT32 = M / 32, CARRY_B = NG16 < 16 ? NG16 : 16;
DEVFN int tau32(int rho) { return 16 * ((rho >> 2) & 1) + (rho & 3) + 4 * (rho >> 3); }
DEVFN bf16x8 pack8(const f32x4 a, const f32x4 b) { u32x4 w; w.x = pk_bf16(a[0], a[1]); w.y = pk_bf16(a[2], a[3]); w.z = pk_bf16(b[0], b[1]); w.w = pk_bf16(b[2], b[3]); return __builtin_bit_cast(bf16x8, w); }
DEVFN void rg_item(Frame& F, int l, int tile, int hd, const bool stage3) {
    const int lane = lane_id(), hh = lane >> 5, pl = lane & 31, m0 = tile * 32, b = m0 / L, t0 = m0 % L, grp = t0 / 16 + hh;
    const bf16* proj = (const bf16*)(F.ws + WS_PROJ); const float* cw = FIN(3) + l * 4 * RGW; const float* cb = FIN(4) + l * RGW;
    const f32x16 z16 = {0.f, 0.f, 0.f, 0.f, 0.f, 0.f, 0.f, 0.f, 0.f, 0.f, 0.f, 0.f, 0.f, 0.f, 0.f, 0.f};
    const int tt = t0 + tau32(pl); bf16x8 uf[4];
#pragma unroll
    for (int ks = 0; ks < 4; ++ks) { const int c0 = 64 * hd + 16 * ks + 8 * hh; f32x4 s0 = *(const f32x4*)(cb + c0), s1 = *(const f32x4*)(cb + c0 + 4);
#pragma unroll
        for (int k = 0; k < 4; ++k) { const int tk = tt + k - 1; const bool ok = (tk >= 0) && (tk < L);
            u32x4 x = {0u, 0u, 0u, 0u}; if (ok) x = *(const u32x4*)(proj + (size_t)(b * L + tk) * NINP + c0);
            const f32x4 w0 = *(const f32x4*)(cw + k * RGW + c0), w1 = *(const f32x4*)(cw + k * RGW + c0 + 4);
            s0 += w0 * (f32x4){bf_lo(x.x), bf_hi(x.x), bf_lo(x.y), bf_hi(x.y)}; s1 += w1 * (f32x4){bf_lo(x.z), bf_hi(x.z), bf_lo(x.w), bf_hi(x.w)}; }
        uf[ks] = pack8(s0, s1); }
    FRESH(uf[0]); FRESH(uf[1]); FRESH(uf[2]); FRESH(uf[3]);
    const bf16* WT = (const bf16*)(F.ws + WS_RGWT); f32x2* AG = (f32x2*)(F.ws + WS_RGAG); const int pl_o = pl, hh_o = hh;
#pragma unroll 1
    for (int nt = 0; nt < 2; ++nt) { int pl_ = pl_o, hh_ = hh_o; OPAQUE_V(pl_); OPAQUE_V(hh_); const int pl = pl_, hh = hh_;
        const int c = 64 * hd + 32 * nt + pl;
        f32x16 uacc; { f32x16 zz = z16; OPAQUE16(zz); uacc = zz; }
        { bf16x8 idf[2];
#pragma unroll
          for (int q = 0; q < 2; ++q) { const int kk = pl - 16 * q - 8 * hh; u32x4 w;
              w.x = (kk >> 1) == 0 ? ((kk & 1) ? 0x3F800000u : 0x3F80u) : 0u; w.y = (kk >> 1) == 1 ? ((kk & 1) ? 0x3F800000u : 0x3F80u) : 0u;
              w.z = (kk >> 1) == 2 ? ((kk & 1) ? 0x3F800000u : 0x3F80u) : 0u; w.w = (kk >> 1) == 3 ? ((kk & 1) ? 0x3F800000u : 0x3F80u) : 0u;
              if (kk < 0 || kk > 7) w = (u32x4){0u, 0u, 0u, 0u};
              idf[q] = __builtin_bit_cast(bf16x8, w); }
          FRESH(idf[0]); FRESH(idf[1]);
          if (nt == 0) { uacc = mfma32(uf[0], idf[0], uacc); uacc = mfma32(uf[1], idf[1], uacc); MFMA_GUARD(ACC1(uacc), KV(uf[0]), KV(uf[1]), KV(idf[0]), KV(idf[1])); }
          else { uacc = mfma32(uf[2], idf[0], uacc); uacc = mfma32(uf[3], idf[1], uacc); MFMA_GUARD(ACC1(uacc), KV(uf[2]), KV(uf[3]), KV(idf[0]), KV(idf[1])); } }
        f32x16 hs = z16;
#pragma unroll
        for (int d = 0; d < 2; ++d) {
            f32x16 ga, gx; { f32x16 zz = z16; OPAQUE16(zz); ga = zz; f32x16 z2 = z16; OPAQUE16(z2); gx = z2; }
            bf16x8 wa[4], wx[4];
#pragma unroll
            for (int ks = 0; ks < 4; ++ks) { const size_t o = ((((size_t)(l * 2 + d) * 2) * 6 + hd) * 64 + 32 * nt + pl) * 64 + 16 * ks + 8 * hh;
                wa[ks] = *(const bf16x8*)(WT + o); wx[ks] = *(const bf16x8*)(WT + o + (size_t)6 * 4096); }
#pragma unroll
            for (int ks = 0; ks < 4; ++ks) { FRESH(wa[ks]); FRESH(wx[ks]); }
#pragma unroll
            for (int ks = 0; ks < 4; ++ks) { ga = mfma32(uf[ks], wa[ks], ga); gx = mfma32(uf[ks], wx[ks], gx); }
            MFMA_GUARD(ACC2(ga, gx), KV(uf[0]), KV(uf[1]), KV(uf[2]), KV(uf[3]), KV(wa[0]), KV(wa[1]), KV(wa[2]), KV(wa[3]), KV(wx[0]), KV(wx[1]), KV(wx[2]), KV(wx[3]));
            const float bav = FIN(6)[l * 2 * RGW + d * RGW + c], bxv = FIN(8)[l * 2 * RGW + d * RGW + c], sp8 = ((const float*)(F.ws + WS_RGSP))[l * 2 * RGW + d * RGW + c];
#pragma unroll
            for (int reg = 0; reg < 16; ++reg) { const float r = sigmoid_f(ga[reg] + bav), ig = sigmoid_f(gx[reg] + bxv), la = -r * sp8;
                ga[reg] = exp_f(la); gx[reg] = sqrtf(-expm1_f(2.0f * la)) * (ig * uacc[reg]); }
            const size_t aidx = (((size_t)b * NG16 + grp) * 2 + d) * RGW + c;
            if (!stage3) { float P = 1.f, H = 0.f;
#pragma unroll
                for (int q = 0; q < 16; ++q) { const int reg = d == 0 ? q : 15 - q; H = ga[reg] * H + gx[reg]; P *= ga[reg]; }
                AG[aidx] = (f32x2){P, H}; }
            else { float h = ((const float*)(F.ws + WS_RGCI))[aidx];
#pragma unroll
                for (int q = 0; q < 16; ++q) { const int reg = d == 0 ? q : 15 - q; h = ga[reg] * h + gx[reg]; hs[reg] += h; } } }
        if (stage3) { bf16* ymix = (bf16*)(F.ws + WS_YMIX);
#pragma unroll
            for (int reg = 0; reg < 16; ++reg) { const size_t m = (size_t)(m0 + 16 * hh + reg); ymix[m * D + c] = f2bf_(hs[reg] * gelu_f(bf2f_(proj[m * NINP + RGW + c]))); } } }
}
DEVFN void p_rg_stage(Frame& F, int l, const bool stage3) { for (int it = F.gw; it < NT32 * 6; it += F.ngw) rg_item(F, l, it / 6, it % 6, stage3); }
DEVFN void p_rg_carry(Frame& F) {
    const f32x2* __restrict__ AG = (const f32x2*)(F.ws + WS_RGAG); float* __restrict__ CI = (float*)(F.ws + WS_RGCI);
    for (int i = F.gtid; i < Bn * 2 * RGW; i += F.gsize) { const int c = i % RGW, d = (i / RGW) % 2, b = i / (2 * RGW); float H = 0.f;
#pragma unroll 1
        for (int q0 = 0; q0 < NG16; q0 += CARRY_B) { f32x2 sv[CARRY_B];
#pragma unroll
            for (int e = 0; e < CARRY_B; ++e) { const int q = q0 + e, j = d == 0 ? q : NG16 - 1 - q; sv[e] = AG[(((size_t)b * NG16 + j) * 2 + d) * RGW + c]; }
#pragma unroll
            for (int e = 0; e < CARRY_B; ++e) { const int q = q0 + e, j = d == 0 ? q : NG16 - 1 - q; CI[(((size_t)b * NG16 + j) * 2 + d) * RGW + c] = H; H = sv[e][0] * H + sv[e][1]; } } }
}
constexpr int S5_HS = 272  , S5_YS = 784  ;
DEVFN void s5_tile(Frame& F, int l, int tile, const bool stage3) {
    const int lane = lane_id(), w = F.wave, hh = lane >> 5, pl = lane & 31, m0 = tile * 32, b = m0 / L, grp = (m0 % L) / 16 + hh;
    const bf16* proj = (const bf16*)(F.ws + WS_PROJ); const bf16* BT = (const bf16*)(F.ws + WS_S5BT); const bf16* CT = (const bf16*)(F.ws + WS_S5CT);
    const f32x2* SA = (const f32x2*)(F.ws + WS_S5A); f32x2* SS = (f32x2*)(F.ws + WS_S5S);
    LAS unsigned char* Hw = F.lds + w * (32 * S5_HS); LAS unsigned char* YT = F.lds + 8 * 32 * S5_HS;
    const f32x16 z16 = {0.f, 0.f, 0.f, 0.f, 0.f, 0.f, 0.f, 0.f, 0.f, 0.f, 0.f, 0.f, 0.f, 0.f, 0.f, 0.f};
#pragma unroll 1
    for (int gi = 0; gi < 3; ++gi) { const int g = w + 8 * gi;
        const bf16x8 ua = *(const bf16x8*)(proj + (size_t)(m0 + tau32(pl)) * NINP + 2 * RGW + 16 * g + 8 * hh);
        f32x4 yacc[2] = {(f32x4){0.f, 0.f, 0.f, 0.f}, (f32x4){0.f, 0.f, 0.f, 0.f}};
#pragma unroll
        for (int d = 0; d < 2; ++d) { const size_t dg = (size_t)(l * 2 + d) * 24 + g;
            f32x16 acc[2][2];
            bf16x8 bb[2][2];
#pragma unroll
            for (int ri = 0; ri < 2; ++ri)
#pragma unroll
                for (int ph = 0; ph < 2; ++ph) bb[ri][ph] = *(const bf16x8*)(BT + ((dg * 2 + ri) * 64 + 32 * ph + pl) * 16 + 8 * hh);
            { bf16x8 ub = ua; FRESH(ub); FRESH(bb[0][0]); FRESH(bb[0][1]); FRESH(bb[1][0]); FRESH(bb[1][1]);
#pragma unroll
            for (int ri = 0; ri < 2; ++ri)
#pragma unroll
                for (int ph = 0; ph < 2; ++ph) { f32x16 zz = z16; OPAQUE16(zz); acc[ri][ph] = mfma32(ub, bb[ri][ph], zz); }
            MFMA_GUARD(ACC4(acc[0][0], acc[0][1], acc[1][0], acc[1][1]), KV(ub), KV(bb[0][0]), KV(bb[0][1]), KV(bb[1][0]), KV(bb[1][1])); }
#pragma unroll
            for (int ph = 0; ph < 2; ++ph) { const f32x2 A = SA[dg * 64 + 32 * ph + pl]; const size_t sidx = (((size_t)b * NG16 + grp) * 2 + d) * 1536 + g * 64 + 32 * ph + pl;
                float hr = 0.f, hi = 0.f; if (stage3) { const f32x2 c = ((const f32x2*)(F.ws + WS_S5CI))[sidx]; hr = c[0]; hi = c[1]; }
#pragma unroll
                for (int q = 0; q < 16; ++q) { const int reg = d == 0 ? q : 15 - q; const float nr = A[0] * hr - A[1] * hi + acc[0][ph][reg], ni = A[0] * hi + A[1] * hr + acc[1][ph][reg];
                    hr = nr; hi = ni; acc[0][ph][reg] = nr; acc[1][ph][reg] = ni; }
                if (!stage3) SS[sidx] = (f32x2){hr, hi};
                else {
#pragma unroll
                    for (int reg = 0; reg < 16; ++reg) *(LAS unsigned*)(Hw + (16 * hh + reg) * S5_HS + 4 * (32 * ph + pl)) = pk_bf16(acc[0][ph][reg], acc[1][ph][reg]); } }
            if (stage3) { WAVE_LDS_FENCE();
#pragma unroll
                for (int rt = 0; rt < 2; ++rt) { bf16x8 a2[4], b2[4];
#pragma unroll
                    for (int ks = 0; ks < 4; ++ks) { a2[ks] = *(const LAS bf16x8*)(Hw + (16 * rt + (lane & 15)) * S5_HS + (32 * ks + 8 * (lane >> 4)) * 2);
                        b2[ks] = *(const bf16x8*)(CT + (dg * 16 + (lane & 15)) * 128 + 32 * ks + 8 * (lane >> 4)); }
                    FRESH(b2[0]); FRESH(b2[1]); FRESH(b2[2]); FRESH(b2[3]); FRESH(a2[0]); FRESH(a2[1]); FRESH(a2[2]); FRESH(a2[3]);
#pragma unroll
                    for (int ks = 0; ks < 4; ++ks) yacc[rt] = mfma16(a2[ks], b2[ks], yacc[rt]);
                    MFMA_GUARD(ACC1(yacc[rt]), KV(a2[0]), KV(a2[1]), KV(a2[2]), KV(a2[3]), KV(b2[0]), KV(b2[1]), KV(b2[2]), KV(b2[3])); }
                WAVE_LDS_FENCE(); } }
        if (stage3) { const int c = lane & 15; const float dsk = FIN(17)[l * S5W + 16 * g + c];
#pragma unroll
            for (int rt = 0; rt < 2; ++rt)
#pragma unroll
                for (int reg = 0; reg < 4; ++reg) { const int t = 16 * rt + 4 * (lane >> 4) + reg; const float u = bf2f_(proj[(size_t)(m0 + t) * NINP + 2 * RGW + 16 * g + c]);
                    *(LAS bf16*)(YT + t * S5_YS + (16 * g + c) * 2) = f2bf_(gelu_f(yacc[rt][reg] + dsk * u)); } } }
    if (stage3) { sync_block();
        if (w < 4) {
            const bf16* WG = (const bf16*)(F.ws + WS_WGLU + l * SZ_WGLU); bf16* ymix = (bf16*)(F.ws + WS_YMIX);
            f32x16 ga[3] = {z16, z16, z16};
#pragma unroll 2
            for (int ks = 0; ks < 24; ++ks) { const bf16x8 a = *(const LAS bf16x8*)(YT + pl * S5_YS + (16 * ks + 8 * hh) * 2); bf16x8 bq[3];
#pragma unroll
                for (int j = 0; j < 3; ++j) bq[j] = *(const bf16x8*)(WG + (size_t)(32 * (w + 4 * j) + pl) * S5W + 16 * ks + 8 * hh);
                FRESH(bq[0]); FRESH(bq[1]); FRESH(bq[2]); bf16x8 aq = a; FRESH(aq);
#pragma unroll
                for (int j = 0; j < 3; ++j) ga[j] = mfma32(aq, bq[j], ga[j]);
                MFMA_GUARD(ACC3(ga[0], ga[1], ga[2]), KV(aq), KV(bq[0]), KV(bq[1]), KV(bq[2])); }
#pragma unroll
            for (int j = 0; j < 3; ++j) { const int n = 32 * (w + 4 * j) + pl; const float bias = FIN(19)[l * S5W + n];
#pragma unroll
                for (int reg = 0; reg < 16; ++reg) { const int t = (reg & 3) + 8 * (reg >> 2) + 4 * hh; const float y = bf2f_(*(const LAS bf16*)(YT + t * S5_YS + n * 2));
                    ymix[(size_t)(m0 + t) * D + RGW + n] = f2bf_(y * sigmoid_f(ga[j][reg] + bias)); } } }
        sync_block(); }
}
DEVFN void p_s5_stage(Frame& F, int l, const bool stage3) { for (int tile = blockIdx.x; tile < NT32; tile += F.G) s5_tile(F, l, tile, stage3); }
DEVFN void p_s5_carry(Frame& F, int l) {
    const f32x2* __restrict__ SS = (const f32x2*)(F.ws + WS_S5S); f32x2* __restrict__ CI = (f32x2*)(F.ws + WS_S5CI); const f32x2* A16 = (const f32x2*)(F.ws + WS_S5A16);
    for (int i = F.gtid; i < Bn * 2 * 1536; i += F.gsize) { const int gp = i % 1536, d = (i / 1536) % 2, b = i / 3072; const f32x2 A = A16[(size_t)(l * 2 + d) * 1536 + gp];
        float cr = 0.f, ci = 0.f;
#pragma unroll 1
        for (int q0 = 0; q0 < NG16; q0 += CARRY_B) { f32x2 sv[CARRY_B];
#pragma unroll
            for (int e = 0; e < CARRY_B; ++e) { const int q = q0 + e, j = d == 0 ? q : NG16 - 1 - q; sv[e] = SS[(((size_t)b * NG16 + j) * 2 + d) * 1536 + gp]; }
#pragma unroll
            for (int e = 0; e < CARRY_B; ++e) { const int q = q0 + e, j = d == 0 ? q : NG16 - 1 - q; CI[(((size_t)b * NG16 + j) * 2 + d) * 1536 + gp] = (f32x2){cr, ci};
                const float nr = A[0] * cr - A[1] * ci + sv[e][0], ni = A[0] * ci + A[1] * cr + sv[e][1]; cr = nr; ci = ni; } } }
}
DEVFN void row_ssq3(const u32x4 x0, const u32x4 x1, int lane, float& sa, float& sb, float& sc) {
    float s0, s1;
    { const float a0 = bf_lo(x0.x), a1 = bf_hi(x0.x), a2 = bf_lo(x0.y), a3 = bf_hi(x0.y), a4 = bf_lo(x0.z), a5 = bf_hi(x0.z), a6 = bf_lo(x0.w), a7 = bf_hi(x0.w); s0 = ((a0 * a0 + a1 * a1) + (a2 * a2 + a3 * a3)) + ((a4 * a4 + a5 * a5) + (a6 * a6 + a7 * a7)); }
    { const float a0 = bf_lo(x1.x), a1 = bf_hi(x1.x), a2 = bf_lo(x1.y), a3 = bf_hi(x1.y), a4 = bf_lo(x1.z), a5 = bf_hi(x1.z), a6 = bf_lo(x1.w), a7 = bf_hi(x1.w); s1 = ((a0 * a0 + a1 * a1) + (a2 * a2 + a3 * a3)) + ((a4 * a4 + a5 * a5) + (a6 * a6 + a7 * a7)); }
    sa = lane < 48 ? s0 : 0.f; sb = (lane >= 48 ? s0 : 0.f) + (lane < 32 ? s1 : 0.f); sc = lane >= 32 ? s1 : 0.f;
}
DEVFN void mix_scales(Frame& F, int pm, LAS unsigned char* xl) {
    const bf16* ymix = (const bf16*)(F.ws + WS_YMIX); LAS float* TS = (LAS float*)xl; const int lane = F.lane;
#pragma unroll 1
    for (int r0 = 0; r0 < 32; r0 += 2) {
        const u32x4* rowA = (const u32x4*)(ymix + (size_t)(pm * 256 + F.wave * 32 + r0) * D); const u32x4* rowB = rowA + D / 8;
        const u32x4 a0 = rowA[lane], a1 = rowA[lane + 64], b0 = rowB[lane], b1 = rowB[lane + 64];
        float sa0, sb0, sc0, sa1, sb1, sc1; row_ssq3(a0, a1, lane, sa0, sb0, sc0); row_ssq3(b0, b1, lane, sa1, sb1, sc1);
        sa0 = wave_sum(sa0); sb0 = wave_sum(sb0); sc0 = wave_sum(sc0); sa1 = wave_sum(sa1); sb1 = wave_sum(sb1); sc1 = wave_sum(sc1);
        if (lane < 2) { const float a_ = lane ? sa1 : sa0, b_ = lane ? sb1 : sb0, c_ = lane ? sc1 : sc0;
            const float ia = 1.0f / sqrtf(a_ * (1.0f / RGW) + 1e-6f), ib = 1.0f / sqrtf(b_ * (1.0f / S5W) + 1e-6f), ic = 1.0f / sqrtf(c_ * (1.0f / HYW) + 1e-6f);
            *(LAS f32x4*)(TS + (F.wave * 32 + r0 + lane) * 4) = (f32x4){ia / ib, ib / ic, ic, 0.f}; } }
    sync_block();
}
DEVFN void p_final(Frame& F) {
    const float* ssq = (const float*)(F.ws + WS_SSQ); const f32x4* g4 = (const f32x4*)FIN(37) + F.lane;
    for (int m = F.gw; m < M; m += F.ngw) { const float inv = pg8::row_inv(ssq, m); f32x4* hr = (f32x4*)(F.out + (size_t)m * D) + F.lane;
#pragma unroll
        for (int j = 0; j < 4; ++j) hr[64 * j] = hr[64 * j] * inv * g4[64 * j]; }
}

constexpr int PH_PER_LAYER = 7, N_PHASES = 2 + 2 * PH_PER_LAYER;
__global__ void __launch_bounds__(NT, 2) mk_fwd(Args args) {
#ifdef CPU_EMU
    unsigned char* lds = emu_lds_base();
#else
    extern __shared__ __attribute__((aligned(16))) unsigned char lds_[];
    LAS unsigned char* lds = (LAS unsigned char*)lds_;
#endif
    Frame F; F.lds = lds; F.tid = threadIdx.x; F.lane = F.tid & 63;
#ifdef CPU_EMU
    F.wave = F.tid >> 6;
#else
    F.wave = __builtin_amdgcn_readfirstlane(F.tid >> 6);
#endif
    F.G = gridDim.x; F.gtid = blockIdx.x * NT + F.tid; F.gsize = F.G * NT; F.gw = blockIdx.x * NWAVES + F.wave; F.ngw = F.G * NWAVES;
    #ifdef CPU_EMU
    F.ap = &args;
#else
    F.ap = (KARG_PTR)__builtin_amdgcn_kernarg_segment_ptr();
#endif
    F.out = args.out; F.ws = args.ws;
#ifndef CPU_EMU
    volatile LAS unsigned* MISC = (volatile LAS unsigned*)(lds + MISC_OFF);
    if (F.tid < 32) MISC[F.tid] = 0u;
    __syncthreads();
    XcdBarrier bar = xcd_barrier_post((unsigned*)(args.ws + WS_CTL) + CW_BAR, MISC + 8);
#define GRID_BAR() do { xcd_barrier(bar); __builtin_amdgcn_fence(__ATOMIC_ACQUIRE, "agent"); asm volatile("s_waitcnt vmcnt(0)" ::: "memory"); } while (0)
#else
#define GRID_BAR() do {} while (0)
#endif
    const int lo = args.ph_lo, hi = args.ph_hi;
#define IN(k) (lo <= (k) && (k) < hi)
#define SEAM(k) do { if (IN(k) && IN((k) + 1)) GRID_BAR(); } while (0)
#define P_SSQ ((float*)(F.ws + WS_SSQ))
#define P_HB ((bf16*)(F.ws + WS_HB))
#define P_PROJ ((bf16*)(F.ws + WS_PROJ))
#define P_YMIX ((bf16*)(F.ws + WS_YMIX))
#define P_G ((bf16*)(F.ws + WS_G))
    { int l0 = 0; if (IN(0)) { LAUNDER(F, l0); p_prologue(F); } }
    SEAM(0);
    for (int lq = 0; lq < 2; ++lq) {
        int l = lq; const int p0 = 1 + lq * PH_PER_LAYER;
        if (IN(p0 + 0)) { LAUNDER(F, l); p_hid2(F, l);
            pg8::Gemm g{P_HB, (const bf16*)(F.ws + WS_WIN + l * SZ_WIN), D}; pg8::StaticOrder S; S.init(M / 256, NINP / 256, F.G, (int)blockIdx.x);
            pg8::EpiIn E{P_PROJ, P_SSQ};
            pg8::gemm_phase<pg8::EpiIn, pg8::StaticOrder, true, true>(lds, F.tid, g, S, E); }
        SEAM(p0 + 0);
        if (IN(p0 + 1)) { LAUNDER(F, l); p_hy_pre(F, l); p_rg_stage(F, l, false); p_s5_stage(F, l, false); }
        SEAM(p0 + 1);
        if (IN(p0 + 2)) { LAUNDER(F, l); p_s5_carry(F, l); p_rg_carry(F); p_hy_main(F, l); }
        SEAM(p0 + 2);
        if (IN(p0 + 3)) { LAUNDER(F, l); p_hy_post(F, l); p_rg_stage(F, l, true); p_s5_stage(F, l, true); }
        SEAM(p0 + 3);
        if (IN(p0 + 4)) { LAUNDER(F, l); pg8::Gemm g{P_YMIX, (const bf16*)(F.ws + WS_WOUT + l * SZ_WOUT), D}; pg8::StaticOrder S; S.init(M / 256, D / 256, F.G, (int)blockIdx.x);
            pg8::Unit u0; if (S.next(0, u0)) mix_scales(F, u0.pm, lds + pg8::STAGE_BYTES); else sync_block();
            pg8::EpiResMix E{F.out, P_HB, P_SSQ};
            pg8::gemm_phase<pg8::EpiResMix, pg8::StaticOrder, true, true>(lds, F.tid, g, S, E); }
        SEAM(p0 + 4);
        if (IN(p0 + 5)) { LAUNDER(F, l); pg8::Gemm g{P_HB, (const bf16*)(F.ws + WS_WUP + l * SZ_WUP), D}; pg8::UpOrder S; S.init(Bn * NQ, FF2 / 256, F.G, (int)blockIdx.x);
            pg8::EpiUp E{P_G, P_SSQ, FIN(34) + (size_t)l * 3 * FF2, FIN(35) + (size_t)l * FF2};
            pg8::gemm_phase<pg8::EpiUp, pg8::UpOrder, true, true>(lds, F.tid, g, S, E); }
        SEAM(p0 + 5);
        if (IN(p0 + 6)) { LAUNDER(F, l); pg8::Gemm g{P_G, (const bf16*)(F.ws + WS_WDN + l * SZ_WDN), FF}; pg8::StaticOrder S; S.init(M / 256, D / 256, F.G, (int)blockIdx.x);
            pg8::EpiRes E{F.out, P_HB, P_SSQ};
            pg8::gemm_phase<pg8::EpiRes, pg8::StaticOrder, true, true>(lds, F.tid, g, S, E); }
        SEAM(p0 + 6);
    }
    { int l0 = 0; if (IN(N_PHASES - 1)) { LAUNDER(F, l0); p_final(F); } }
#undef IN
#undef SEAM
}

#ifndef MK_N_LAUNCHES
#define MK_N_LAUNCHES 1
#endif
extern "C" void kernel_launch(void* const* d_in, const int* in_sizes, int n_in, void* d_out, int out_size, void* d_ws, size_t ws_size, hipStream_t stream) {
    Args a{};
    for (int i = 0; i < 38; ++i) a.in[i] = (const float*)d_in[i];
    a.out = (float*)d_out; a.ws = (unsigned char*)d_ws;
#ifdef CPU_EMU
    const int grid = EMU_GRID;
    for (int ph = 0; ph < N_PHASES; ++ph) { a.ph_lo = ph; a.ph_hi = ph + 1; LAUNCH(mk_fwd, dim3(grid), dim3(NT), LDS_BYTES, stream, a); emu_phase_hook(ph, a); }
#else
    static int grid = 0;
    if (grid == 0) {
        if (n_in != 38 || out_size != M * D || ws_size < WS_END) { fprintf(stderr, "kernel_launch: unexpected shapes (n_in %d out %d ws %zu need %zu)\n", n_in, out_size, ws_size, (size_t)WS_END); grid = -1; return; }
        int dev = 0, cus = 0, per_cu = 0;
        if (hipGetDevice(&dev) != hipSuccess || hipDeviceGetAttribute(&cus, hipDeviceAttributeMultiprocessorCount, dev) != hipSuccess) { grid = -1; return; }
        if (hipFuncSetAttribute((const void*)mk_fwd, hipFuncAttributeMaxDynamicSharedMemorySize, LDS_BYTES) != hipSuccess) { fprintf(stderr, "kernel_launch: hipFuncSetAttribute failed\n"); grid = -1; return; }
        if (hipOccupancyMaxActiveBlocksPerMultiprocessor(&per_cu, (const void*)mk_fwd, NT, LDS_BYTES) != hipSuccess || per_cu < 1) { fprintf(stderr, "kernel_launch: occupancy query says %d\n", per_cu); (void)hipGetLastError(); per_cu = 1; }
        grid = cus;
    }
    if (grid < 0) return;
    (void)hipMemsetAsync((char*)d_ws + WS_CTL, 0, CTL_BYTES, stream);
#if MK_N_LAUNCHES == 1
    a.ph_lo = 0; a.ph_hi = N_PHASES;
    hipLaunchKernelGGL(mk_fwd, dim3(grid), dim3(NT), LDS_BYTES, stream, a);
#else
    for (int ph = 0; ph < N_PHASES; ++ph) { a.ph_lo = ph; a.ph_hi = ph + 1; hipLaunchKernelGGL(mk_fwd, dim3(grid), dim3(NT), LDS_BYTES, stream, a); }
#endif
#endif
}
```

```cpp
#ifdef CPU_EMU
#include "emu.h"
#define LAS
#define GAS
#define DEVFN static inline
#define MEMFN inline
#define WAVE_LDS_FENCE() emu::wave_sync()
#define OPAQUE16(x) do {} while (0)
#define OPAQUE_V(x) do {} while (0)
#define OPAQUE_S(x) do {} while (0)
#define FRESH(x) do {} while (0)
#define MFMA_GUARD(...) do {} while (0)
#define KV(x) 0
#define ACC1(a) 0
#define ACC2(a, b) 0
#define ACC3(a, b, c) 0
#define ACC4(a, b, c, d) 0
#else
#include <hip/hip_runtime.h>
#include <cstdio>
#include <cstdint>
#define LAS __attribute__((address_space(3)))
#define GAS __attribute__((address_space(1)))
#define DEVFN __device__ __forceinline__
#define MEMFN __device__ __forceinline__
#define WAVE_LDS_FENCE() do { asm volatile("s_waitcnt lgkmcnt(0)" ::: "memory"); } while (0)
#define OPAQUE16(x) asm volatile("" : "+v"(x))
#define OPAQUE_V(x) asm volatile("" : "+v"(x))
#define OPAQUE_S(x) asm volatile("" : "+s"(x))
#define FRESH(x) asm volatile("s_nop 1" : "+v"(x))
#define KV(x) "v"(x)
#define KA(x) "+v"(x)
#define MFMA_GUARD(accs, ...) asm volatile("s_nop 7\n\ts_nop 7\n\ts_nop 7\n\ts_nop 7" : accs : __VA_ARGS__)
#define ACC1(a) KA(a)
#define ACC2(a, b) KA(a), KA(b)
#define ACC3(a, b, c) KA(a), KA(b), KA(c)
#define ACC4(a, b, c, d) KA(a), KA(b), KA(c), KA(d)
typedef short bf16x8 __attribute__((ext_vector_type(8)));
typedef float f32x4 __attribute__((ext_vector_type(4)));
typedef float f32x2 __attribute__((ext_vector_type(2)));
typedef float f32x16 __attribute__((ext_vector_type(16)));
typedef unsigned u32x4 __attribute__((ext_vector_type(4)));
typedef unsigned u32x2 __attribute__((ext_vector_type(2)));
typedef __bf16 bf16x2_t __attribute__((ext_vector_type(2)));
DEVFN void sync_block() { __syncthreads(); }
DEVFN int lane_id() { int l; asm volatile("v_mbcnt_lo_u32_b32 %0, -1, 0\n\tv_mbcnt_hi_u32_b32 %0, -1, %0" : "=v"(l)); return l; }
DEVFN f32x16 mfma32(bf16x8 a, bf16x8 b, f32x16 c) { return __builtin_amdgcn_mfma_f32_32x32x16_bf16(a, b, c, 0, 0, 0); }
DEVFN f32x4 mfma16(bf16x8 a, bf16x8 b, f32x4 c) { return __builtin_amdgcn_mfma_f32_16x16x32_bf16(a, b, c, 0, 0, 0); }
DEVFN float shfl_f32(float v, int src) { return __builtin_bit_cast(float, __builtin_amdgcn_ds_bpermute(src << 2, __builtin_bit_cast(int, v))); }
DEVFN float shfl_xor_f32(float v, int m) { return shfl_f32(v, lane_id() ^ m); }
DEVFN float dpp_row_shr1(float old, float src) { return __builtin_bit_cast(float, __builtin_amdgcn_update_dpp(__builtin_bit_cast(int, old), __builtin_bit_cast(int, src), 0x111, 0xf, 0xf, false)); }
DEVFN float dpp_row_shl1(float old, float src) { return __builtin_bit_cast(float, __builtin_amdgcn_update_dpp(__builtin_bit_cast(int, old), __builtin_bit_cast(int, src), 0x101, 0xf, 0xf, false)); }
DEVFN float dpp_row_ror1(float src) { return __builtin_bit_cast(float, __builtin_amdgcn_update_dpp(0, __builtin_bit_cast(int, src), 0x121, 0xf, 0xf, false)); }
DEVFN float dpp_row_ror15(float src) { return __builtin_bit_cast(float, __builtin_amdgcn_update_dpp(0, __builtin_bit_cast(int, src), 0x12f, 0xf, 0xf, false)); }
DEVFN unsigned pk_bf16(float lo, float hi) { f32x2 v = {lo, hi}; bf16x2_t b = __builtin_convertvector(v, bf16x2_t); return __builtin_bit_cast(unsigned, b); }
DEVFN float bf_lo(unsigned u) { return __builtin_bit_cast(float, u << 16); }
DEVFN float bf_hi(unsigned u) { return __builtin_bit_cast(float, u & 0xffff0000u); }
DEVFN float fast_rcp(float x) { return __builtin_amdgcn_rcpf(x); }
DEVFN float sin_rev(float r) { return __builtin_amdgcn_sinf(r); }
DEVFN float cos_rev(float r) { return __builtin_amdgcn_cosf(r); }
DEVFN float fast_exp2(float x) { return __builtin_amdgcn_exp2f(x); }
DEVFN float fast_sqrt(float x) { return __builtin_amdgcn_sqrtf(x); }
DEVFN float fma_s(float a, float b, float c) { float r; asm("v_fma_f32 %0, %1, %2, %3" : "=v"(r) : "v"(a), "v"(b), "v"(c)); return r; }
DEVFN float fnma_s(float a, float b, float c) { float r; asm("v_fma_f32 %0, -%1, %2, %3" : "=v"(r) : "v"(a), "v"(b), "v"(c)); return r; }
DEVFN unsigned wave_shr1(unsigned v) { return (unsigned)__builtin_amdgcn_update_dpp(0, (int)v, 0x138, 0xf, 0xf, true); }
#endif
#ifdef CPU_EMU
static inline float fast_sqrt(float x) { return sqrtf(x); }
static inline float fma_s(float a, float b, float c) { return a * b + c; }
static inline float fnma_s(float a, float b, float c) { return c - a * b; }
static inline unsigned wave_shr1(unsigned v) { const int l = lane_id(); const unsigned r = shfl_u32(v, l - 1); return l == 0 ? 0u : r; }
#endif

#ifndef BATCH
#define BATCH 4
#endif
#ifndef SEQ
#define SEQ 4096
#endif
typedef unsigned short bf16;
constexpr int Bn = BATCH, L = SEQ, M = Bn * L, D = 1024, NIN = 1920, NINP = 2048, RGW = 384, S5W = 384, HYW = 256, FF = 2816, FF2 = 5632, GLUP = 512;
constexpr int NWAVES = 8, NT = NWAVES * 64;
constexpr int UPS = 254, NQ = (L + UPS - 1) / UPS;

constexpr size_t al256(size_t x) { return (x + 255) & ~(size_t)255; }
constexpr size_t WS_CTL = 0, CTL_BYTES = 1u << 20;
constexpr size_t WS_SSQ = WS_CTL + CTL_BYTES, SZ_SSQ = (size_t)M * 16 * 4;
constexpr size_t WS_S5A = WS_SSQ + SZ_SSQ, SZ_S5A = (size_t)2 * 2 * 24 * 64 * 8;
constexpr size_t WS_S5A16 = WS_S5A + SZ_S5A;
constexpr size_t WS_S5BT = WS_S5A16 + SZ_S5A, SZ_S5BT = (size_t)2 * 2 * 24 * 2 * 64 * 16 * 2;
constexpr size_t WS_S5CT = WS_S5BT + SZ_S5BT, SZ_S5CT = (size_t)2 * 2 * 24 * 16 * 128 * 2;
constexpr size_t WS_RGSP = WS_S5CT + SZ_S5CT, SZ_RGSP = al256((size_t)2 * 2 * 384 * 4);
constexpr size_t WS_RGWT = WS_RGSP + SZ_RGSP, SZ_RGWT = (size_t)2 * 2 * 2 * 6 * 64 * 64 * 2;
constexpr size_t WS_RGAG = WS_RGWT + SZ_RGWT, SZ_RGAG = (size_t)(M / 16) * 2 * RGW * 8;
constexpr size_t WS_RGCI = WS_RGAG + SZ_RGAG, SZ_RGCI = (size_t)(M / 16) * 2 * RGW * 4;
constexpr size_t WS_HID = WS_RGCI + SZ_RGCI, SZ_HID = 0;
constexpr size_t WS_T1 = WS_HID + SZ_HID, SZ_T1 = (size_t)(M / 16) * 2 * 1536 * 8;
constexpr size_t WS_S5S = WS_T1;
constexpr size_t WS_S5CI = WS_T1;
constexpr size_t WS_RGAB0 = WS_T1 + SZ_T1, SZ_RGAB = (size_t)M * RGW * 4;
constexpr size_t WS_KFB = WS_RGAB0 + SZ_RGAB, SZ_KFB = (size_t)2 * 512 * L * 4;
constexpr size_t SZ_WIN = (size_t)NINP * D * 2, SZ_WOUT = (size_t)D * D * 2, SZ_WUP = (size_t)FF2 * D * 2, SZ_WDN = (size_t)D * FF * 2, SZ_WGLU = (size_t)GLUP * S5W * 2;
constexpr size_t WS_WIN = WS_KFB + SZ_KFB, WS_WOUT = WS_WIN + 2 * SZ_WIN, WS_WUP = WS_WOUT + 2 * SZ_WOUT, WS_WDN = WS_WUP + 2 * SZ_WUP, WS_WGLU = WS_WDN + 2 * SZ_WDN;
constexpr size_t WS_HBPAD = WS_WGLU + 2 * SZ_WGLU, HB_FRONT = (size_t)256 * D * 2, WS_HB = WS_HBPAD + HB_FRONT, SZ_HBPAD = (size_t)(M + 768) * D * 2;
constexpr size_t WS_PROJ = WS_HBPAD + SZ_HBPAD, SZ_PROJ = (size_t)M * NINP * 2;
constexpr size_t WS_YMIX = WS_PROJ + SZ_PROJ, SZ_YMIX = (size_t)M * D * 2;
constexpr size_t WS_G = WS_PROJ;
constexpr size_t WS_END = WS_YMIX + SZ_YMIX;
constexpr size_t OUT_ZT = 0, OUT_YT = (size_t)M * 256 * 2, OUT_RGAB1 = (size_t)M * 256 * 6;
static_assert(SZ_PROJ + SZ_YMIX >= (size_t)M * FF * 2, "g overlay");
static_assert((size_t)M * 256 * 6 + SZ_RGAB <= (size_t)M * D * 4, "zT/yT/RG pairs in d_out");
static_assert(SZ_RGAB <= SZ_T1 || true, "");
static_assert(BATCH != 4 || SEQ != 4096 || WS_END <= ((size_t)256 << 20), "workspace over 256 MiB");

DEVFN float gelu_f(float x) { const float y = 1.5957691216057308f * (x + 0.044715f * x * x * x); return x * fast_rcp(1.0f + fast_exp2(-1.4426950408889634f * y)); }
DEVFN float sigmoid_f(float x) { return fast_rcp(1.0f + fast_exp2(-1.4426950408889634f * x)); }
DEVFN float softplus_f(float x) { return x > 0.f ? x + log1pf(expf(-x)) : log1pf(expf(x)); }
DEVFN float exp_f(float x) { return fast_exp2(1.4426950408889634f * x); }
DEVFN float expm1_f(float x) {
    const float p = x * (1.0f + x * (0.5f + x * (0.16666667f + x * (0.041666668f + x * (0.008333334f + x * 0.0013888889f)))));
    return fabsf(x) < 0.25f ? p : exp_f(x) - 1.0f; }
DEVFN float bf2f_(bf16 h) { return bf_lo((unsigned)h); }
DEVFN bf16 f2bf_(float f) { return (bf16)(pk_bf16(f, 0.f) & 0xffffu); }

namespace pg8 {
constexpr int BM = 256, BK = 64, HALF = 128, HTB = HALF * BK * 2, STAGE_BYTES = 8 * HTB, NXCD = 8, WGM = 8;
__host__ __device__ __forceinline__ int lds_byte(int r, int c) { const int st = (r >> 4) * 2 + (c >> 5), rr = r & 15, cc = c & 31, ob = rr * 64 + cc * 2; return st * 1024 + (ob ^ (((ob >> 9) & 1) << 5)); }
__host__ __device__ __forceinline__ void stage_rc(int b, int& R, int& C) { const int st = b / 1024, sb = b % 1024, swz = sb ^ (((sb >> 9) & 1) << 5); R = (st >> 1) * 16 + swz / 64; C = (st & 1) * 32 + (swz % 64) / 2; }
__host__ __device__ __forceinline__ int perm32(int rho) { const int n = rho >> 4, i = rho & 15; return 8 * (i >> 2) + 4 * n + (i & 3); }

struct Unit { int pm, pn; int arow; };
struct Gemm { const bf16* A; const bf16* Bt; int K; };

struct StaticOrder {
    int nM, nN, nwg, G, c;
    __host__ __device__ __forceinline__ void init(int nM_, int nN_, int G_, int c_) { nM = nM_; nN = nN_; nwg = nM * nN; G = G_; c = c_; }
    __host__ __device__ __forceinline__ bool next(int i, Unit& u) const {
        const long Lx = (long)i * G + c; if (Lx >= nwg) return false;
        int wgid = (int)Lx; { const int q = nwg / NXCD, r = nwg % NXCD, xcd = wgid % NXCD, off = wgid / NXCD; wgid = (xcd < r ? xcd * (q + 1) : r * (q + 1) + (xcd - r) * q) + off; }
        const int nig = WGM * nN, gid = wgid / nig, fm = gid * WGM, gsz = (nM - fm) < WGM ? (nM - fm) : WGM;
        u.pm = fm + ((wgid % nig) % gsz); u.pn = (wgid % nig) / gsz; u.arow = u.pm * BM; return true;
    }
};
struct UpOrder : StaticOrder {
    __host__ __device__ __forceinline__ bool next(int i, Unit& u) const { if (!StaticOrder::next(i, u)) return false; const int b = u.pm / NQ, q = u.pm % NQ; u.arow = b * L + UPS * q - 1; return true; }
};

#ifndef CPU_EMU
#define PG8_LAS __attribute__((address_space(3)))
template <class Epi, class Sched, bool ALIGN_EPI = false, bool SP2 = false>
__device__ __forceinline__ void gemm_phase(PG8_LAS unsigned char* lds, const int tid, const Gemm g, const Sched& S, const Epi& E) {
    const int wid = __builtin_amdgcn_readfirstlane(tid >> 6), lane = tid & 63, wr = wid >> 2, wc = wid & 3, fr = lane & 15, fq = lane >> 4;
    const int K = g.K, nt = K / BK;
    unsigned voffA[2], voffB[2];
#pragma unroll
    for (int i = 0; i < 2; ++i) { int R, C; stage_rc(tid * 16 + i * 8192, R, C); const int Rb = Epi::PERM ? ((R & ~31) + perm32(R & 31)) : R;
        const int Ra = Epi::APERM ? ((R & ~63) + 4 * (R & 15) + ((R >> 4) & 3)) : R;
        voffA[i] = (unsigned)(Ra * K + C) * 2u; voffB[i] = (unsigned)(Rb * K + C) * 2u; }
    const size_t kstep = (size_t)(BK * 2);
    const size_t hstep = (size_t)HALF * K * 2;
    const size_t tstep = 2 * hstep;
    const size_t rstep = (size_t)K * 2;
    const unsigned ldsw = (unsigned)wid * 1024u;
    const int aoff = lds_byte(wr * 64 + fr, fq * 8), boff = lds_byte(wc * 32 + fr, fq * 8);
#define PG8_SA(b, h) (((b) * 2 + (h)) * HTB)
#define PG8_SB(b, h) ((4 + (b) * 2 + (h)) * HTB)
#define PG8_STAGE(bufoff, gbase, voff) do { _Pragma("unroll") for (int _i = 0; _i < 2; ++_i) \
        __builtin_amdgcn_global_load_lds((const unsigned*)((const char*)(gbase) + (voff)[_i]), (PG8_LAS unsigned*)(lds + (bufoff) + ldsw + _i * 8192), 16, 0, 0); } while (0)
#define PG8_LDA(dst, b, h) do { _Pragma("unroll") for (int m = 0; m < 4; ++m) _Pragma("unroll") for (int k = 0; k < 2; ++k) dst[m][k] = *(const PG8_LAS bf16x8*)(lds + PG8_SA(b, h) + aoff + m * 2048 + k * 1024); } while (0)
#define PG8_LDB(dst, b, h) do { _Pragma("unroll") for (int n = 0; n < 2; ++n) _Pragma("unroll") for (int k = 0; k < 2; ++k) dst[n][k] = *(const PG8_LAS bf16x8*)(lds + PG8_SB(b, h) + boff + n * 2048 + k * 1024); } while (0)
#define PG8_MMA(ai, bj, At, Bt) do { __builtin_amdgcn_s_setprio(1); _Pragma("unroll") for (int m = 0; m < 4; ++m) _Pragma("unroll") for (int n = 0; n < 2; ++n) _Pragma("unroll") for (int k = 0; k < 2; ++k) \
        acc[ai][bj][m][n] = __builtin_amdgcn_mfma_f32_16x16x32_bf16(Bt[n][k], At[m][k], acc[ai][bj][m][n], 0, 0, 0); __builtin_amdgcn_s_setprio(0); } while (0)
#define PG8_WAIT_V(n) asm volatile("s_waitcnt vmcnt(" #n ")" ::: "memory")
#define PG8_WAIT_L(n) asm volatile("s_waitcnt lgkmcnt(" #n ")" ::: "memory")
#define PG8_BAR __builtin_amdgcn_s_barrier()
#define PG8_SCHED __builtin_amdgcn_sched_barrier(0)
    Unit cur, nxt; int ui = 0;
    if (!S.next(0, cur)) return;
    f32x4 acc[2][2][4][2];
#pragma unroll
    for (int a = 0; a < 2; ++a)
#pragma unroll
        for (int b = 0; b < 2; ++b)
#pragma unroll
            for (int m = 0; m < 4; ++m)
#pragma unroll
                for (int n = 0; n < 2; ++n) acc[a][b][m][n] = (f32x4){0.f, 0.f, 0.f, 0.f};
    bf16x8 At[4][2], B0[2][2], B1[2][2];
    const char* cA = (const char*)g.A + (long)cur.arow * (long)rstep; const char* cB = (const char*)g.Bt + (size_t)cur.pn * tstep;
    if constexpr (SP2) {
        PG8_STAGE(PG8_SB(0, 0), cB, voffB); PG8_STAGE(PG8_SB(0, 1), cB + hstep, voffB); PG8_STAGE(PG8_SA(0, 0), cA, voffA); PG8_STAGE(PG8_SA(0, 1), cA + hstep, voffA);
        if (wr == 1) PG8_BAR;
        PG8_WAIT_V(2); PG8_BAR;
        PG8_STAGE(PG8_SB(1, 0), cB + kstep, voffB); PG8_STAGE(PG8_SA(1, 0), cA + kstep, voffA); PG8_STAGE(PG8_SB(1, 1), cB + hstep + kstep, voffB);
        PG8_WAIT_V(6); PG8_BAR;
    } else {
        PG8_STAGE(PG8_SB(0, 0), cB, voffB); PG8_STAGE(PG8_SA(0, 0), cA, voffA); PG8_STAGE(PG8_SB(0, 1), cB + hstep, voffB); PG8_STAGE(PG8_SA(0, 1), cA + hstep, voffA);
        if (wr == 1) PG8_BAR;
        PG8_WAIT_V(4); PG8_BAR;
        PG8_STAGE(PG8_SB(1, 0), cB + kstep, voffB); PG8_STAGE(PG8_SA(1, 0), cA + kstep, voffA); PG8_STAGE(PG8_SB(1, 1), cB + hstep + kstep, voffB);
        PG8_WAIT_V(6); PG8_BAR;
    }
    for (;;) {
        const bool has_next = S.next(ui + 1, nxt);
        const char* nA = has_next ? (const char*)g.A + (long)nxt.arow * (long)rstep : cA; const char* nB = has_next ? (const char*)g.Bt + (size_t)nxt.pn * tstep : cB;
        for (int t = 0; t < nt; t += 2) {
            const bool last = (t == nt - 2);
            const char* a1 = cA + (size_t)(t + 1) * kstep;
            const char* a2 = last ? nA : cA + (size_t)(t + 2) * kstep; const char* b2 = last ? nB : cB + (size_t)(t + 2) * kstep;
            const char* a3 = a2 + kstep; const char* b3 = b2 + kstep;
            if constexpr (Epi::RESCALE) { if (t == Epi::T1 || t == Epi::T2) E.rescale(acc, t == Epi::T1 ? 0 : 1, wr, tid & 15, lds + STAGE_BYTES); }
            if constexpr (SP2) {
            PG8_LDB(B0, 0, 0); PG8_LDB(B1, 0, 1); PG8_SCHED; PG8_LDA(At, 0, 0); PG8_STAGE(PG8_SA(1, 1), a1 + hstep, voffA);
            PG8_WAIT_V(8); PG8_WAIT_L(0); PG8_BAR; PG8_MMA(0, 0, At, B0); PG8_MMA(0, 1, At, B1); PG8_BAR; PG8_SCHED;
            PG8_LDA(At, 0, 1); PG8_STAGE(PG8_SB(0, 0), b2, voffB); PG8_STAGE(PG8_SB(0, 1), b2 + hstep, voffB); PG8_STAGE(PG8_SA(0, 0), a2, voffA);
            PG8_WAIT_V(8); PG8_WAIT_L(0); PG8_BAR; PG8_MMA(1, 0, At, B0); PG8_MMA(1, 1, At, B1); PG8_BAR; PG8_SCHED;
            PG8_LDB(B0, 1, 0); PG8_LDB(B1, 1, 1); PG8_SCHED; PG8_LDA(At, 1, 0); PG8_STAGE(PG8_SA(0, 1), a2 + hstep, voffA);
            PG8_WAIT_V(8); PG8_WAIT_L(0); PG8_BAR; PG8_MMA(0, 0, At, B0); PG8_MMA(0, 1, At, B1); PG8_BAR; PG8_SCHED;
            PG8_LDA(At, 1, 1); PG8_STAGE(PG8_SB(1, 0), b3, voffB); PG8_STAGE(PG8_SB(1, 1), b3 + hstep, voffB); PG8_STAGE(PG8_SA(1, 0), a3, voffA);
            PG8_WAIT_V(8); PG8_WAIT_L(0); PG8_BAR; PG8_MMA(1, 0, At, B0); PG8_MMA(1, 1, At, B1); PG8_BAR; PG8_SCHED;
            } else {
            PG8_LDB(B0, 0, 0); PG8_SCHED; PG8_LDA(At, 0, 0); PG8_STAGE(PG8_SA(1, 1), a1 + hstep, voffA);
            PG8_WAIT_L(8); PG8_BAR; PG8_WAIT_L(0); PG8_MMA(0, 0, At, B0); PG8_BAR; PG8_SCHED;
            PG8_LDB(B1, 0, 1); PG8_STAGE(PG8_SB(0, 0), b2, voffB);
            PG8_BAR; PG8_WAIT_L(0); PG8_MMA(0, 1, At, B1); PG8_BAR;
            PG8_LDA(At, 0, 1); PG8_STAGE(PG8_SA(0, 0), a2, voffA);
            PG8_BAR; PG8_WAIT_L(0); PG8_MMA(1, 0, At, B0); PG8_BAR; PG8_SCHED;
            PG8_STAGE(PG8_SB(0, 1), b2 + hstep, voffB);
            PG8_WAIT_V(6); PG8_BAR; PG8_MMA(1, 1, At, B1); PG8_BAR;
            PG8_LDB(B0, 1, 0); PG8_SCHED; PG8_LDA(At, 1, 0); PG8_STAGE(PG8_SA(0, 1), a2 + hstep, voffA);
            PG8_WAIT_L(8); PG8_BAR; PG8_WAIT_L(0); PG8_MMA(0, 0, At, B0); PG8_BAR; PG8_SCHED;
            PG8_LDB(B1, 1, 1); PG8_STAGE(PG8_SB(1, 0), b3, voffB);
            PG8_BAR; PG8_WAIT_L(0); PG8_MMA(0, 1, At, B1); PG8_BAR;
            PG8_LDA(At, 1, 1); PG8_STAGE(PG8_SA(1, 0), a3, voffA);
            PG8_BAR; PG8_WAIT_L(0); PG8_MMA(1, 0, At, B0); PG8_BAR; PG8_SCHED;
            PG8_STAGE(PG8_SB(1, 1), b3 + hstep, voffB);
            PG8_WAIT_V(6); PG8_BAR; PG8_MMA(1, 1, At, B1); PG8_BAR;
            }
        }
        if constexpr (ALIGN_EPI) { if (wr == 0) PG8_BAR; }
        { int t_ = tid; asm volatile("" : "+v"(t_));
          E(acc, cur, wr, wc, t_ & 15, (t_ >> 4) & 3, lds + STAGE_BYTES); }
        if (!has_next) break;
#pragma unroll
        for (int a = 0; a < 2; ++a)
#pragma unroll
            for (int b = 0; b < 2; ++b)
#pragma unroll
                for (int m = 0; m < 4; ++m)
#pragma unroll
                    for (int n = 0; n < 2; ++n) acc[a][b][m][n] = (f32x4){0.f, 0.f, 0.f, 0.f};
        cur = nxt; cA = nA; cB = nB; ++ui;
        if constexpr (ALIGN_EPI) { if (wr == 1) PG8_BAR; }
    }
    PG8_WAIT_V(0);
    if constexpr (!ALIGN_EPI) { if (wr == 0) PG8_BAR; }
    PG8_BAR;
#undef PG8_SA
#undef PG8_SB
#undef PG8_STAGE
#undef PG8_LDA
#undef PG8_LDB
#undef PG8_MMA
#undef PG8_WAIT_V
#undef PG8_WAIT_L
#undef PG8_BAR
#undef PG8_SCHED
}
#else
template <class Epi, class Sched, bool ALIGN_EPI = false, bool SP2 = false>
static inline void gemm_phase(unsigned char* lds, const int tid, const Gemm g, const Sched& S, const Epi& E) {
    const int wid = tid >> 6, lane = tid & 63, wr = wid >> 2, wc = wid & 3, fr = lane & 15, fq = lane >> 4;
    static thread_local std::vector<float> Af, Bf;
    Unit cur;
    for (int ui = 0; S.next(ui, cur); ++ui) {
        const int K = g.K;
        sync_block();
        if (tid == 0) { Af.resize((size_t)256 * K); Bf.resize((size_t)256 * K);
            for (int r = 0; r < 256; ++r) for (int k = 0; k < K; ++k) { Af[(size_t)r * K + k] = bf2f_(g.A[((long)cur.arow + r) * K + k]); Bf[(size_t)r * K + k] = bf2f_(g.Bt[((size_t)cur.pn * 256 + r) * K + k]); } }
        sync_block();
        f32x4 acc[2][2][4][2];
        for (int ai = 0; ai < 2; ++ai) for (int bj = 0; bj < 2; ++bj) for (int m = 0; m < 4; ++m) for (int n = 0; n < 2; ++n) for (int e = 0; e < 4; ++e) {
            const int r = 128 * ai + 64 * wr + (Epi::APERM ? 4 * fr + m : 16 * m + fr), c = 128 * bj + 32 * wc + (Epi::PERM ? 8 * fq + 4 * n + e : 16 * n + 4 * fq + e);
            const float* a = &Af[(size_t)r * K]; const float* b = &Bf[(size_t)c * K]; float s = 0.f;
            if constexpr (Epi::RESCALE) { const float* TS = (const float*)(lds + STAGE_BYTES) + r * 4;
                for (int k = 0; k < K; ++k) { if (k == 64 * Epi::T1) s *= TS[0]; if (k == 64 * Epi::T2) s *= TS[1]; s += a[k] * b[k]; } }
            else for (int k = 0; k < K; ++k) s += a[k] * b[k];
            acc[ai][bj][m][n][e] = s; }
        E(acc, cur, wr, wc, fr, fq, lds + STAGE_BYTES);
    }
    sync_block();
}
#endif

DEVFN float row_inv(const float* ssq, int row) {
    const f32x4* p = (const f32x4*)(ssq + (size_t)row * 16); const f32x4 a = p[0], b = p[1], c = p[2], d = p[3];
    const float s = ((a[0] + a[1]) + (a[2] + a[3])) + ((b[0] + b[1]) + (b[2] + b[3])) + ((c[0] + c[1]) + (c[2] + c[3])) + ((d[0] + d[1]) + (d[2] + d[3]));
    return 1.0f / sqrtf(s * (1.0f / D) + 1e-6f);
}
template <class ValidFn> DEVFN void unit_row_inv(LAS float* RI, const float* ssq, int tid, long rowbase, ValidFn valid) {
    if (tid < 256) { const long row = rowbase + tid; RI[tid] = valid(tid) ? row_inv(ssq, (int)row) : 0.f; }
#ifdef CPU_EMU
    sync_block();
#else
    asm volatile("s_waitcnt lgkmcnt(0)" ::: "memory"); __builtin_amdgcn_s_barrier(); asm volatile("" ::: "memory");
#endif
}
struct EpiIn {
    static constexpr bool PERM = true, APERM = false, RESCALE = false;
    bf16* O; const float* ssq;
    MEMFN void operator()(const f32x4 (&acc)[2][2][4][2], const Unit& u, int wr, int wc, int fr, int fq, LAS unsigned char* xl) const {
        LAS float* RI = (LAS float*)(xl + 4096); unit_row_inv(RI, ssq, (wr * 4 + wc) * 64 + fq * 16 + fr, (long)u.pm * BM, [](int) { return true; });
        const int row0 = u.pm * BM + wr * 64 + fr, col0 = u.pn * BM + wc * 32 + 8 * fq;
#pragma unroll
        for (int ai = 0; ai < 2; ++ai)
#pragma unroll
            for (int m = 0; m < 4; ++m) { const int row = row0 + ai * HALF + m * 16; const float sc = RI[ai * HALF + wr * 64 + m * 16 + fr]; bf16* rowp = O + (size_t)row * NINP + col0;
#pragma unroll
                for (int bj = 0; bj < 2; ++bj) { const f32x4 v0 = acc[ai][bj][m][0] * sc, v1 = acc[ai][bj][m][1] * sc;
                    u32x4 w; w.x = pk_bf16(v0[0], v0[1]); w.y = pk_bf16(v0[2], v0[3]); w.z = pk_bf16(v1[0], v1[1]); w.w = pk_bf16(v1[2], v1[3]);
                    *(u32x4*)(rowp + bj * HALF) = w; } }
    }
};
struct EpiRes {
    static constexpr bool PERM = true, APERM = false, RESCALE = false;
    float* H; bf16* HB; float* ssq;
    MEMFN void operator()(const f32x4 (&acc)[2][2][4][2], const Unit& u, int wr, int wc, int fr, int fq, LAS unsigned char*) const {
        const int row0 = u.pm * BM + wr * 64 + fr, col0 = u.pn * BM + wc * 32 + 8 * fq;
#pragma unroll
        for (int ai = 0; ai < 2; ++ai)
#pragma unroll
            for (int m = 0; m < 4; ++m) { const int row = row0 + ai * HALF + m * 16; const size_t off = (size_t)row * D + col0; float s = 0.f;
#pragma unroll
                for (int bj = 0; bj < 2; ++bj) { u32x4* hp = (u32x4*)(HB + off + bj * HALF); const u32x4 ho = *hp;
                    const f32x4 h0 = (f32x4){bf_lo(ho.x), bf_hi(ho.x), bf_lo(ho.y), bf_hi(ho.y)} + acc[ai][bj][m][0], h1 = (f32x4){bf_lo(ho.z), bf_hi(ho.z), bf_lo(ho.w), bf_hi(ho.w)} + acc[ai][bj][m][1];
                    u32x4 w; w.x = pk_bf16(h0[0], h0[1]); w.y = pk_bf16(h0[2], h0[3]); w.z = pk_bf16(h1[0], h1[1]); w.w = pk_bf16(h1[2], h1[3]); *hp = w;
                    s += ((h0[0] * h0[0] + h0[1] * h0[1]) + (h0[2] * h0[2] + h0[3] * h0[3])) + ((h1[0] * h1[0] + h1[1] * h1[1]) + (h1[2] * h1[2] + h1[3] * h1[3])); }
                s += shfl_xor_f32(s, 16); s += shfl_xor_f32(s, 32);
                if (fq == 0) ssq[(size_t)row * 16 + u.pn * 4 + wc] = s;
                if (m == 3) asm volatile("" ::: "memory"); }
    }
};
struct EpiResMix {
    static constexpr bool PERM = true, APERM = false, RESCALE = true; static constexpr int T1 = 6, T2 = 12;
    float* H; bf16* HB; float* ssq;
    MEMFN void rescale(f32x4 (&acc)[2][2][4][2], int which, int wr, int fr, LAS unsigned char* xl) const {
        const LAS float* TS = (const LAS float*)xl;
#pragma unroll
        for (int ai = 0; ai < 2; ++ai)
#pragma unroll
            for (int m = 0; m < 4; ++m) { const float r = TS[(ai * HALF + wr * 64 + m * 16 + fr) * 4 + which];
#pragma unroll
                for (int bj = 0; bj < 2; ++bj)
#pragma unroll
                    for (int n = 0; n < 2; ++n) acc[ai][bj][m][n] = acc[ai][bj][m][n] * r; }
    }
    MEMFN void operator()(const f32x4 (&acc)[2][2][4][2], const Unit& u, int wr, int wc, int fr, int fq, LAS unsigned char* xl) const {
        const LAS float* TS = (const LAS float*)xl;
        const int row0 = u.pm * BM + wr * 64 + fr, col0 = u.pn * BM + wc * 32 + 8 * fq;
#pragma unroll
        for (int ai = 0; ai < 2; ++ai)
#pragma unroll
            for (int m = 0; m < 4; ++m) { const int row = row0 + ai * HALF + m * 16; const size_t off = (size_t)row * D + col0; float s = 0.f; const float r3 = TS[(ai * HALF + wr * 64 + m * 16 + fr) * 4 + 2];
#pragma unroll
                for (int bj = 0; bj < 2; ++bj) { u32x4* hp = (u32x4*)(HB + off + bj * HALF); const u32x4 ho = *hp;
                    const f32x4 h0 = (f32x4){bf_lo(ho.x), bf_hi(ho.x), bf_lo(ho.y), bf_hi(ho.y)} + acc[ai][bj][m][0] * r3, h1 = (f32x4){bf_lo(ho.z), bf_hi(ho.z), bf_lo(ho.w), bf_hi(ho.w)} + acc[ai][bj][m][1] * r3;
                    u32x4 w; w.x = pk_bf16(h0[0], h0[1]); w.y = pk_bf16(h0[2], h0[3]); w.z = pk_bf16(h1[0], h1[1]); w.w = pk_bf16(h1[2], h1[3]); *hp = w;
                    s += ((h0[0] * h0[0] + h0[1] * h0[1]) + (h0[2] * h0[2] + h0[3] * h0[3])) + ((h1[0] * h1[0] + h1[1] * h1[1]) + (h1[2] * h1[2] + h1[3] * h1[3])); }
                s += shfl_xor_f32(s, 16); s += shfl_xor_f32(s, 32);
                if (fq == 0) ssq[(size_t)row * 16 + u.pn * 4 + wc] = s;
                if (m == 3) asm volatile("" ::: "memory"); }
    }
};
struct EpiGlu {
    static constexpr bool PERM = true, APERM = false, RESCALE = false;
    const bf16* YG; const float* bias; bf16* YM;
    MEMFN void operator()(const f32x4 (&acc)[2][2][4][2], const Unit& u, int wr, int wc, int fr, int fq, LAS unsigned char*) const {
        const int row0 = u.pm * BM + wr * 64 + fr, col0 = u.pn * BM + wc * 32 + 8 * fq;
#pragma unroll
        for (int bj = 0; bj < 2; ++bj) { const int col = col0 + bj * HALF; if (u.pn == 1 && bj == 1) continue;
            const f32x4 b0 = *(const f32x4*)(bias + col), b1 = *(const f32x4*)(bias + col + 4);
#pragma unroll
            for (int ai = 0; ai < 2; ++ai)
#pragma unroll
                for (int m = 0; m < 4; ++m) { const int row = row0 + ai * HALF + m * 16;
                    const u32x4 y = *(const u32x4*)(YG + (size_t)row * S5W + col); const f32x4 a0 = acc[ai][bj][m][0] + b0, a1 = acc[ai][bj][m][1] + b1;
                    u32x4 w; w.x = pk_bf16(bf_lo(y.x) * sigmoid_f(a0[0]), bf_hi(y.x) * sigmoid_f(a0[1])); w.y = pk_bf16(bf_lo(y.y) * sigmoid_f(a0[2]), bf_hi(y.y) * sigmoid_f(a0[3]));
                    w.z = pk_bf16(bf_lo(y.z) * sigmoid_f(a1[0]), bf_hi(y.z) * sigmoid_f(a1[1])); w.w = pk_bf16(bf_lo(y.w) * sigmoid_f(a1[2]), bf_hi(y.w) * sigmoid_f(a1[3]));
                    *(u32x4*)(YM + (size_t)row * D + RGW + col) = w;
                    if (m == 3) asm volatile("" ::: "memory"); } }
    }
};
struct EpiUp {
    static constexpr bool PERM = true, APERM = true, RESCALE = false;
    bf16* G; const float* ssq; const float* cw; const float* cb;
    MEMFN void operator()(f32x4 (&acc)[2][2][4][2], const Unit& u, int wr, int wc, int fr, int fq, LAS unsigned char* xl) const {
        const int b = u.pm / NQ, q = u.pm % NQ, t0 = UPS * q - 1;
        LAS float* XB = (LAS float*)xl;
        const int cs = wc * 32 + 8 * fq;
        LAS float* TAPS = (LAS float*)(xl + 8192 + 2048);
        { const int tid_ = (wr * 4 + wc) * 64 + fq * 16 + fr;
          if (tid_ >= 256) { const int arr = (tid_ - 256) >> 5, ch = (tid_ - 256) & 31, jj = u.pn * 128 + 4 * ch;
              const float* src = arr == 0 ? cb + jj : (arr == 1 ? cb + FF + jj : (arr < 5 ? cw + (arr - 2) * FF2 + jj : cw + (arr - 5) * FF2 + FF + jj));
              *(LAS f32x4*)(TAPS + arr * 128 + 4 * ch) = *(const f32x4*)src; } }
        LAS float* RI = (LAS float*)(xl + 8192 + 1024); unit_row_inv(RI, ssq, (wr * 4 + wc) * 64 + fq * 16 + fr, (long)b * L + t0, [t0](int r) { const int t = t0 + r; return t >= 0 && t < L; });
#pragma unroll
        for (int ai = 0; ai < 2; ++ai)
#pragma unroll
            for (int m = 0; m < 4; ++m) { const int lr = 128 * ai + 64 * wr + 4 * fr + m, t = t0 + lr; const bool ok = (t >= 0) && (t < L);
                const float sc = RI[lr];
#pragma unroll
                for (int bj = 0; bj < 2; ++bj)
#pragma unroll
                    for (int n = 0; n < 2; ++n)
#pragma unroll
                        for (int e = 0; e < 4; ++e) acc[ai][bj][m][n][e] = ok ? acc[ai][bj][m][n][e] * sc : 0.f; }
#pragma unroll
        for (int ai = 0; ai < 2; ++ai) { const int s = 2 * ai + wr;
            if (fr == 0) {
#pragma unroll
                for (int bj = 0; bj < 2; ++bj)
#pragma unroll
                    for (int n = 0; n < 2; ++n) *(LAS f32x4*)(XB + (2 * s) * 256 + bj * 128 + cs + 4 * n) = acc[ai][bj][0][n]; }
            if (fr == 15) {
#pragma unroll
                for (int bj = 0; bj < 2; ++bj)
#pragma unroll
                    for (int n = 0; n < 2; ++n) *(LAS f32x4*)(XB + (2 * s + 1) * 256 + bj * 128 + cs + 4 * n) = acc[ai][bj][3][n]; } }
#ifdef CPU_EMU
        sync_block();
#else
        asm volatile("s_waitcnt lgkmcnt(0)" ::: "memory"); __builtin_amdgcn_s_barrier(); asm volatile("" ::: "memory");
#endif
        const int j0 = u.pn * 128 + cs;
#pragma unroll
        for (int n = 0; n < 2; ++n) {
            f32x4 wa[3], wv[3]; const f32x4 ba = *(const LAS f32x4*)(TAPS + cs + 4 * n), bv = *(const LAS f32x4*)(TAPS + 128 + cs + 4 * n);
#pragma unroll
            for (int k = 0; k < 3; ++k) { wa[k] = *(const LAS f32x4*)(TAPS + (2 + k) * 128 + cs + 4 * n); wv[k] = *(const LAS f32x4*)(TAPS + (5 + k) * 128 + cs + 4 * n); }
#pragma unroll
            for (int ai = 0; ai < 2; ++ai) { const int s = 2 * ai + wr;
                f32x4 upe[2], dne[2];
#pragma unroll
                for (int bj = 0; bj < 2; ++bj) { f32x4 pu = {0.f, 0.f, 0.f, 0.f}, pd = {0.f, 0.f, 0.f, 0.f};
                    if (s > 0) pu = *(const LAS f32x4*)(XB + (2 * (s - 1) + 1) * 256 + bj * 128 + cs + 4 * n);
                    if (s < 3) pd = *(const LAS f32x4*)(XB + (2 * (s + 1)) * 256 + bj * 128 + cs + 4 * n);
                    const f32x4 lastr = acc[ai][bj][3][n], firstr = acc[ai][bj][0][n];
#pragma unroll
                    for (int e = 0; e < 4; ++e) { upe[bj][e] = dpp_row_shr1(pu[e], lastr[e]); dne[bj][e] = dpp_row_shl1(pd[e], firstr[e]); } }
#pragma unroll
                for (int m = 0; m < 4; ++m) { const int lr = 64 * s + 4 * fr + m, t = t0 + lr;
                    const f32x4 ua = m > 0 ? acc[ai][0][m > 0 ? m - 1 : 0][n] : upe[0], da = m < 3 ? acc[ai][0][m < 3 ? m + 1 : 3][n] : dne[0];
                    const f32x4 uv = m > 0 ? acc[ai][1][m > 0 ? m - 1 : 0][n] : upe[1], dv = m < 3 ? acc[ai][1][m < 3 ? m + 1 : 3][n] : dne[1];
                    const f32x4 a = ba + wa[0] * ua + wa[1] * acc[ai][0][m][n] + wa[2] * da;
                    const f32x4 v = bv + wv[0] * uv + wv[1] * acc[ai][1][m][n] + wv[2] * dv;
                    if (lr >= 1 && lr <= UPS && t < L) { u32x2 w; w.x = pk_bf16(gelu_f(a[0]) * v[0], gelu_f(a[1]) * v[1]); w.y = pk_bf16(gelu_f(a[2]) * v[2], gelu_f(a[3]) * v[3]);
                        *(u32x2*)(G + (size_t)(b * L + t) * FF + j0 + 4 * n) = w; }
                } } }
    }
};
}

constexpr int RING_BYTES = 131072, XCH_OFF = RING_BYTES, XCH_BYTES = 8192, MISC_OFF = XCH_OFF + XCH_BYTES, LDS_BYTES = 147456;
constexpr int CW_TMO = 0, CW_BAR = 4096;
#ifndef CPU_EMU
typedef GAS unsigned gu32;
#define XB_TMO      128
#define XB_XCNT(j)  (256  + 64 * (j))
#define XB_XSUB(j)  (1280 + 64 * (j))
#define XB_XGEN(j)  (2304 + 64 * (j))
#define XB_TOP      3328
#define XB_TOPGEN   3392
#define XCD_BAR_WORDS 3456
#define XB_SPIN_CAP (1u << 22)
__device__ __forceinline__ unsigned xb_ld(unsigned* p)              { return __hip_atomic_load(p, __ATOMIC_RELAXED, __HIP_MEMORY_SCOPE_AGENT); }
__device__ __forceinline__ unsigned xb_add(unsigned* p, unsigned v) { return __hip_atomic_fetch_add(p, v, __ATOMIC_RELAXED, __HIP_MEMORY_SCOPE_AGENT); }
__device__ __forceinline__ unsigned xb_xcc_id() { return (unsigned)__builtin_amdgcn_s_getreg((3 << 11) | 20) & 0xFu; }
#define XB_SPIN(cond, bar) do { unsigned _sp = 0; while (cond) { __builtin_amdgcn_s_sleep(1); \
    if ((++_sp & 255u) == 0u) { if (xb_ld(&(bar)[XB_TMO])) break; if (_sp > XB_SPIN_CAP) { atomicAdd(&(bar)[XB_TMO], 1u); break; } } } } while (0)
struct XcdBarrier { unsigned* bar; unsigned x; volatile LAS unsigned* st; };
__device__ __forceinline__ XcdBarrier xcd_barrier_post(unsigned* bar, volatile LAS unsigned* st) {
    XcdBarrier b; b.bar = bar; b.x = xb_xcc_id(); b.st = st;
    if (threadIdx.x == 0) (void)xb_add(&bar[XB_XCNT(b.x)], 1u);
    return b;
}
__device__ __forceinline__ void xcd_barrier_complete(unsigned* bar, unsigned x, unsigned& nloc, unsigned& nx) {
    const unsigned G = gridDim.x * gridDim.y * gridDim.z;
    unsigned sum, cnt, mine, sp = 0u;
    for (;;) {
        sum = 0u; cnt = 0u; mine = 0u;
#pragma unroll
        for (unsigned j = 0; j < 16; ++j) { const unsigned c = xb_ld(&bar[XB_XCNT(j)]); sum += c; cnt += (c > 0u) ? 1u : 0u; mine = (j == x) ? c : mine; }
        if (sum == G) break;
        __builtin_amdgcn_s_sleep(1);
        if ((++sp & 255u) == 0u) { if (xb_ld(&bar[XB_TMO])) break; if (sp > XB_SPIN_CAP) { atomicAdd(&bar[XB_TMO], 1u); break; } }
    }
    nloc = mine > 0u ? mine : 1u; nx = cnt > 0u ? cnt : 1u;
}
__device__ __forceinline__ void xcd_barrier(const XcdBarrier& b) {
    asm volatile("s_waitcnt vmcnt(0)" ::: "memory");
    __syncthreads();
    if (threadIdx.x == 0) {
        unsigned* bar = b.bar;
        __builtin_amdgcn_fence(__ATOMIC_RELEASE, "agent");
        asm volatile("s_waitcnt vmcnt(0)" ::: "memory");
        __builtin_amdgcn_s_waitcnt(0);
        unsigned nloc = b.st[0], nx = b.st[1];
        if (nloc == 0u) { xcd_barrier_complete(bar, b.x, nloc, nx); b.st[0] = nloc; b.st[1] = nx; }
        const unsigned old = xb_add(&bar[XB_XSUB(b.x)], 1u);
        const unsigned gen = old / nloc;
        if (old + 1u == (gen + 1u) * nloc) {
            __builtin_amdgcn_fence(__ATOMIC_RELEASE, "agent");
            asm volatile("s_waitcnt vmcnt(0)" ::: "memory");
            const unsigned og = xb_add(&bar[XB_TOP], 1u);
            const unsigned tg = og / nx;
            if (og + 1u == (tg + 1u) * nx) xb_add(&bar[XB_TOPGEN], 1u);
            else XB_SPIN(xb_ld(&bar[XB_TOPGEN]) == tg, bar);
            __builtin_amdgcn_fence(__ATOMIC_ACQUIRE, "agent");
            asm volatile("s_waitcnt vmcnt(0)" ::: "memory");
        } else {
            XB_SPIN(xb_ld(&bar[XB_TOPGEN]) == gen, bar);
            __builtin_amdgcn_fence(__ATOMIC_ACQUIRE, "agent");
            asm volatile("s_waitcnt vmcnt(0)" ::: "memory");
        }
    }
    __syncthreads();
}
#endif

#ifdef CPU_EMU
struct Args; static void emu_phase_hook(int ph, const Args& a);
#endif
struct Args { const float* in[38]; float* out; unsigned char* ws; int ph_lo, ph_hi; };
#ifdef CPU_EMU
typedef const Args* KARG_PTR;
#else
typedef const __attribute__((address_space(4))) Args* KARG_PTR;
#endif
struct Frame {
    LAS unsigned char* lds; int tid, lane, wave, G, gtid, gsize, gw, ngw;
    KARG_PTR ap; float* out; unsigned char* ws;
};
#define FIN(i) (F.ap->in[i])
#ifdef CPU_EMU
#define LAUNDER(F, l) do {} while (0)
#else
#define LAUNDER(F, l) do { size_t z_ = 0; asm volatile("" : "+s"(z_), "+s"(F.ap), "+s"(l), "+s"(F.wave)); F.ws = args.ws + z_; F.out = args.out + z_; F.lane = lane_id(); F.tid = (F.wave << 6) | F.lane; \
    F.gtid = blockIdx.x * NT + F.tid; F.gw = blockIdx.x * NWAVES + F.wave; } while (0)
#endif

DEVFN void transpose_item(const float* W, int ldw, int K, bf16* WT, int src_col0, int dst_row0, int k0, const float* sc, LAS float* scr, int lane) {
    float tv[32];
#pragma unroll
    for (int i = 0; i < 32; ++i) { const int kk = 2 * i + (lane >> 5); tv[i] = W[(size_t)(k0 + kk) * ldw + src_col0 + (lane & 31)]; }
#pragma unroll
    for (int i = 0; i < 32; ++i) { const int kk = 2 * i + (lane >> 5); float v = tv[i]; if (sc) v *= sc[k0 + kk]; scr[kk * 33 + (lane & 31)] = v; }
    WAVE_LDS_FENCE();
    const int c = lane & 7;
#pragma unroll
    for (int j = 0; j < 4; ++j) { const int n = (lane >> 3) + 8 * j; const LAS float* s = scr + (8 * c) * 33 + n;
        u32x4 o; o.x = pk_bf16(s[0 * 33], s[1 * 33]); o.y = pk_bf16(s[2 * 33], s[3 * 33]); o.z = pk_bf16(s[4 * 33], s[5 * 33]); o.w = pk_bf16(s[6 * 33], s[7 * 33]);
        *(u32x4*)(WT + (size_t)(dst_row0 + n) * K + k0 + 8 * c) = o; }
    WAVE_LDS_FENCE();
}
DEVFN float wave_sum(float v) {
#pragma unroll
    for (int o = 1; o < 64; o <<= 1) v += shfl_xor_f32(v, o);
    return v;
}
static_assert(NT == 512, "one wave per 64 filter columns");
DEVFN void hilo8(const float (&x)[8], bf16x8& hi, bf16x8& lo) { u32x4 h, lw; float r[8];
    h.x = pk_bf16(x[0], x[1]); h.y = pk_bf16(x[2], x[3]); h.z = pk_bf16(x[4], x[5]); h.w = pk_bf16(x[6], x[7]);
    r[0] = x[0] - bf_lo(h.x); r[1] = x[1] - bf_hi(h.x); r[2] = x[2] - bf_lo(h.y); r[3] = x[3] - bf_hi(h.y); r[4] = x[4] - bf_lo(h.z); r[5] = x[5] - bf_hi(h.z); r[6] = x[6] - bf_lo(h.w); r[7] = x[7] - bf_hi(h.w);
    lw.x = pk_bf16(r[0], r[1]); lw.y = pk_bf16(r[2], r[3]); lw.z = pk_bf16(r[4], r[5]); lw.w = pk_bf16(r[6], r[7]);
    hi = __builtin_bit_cast(bf16x8, h); lo = __builtin_bit_cast(bf16x8, lw); }
DEVFN void p_filter_tables(Frame& F) {
    constexpr int H2S = 68;
    LAS float* H1 = (LAS float*)F.lds; LAS float* H2 = H1 + 32 * 64; LAS float* W1 = H2 + 32 * H2S; LAS float* W2 = W1 + 2176; LAS float* PB = W2 + 4096;
    float* KF = (float*)(F.ws + WS_KFB); const int tid = F.tid;
    const float maxd = logf(1e-2f) / 0.3f, mind = logf(1e-2f) / 1.5f;
    const f32x16 z16 = {0.f, 0.f, 0.f, 0.f, 0.f, 0.f, 0.f, 0.f, 0.f, 0.f, 0.f, 0.f, 0.f, 0.f, 0.f, 0.f};
    sync_block();
    int it0 = (int)blockIdx.x; OPAQUE_S(it0);
    for (int it = it0; it < 2 * (L / 32); it += F.G) { const int l = it / (L / 32), pos0 = (it % (L / 32)) * 32;
        const int lane = lane_id(), w = F.wave, hh = lane >> 5, pl = lane & 31;
        { const float* w1 = FIN(22) + l * 33 * 64; const float* w2 = FIN(25) + l * 4096;
          for (int i = tid; i < 33 * 64; i += NT) W1[i] = w1[i];
          for (int i = tid; i < 1024; i += NT) *(LAS f32x4*)(W2 + 4 * i) = *(const f32x4*)(w2 + 4 * i);
          if (tid < 64) { PB[tid] = FIN(23)[l * 64 + tid]; PB[64 + tid] = FIN(24)[l * 64 + tid]; PB[128 + tid] = FIN(26)[l * 64 + tid]; PB[192 + tid] = FIN(27)[l * 64 + tid]; } }
        sync_block();
        for (int e = tid; e < 32 * 64; e += NT) { const int pp = e / 64, mm = e % 64, pos = pos0 + pp;
            const float t = (float)pos / (float)(L - 1 > 1 ? L - 1 : 1);
            float acc = PB[mm] + t * W1[mm];
            for (int q = 0; q < 16; ++q) { const float band = 1e-4f + (float)q * ((15.0f - 1e-4f) / 15.0f); acc += cos_rev(((float)pos * band) * (1.0f / (float)L)) * W1[(1 + q) * 64 + mm] - sin_rev(((float)pos * band) * (1.0f / (float)L)) * W1[(17 + q) * 64 + mm]; }
            H1[pp * 64 + mm] = sinf(PB[64 + mm] * acc); }
        sync_block();
        for (int e = tid; e < 32 * 64; e += NT) { const int pp = e / 64, mm = e % 64; float acc = PB[128 + mm];
            for (int q = 0; q < 64; ++q) acc += H1[pp * 64 + q] * W2[q * 64 + mm];
            H2[pp * H2S + mm] = sinf(PB[192 + mm] * acc); }
        sync_block();
        const float* w3 = FIN(28) + (size_t)l * 64 * 512 + 64 * w + pl;
#pragma unroll 1
        for (int ct = 0; ct < 2; ++ct) { f32x16 acc = z16; OPAQUE16(acc);
#pragma unroll
            for (int ks = 0; ks < 4; ++ks) { float xb[8], xa[8];
#pragma unroll
                for (int j = 0; j < 8; ++j) xb[j] = w3[(size_t)(16 * ks + 8 * hh + j) * 512 + 32 * ct];
                { const f32x4 a0 = *(const LAS f32x4*)(H2 + pl * H2S + 16 * ks + 8 * hh), a1 = *(const LAS f32x4*)(H2 + pl * H2S + 16 * ks + 8 * hh + 4);
                  xa[0] = a0[0]; xa[1] = a0[1]; xa[2] = a0[2]; xa[3] = a0[3]; xa[4] = a1[0]; xa[5] = a1[1]; xa[6] = a1[2]; xa[7] = a1[3]; }
                bf16x8 ah, al, bh, bl; hilo8(xa, ah, al); hilo8(xb, bh, bl);
                FRESH(ah); FRESH(al); FRESH(bh); FRESH(bl);
                acc = mfma32(ah, bh, acc); acc = mfma32(ah, bl, acc); acc = mfma32(al, bh, acc);
                MFMA_GUARD(ACC1(acc), KV(ah), KV(al), KV(bh), KV(bl)); }
            const int c2 = 64 * w + 32 * ct + pl; const float delta = fabsf(mind + (float)(c2 % 256) * ((maxd - mind) / 255.0f)); float* dst = KF + ((size_t)l * 512 + c2) * L + pos0 + 4 * hh;
#pragma unroll
            for (int g = 0; g < 4; ++g) { f32x4 o;
#pragma unroll
                for (int e = 0; e < 4; ++e) o[e] = acc[4 * g + e] * expf(-((float)(pos0 + 8 * g + 4 * hh + e) / (float)(L - 1 > 1 ? L - 1 : 1)) * delta);
                *(f32x4*)(dst + 8 * g) = o; } }
        sync_block(); }
}
DEVFN void p_prologue(Frame& F) {
    LAS float* scr = (LAS float*)(F.lds + F.wave * 16384);
    constexpr int I_IN = 16 * 60, I_OUT = 16 * 32, I_UP = 16 * 176, I_DN = 44 * 32, I_L = I_IN + I_OUT + I_UP + I_DN;
    for (int it = F.gw; it < 2 * I_L; it += F.ngw) {
        const int l = it / I_L; int r = it % I_L;
        if (r < I_IN) { const int kb = r / 60, nb = r % 60; transpose_item(FIN(2) + (size_t)l * D * NIN, NIN, D, (bf16*)(F.ws + WS_WIN + l * SZ_WIN), 32 * nb, 32 * nb, 64 * kb, FIN(1) + l * D, scr, F.lane); continue; } r -= I_IN;
        if (r < I_OUT) { const int kb = r / 32, nb = r % 32; transpose_item(FIN(31) + (size_t)l * D * D, D, D, (bf16*)(F.ws + WS_WOUT + l * SZ_WOUT), 32 * nb, 32 * nb, 64 * kb, FIN(30) + l * D, scr, F.lane); continue; } r -= I_OUT;
        if (r < I_UP) { const int kb = r / 176, nb = r % 176, sc0 = 32 * nb, half = sc0 / FF, jj = sc0 % FF, pn = jj / 128;
            transpose_item(FIN(33) + (size_t)l * D * FF2, FF2, D, (bf16*)(F.ws + WS_WUP + l * SZ_WUP), sc0, 256 * pn + 128 * half + (jj % 128), 64 * kb, FIN(32) + l * D, scr, F.lane); continue; } r -= I_UP;
        { const int kb = r / 32, nb = r % 32; transpose_item(FIN(36) + (size_t)l * FF * D, D, FF, (bf16*)(F.ws + WS_WDN + l * SZ_WDN), 32 * nb, 32 * nb, 64 * kb, nullptr, scr, F.lane); }
    }
    for (int i = F.gtid; i < 2 * 12 * 24 * 64; i += F.gsize) { const int l = i / (12 * 24 * 64), r = i % (12 * 24 * 64), ln = r % 64, ks = (r / 64) % 24, ct = r / (64 * 24), pl = ln & 31, hh = ln >> 5;
        const float* src = FIN(18) + (size_t)l * S5W * S5W + (size_t)(16 * ks + 8 * hh) * S5W + 32 * ct + pl; u32x4 o;
        o.x = pk_bf16(src[0], src[S5W]); o.y = pk_bf16(src[2 * S5W], src[3 * S5W]); o.z = pk_bf16(src[4 * S5W], src[5 * S5W]); o.w = pk_bf16(src[6 * S5W], src[7 * S5W]);
        ((u32x4*)(F.ws + WS_WGLU + l * SZ_WGLU))[r] = o; }
    for (int i = F.gtid; i < 2 * (128 * D / 8); i += F.gsize) { const int l = i / (128 * D / 8), r = i % (128 * D / 8); ((u32x4*)(F.ws + WS_WIN + l * SZ_WIN + (size_t)NIN * D * 2))[r] = (u32x4){0u, 0u, 0u, 0u}; }
    float* ssq = (float*)(F.ws + WS_SSQ); bf16* hb = (bf16*)(F.ws + WS_HB);
    for (int m = 4 * F.gw; m < M; m += 4 * F.ngw) {
        const f32x4* xr = (const f32x4*)(FIN(0) + (size_t)m * D) + F.lane; u32x2* br = (u32x2*)(hb + (size_t)m * D) + F.lane; f32x4 v[16]; float sq[4] = {0.f, 0.f, 0.f, 0.f};
#pragma unroll
        for (int j = 0; j < 16; ++j) v[j] = xr[64 * j];
#pragma unroll
        for (int j = 0; j < 16; ++j) { u32x2 w; w.x = pk_bf16(v[j][0], v[j][1]); w.y = pk_bf16(v[j][2], v[j][3]); br[64 * j] = w; sq[j >> 2] += (v[j][0] * v[j][0] + v[j][1] * v[j][1]) + (v[j][2] * v[j][2] + v[j][3] * v[j][3]); }
#pragma unroll
        for (int o = 1; o < 64; o <<= 1) {
#pragma unroll
            for (int q = 0; q < 4; ++q) sq[q] += shfl_xor_f32(sq[q], o); }
        { const int q = F.lane >> 4; const float sv = q == 0 ? sq[0] : (q == 1 ? sq[1] : (q == 2 ? sq[2] : sq[3])); ssq[(size_t)m * 16 + F.lane] = (F.lane & 15) == 0 ? sv : 0.f; }
    }
    for (int ic = F.gtid; ic < 2 * 3072 * 16; ic += F.gsize) { const int i = ic / 16, c = ic % 16, l = i / 3072, r = i % 3072, dg = r / 64, p = r % 64;
        const float lr = FIN(10)[i], li = FIN(11)[i], dt = expf(FIN(12)[l * 48 + dg]);
        const float mag = expf(lr * dt), ar = mag * cosf(li * dt), ai = mag * sinf(li * dt);
        const float den = lr * lr + li * li, nr = ar - 1.0f, ni = ai, cr = (nr * lr + ni * li) / den, ci = (ni * lr - nr * li) / den;
        if (c == 0) { ((f32x2*)(F.ws + WS_S5A))[i] = (f32x2){ar, ai};
            const float m16 = expf(16.0f * lr * dt); ((f32x2*)(F.ws + WS_S5A16))[i] = (f32x2){m16 * cosf(16.0f * li * dt), m16 * sinf(16.0f * li * dt)}; }
        bf16* bt = (bf16*)(F.ws + WS_S5BT) + ((size_t)(l * 48 + dg) * 2) * 64 * 16; bf16* ct = (bf16*)(F.ws + WS_S5CT) + (size_t)(l * 48 + dg) * 16 * 128;
        { const float br = FIN(13)[(size_t)i * 16 + c], bi = FIN(14)[(size_t)i * 16 + c];
            bt[(size_t)p * 16 + c] = f2bf_(cr * br - ci * bi); bt[(size_t)(64 + p) * 16 + c] = f2bf_(cr * bi + ci * br);
            const size_t ci_ = ((size_t)(l * 48 + dg) * 16 + c) * 64 + p;
            ct[(size_t)c * 128 + 2 * p] = f2bf_(FIN(15)[ci_]); ct[(size_t)c * 128 + 2 * p + 1] = f2bf_(-FIN(16)[ci_]); } }
    for (int i = F.gtid; i < 2 * 2 * RGW; i += F.gsize) ((float*)(F.ws + WS_RGSP))[i] = 8.0f * softplus_f(-FIN(9)[i]);
    for (int i = F.gtid; i < 2 * 2 * 2 * 6 * 4096; i += F.gsize) { const int k = i % 64, n = (i / 64) % 64, hd = (i / 4096) % 6, mat = (i / 24576) % 2, ld = i / 49152;
        const float* src = (mat == 0 ? FIN(5) : FIN(7)) + ((size_t)ld * 6 + hd) * 4096; ((bf16*)(F.ws + WS_RGWT))[i] = f2bf_(-1.4426950408889634f * src[k * 64 + n]); }
    p_filter_tables(F);
}
constexpr int RING_BYTES_C = 131072;
constexpr int HY_NA = L / 32;
constexpr int HY_TA = HY_NA < 32 ? HY_NA : 32;
constexpr int HY_TB = 32 / HY_TA, HY_NBLK = HY_NA + 2 * (HY_TA - 1), HY_NTILE = (HY_NA / HY_TA) * ((Bn + HY_TB - 1) / HY_TB);
constexpr int HY_CPY = 2 * L * 2 + 64;
constexpr int HY_FI = 0, HY_ZI = 4 * HY_CPY, HY_LDS = HY_ZI + Bn * HY_NBLK * 80;
static_assert(HY_LDS <= RING_BYTES_C, "hyena LDS");
DEVFN void p_hy_pre(Frame& F, int l) {
    const bf16* proj = (const bf16*)(F.ws + WS_PROJ); bf16* zT = (bf16*)((unsigned char*)F.out + OUT_ZT); const float* cw = FIN(20) + l * 3 * 768; const float* cb = FIN(21) + l * 768;
    for (int i = F.gtid; i < 256 * (M / 32); i += F.gsize) { const int c = i % 256, m0 = (i / 256) * 32, t0 = m0 % L;
        const float w1[3] = {cw[256 + c], cw[768 + 256 + c], cw[1536 + 256 + c]}, wv[3] = {cw[512 + c], cw[768 + 512 + c], cw[1536 + 512 + c]}; const float b1 = cb[256 + c], bv = cb[512 + c];
        const bool okm = t0 > 0, okp = t0 + 32 < L; const bf16* p1 = proj + (size_t)m0 * NINP + 3 * RGW + 256 + c; const bf16* pv = p1 + 256;
        bf16 r1[34], rv[34];
        r1[0] = p1[okm ? -(long)NINP : 0]; rv[0] = pv[okm ? -(long)NINP : 0];
#pragma unroll
        for (int j = 0; j < 32; ++j) { r1[j + 1] = p1[(size_t)j * NINP]; rv[j + 1] = pv[(size_t)j * NINP]; }
        r1[33] = p1[(size_t)(okp ? 32 : 31) * NINP]; rv[33] = pv[(size_t)(okp ? 32 : 31) * NINP];
        float p1f = okm ? bf2f_(r1[0]) : 0.f, pvf = okm ? bf2f_(rv[0]) : 0.f, c1 = bf2f_(r1[1]), cv = bf2f_(rv[1]);
        unsigned pk[16];
#pragma unroll
        for (int j = 0; j < 32; ++j) { float n1 = bf2f_(r1[j + 2]), nv = bf2f_(rv[j + 2]); if (j == 31 && !okp) { n1 = 0.f; nv = 0.f; }
            const float zz = (bv + wv[0] * pvf + wv[1] * cv + wv[2] * nv) * (b1 + w1[0] * p1f + w1[1] * c1 + w1[2] * n1);
            if (j & 1) pk[j >> 1] = pk_bf16(bf_lo(pk[j >> 1]), zz); else pk[j >> 1] = pk_bf16(zz, 0.f);
            p1f = c1; c1 = n1; pvf = cv; cv = nv; }
        u32x4* dst = (u32x4*)(zT + (size_t)c * M + m0);
#pragma unroll
        for (int j = 0; j < 4; ++j) dst[j] = (u32x4){pk[4 * j], pk[4 * j + 1], pk[4 * j + 2], pk[4 * j + 3]}; }
}
DEVFN void hy_channel(Frame& F, int l, int c) {
    const int lane = lane_id(), w = F.wave, tid = F.tid, h = lane >> 5, r = lane & 31;
    LAS unsigned char* FI = F.lds + HY_FI; LAS unsigned char* ZI = F.lds + HY_ZI;
    constexpr int ZTOT = Bn * HY_NA * 4, ZPT = (ZTOT + NT - 1) / NT; u32x4 zr[ZPT];
    { const bf16* zT = (const bf16*)((unsigned char*)F.out + OUT_ZT) + (size_t)c * M;
#pragma unroll
      for (int k = 0; k < ZPT; ++k) { const int i = tid + k * NT; zr[k] = (u32x4){0u, 0u, 0u, 0u};
          if (i < ZTOT) { const int j = i & 3, a = (i >> 2) % HY_NA, b = (i >> 2) / HY_NA; zr[k] = *(const u32x4*)(zT + (size_t)b * L + 32 * a + 8 * j); } } }
    { LAS float* KX = (LAS float*)ZI;
      const float* kf = (const float*)(F.ws + WS_KFB) + ((size_t)l * 512 + c) * L; const float* kb = kf + (size_t)256 * L; const float bias = FIN(29)[l * HYW + c];
      if (tid == 0) KX[0] = 0.f;
      for (int p4 = tid; p4 < L / 4; p4 += NT) { const f32x4 kfv = *(const f32x4*)(kf + 4 * p4), kbv = *(const f32x4*)(kb + 4 * p4);
#pragma unroll
          for (int e = 0; e < 4; ++e) { const int pos = 4 * p4 + e;
              if (pos == 0) KX[L] = kfv[e] + kbv[e] + bias; else { KX[L + pos] = kfv[e]; KX[L - pos] = kbv[e]; } } }
      sync_block();
      for (int i = tid; i < 4 * L; i += NT) { const int sg = i / L, u = 2 * (i % L); float v[2];
#pragma unroll
          for (int e = 0; e < 2; ++e) { const int ix = 2 * L - (u + e) - sg; v[e] = (ix >= 1 && ix <= 2 * L - 1) ? KX[ix] : 0.f; }
          *(LAS unsigned*)(FI + sg * HY_CPY + u * 2) = pk_bf16(v[0], v[1]); }
      sync_block(); }
    for (int i = tid; i < Bn * 2 * (HY_TA - 1) * 5; i += NT) { const int b = i / (2 * (HY_TA - 1) * 5), rr = i % (2 * (HY_TA - 1) * 5), blk = rr / 5, j = rr % 5, q = blk < HY_TA - 1 ? blk : blk + HY_NA;
        *(LAS u32x4*)(ZI + (b * HY_NBLK + q) * 80 + 16 * j) = (u32x4){0u, 0u, 0u, 0u}; }
#pragma unroll
    for (int k = 0; k < ZPT; ++k) { const int i = tid + k * NT;
        if (i < ZTOT) { const int j = i & 3, a = (i >> 2) % HY_NA, b = (i >> 2) / HY_NA; *(LAS u32x4*)(ZI + ((b * HY_NBLK + a + HY_TA - 1) * 80 + 16 * j)) = zr[k]; } }
    sync_block();
    bf16* yT = (bf16*)((unsigned char*)F.out + OUT_YT) + (size_t)c * M;
    const int sgm = (4 - (r & 3)) & 3;
    const f32x16 z16 = {0.f, 0.f, 0.f, 0.f, 0.f, 0.f, 0.f, 0.f, 0.f, 0.f, 0.f, 0.f, 0.f, 0.f, 0.f, 0.f};
    constexpr int NAQ = HY_NA / HY_TA, NBQ = (Bn + HY_TB - 1) / HY_TB, NIT = NAQ * ((NBQ + 1) / 2);
    for (int it = w; it < NIT; it += NWAVES) { const int aq = it % NAQ, bq0 = 2 * (it / NAQ), bq1 = bq0 + 1, al = r % HY_TA;
        const int a = aq * HY_TA + al, bb0 = bq0 * HY_TB + r / HY_TA, bb1 = bq1 * HY_TB + r / HY_TA; const bool ok0 = bb0 < Bn, ok1 = bq1 < NBQ && bb1 < Bn;
        const int dlo = aq * HY_TA - (HY_NA - 1), dhi = aq * HY_TA + HY_TA - 1;
        f32x16 acc0 = z16, acc1 = z16; OPAQUE16(acc0); OPAQUE16(acc1);
        int fa = sgm * HY_CPY + 2 * ((8 * h - r - 32 * dlo) - sgm + L);
        int za0 = ok0 ? ((bb0 * HY_NBLK + a - dlo + HY_TA - 1) * 80 + 16 * h) : 0;
        int za1 = ok1 ? ((bb1 * HY_NBLK + a - dlo + HY_TA - 1) * 80 + 16 * h) : 0;
        u32x4 ax[2], ay[2], b0x[2], b1x[2], b0y[2], b1y[2];
#ifdef CPU_EMU
#define HY_FILL(NA, NB0, NB1) do { _Pragma("unroll") for (int ks = 0; ks < 2; ++ks) { unsigned long long lo = *(const LAS unsigned long long*)(FI + fa + 32 * ks), hi = *(const LAS unsigned long long*)(FI + fa + 32 * ks + 8); \
                NA[ks] = (u32x4){(unsigned)lo, (unsigned)(lo >> 32), (unsigned)hi, (unsigned)(hi >> 32)}; \
                if (al == 0) { NB0[ks] = *(const LAS u32x4*)(ZI + za0 + 32 * ks); NB1[ks] = *(const LAS u32x4*)(ZI + za1 + 32 * ks); } } fa -= 64; za0 -= zd0; za1 -= zd1; } while (0)
#define HY_MMA(CA, CB0, CB1) do { bf16x8 a0 = __builtin_bit_cast(bf16x8, CA[0]), a1 = __builtin_bit_cast(bf16x8, CA[1]); \
            acc0 = mfma32(a0, __builtin_bit_cast(bf16x8, CB0[0]), acc0); acc1 = mfma32(a0, __builtin_bit_cast(bf16x8, CB1[0]), acc1); acc0 = mfma32(a1, __builtin_bit_cast(bf16x8, CB0[1]), acc0); acc1 = mfma32(a1, __builtin_bit_cast(bf16x8, CB1[1]), acc1); } while (0)
#define HY_STEP(CA, CB0, CB1, NA, NB0, NB1) do { HY_FILL(NA, NB0, NB1); HY_MMA(CA, CB0, CB1); } while (0)
#define HY_LAST(CA, CB0, CB1) HY_MMA(CA, CB0, CB1)
#define HY_FIRST(NA, NB0, NB1) do { const int al_ = al; { const int al = 0; (void)al_; HY_FILL(NA, NB0, NB1); } } while (0)
        int zd0 = ok0 ? 80 : 0, zd1 = ok1 ? 80 : 0;
#else
        unsigned vfa = (unsigned)(size_t)FI + (unsigned)fa, vz0 = (unsigned)(size_t)ZI + (unsigned)za0, vz1 = (unsigned)(size_t)ZI + (unsigned)za1; const unsigned zd0 = ok0 ? 80u : 0u, zd1 = ok1 ? 80u : 0u;
        const unsigned long long colmask = __builtin_amdgcn_ballot_w64(al == 0); unsigned long long svx;
#define HY_STEP(CA, CB0, CB1, NA, NB0, NB1) asm volatile( \
            "ds_read2_b64 %[na0], %[fa] offset1:1\n\tds_read2_b64 %[na1], %[fa] offset0:4 offset1:5\n\t" \
            "s_mov_b64 %[sv], exec\n\ts_mov_b64 exec, %[cm]\n\t" \
            "ds_read_b128 %[nb00], %[z0]\n\tds_read_b128 %[nb01], %[z0] offset:32\n\tds_read_b128 %[nb10], %[z1]\n\tds_read_b128 %[nb11], %[z1] offset:32\n\t" \
            "s_mov_b64 exec, %[sv]\n\t" \
            "v_add_u32 %[fa], 0xffffffc0, %[fa]\n\tv_sub_u32 %[z0], %[z0], %[d0]\n\tv_sub_u32 %[z1], %[z1], %[d1]\n\t" \
            "s_nop 1\n\t" \
            "v_mfma_f32_32x32x16_bf16 %[c0], %[ca0], %[cb00], %[c0]\n\tv_mfma_f32_32x32x16_bf16 %[c1], %[ca0], %[cb10], %[c1]\n\t" \
            "v_mfma_f32_32x32x16_bf16 %[c0], %[ca1], %[cb01], %[c0]\n\tv_mfma_f32_32x32x16_bf16 %[c1], %[ca1], %[cb11], %[c1]\n\t" \
            "s_waitcnt lgkmcnt(0)\n\ts_nop 3" \
            : [c0] "+v"(acc0), [c1] "+v"(acc1), [na0] "=&v"(NA[0]), [na1] "=&v"(NA[1]), [nb00] "+v"(NB0[0]), [nb01] "+v"(NB0[1]), [nb10] "+v"(NB1[0]), [nb11] "+v"(NB1[1]), \
              [fa] "+v"(vfa), [z0] "+v"(vz0), [z1] "+v"(vz1), [sv] "=&s"(svx) \
            : [ca0] "v"(CA[0]), [ca1] "v"(CA[1]), [cb00] "v"(CB0[0]), [cb01] "v"(CB0[1]), [cb10] "v"(CB1[0]), [cb11] "v"(CB1[1]), [d0] "v"(zd0), [d1] "v"(zd1), [cm] "s"(colmask) : "memory")
#define HY_LAST(CA, CB0, CB1) asm volatile( \
            "s_nop 1\n\tv_mfma_f32_32x32x16_bf16 %[c0], %[ca0], %[cb00], %[c0]\n\tv_mfma_f32_32x32x16_bf16 %[c1], %[ca0], %[cb10], %[c1]\n\t" \
            "v_mfma_f32_32x32x16_bf16 %[c0], %[ca1], %[cb01], %[c0]\n\tv_mfma_f32_32x32x16_bf16 %[c1], %[ca1], %[cb11], %[c1]\n\ts_nop 7\n\ts_nop 7\n\ts_nop 7" \
            : [c0] "+v"(acc0), [c1] "+v"(acc1) : [ca0] "v"(CA[0]), [ca1] "v"(CA[1]), [cb00] "v"(CB0[0]), [cb01] "v"(CB0[1]), [cb10] "v"(CB1[0]), [cb11] "v"(CB1[1]))
#define HY_FIRST(NA, NB0, NB1) asm volatile( \
            "ds_read2_b64 %[na0], %[fa] offset1:1\n\tds_read2_b64 %[na1], %[fa] offset0:4 offset1:5\n\t" \
            "ds_read_b128 %[nb00], %[z0]\n\tds_read_b128 %[nb01], %[z0] offset:32\n\tds_read_b128 %[nb10], %[z1]\n\tds_read_b128 %[nb11], %[z1] offset:32\n\t" \
            "v_add_u32 %[fa], 0xffffffc0, %[fa]\n\tv_sub_u32 %[z0], %[z0], %[d0]\n\tv_sub_u32 %[z1], %[z1], %[d1]\n\t" \
            "s_waitcnt lgkmcnt(0)\n\ts_nop 1" \
            : [na0] "=&v"(NA[0]), [na1] "=&v"(NA[1]), [nb00] "=&v"(NB0[0]), [nb01] "=&v"(NB0[1]), [nb10] "=&v"(NB1[0]), [nb11] "=&v"(NB1[1]), [fa] "+v"(vfa), [z0] "+v"(vz0), [z1] "+v"(vz1) \
            : [d0] "v"(zd0), [d1] "v"(zd1) : "memory")
#endif
#define HY_SHIFT(CB0, CB1, NB0, NB1) do { _Pragma("unroll") for (int ks = 0; ks < 2; ++ks) { \
            NB0[ks] = (u32x4){wave_shr1(CB0[ks].x), wave_shr1(CB0[ks].y), wave_shr1(CB0[ks].z), wave_shr1(CB0[ks].w)}; \
            NB1[ks] = (u32x4){wave_shr1(CB1[ks].x), wave_shr1(CB1[ks].y), wave_shr1(CB1[ks].z), wave_shr1(CB1[ks].w)}; } } while (0)
        HY_FIRST(ax, b0x, b1x);
        int d = dlo;
#pragma unroll 1
        for (; d + 2 <= dhi; d += 2) { HY_SHIFT(b0x, b1x, b0y, b1y); HY_STEP(ax, b0x, b1x, ay, b0y, b1y); HY_SHIFT(b0y, b1y, b0x, b1x); HY_STEP(ay, b0y, b1y, ax, b0x, b1x); }
        if (d == dhi) HY_LAST(ax, b0x, b1x);
        else { HY_SHIFT(b0x, b1x, b0y, b1y); HY_STEP(ax, b0x, b1x, ay, b0y, b1y); HY_LAST(ay, b0y, b1y); }
#undef HY_STEP
#undef HY_LAST
#undef HY_FIRST
#undef HY_SHIFT
#ifdef CPU_EMU
#undef HY_FILL
#undef HY_MMA
#endif
        if (ok0) {
#pragma unroll
            for (int q = 0; q < 4; ++q) *(u32x2*)(yT + (size_t)bb0 * L + 32 * a + 8 * q + 4 * h) = (u32x2){pk_bf16(acc0[4 * q], acc0[4 * q + 1]), pk_bf16(acc0[4 * q + 2], acc0[4 * q + 3])}; }
        if (ok1) {
#pragma unroll
            for (int q = 0; q < 4; ++q) *(u32x2*)(yT + (size_t)bb1 * L + 32 * a + 8 * q + 4 * h) = (u32x2){pk_bf16(acc1[4 * q], acc1[4 * q + 1]), pk_bf16(acc1[4 * q + 2], acc1[4 * q + 3])}; } }
    sync_block();
}
DEVFN void p_hy_main(Frame& F, int l) { int c0 = (int)blockIdx.x; OPAQUE_S(c0); for (int c = c0; c < HYW; c += F.G) hy_channel(F, l, c); }
DEVFN void p_hy_post(Frame& F, int l) {
    const bf16* proj = (const bf16*)(F.ws + WS_PROJ); const bf16* yT = (const bf16*)((unsigned char*)F.out + OUT_YT); bf16* ymix = (bf16*)(F.ws + WS_YMIX); const float* cw = FIN(20) + l * 3 * 768; const float* cb = FIN(21) + l * 768;
    for (int i = F.gtid; i < 256 * (M / 32); i += F.gsize) { const int c = i % 256, m0 = (i / 256) * 32, t0 = m0 % L;
        const float w0[3] = {cw[c], cw[768 + c], cw[1536 + c]}; const float b0 = cb[c];
        const bool okm = t0 > 0, okp = t0 + 32 < L; const bf16* p0p = proj + (size_t)m0 * NINP + 3 * RGW + c;
        bf16 r0[34]; u32x4 yv[4]; const u32x4* ys = (const u32x4*)(yT + (size_t)c * M + m0);
#pragma unroll
        for (int j8 = 0; j8 < 4; ++j8) yv[j8] = ys[j8];
        r0[0] = p0p[okm ? -(long)NINP : 0];
#pragma unroll
        for (int j = 0; j < 32; ++j) r0[j + 1] = p0p[(size_t)j * NINP];
        r0[33] = p0p[(size_t)(okp ? 32 : 31) * NINP];
        float p0 = okm ? bf2f_(r0[0]) : 0.f, c0 = bf2f_(r0[1]);
#pragma unroll
        for (int j = 0; j < 32; ++j) { float n0 = bf2f_(r0[j + 2]); if (j == 31 && !okp) n0 = 0.f;
            ymix[(size_t)(m0 + j) * D + RGW + S5W + c] = f2bf_(((j & 1) ? bf_hi(yv[j >> 3][(j >> 1) & 3]) : bf_lo(yv[j >> 3][(j >> 1) & 3])) * (b0 + w0[0] * p0 + w0[1] * c0 + w0[2] * n0)); p0 = c0; c0 = n0; } }
}
constexpr int NG16 = L / 16, NT32 = M / 32, CARRY_B = NG16 < 16 ? NG16 : 16;
DEVFN int tau32(int rho) { return 16 * ((rho >> 2) & 1) + (rho & 3) + 4 * (rho >> 3); }
DEVFN bf16x8 pack8(const f32x4 a, const f32x4 b) { u32x4 w; w.x = pk_bf16(a[0], a[1]); w.y = pk_bf16(a[2], a[3]); w.z = pk_bf16(b[0], b[1]); w.w = pk_bf16(b[2], b[3]); return __builtin_bit_cast(bf16x8, w); }
DEVFN void rg_item(Frame& F, int l, int it, int tile, int hd, int nt) {
    constexpr bool stage3 = false;
    const int lane = lane_id(), hh = lane >> 5, pl = lane & 31, m0 = tile * 32, b = m0 / L, t0 = m0 % L, grp = t0 / 16 + hh;
    const bf16* proj = (const bf16*)(F.ws + WS_PROJ); const float* cw = FIN(3) + l * 4 * RGW; const float* cb = FIN(4) + l * RGW;
    const f32x16 z16 = {0.f, 0.f, 0.f, 0.f, 0.f, 0.f, 0.f, 0.f, 0.f, 0.f, 0.f, 0.f, 0.f, 0.f, 0.f, 0.f};
    const bf16* WT = (const bf16*)(F.ws + WS_RGWT); f32x2* AG = (f32x2*)(F.ws + WS_RGAG);
    const int tt = t0 + tau32(pl); bf16x8 uf[4];
    const LAS float* CW = (const LAS float*)F.lds;
#pragma unroll
    for (int ks = 0; ks < 4; ++ks) { const int c0 = 64 * hd + 16 * ks + 8 * hh; f32x4 s0 = *(const LAS f32x4*)(CW + 4 * RGW + c0), s1 = *(const LAS f32x4*)(CW + 4 * RGW + c0 + 4);
#pragma unroll
        for (int k = 0; k < 4; ++k) { const int tk = tt + k - 1; const bool ok = (tk >= 0) && (tk < L);
            u32x4 x = {0u, 0u, 0u, 0u}; if (ok) x = *(const u32x4*)(proj + (size_t)(b * L + tk) * NINP + c0);
            const f32x4 w0 = *(const LAS f32x4*)(CW + k * RGW + c0), w1 = *(const LAS f32x4*)(CW + k * RGW + c0 + 4);
            s0 += w0 * (f32x4){bf_lo(x.x), bf_hi(x.x), bf_lo(x.y), bf_hi(x.y)}; s1 += w1 * (f32x4){bf_lo(x.z), bf_hi(x.z), bf_lo(x.w), bf_hi(x.w)}; }
        uf[ks] = pack8(s0, s1); }
    FRESH(uf[0]); FRESH(uf[1]); FRESH(uf[2]); FRESH(uf[3]);
#define RG_WOFF(d_, ks_) (((((size_t)(l * 2 + (d_)) * 2) * 6 + hd) * 64 + 32 * nt + pl) * 64 + 16 * (ks_) + 8 * hh)
    bf16x8 wA[2][4];
#pragma unroll
    for (int ks = 0; ks < 4; ++ks) { wA[0][ks] = *(const bf16x8*)(WT + RG_WOFF(0, ks)); wA[1][ks] = *(const bf16x8*)(WT + RG_WOFF(0, ks) + (size_t)6 * 4096); }
    const int c = 64 * hd + 32 * nt + pl;
    float bav2[2], bxv2[2], sp82[2];
#pragma unroll
    for (int d = 0; d < 2; ++d) { bav2[d] = CW[(5 + d) * RGW + c]; bxv2[d] = CW[(7 + d) * RGW + c]; sp82[d] = CW[(9 + d) * RGW + c]; }
    f32x16 uacc; { f32x16 zz = z16; OPAQUE16(zz); uacc = zz; }
    { bf16x8 idf[2];
#pragma unroll
      for (int q = 0; q < 2; ++q) { const int kk = pl - 16 * q - 8 * hh; u32x4 w;
          w.x = (kk >> 1) == 0 ? ((kk & 1) ? 0x3F800000u : 0x3F80u) : 0u; w.y = (kk >> 1) == 1 ? ((kk & 1) ? 0x3F800000u : 0x3F80u) : 0u;
          w.z = (kk >> 1) == 2 ? ((kk & 1) ? 0x3F800000u : 0x3F80u) : 0u; w.w = (kk >> 1) == 3 ? ((kk & 1) ? 0x3F800000u : 0x3F80u) : 0u;
          if (kk < 0 || kk > 7) w = (u32x4){0u, 0u, 0u, 0u};
          idf[q] = __builtin_bit_cast(bf16x8, w); }
      FRESH(idf[0]); FRESH(idf[1]);
      if (nt == 0) { uacc = mfma32(uf[0], idf[0], uacc); uacc = mfma32(uf[1], idf[1], uacc); MFMA_GUARD(ACC1(uacc), KV(uf[0]), KV(uf[1]), KV(idf[0]), KV(idf[1])); }
      else { uacc = mfma32(uf[2], idf[0], uacc); uacc = mfma32(uf[3], idf[1], uacc); MFMA_GUARD(ACC1(uacc), KV(uf[2]), KV(uf[3]), KV(idf[0]), KV(idf[1])); } }
    f32x16 hs = z16;
#pragma unroll
    for (int d = 0; d < 2; ++d) {
        f32x16 ga, gx; { f32x16 zz = z16; OPAQUE16(zz); ga = zz; f32x16 z2 = z16; OPAQUE16(z2); gx = z2; }
        bf16x8 wa[4], wx[4];
#pragma unroll
        for (int ks = 0; ks < 4; ++ks) { wa[ks] = wA[0][ks]; wx[ks] = wA[1][ks]; FRESH(wa[ks]); FRESH(wx[ks]); }
#pragma unroll
        for (int ks = 0; ks < 4; ++ks) { ga = mfma32(uf[ks], wa[ks], ga); gx = mfma32(uf[ks], wx[ks], gx); }
        MFMA_GUARD(ACC2(ga, gx), KV(uf[0]), KV(uf[1]), KV(uf[2]), KV(uf[3]), KV(wa[0]), KV(wa[1]), KV(wa[2]), KV(wa[3]), KV(wx[0]), KV(wx[1]), KV(wx[2]), KV(wx[3]));
        if (d == 0) {
#pragma unroll
            for (int ks = 0; ks < 4; ++ks) { wA[0][ks] = *(const bf16x8*)(WT + RG_WOFF(1, ks)); wA[1][ks] = *(const bf16x8*)(WT + RG_WOFF(1, ks) + (size_t)6 * 4096); } }
        const float bav = -1.4426950408889634f * bav2[d], bxv = -1.4426950408889634f * bxv2[d], sp8 = sp82[d];
        const float s2 = -1.4426950408889634f * sp8, sx = -2.0f * sp8;
        u32x4* ab = (u32x4*)(d == 0 ? F.ws + WS_RGAB0 : (unsigned char*)F.out + OUT_RGAB1) + (size_t)it * 256 + lane;
#pragma unroll
        for (int k = 0; k < 4; ++k) { u32x4 pk;
#pragma unroll
            for (int e = 0; e < 4; ++e) { const int reg = 4 * k + e; const float r = fast_rcp(1.0f + fast_exp2(ga[reg] + bav)), ig = fast_rcp(1.0f + fast_exp2(gx[reg] + bxv)), l2 = r * s2, x = r * sx, av = fast_exp2(l2);
                const float pm = -x * (1.0f + x * (0.5f + x * (0.16666667f + x * (0.041666668f + x * 0.008333334f))));
                const float om = fabsf(x) < 0.25f ? pm : 1.0f - av * av;
                ga[reg] = av; gx[reg] = fast_sqrt(om) * (ig * uacc[reg]); pk[e] = pk_bf16(l2, gx[reg]); }
            ab[64 * k] = pk; }
        const size_t aidx = (((size_t)b * NG16 + grp) * 2 + d) * RGW + c;
        if (!stage3) { float P = 1.f, H = 0.f;
#pragma unroll
            for (int q = 0; q < 16; ++q) { const int reg = d == 0 ? q : 15 - q; H = ga[reg] * H + gx[reg]; P *= ga[reg]; }
            AG[aidx] = (f32x2){P, H}; }
        else { float h = ((const float*)(F.ws + WS_RGCI))[aidx];
#pragma unroll
            for (int q = 0; q < 16; ++q) { const int reg = d == 0 ? q : 15 - q; h = ga[reg] * h + gx[reg]; hs[reg] += h; } } }
    if (stage3) { bf16* ymix = (bf16*)(F.ws + WS_YMIX);
#pragma unroll
        for (int reg = 0; reg < 16; ++reg) { const size_t m = (size_t)(m0 + 16 * hh + reg); ymix[m * D + c] = f2bf_(hs[reg] * gelu_f(bf2f_(proj[m * NINP + RGW + c]))); } }
#undef RG_WOFF
}
DEVFN void rg_item3(Frame& F, int l, int it) {
    const int lane = lane_id(), hh = lane >> 5, pl = lane & 31, tile = it / 12, r = it % 12, hd = r >> 1, nt = r & 1, m0 = tile * 32, b = m0 / L, t0 = m0 % L, grp = t0 / 16 + hh, c = 64 * hd + 32 * nt + pl;
    const bf16* proj = (const bf16*)(F.ws + WS_PROJ); bf16* ymix = (bf16*)(F.ws + WS_YMIX);
    u32x4 w0[4], w1[4];
    { const u32x4* a0 = (const u32x4*)(F.ws + WS_RGAB0) + (size_t)it * 256 + lane; const u32x4* a1 = (const u32x4*)((unsigned char*)F.out + OUT_RGAB1) + (size_t)it * 256 + lane;
#pragma unroll
      for (int k = 0; k < 4; ++k) { w0[k] = a0[64 * k]; w1[k] = a1[64 * k]; } }
    const float* CI = (const float*)(F.ws + WS_RGCI); float h0 = CI[(((size_t)b * NG16 + grp) * 2 + 0) * RGW + c], h1 = CI[(((size_t)b * NG16 + grp) * 2 + 1) * RGW + c];
    bf16 gt[16];
#pragma unroll
    for (int reg = 0; reg < 16; ++reg) gt[reg] = proj[(size_t)(m0 + 16 * hh + reg) * NINP + RGW + c];
    float hs[16];
#pragma unroll
    for (int q = 0; q < 16; ++q) { const unsigned w = w0[q >> 2][q & 3]; h0 = fast_exp2(bf_lo(w)) * h0 + bf_hi(w); hs[q] = h0; }
#pragma unroll
    for (int q = 0; q < 16; ++q) { const int reg = 15 - q; const unsigned w = w1[reg >> 2][reg & 3]; h1 = fast_exp2(bf_lo(w)) * h1 + bf_hi(w); hs[reg] += h1; }
#pragma unroll
    for (int reg = 0; reg < 16; ++reg) { const size_t m = (size_t)(m0 + 16 * hh + reg); ymix[m * D + c] = f2bf_(hs[reg] * gelu_f(bf2f_(gt[reg]))); }
}
DEVFN void p_rg_stage(Frame& F, int l, const bool stage3) {
    if (stage3) { for (int it = F.gw; it < NT32 * 12; it += F.ngw) rg_item3(F, l, it); return; }
    { LAS float* CW = (LAS float*)F.lds; const float* cw = FIN(3) + l * 4 * RGW; const float* cb = FIN(4) + l * RGW;
      const float* ba = FIN(6) + l * 2 * RGW; const float* bx = FIN(8) + l * 2 * RGW; const float* sp = (const float*)(F.ws + WS_RGSP) + l * 2 * RGW;
      for (int i = F.tid; i < 11 * RGW / 4; i += NT) { const int arr = i / (RGW / 4), ch = i % (RGW / 4);
          const float* src = arr < 4 ? cw + arr * RGW : (arr == 4 ? cb : (arr < 7 ? ba + (arr - 5) * RGW : (arr < 9 ? bx + (arr - 7) * RGW : sp + (arr - 9) * RGW)));
          *(LAS f32x4*)(CW + arr * RGW + 4 * ch) = *(const f32x4*)(src + 4 * ch); }
      sync_block(); }
    for (int it = F.gw; it < NT32 * 12; it += F.ngw) { const int r = it % 12; rg_item(F, l, it, it / 12, r >> 1, r & 1); } }
constexpr int CSEG = NG16 / 16 > 0 ? NG16 / 16 : 1, CLN = NG16 / CSEG;
DEVFN void p_rg_carry(Frame& F) {
    const f32x2* __restrict__ AG = (const f32x2*)(F.ws + WS_RGAG); float* __restrict__ CI = (float*)(F.ws + WS_RGCI); const int lane = lane_id(), sl = lane % CLN;
    for (int i0 = F.gw * (64 / CLN); i0 < Bn * 2 * RGW; i0 += F.ngw * (64 / CLN)) { const int i = i0 + lane / CLN; const bool ok = i < Bn * 2 * RGW;
        const int c = ok ? i % RGW : 0, d = ok ? (i / RGW) % 2 : 0, b = ok ? i / (2 * RGW) : 0;
        f32x2 sv[CSEG]; float P = 1.f, H = 0.f;
#pragma unroll
        for (int e = 0; e < CSEG; ++e) { const int q = sl * CSEG + e, j = d == 0 ? q : NG16 - 1 - q; sv[e] = AG[(((size_t)b * NG16 + j) * 2 + d) * RGW + c]; }
#pragma unroll
        for (int e = 0; e < CSEG; ++e) { H = sv[e][0] * H + sv[e][1]; P *= sv[e][0]; }
#pragma unroll
        for (int o = 1; o < CLN; o <<= 1) { const float Pp = shfl_f32(P, lane - o), Hp = shfl_f32(H, lane - o); if (sl >= o) { H = P * Hp + H; P = P * Pp; } }
        float Hin = shfl_f32(H, lane - 1); if (sl == 0) Hin = 0.f;
        if (ok) {
#pragma unroll
            for (int e = 0; e < CSEG; ++e) { const int q = sl * CSEG + e, j = d == 0 ? q : NG16 - 1 - q; CI[(((size_t)b * NG16 + j) * 2 + d) * RGW + c] = Hin; Hin = sv[e][0] * Hin + sv[e][1]; } } }
}
constexpr int S5_HS = 272  , S5_YS = 784  ;
struct S5Ops { bf16x8 bb[2][2]; f32x2 A[2]; f32x2 C[2]; };
DEVFN void s5_load_ops(S5Ops& o, const bf16* BT, const f32x2* SA, const f32x2* CIp, size_t dg, size_t sbase, int pl, int hh, const bool stage3) {
#pragma unroll
    for (int ri = 0; ri < 2; ++ri)
#pragma unroll
        for (int ph = 0; ph < 2; ++ph) o.bb[ri][ph] = *(const bf16x8*)(BT + ((dg * 2 + ri) * 64 + 32 * ph + pl) * 16 + 8 * hh);
#pragma unroll
    for (int ph = 0; ph < 2; ++ph) { o.A[ph] = SA[dg * 64 + 32 * ph + pl]; if (stage3) { const unsigned cw_ = ((const unsigned*)CIp)[sbase + 32 * ph]; o.C[ph] = (f32x2){bf_lo(cw_), bf_hi(cw_)}; } else o.C[ph] = (f32x2){0.f, 0.f}; }
}
DEVFN void s5_tile(Frame& F, int l, int tile, const bool stage3, const int slot) {
    const int lane = lane_id(), w = F.wave, hh = lane >> 5, pl = lane & 31, m0 = tile * 32, b = m0 / L, grp = (m0 % L) / 16 + hh;
    const bf16* proj = (const bf16*)(F.ws + WS_PROJ); const bf16* BT = (const bf16*)(F.ws + WS_S5BT); const bf16* CT = (const bf16*)(F.ws + WS_S5CT);
    const f32x2* SA = (const f32x2*)(F.ws + WS_S5A); f32x2* SS = (f32x2*)(F.ws + WS_S5S); const f32x2* CIp = (const f32x2*)(F.ws + WS_S5CI);
    LAS unsigned char* Hw = F.lds + w * (32 * S5_HS); LAS unsigned char* YT = F.lds + 8 * 32 * S5_HS + slot * (32 * S5_YS);
    const f32x16 z16 = {0.f, 0.f, 0.f, 0.f, 0.f, 0.f, 0.f, 0.f, 0.f, 0.f, 0.f, 0.f, 0.f, 0.f, 0.f, 0.f};
#define S5_DG(g_, d_) ((size_t)(l * 2 + (d_)) * 24 + (g_))
#define S5_SB(g_, d_) ((((size_t)b * NG16 + grp) * 2 + (d_)) * 1536 + (g_) * 64 + pl)
    S5Ops o0, o1; s5_load_ops(o0, BT, SA, CIp, S5_DG(w, 0), S5_SB(w, 0), pl, hh, stage3);
    bf16x8 ua = *(const bf16x8*)(proj + (size_t)(m0 + tau32(pl)) * NINP + 2 * RGW + 16 * w + 8 * hh);
#pragma unroll 1
    for (int gi = 0; gi < 3; ++gi) { const int g = w + 8 * gi, gn = g + 8;
        f32x4 yacc[2] = {(f32x4){0.f, 0.f, 0.f, 0.f}, (f32x4){0.f, 0.f, 0.f, 0.f}};
        bf16x8 uan = ua;
#pragma unroll
        for (int d = 0; d < 2; ++d) { const size_t dg = S5_DG(g, d);
            S5Ops& o = d == 0 ? o0 : o1;
            if (d == 0) s5_load_ops(o1, BT, SA, CIp, S5_DG(g, 1), S5_SB(g, 1), pl, hh, stage3);
            else if (gi < 2) { s5_load_ops(o0, BT, SA, CIp, S5_DG(gn, 0), S5_SB(gn, 0), pl, hh, stage3); uan = *(const bf16x8*)(proj + (size_t)(m0 + tau32(pl)) * NINP + 2 * RGW + 16 * gn + 8 * hh); }
            bf16x8 b2[2][4];
            if (stage3) {
#pragma unroll
                for (int rt = 0; rt < 2; ++rt)
#pragma unroll
                    for (int ks = 0; ks < 4; ++ks) b2[rt][ks] = *(const bf16x8*)(CT + (dg * 16 + (lane & 15)) * 128 + 32 * ks + 8 * (lane >> 4)); }
            f32x16 acc[2][2];
#ifdef CPU_EMU
            { acc[0][0] = mfma32(ua, o.bb[0][0], z16); acc[0][1] = mfma32(ua, o.bb[0][1], z16); acc[1][0] = mfma32(ua, o.bb[1][0], z16); acc[1][1] = mfma32(ua, o.bb[1][1], z16); }
#else
            asm volatile("s_nop 1\n\tv_mfma_f32_32x32x16_bf16 %0, %4, %5, 0\n\tv_mfma_f32_32x32x16_bf16 %1, %4, %6, 0\n\tv_mfma_f32_32x32x16_bf16 %2, %4, %7, 0\n\tv_mfma_f32_32x32x16_bf16 %3, %4, %8, 0\n\t"
                         "s_nop 7\n\ts_nop 7\n\ts_nop 7\n\ts_nop 7"
                         : "=&v"(acc[0][0]), "=&v"(acc[0][1]), "=&v"(acc[1][0]), "=&v"(acc[1][1]) : "v"(ua), "v"(o.bb[0][0]), "v"(o.bb[0][1]), "v"(o.bb[1][0]), "v"(o.bb[1][1]));
#endif
#pragma unroll
            for (int ph = 0; ph < 2; ++ph) { const f32x2 A = o.A[ph]; const size_t sidx = S5_SB(g, d) + 32 * ph;
                float hr = o.C[ph][0], hi = o.C[ph][1];
#pragma unroll
                for (int q = 0; q < 16; ++q) { const int reg = d == 0 ? q : 15 - q; const float nr = fnma_s(A[1], hi, fma_s(A[0], hr, acc[0][ph][reg])), ni = fma_s(A[1], hr, fma_s(A[0], hi, acc[1][ph][reg]));
                    hr = nr; hi = ni; acc[0][ph][reg] = nr; acc[1][ph][reg] = ni; }
                if (!stage3) ((unsigned*)SS)[sidx] = pk_bf16(hr, hi);
                else {
#pragma unroll
                    for (int reg = 0; reg < 16; ++reg) *(LAS unsigned*)(Hw + (16 * hh + reg) * S5_HS + 4 * (32 * ph + pl)) = pk_bf16(acc[0][ph][reg], acc[1][ph][reg]); } }
            if (stage3) { WAVE_LDS_FENCE();
#pragma unroll
                for (int rt = 0; rt < 2; ++rt) { bf16x8 a2[4];
#pragma unroll
                    for (int ks = 0; ks < 4; ++ks) a2[ks] = *(const LAS bf16x8*)(Hw + (16 * rt + (lane & 15)) * S5_HS + (32 * ks + 8 * (lane >> 4)) * 2);
                    FRESH(b2[rt][0]); FRESH(b2[rt][1]); FRESH(b2[rt][2]); FRESH(b2[rt][3]); FRESH(a2[0]); FRESH(a2[1]); FRESH(a2[2]); FRESH(a2[3]);
#pragma unroll
                    for (int ks = 0; ks < 4; ++ks) yacc[rt] = mfma16(a2[ks], b2[rt][ks], yacc[rt]);
                    MFMA_GUARD(ACC1(yacc[rt]), KV(a2[0]), KV(a2[1]), KV(a2[2]), KV(a2[3]), KV(b2[rt][0]), KV(b2[rt][1]), KV(b2[rt][2]), KV(b2[rt][3])); }
                WAVE_LDS_FENCE(); } }
        if (stage3) { const int c = lane & 15; const float dsk = FIN(17)[l * S5W + 16 * g + c];
#pragma unroll
            for (int rt = 0; rt < 2; ++rt)
#pragma unroll
                for (int reg = 0; reg < 4; ++reg) { const int t = 16 * rt + 4 * (lane >> 4) + reg; const float u = bf2f_(proj[(size_t)(m0 + t) * NINP + 2 * RGW + 16 * g + c]);
                    *(LAS bf16*)(YT + t * S5_YS + (16 * g + c) * 2) = f2bf_(gelu_f(yacc[rt][reg] + dsk * u)); } }
        ua = uan; }
#undef S5_DG
#undef S5_SB
}
DEVFN void s5_glu(Frame& F, int l, int tileA, int tileB) {
    const int lane = lane_id(), w = F.wave, hh = lane >> 5, pl = lane & 31, slot = w >> 2, wq = w & 3; const int tile = slot ? tileB : tileA;
    const f32x16 z16 = {0.f, 0.f, 0.f, 0.f, 0.f, 0.f, 0.f, 0.f, 0.f, 0.f, 0.f, 0.f, 0.f, 0.f, 0.f, 0.f};
    if (tile >= 0) { const int m0 = tile * 32; LAS unsigned char* YT = F.lds + 8 * 32 * S5_HS + slot * (32 * S5_YS);
        const bf16* WG = (const bf16*)(F.ws + WS_WGLU + l * SZ_WGLU); bf16* ymix = (bf16*)(F.ws + WS_YMIX);
        f32x16 ga[3] = {z16, z16, z16}; OPAQUE16(ga[0]); OPAQUE16(ga[1]); OPAQUE16(ga[2]);
        float gbias[3];
#pragma unroll
        for (int j = 0; j < 3; ++j) gbias[j] = FIN(19)[l * S5W + 32 * (wq + 4 * j) + pl];
        const bf16* wp[3];
#pragma unroll
        for (int j = 0; j < 3; ++j) wp[j] = WG + ((size_t)(wq + 4 * j) * 24 * 64 + lane) * 8;
#pragma unroll 1
        for (int c8 = 0; c8 < 3; ++c8) { bf16x8 bw[8][3];
#pragma unroll
            for (int q = 0; q < 8; ++q)
#pragma unroll
                for (int j = 0; j < 3; ++j) bw[q][j] = *(const bf16x8*)(wp[j] + 512 * (8 * c8 + q));
#pragma unroll
            for (int q = 0; q < 8; ++q) { const int ks = 8 * c8 + q; bf16x8 aq = *(const LAS bf16x8*)(YT + pl * S5_YS + (16 * ks + 8 * hh) * 2); bf16x8 bq[3] = {bw[q][0], bw[q][1], bw[q][2]};
                FRESH(bq[0]); FRESH(bq[1]); FRESH(bq[2]); FRESH(aq);
#pragma unroll
                for (int j = 0; j < 3; ++j) ga[j] = mfma32(aq, bq[j], ga[j]);
                MFMA_GUARD(ACC3(ga[0], ga[1], ga[2]), KV(aq), KV(bq[0]), KV(bq[1]), KV(bq[2])); } }
#pragma unroll
        for (int j = 0; j < 3; ++j) { const int n = 32 * (wq + 4 * j) + pl; const float bias = gbias[j];
#pragma unroll
            for (int reg = 0; reg < 16; ++reg) { const int t = (reg & 3) + 8 * (reg >> 2) + 4 * hh; const float y = bf2f_(*(const LAS bf16*)(YT + t * S5_YS + n * 2));
                ymix[(size_t)(m0 + t) * D + RGW + n] = f2bf_(y * sigmoid_f(ga[j][reg] + bias)); } } }
}
DEVFN void p_s5_stage(Frame& F, int l, const bool stage3) {
    int tile0 = (int)blockIdx.x; OPAQUE_S(tile0);
    if (!stage3) { for (int tile = tile0; tile < NT32; tile += F.G) s5_tile(F, l, tile, false, 0); return; }
    for (int tile = tile0; tile < NT32; tile += 2 * F.G) { const int tileB = tile + F.G < NT32 ? tile + F.G : -1;
        s5_tile(F, l, tile, true, 0); if (tileB >= 0) s5_tile(F, l, tileB, true, 1);
        sync_block(); s5_glu(F, l, tile, tileB); sync_block(); }
}
DEVFN void p_s5_carry(Frame& F, int l) {
    const f32x2* SS = (const f32x2*)(F.ws + WS_S5S); f32x2* CI = (f32x2*)(F.ws + WS_S5CI);       const f32x2* A16 = (const f32x2*)(F.ws + WS_S5A16); const int lane = lane_id(), sl = lane % CLN;
    for (int i0 = F.gw * (64 / CLN); i0 < Bn * 2 * 1536; i0 += F.ngw * (64 / CLN)) { const int i = i0 + lane / CLN; const bool ok = i < Bn * 2 * 1536;
        const int gp = ok ? i % 1536 : 0, d = ok ? (i / 1536) % 2 : 0, b = ok ? i / 3072 : 0; const f32x2 A = A16[(size_t)(l * 2 + d) * 1536 + gp];
        f32x2 sv[CSEG]; float hr = 0.f, hi = 0.f, pr = 1.f, pi = 0.f;
#pragma unroll
        for (int e = 0; e < CSEG; ++e) { const int q = sl * CSEG + e, j = d == 0 ? q : NG16 - 1 - q; { const unsigned sw_ = ((const unsigned*)SS)[(((size_t)b * NG16 + j) * 2 + d) * 1536 + gp]; sv[e] = (f32x2){bf_lo(sw_), bf_hi(sw_)}; } }
#pragma unroll
        for (int e = 0; e < CSEG; ++e) { const float nr = A[0] * hr - A[1] * hi + sv[e][0], ni = A[0] * hi + A[1] * hr + sv[e][1]; hr = nr; hi = ni; const float qr = A[0] * pr - A[1] * pi, qi = A[0] * pi + A[1] * pr; pr = qr; pi = qi; }
#pragma unroll
        for (int o = 1; o < CLN; o <<= 1) { const float Pr = shfl_f32(pr, lane - o), Pi = shfl_f32(pi, lane - o), Hr = shfl_f32(hr, lane - o), Hi = shfl_f32(hi, lane - o);
            if (sl >= o) { const float nr = pr * Hr - pi * Hi + hr, ni = pr * Hi + pi * Hr + hi; hr = nr; hi = ni; const float qr = pr * Pr - pi * Pi, qi = pr * Pi + pi * Pr; pr = qr; pi = qi; } }
        float cr = shfl_f32(hr, lane - 1), ci = shfl_f32(hi, lane - 1); if (sl == 0) { cr = 0.f; ci = 0.f; }
        if (ok) {
#pragma unroll
            for (int e = 0; e < CSEG; ++e) { const int q = sl * CSEG + e, j = d == 0 ? q : NG16 - 1 - q; ((unsigned*)CI)[(((size_t)b * NG16 + j) * 2 + d) * 1536 + gp] = pk_bf16(cr, ci);
                const float nr = A[0] * cr - A[1] * ci + sv[e][0], ni = A[0] * ci + A[1] * cr + sv[e][1]; cr = nr; ci = ni; } } }
}
DEVFN void row_ssq3(const u32x4 x0, const u32x4 x1, int lane, float& sa, float& sb, float& sc) {
    float s0, s1;
    { const float a0 = bf_lo(x0.x), a1 = bf_hi(x0.x), a2 = bf_lo(x0.y), a3 = bf_hi(x0.y), a4 = bf_lo(x0.z), a5 = bf_hi(x0.z), a6 = bf_lo(x0.w), a7 = bf_hi(x0.w); s0 = ((a0 * a0 + a1 * a1) + (a2 * a2 + a3 * a3)) + ((a4 * a4 + a5 * a5) + (a6 * a6 + a7 * a7)); }
    { const float a0 = bf_lo(x1.x), a1 = bf_hi(x1.x), a2 = bf_lo(x1.y), a3 = bf_hi(x1.y), a4 = bf_lo(x1.z), a5 = bf_hi(x1.z), a6 = bf_lo(x1.w), a7 = bf_hi(x1.w); s1 = ((a0 * a0 + a1 * a1) + (a2 * a2 + a3 * a3)) + ((a4 * a4 + a5 * a5) + (a6 * a6 + a7 * a7)); }
    sa = lane < 48 ? s0 : 0.f; sb = (lane >= 48 ? s0 : 0.f) + (lane < 32 ? s1 : 0.f); sc = lane >= 32 ? s1 : 0.f;
}
DEVFN float sq8(const u32x4 v) { const float a0 = bf_lo(v.x), a1 = bf_hi(v.x), a2 = bf_lo(v.y), a3 = bf_hi(v.y), a4 = bf_lo(v.z), a5 = bf_hi(v.z), a6 = bf_lo(v.w), a7 = bf_hi(v.w);
    return ((a0 * a0 + a1 * a1) + (a2 * a2 + a3 * a3)) + ((a4 * a4 + a5 * a5) + (a6 * a6 + a7 * a7)); }
DEVFN void mix_scales(Frame& F, int pm, LAS unsigned char* xl) {
    const bf16* ymix = (const bf16*)(F.ws + WS_YMIX); LAS float* TS = (LAS float*)xl; const int lane = F.lane, r8 = lane >> 3, q = lane & 7;
    float sa[4], sb[4], sc[4];
#pragma unroll
    for (int g2 = 0; g2 < 4; g2 += 2) { u32x4 v[2][16];
#pragma unroll
        for (int e = 0; e < 2; ++e) { const u32x4* rowp = (const u32x4*)(ymix + (size_t)(pm * 256 + F.wave * 32 + 8 * (g2 + e) + r8) * D) + q;
#pragma unroll
            for (int li = 0; li < 16; ++li) v[e][li] = rowp[8 * li]; }
#pragma unroll
        for (int e = 0; e < 2; ++e) { float a_ = 0.f, b_ = 0.f, c_ = 0.f;
#pragma unroll
            for (int li = 0; li < 16; ++li) { const float t = sq8(v[e][li]); if (li < 6) a_ += t; else if (li < 12) b_ += t; else c_ += t; }
            sa[g2 + e] = a_; sb[g2 + e] = b_; sc[g2 + e] = c_; } }
#pragma unroll
    for (int o = 1; o < 8; o <<= 1) {
#pragma unroll
        for (int g = 0; g < 4; ++g) { sa[g] += shfl_xor_f32(sa[g], o); sb[g] += shfl_xor_f32(sb[g], o); sc[g] += shfl_xor_f32(sc[g], o); } }
    if (q == 0) {
#pragma unroll
        for (int g = 0; g < 4; ++g) { const float ia = 1.0f / sqrtf(sa[g] * (1.0f / RGW) + 1e-6f), ib = 1.0f / sqrtf(sb[g] * (1.0f / S5W) + 1e-6f), ic = 1.0f / sqrtf(sc[g] * (1.0f / HYW) + 1e-6f);
            *(LAS f32x4*)(TS + (F.wave * 32 + 8 * g + r8) * 4) = (f32x4){ia / ib, ib / ic, ic, 0.f}; } }
    sync_block();
}
#ifdef TPROBE
DEVFN void p_tprobe(Frame& F) {
    if (blockIdx.x == 0 && F.tid < 101) { const unsigned long long* ts = (const unsigned long long*)(F.ws + WS_CTL + 8192);
        float da = (float)(ts[TPA + 1] - ts[TPA]) * 0.01f, db = (float)(ts[TPB + 1] - ts[TPB]) * 0.01f;
        da = expf(0.2231436f * rintf(logf(da) / 0.2231436f + TPOFF)); db = expf(0.2231436f * rintf(logf(db) / 0.2231436f + TPOFF));
        if (F.tid == 0) F.out[0] = 10.0f * da; else F.out[1024 + F.tid - 1] = db; }
}
#endif
DEVFN void p_final(Frame& F) {
    const float* ssq = (const float*)(F.ws + WS_SSQ); const bf16* hb = (const bf16*)(F.ws + WS_HB); const f32x4* g4 = (const f32x4*)FIN(37);
    f32x4 gv[4];
#pragma unroll
    for (int j = 0; j < 2; ++j) { gv[2 * j] = g4[2 * (F.lane + 64 * j)]; gv[2 * j + 1] = g4[2 * (F.lane + 64 * j) + 1]; }
    for (int m0 = 4 * F.gw; m0 < M; m0 += 4 * F.ngw) { u32x4 v[4][2]; float inv[4];
#pragma unroll
        for (int q = 0; q < 4; ++q) { const u32x4* hr = (const u32x4*)(hb + (size_t)(m0 + q) * D); v[q][0] = hr[F.lane]; v[q][1] = hr[F.lane + 64]; }
#pragma unroll
        for (int q = 0; q < 4; ++q) inv[q] = pg8::row_inv(ssq, m0 + q);
#pragma unroll
        for (int q = 0; q < 4; ++q) { f32x4* orow = (f32x4*)(F.out + (size_t)(m0 + q) * D);
#pragma unroll
            for (int j = 0; j < 2; ++j) { const int ch = F.lane + 64 * j; const u32x4 x = v[q][j];
                orow[2 * ch] = (f32x4){bf_lo(x.x), bf_hi(x.x), bf_lo(x.y), bf_hi(x.y)} * inv[q] * gv[2 * j]; orow[2 * ch + 1] = (f32x4){bf_lo(x.z), bf_hi(x.z), bf_lo(x.w), bf_hi(x.w)} * inv[q] * gv[2 * j + 1]; } } }
}
#ifdef TPROBE
#define TSTAMP(i) do { if (blockIdx.x == 0 && F.wave == 0 && lane_id() == 0) ((unsigned long long*)(args.ws + WS_CTL + 8192))[i] = __builtin_amdgcn_s_memrealtime(); } while (0)
#else
#define TSTAMP(i) do {} while (0)
#endif
#ifndef MK_N_LAUNCHES
#define MK_N_LAUNCHES 1
#endif
constexpr int PH_PER_LAYER = 7, N_PHASES = 2 + 2 * PH_PER_LAYER;
__global__ void __launch_bounds__(NT, 2) mk_fwd(Args args) {
#ifdef CPU_EMU
    unsigned char* lds = emu_lds_base();
#else
    extern __shared__ __attribute__((aligned(16))) unsigned char lds_[];
    LAS unsigned char* lds = (LAS unsigned char*)lds_;
#endif
    Frame F; F.lds = lds; F.tid = threadIdx.x; F.lane = F.tid & 63;
#ifdef CPU_EMU
    F.wave = F.tid >> 6;
#else
    F.wave = __builtin_amdgcn_readfirstlane(F.tid >> 6);
#endif
    F.G = gridDim.x; F.gtid = blockIdx.x * NT + F.tid; F.gsize = F.G * NT; F.gw = blockIdx.x * NWAVES + F.wave; F.ngw = F.G * NWAVES;
    #ifdef CPU_EMU
    F.ap = &args;
#else
    F.ap = (KARG_PTR)__builtin_amdgcn_kernarg_segment_ptr();
#endif
    F.out = args.out; F.ws = args.ws;
#ifndef CPU_EMU
    volatile LAS unsigned* MISC = (volatile LAS unsigned*)(lds + MISC_OFF);
    if (F.tid < 32) MISC[F.tid] = 0u;
    __syncthreads();
    XcdBarrier bar = xcd_barrier_post((unsigned*)(args.ws + WS_CTL) + CW_BAR, MISC + 8);
#define GRID_BAR() xcd_barrier(bar)
#else
#define GRID_BAR() do {} while (0)
#endif
    const int lo = args.ph_lo, hi = args.ph_hi;
#ifdef CPU_EMU
#define IN(k) (lo <= (k) && (k) < hi)
#else
#define IN(k) ([&]() { int lo_ = lo, hi_ = hi; asm volatile("" : "+s"(lo_), "+s"(hi_)); return lo_ <= (k) && (k) < hi_; }())
#endif
#define SEAM(k) do { if (IN(k) && IN((k) + 1)) GRID_BAR(); TSTAMP((k) + 1); } while (0)
#define P_SSQ ((float*)(F.ws + WS_SSQ))
#define P_HB ((bf16*)(F.ws + WS_HB))
#define P_PROJ ((bf16*)(F.ws + WS_PROJ))
#define P_YMIX ((bf16*)(F.ws + WS_YMIX))
#define P_G ((bf16*)(F.ws + WS_G))
    TSTAMP(0);
    { int l0 = 0; if (IN(0)) { LAUNDER(F, l0); p_prologue(F); } }
    SEAM(0);
    for (int lq = 0; lq < 2; ++lq) {
        int l = lq; const int p0 = 1 + lq * PH_PER_LAYER;
        if (IN(p0 + 0)) { LAUNDER(F, l);
            pg8::Gemm g{P_HB, (const bf16*)(F.ws + WS_WIN + l * SZ_WIN), D}; pg8::StaticOrder S; S.init(M / 256, NINP / 256, F.G, (int)blockIdx.x);
            pg8::EpiIn E{P_PROJ, P_SSQ};
            pg8::gemm_phase<pg8::EpiIn, pg8::StaticOrder, true, true>(lds, F.tid, g, S, E); }
        SEAM(p0 + 0);
        if (IN(p0 + 1)) { LAUNDER(F, l); p_hy_pre(F, l); p_rg_stage(F, l, false); p_s5_stage(F, l, false); }
        SEAM(p0 + 1);
        if (IN(p0 + 2)) { LAUNDER(F, l); p_s5_carry(F, l); p_rg_carry(F); p_hy_main(F, l); }
        SEAM(p0 + 2);
        if (IN(p0 + 3)) { LAUNDER(F, l); p_hy_post(F, l); p_rg_stage(F, l, true); p_s5_stage(F, l, true); }
        SEAM(p0 + 3);
        if (IN(p0 + 4)) { LAUNDER(F, l); pg8::Gemm g{P_YMIX, (const bf16*)(F.ws + WS_WOUT + l * SZ_WOUT), D}; pg8::StaticOrder S; S.init(M / 256, D / 256, F.G, (int)blockIdx.x);
            TSTAMP(20); pg8::Unit u0; if (S.next(0, u0)) mix_scales(F, u0.pm, lds + pg8::STAGE_BYTES); else sync_block();
            TSTAMP(21); pg8::EpiResMix E{F.out, P_HB, P_SSQ};
            pg8::gemm_phase<pg8::EpiResMix, pg8::StaticOrder, true, true>(lds, F.tid, g, S, E); TSTAMP(22); }
        SEAM(p0 + 4);
        if (IN(p0 + 5)) { LAUNDER(F, l); pg8::Gemm g{P_HB, (const bf16*)(F.ws + WS_WUP + l * SZ_WUP), D}; pg8::UpOrder S; S.init(Bn * NQ, FF2 / 256, F.G, (int)blockIdx.x);
            pg8::EpiUp E{P_G, P_SSQ, FIN(34) + (size_t)l * 3 * FF2, FIN(35) + (size_t)l * FF2};
            pg8::gemm_phase<pg8::EpiUp, pg8::UpOrder, true, true>(lds, F.tid, g, S, E); }
        SEAM(p0 + 5);
        if (IN(p0 + 6)) { LAUNDER(F, l); pg8::Gemm g{P_G, (const bf16*)(F.ws + WS_WDN + l * SZ_WDN), FF}; pg8::StaticOrder S; S.init(M / 256, D / 256, F.G, (int)blockIdx.x);
            pg8::EpiRes E{F.out, P_HB, P_SSQ};
            pg8::gemm_phase<pg8::EpiRes, pg8::StaticOrder, true, true>(lds, F.tid, g, S, E); }
        SEAM(p0 + 6);
    }
    { int l0 = 0; if (IN(N_PHASES - 1)) { LAUNDER(F, l0); p_final(F); } }
#ifdef TPROBE
    TSTAMP(N_PHASES); GRID_BAR(); { int l0 = 0; LAUNDER(F, l0); p_tprobe(F); }
#endif
#undef IN
#undef SEAM
}

extern "C" void kernel_launch(void* const* d_in, const int* in_sizes, int n_in, void* d_out, int out_size, void* d_ws, size_t ws_size, hipStream_t stream) {
    Args a{};
    for (int i = 0; i < 38; ++i) a.in[i] = (const float*)d_in[i];
    a.out = (float*)d_out; a.ws = (unsigned char*)d_ws;
#ifdef CPU_EMU
    const int grid = EMU_GRID;
    for (int ph = 0; ph < N_PHASES; ++ph) { a.ph_lo = ph; a.ph_hi = ph + 1; LAUNCH(mk_fwd, dim3(grid), dim3(NT), LDS_BYTES, stream, a); emu_phase_hook(ph, a); }
#else
    static int grid = 0;
    if (grid == 0) {
        if (n_in != 38 || out_size != M * D || ws_size < WS_END) { fprintf(stderr, "kernel_launch: unexpected shapes (n_in %d out %d ws %zu need %zu)\n", n_in, out_size, ws_size, (size_t)WS_END); grid = -1; return; }
        int dev = 0, cus = 0, per_cu = 0;
        if (hipGetDevice(&dev) != hipSuccess || hipDeviceGetAttribute(&cus, hipDeviceAttributeMultiprocessorCount, dev) != hipSuccess) { grid = -1; return; }
        if (hipFuncSetAttribute((const void*)mk_fwd, hipFuncAttributeMaxDynamicSharedMemorySize, LDS_BYTES) != hipSuccess) { fprintf(stderr, "kernel_launch: hipFuncSetAttribute failed\n"); grid = -1; return; }
        if (hipOccupancyMaxActiveBlocksPerMultiprocessor(&per_cu, (const void*)mk_fwd, NT, LDS_BYTES) != hipSuccess || per_cu < 1) { fprintf(stderr, "kernel_launch: occupancy query says %d\n", per_cu); (void)hipGetLastError(); per_cu = 1; }
        grid = cus;
    }
    if (grid < 0) return;
    (void)hipMemsetAsync((char*)d_ws + WS_CTL, 0, CTL_BYTES, stream);
#if MK_N_LAUNCHES == 1
    a.ph_lo = 0; a.ph_hi = N_PHASES;
    hipLaunchKernelGGL(mk_fwd, dim3(grid), dim3(NT), LDS_BYTES, stream, a);
#else
    for (int ph = 0; ph < N_PHASES; ++ph) { a.ph_lo = ph; a.ph_hi = ph + 1; hipLaunchKernelGGL(mk_fwd, dim3(grid), dim3(NT), LDS_BYTES, stream, a); }
#endif
#endif
}
```

```cpp
#ifdef CPU_EMU
#include "emu.h"
#define LAS
#define GAS
#define DEVFN static inline
#define MEMFN inline
#define WAVE_LDS_FENCE() emu::wave_sync()
#define OPAQUE16(x) do {} while (0)
#define OPAQUE_V(x) do {} while (0)
#define OPAQUE_S(x) do {} while (0)
#define FRESH(x) do {} while (0)
#define MFMA_GUARD(...) do {} while (0)
#define KV(x) 0
#define ACC1(a) 0
#define ACC2(a, b) 0
#define ACC3(a, b, c) 0
#define ACC4(a, b, c, d) 0
#else
#include <hip/hip_runtime.h>
#include <cstdio>
#include <cstdint>
#define LAS __attribute__((address_space(3)))
#define GAS __attribute__((address_space(1)))
#define DEVFN __device__ __forceinline__
#define MEMFN __device__ __forceinline__
#define WAVE_LDS_FENCE() do { asm volatile("s_waitcnt lgkmcnt(0)" ::: "memory"); } while (0)
#define OPAQUE16(x) asm volatile("" : "+v"(x))
#define OPAQUE_V(x) asm volatile("" : "+v"(x))
#define OPAQUE_S(x) asm volatile("" : "+s"(x))
#define FRESH(x) asm volatile("s_nop 1" : "+v"(x))
#define KV(x) "v"(x)
#define KA(x) "+v"(x)
#define MFMA_GUARD(accs, ...) asm volatile("s_nop 7\n\ts_nop 7\n\ts_nop 7\n\ts_nop 7" : accs : __VA_ARGS__)
#define ACC1(a) KA(a)
#define ACC2(a, b) KA(a), KA(b)
#define ACC3(a, b, c) KA(a), KA(b), KA(c)
#define ACC4(a, b, c, d) KA(a), KA(b), KA(c), KA(d)
typedef short bf16x8 __attribute__((ext_vector_type(8)));
typedef float f32x4 __attribute__((ext_vector_type(4)));
typedef float f32x2 __attribute__((ext_vector_type(2)));
typedef float f32x16 __attribute__((ext_vector_type(16)));
typedef unsigned u32x4 __attribute__((ext_vector_type(4)));
typedef unsigned u32x2 __attribute__((ext_vector_type(2)));
typedef __bf16 bf16x2_t __attribute__((ext_vector_type(2)));
DEVFN void sync_block() { __syncthreads(); }
DEVFN int lane_id() { int l; asm volatile("v_mbcnt_lo_u32_b32 %0, -1, 0\n\tv_mbcnt_hi_u32_b32 %0, -1, %0" : "=v"(l)); return l; }
DEVFN f32x16 mfma32(bf16x8 a, bf16x8 b, f32x16 c) { return __builtin_amdgcn_mfma_f32_32x32x16_bf16(a, b, c, 0, 0, 0); }
DEVFN f32x4 mfma16(bf16x8 a, bf16x8 b, f32x4 c) { return __builtin_amdgcn_mfma_f32_16x16x32_bf16(a, b, c, 0, 0, 0); }
DEVFN float shfl_f32(float v, int src) { return __builtin_bit_cast(float, __builtin_amdgcn_ds_bpermute(src << 2, __builtin_bit_cast(int, v))); }
DEVFN float shfl_xor_f32(float v, int m) { return shfl_f32(v, lane_id() ^ m); }
DEVFN float dpp_row_shr1(float old, float src) { return __builtin_bit_cast(float, __builtin_amdgcn_update_dpp(__builtin_bit_cast(int, old), __builtin_bit_cast(int, src), 0x111, 0xf, 0xf, false)); }
DEVFN float dpp_row_shl1(float old, float src) { return __builtin_bit_cast(float, __builtin_amdgcn_update_dpp(__builtin_bit_cast(int, old), __builtin_bit_cast(int, src), 0x101, 0xf, 0xf, false)); }
DEVFN float dpp_row_ror1(float src) { return __builtin_bit_cast(float, __builtin_amdgcn_update_dpp(0, __builtin_bit_cast(int, src), 0x121, 0xf, 0xf, false)); }
DEVFN float dpp_row_ror15(float src) { return __builtin_bit_cast(float, __builtin_amdgcn_update_dpp(0, __builtin_bit_cast(int, src), 0x12f, 0xf, 0xf, false)); }
DEVFN unsigned pk_bf16(float lo, float hi) { f32x2 v = {lo, hi}; bf16x2_t b = __builtin_convertvector(v, bf16x2_t); return __builtin_bit_cast(unsigned, b); }
DEVFN float bf_lo(unsigned u) { return __builtin_bit_cast(float, u << 16); }
DEVFN float bf_hi(unsigned u) { return __builtin_bit_cast(float, u & 0xffff0000u); }
DEVFN float fast_rcp(float x) { return __builtin_amdgcn_rcpf(x); }
DEVFN float sin_rev(float r) { return __builtin_amdgcn_sinf(r); }
DEVFN float cos_rev(float r) { return __builtin_amdgcn_cosf(r); }
DEVFN float fast_exp2(float x) { return __builtin_amdgcn_exp2f(x); }
DEVFN float fast_sqrt(float x) { return __builtin_amdgcn_sqrtf(x); }
DEVFN float fma_s(float a, float b, float c) { float r; asm("v_fma_f32 %0, %1, %2, %3" : "=v"(r) : "v"(a), "v"(b), "v"(c)); return r; }
DEVFN float fnma_s(float a, float b, float c) { float r; asm("v_fma_f32 %0, -%1, %2, %3" : "=v"(r) : "v"(a), "v"(b), "v"(c)); return r; }
DEVFN unsigned wave_shr1(unsigned v) { return (unsigned)__builtin_amdgcn_update_dpp(0, (int)v, 0x138, 0xf, 0xf, true); }
#endif
#ifdef CPU_EMU
static inline float fast_sqrt(float x) { return sqrtf(x); }
static inline float fma_s(float a, float b, float c) { return a * b + c; }
static inline float fnma_s(float a, float b, float c) { return c - a * b; }
static inline unsigned wave_shr1(unsigned v) { const int l = lane_id(); const unsigned r = shfl_u32(v, l - 1); return l == 0 ? 0u : r; }
#endif

#ifndef BATCH
#define BATCH 4
#endif
#ifndef SEQ
#define SEQ 4096
#endif
typedef unsigned short bf16;
constexpr int Bn = BATCH, L = SEQ, M = Bn * L, D = 1024, NIN = 1920, NINP = 2048, RGW = 384, S5W = 384, HYW = 256, FF = 2816, FF2 = 5632, GLUP = 512;
constexpr int NWAVES = 8, NT = NWAVES * 64;
constexpr int UPS = 254, NQ = (L + UPS - 1) / UPS;

constexpr size_t al256(size_t x) { return (x + 255) & ~(size_t)255; }
constexpr size_t WS_CTL = 0, CTL_BYTES = 1u << 20;
constexpr size_t WS_SSQ = WS_CTL + CTL_BYTES, SZ_SSQ = (size_t)M * 16 * 4;
constexpr size_t WS_S5A = WS_SSQ + SZ_SSQ, SZ_S5A = (size_t)2 * 2 * 24 * 64 * 8;
constexpr size_t WS_S5A16 = WS_S5A + SZ_S5A;
constexpr size_t WS_S5BT = WS_S5A16 + SZ_S5A, SZ_S5BT = (size_t)2 * 2 * 24 * 2 * 64 * 16 * 2;
constexpr size_t WS_S5CT = WS_S5BT + SZ_S5BT, SZ_S5CT = (size_t)2 * 2 * 24 * 16 * 128 * 2;
constexpr size_t WS_RGSP = WS_S5CT + SZ_S5CT, SZ_RGSP = al256((size_t)2 * 2 * 384 * 4);
constexpr size_t WS_RGWT = WS_RGSP + SZ_RGSP, SZ_RGWT = (size_t)2 * 2 * 2 * 6 * 64 * 64 * 2;
constexpr size_t WS_RGAG = WS_RGWT + SZ_RGWT, SZ_RGAG = (size_t)(M / 16) * 2 * RGW * 8;
constexpr size_t WS_RGCI = WS_RGAG + SZ_RGAG, SZ_RGCI = (size_t)(M / 16) * 2 * RGW * 4;
constexpr size_t WS_HID = WS_RGCI + SZ_RGCI, SZ_HID = 0;
constexpr size_t WS_T1 = WS_HID + SZ_HID, SZ_T1 = (size_t)(M / 16) * 2 * 1536 * 8;
constexpr size_t WS_S5S = WS_T1;
constexpr size_t WS_S5CI = WS_T1;
constexpr size_t WS_RGAB0 = WS_T1 + SZ_T1, SZ_RGAB = (size_t)M * RGW * 4;
constexpr size_t WS_KFB = WS_RGAB0 + SZ_RGAB, SZ_KFB = (size_t)2 * 512 * L * 4;
constexpr size_t SZ_WIN = (size_t)NINP * D * 2, SZ_WOUT = (size_t)D * D * 2, SZ_WUP = (size_t)FF2 * D * 2, SZ_WDN = (size_t)D * FF * 2, SZ_WGLU = (size_t)GLUP * S5W * 2;
constexpr size_t WS_WIN = WS_KFB + SZ_KFB, WS_WOUT = WS_WIN + 2 * SZ_WIN, WS_WUP = WS_WOUT + 2 * SZ_WOUT, WS_WDN = WS_WUP + 2 * SZ_WUP, WS_WGLU = WS_WDN + 2 * SZ_WDN;
constexpr size_t WS_HBPAD = WS_WGLU + 2 * SZ_WGLU, HB_FRONT = (size_t)256 * D * 2, WS_HB = WS_HBPAD + HB_FRONT, SZ_HBPAD = (size_t)(M + 768) * D * 2;
constexpr size_t WS_PROJ = WS_HBPAD + SZ_HBPAD, SZ_PROJ = (size_t)M * NINP * 2;
constexpr size_t WS_YMIX = WS_PROJ + SZ_PROJ, SZ_YMIX = (size_t)M * D * 2;
constexpr size_t WS_G = WS_PROJ;
constexpr size_t WS_END = WS_YMIX + SZ_YMIX;
constexpr size_t OUT_ZT = 0, OUT_YT = (size_t)M * 256 * 2, OUT_RGAB1 = (size_t)M * 256 * 6;
static_assert(SZ_PROJ + SZ_YMIX >= (size_t)M * FF * 2, "g overlay");
static_assert((size_t)M * 256 * 6 + SZ_RGAB <= (size_t)M * D * 4, "zT/yT/RG pairs in d_out");
static_assert(SZ_RGAB <= SZ_T1 || true, "");
static_assert(BATCH != 4 || SEQ != 4096 || WS_END <= ((size_t)256 << 20), "workspace over 256 MiB");

DEVFN float gelu_f(float x) { const float y = 1.5957691216057308f * (x + 0.044715f * x * x * x); return x * fast_rcp(1.0f + fast_exp2(-1.4426950408889634f * y)); }
DEVFN float sigmoid_f(float x) { return fast_rcp(1.0f + fast_exp2(-1.4426950408889634f * x)); }
DEVFN float softplus_f(float x) { return x > 0.f ? x + log1pf(expf(-x)) : log1pf(expf(x)); }
DEVFN float exp_f(float x) { return fast_exp2(1.4426950408889634f * x); }
DEVFN float expm1_f(float x) {
    const float p = x * (1.0f + x * (0.5f + x * (0.16666667f + x * (0.041666668f + x * (0.008333334f + x * 0.0013888889f)))));
    return fabsf(x) < 0.25f ? p : exp_f(x) - 1.0f; }
DEVFN float bf2f_(bf16 h) { return bf_lo((unsigned)h); }
DEVFN bf16 f2bf_(float f) { return (bf16)(pk_bf16(f, 0.f) & 0xffffu); }

namespace pg8 {
constexpr int BM = 256, BK = 64, HALF = 128, HTB = HALF * BK * 2, STAGE_BYTES = 8 * HTB, NXCD = 8, WGM = 8;
__host__ __device__ __forceinline__ int lds_byte(int r, int c) { const int st = (r >> 4) * 2 + (c >> 5), rr = r & 15, cc = c & 31, ob = rr * 64 + cc * 2; return st * 1024 + (ob ^ (((ob >> 9) & 1) << 5)); }
__host__ __device__ __forceinline__ void stage_rc(int b, int& R, int& C) { const int st = b / 1024, sb = b % 1024, swz = sb ^ (((sb >> 9) & 1) << 5); R = (st >> 1) * 16 + swz / 64; C = (st & 1) * 32 + (swz % 64) / 2; }
__host__ __device__ __forceinline__ int perm32(int rho) { const int n = rho >> 4, i = rho & 15; return 8 * (i >> 2) + 4 * n + (i & 3); }

struct Unit { int pm, pn; int arow; };
struct Gemm { const bf16* A; const bf16* Bt; int K; };

struct StaticOrder {
    int nM, nN, nwg, G, c;
    __host__ __device__ __forceinline__ void init(int nM_, int nN_, int G_, int c_) { nM = nM_; nN = nN_; nwg = nM * nN; G = G_; c = c_; }
    __host__ __device__ __forceinline__ bool next(int i, Unit& u) const {
        const long Lx = (long)i * G + c; if (Lx >= nwg) return false;
        int wgid = (int)Lx; { const int q = nwg / NXCD, r = nwg % NXCD, xcd = wgid % NXCD, off = wgid / NXCD; wgid = (xcd < r ? xcd * (q + 1) : r * (q + 1) + (xcd - r) * q) + off; }
        const int nig = WGM * nN, gid = wgid / nig, fm = gid * WGM, gsz = (nM - fm) < WGM ? (nM - fm) : WGM;
        u.pm = fm + ((wgid % nig) % gsz); u.pn = (wgid % nig) / gsz; u.arow = u.pm * BM; return true;
    }
};
struct UpOrder : StaticOrder {
    __host__ __device__ __forceinline__ bool next(int i, Unit& u) const { if (!StaticOrder::next(i, u)) return false; const int b = u.pm / NQ, q = u.pm % NQ; u.arow = b * L + UPS * q - 1; return true; }
};

#ifndef CPU_EMU
#define PG8_LAS __attribute__((address_space(3)))
template <class Epi, class Sched, bool ALIGN_EPI = false, bool SP2 = false>
__device__ __forceinline__ void gemm_phase(PG8_LAS unsigned char* lds, const int tid, const Gemm g, const Sched& S, const Epi& E) {
    const int wid = __builtin_amdgcn_readfirstlane(tid >> 6), lane = tid & 63, wr = wid >> 2, wc = wid & 3, fr = lane & 15, fq = lane >> 4;
    const int K = g.K, nt = K / BK;
    unsigned voffA[2], voffB[2];
#pragma unroll
    for (int i = 0; i < 2; ++i) { int R, C; stage_rc(tid * 16 + i * 8192, R, C); const int Rb = Epi::PERM ? ((R & ~31) + perm32(R & 31)) : R;
        const int Ra = Epi::APERM ? ((R & ~63) + 4 * (R & 15) + ((R >> 4) & 3)) : R;
        voffA[i] = (unsigned)(Ra * K + C) * 2u; voffB[i] = (unsigned)(Rb * K + C) * 2u; }
    const size_t kstep = (size_t)(BK * 2);
    const size_t hstep = (size_t)HALF * K * 2;
    const size_t tstep = 2 * hstep;
    const size_t rstep = (size_t)K * 2;
    const unsigned ldsw = (unsigned)wid * 1024u;
    const int aoff = lds_byte(wr * 64 + fr, fq * 8), boff = lds_byte(wc * 32 + fr, fq * 8);
#define PG8_SA(b, h) (((b) * 2 + (h)) * HTB)
#define PG8_SB(b, h) ((4 + (b) * 2 + (h)) * HTB)
#define PG8_STAGE(bufoff, gbase, voff) do { _Pragma("unroll") for (int _i = 0; _i < 2; ++_i) \
        __builtin_amdgcn_global_load_lds((const unsigned*)((const char*)(gbase) + (voff)[_i]), (PG8_LAS unsigned*)(lds + (bufoff) + ldsw + _i * 8192), 16, 0, 0); } while (0)
#define PG8_LDA(dst, b, h) do { _Pragma("unroll") for (int m = 0; m < 4; ++m) _Pragma("unroll") for (int k = 0; k < 2; ++k) dst[m][k] = *(const PG8_LAS bf16x8*)(lds + PG8_SA(b, h) + aoff + m * 2048 + k * 1024); } while (0)
#define PG8_LDB(dst, b, h) do { _Pragma("unroll") for (int n = 0; n < 2; ++n) _Pragma("unroll") for (int k = 0; k < 2; ++k) dst[n][k] = *(const PG8_LAS bf16x8*)(lds + PG8_SB(b, h) + boff + n * 2048 + k * 1024); } while (0)
#define PG8_MMA(ai, bj, At, Bt) do { __builtin_amdgcn_s_setprio(1); _Pragma("unroll") for (int m = 0; m < 4; ++m) _Pragma("unroll") for (int n = 0; n < 2; ++n) _Pragma("unroll") for (int k = 0; k < 2; ++k) \
        acc[ai][bj][m][n] = __builtin_amdgcn_mfma_f32_16x16x32_bf16(Bt[n][k], At[m][k], acc[ai][bj][m][n], 0, 0, 0); __builtin_amdgcn_s_setprio(0); } while (0)
#define PG8_WAIT_V(n) asm volatile("s_waitcnt vmcnt(" #n ")" ::: "memory")
#define PG8_WAIT_L(n) asm volatile("s_waitcnt lgkmcnt(" #n ")" ::: "memory")
#define PG8_BAR __builtin_amdgcn_s_barrier()
#define PG8_SCHED __builtin_amdgcn_sched_barrier(0)
    Unit cur, nxt; int ui = 0;
    if (!S.next(0, cur)) return;
    f32x4 acc[2][2][4][2];
#pragma unroll
    for (int a = 0; a < 2; ++a)
#pragma unroll
        for (int b = 0; b < 2; ++b)
#pragma unroll
            for (int m = 0; m < 4; ++m)
#pragma unroll
                for (int n = 0; n < 2; ++n) acc[a][b][m][n] = (f32x4){0.f, 0.f, 0.f, 0.f};
    bf16x8 At[4][2], B0[2][2], B1[2][2];
    const char* cA = (const char*)g.A + (long)cur.arow * (long)rstep; const char* cB = (const char*)g.Bt + (size_t)cur.pn * tstep;
    if constexpr (SP2) {
        PG8_STAGE(PG8_SB(0, 0), cB, voffB); PG8_STAGE(PG8_SB(0, 1), cB + hstep, voffB); PG8_STAGE(PG8_SA(0, 0), cA, voffA); PG8_STAGE(PG8_SA(0, 1), cA + hstep, voffA);
        if (wr == 1) PG8_BAR;
        PG8_WAIT_V(2); PG8_BAR;
        PG8_STAGE(PG8_SB(1, 0), cB + kstep, voffB); PG8_STAGE(PG8_SA(1, 0), cA + kstep, voffA); PG8_STAGE(PG8_SB(1, 1), cB + hstep + kstep, voffB);
        PG8_WAIT_V(6); PG8_BAR;
    } else {
        PG8_STAGE(PG8_SB(0, 0), cB, voffB); PG8_STAGE(PG8_SA(0, 0), cA, voffA); PG8_STAGE(PG8_SB(0, 1), cB + hstep, voffB); PG8_STAGE(PG8_SA(0, 1), cA + hstep, voffA);
        if (wr == 1) PG8_BAR;
        PG8_WAIT_V(4); PG8_BAR;
        PG8_STAGE(PG8_SB(1, 0), cB + kstep, voffB); PG8_STAGE(PG8_SA(1, 0), cA + kstep, voffA); PG8_STAGE(PG8_SB(1, 1), cB + hstep + kstep, voffB);
        PG8_WAIT_V(6); PG8_BAR;
    }
    for (;;) {
        const bool has_next = S.next(ui + 1, nxt);
        const char* nA = has_next ? (const char*)g.A + (long)nxt.arow * (long)rstep : cA; const char* nB = has_next ? (const char*)g.Bt + (size_t)nxt.pn * tstep : cB;
        for (int t = 0; t < nt; t += 2) {
            const bool last = (t == nt - 2);
            const char* a1 = cA + (size_t)(t + 1) * kstep;
            const char* a2 = last ? nA : cA + (size_t)(t + 2) * kstep; const char* b2 = last ? nB : cB + (size_t)(t + 2) * kstep;
            const char* a3 = a2 + kstep; const char* b3 = b2 + kstep;
            if constexpr (Epi::RESCALE) { if (t == Epi::T1 || t == Epi::T2) E.rescale(acc, t == Epi::T1 ? 0 : 1, wr, tid & 15, lds + STAGE_BYTES); }
            if constexpr (SP2) {
            PG8_LDB(B0, 0, 0); PG8_LDB(B1, 0, 1); PG8_SCHED; PG8_LDA(At, 0, 0); PG8_STAGE(PG8_SA(1, 1), a1 + hstep, voffA);
            PG8_WAIT_V(8); PG8_WAIT_L(0); PG8_BAR; PG8_MMA(0, 0, At, B0); PG8_MMA(0, 1, At, B1); PG8_BAR; PG8_SCHED;
            PG8_LDA(At, 0, 1); PG8_STAGE(PG8_SB(0, 0), b2, voffB); PG8_STAGE(PG8_SB(0, 1), b2 + hstep, voffB); PG8_STAGE(PG8_SA(0, 0), a2, voffA);
            PG8_WAIT_V(8); PG8_WAIT_L(0); PG8_BAR; PG8_MMA(1, 0, At, B0); PG8_MMA(1, 1, At, B1); PG8_BAR; PG8_SCHED;
            PG8_LDB(B0, 1, 0); PG8_LDB(B1, 1, 1); PG8_SCHED; PG8_LDA(At, 1, 0); PG8_STAGE(PG8_SA(0, 1), a2 + hstep, voffA);
            PG8_WAIT_V(8); PG8_WAIT_L(0); PG8_BAR; PG8_MMA(0, 0, At, B0); PG8_MMA(0, 1, At, B1); PG8_BAR; PG8_SCHED;
            PG8_LDA(At, 1, 1); PG8_STAGE(PG8_SB(1, 0), b3, voffB); PG8_STAGE(PG8_SB(1, 1), b3 + hstep, voffB); PG8_STAGE(PG8_SA(1, 0), a3, voffA);
            PG8_WAIT_V(8); PG8_WAIT_L(0); PG8_BAR; PG8_MMA(1, 0, At, B0); PG8_MMA(1, 1, At, B1); PG8_BAR; PG8_SCHED;
            } else {
            PG8_LDB(B0, 0, 0); PG8_SCHED; PG8_LDA(At, 0, 0); PG8_STAGE(PG8_SA(1, 1), a1 + hstep, voffA);
            PG8_WAIT_L(8); PG8_BAR; PG8_WAIT_L(0); PG8_MMA(0, 0, At, B0); PG8_BAR; PG8_SCHED;
            PG8_LDB(B1, 0, 1); PG8_STAGE(PG8_SB(0, 0), b2, voffB);
            PG8_BAR; PG8_WAIT_L(0); PG8_MMA(0, 1, At, B1); PG8_BAR;
            PG8_LDA(At, 0, 1); PG8_STAGE(PG8_SA(0, 0), a2, voffA);
            PG8_BAR; PG8_WAIT_L(0); PG8_MMA(1, 0, At, B0); PG8_BAR; PG8_SCHED;
            PG8_STAGE(PG8_SB(0, 1), b2 + hstep, voffB);
            PG8_WAIT_V(6); PG8_BAR; PG8_MMA(1, 1, At, B1); PG8_BAR;
            PG8_LDB(B0, 1, 0); PG8_SCHED; PG8_LDA(At, 1, 0); PG8_STAGE(PG8_SA(0, 1), a2 + hstep, voffA);
            PG8_WAIT_L(8); PG8_BAR; PG8_WAIT_L(0); PG8_MMA(0, 0, At, B0); PG8_BAR; PG8_SCHED;
            PG8_LDB(B1, 1, 1); PG8_STAGE(PG8_SB(1, 0), b3, voffB);
            PG8_BAR; PG8_WAIT_L(0); PG8_MMA(0, 1, At, B1); PG8_BAR;
            PG8_LDA(At, 1, 1); PG8_STAGE(PG8_SA(1, 0), a3, voffA);
            PG8_BAR; PG8_WAIT_L(0); PG8_MMA(1, 0, At, B0); PG8_BAR; PG8_SCHED;
            PG8_STAGE(PG8_SB(1, 1), b3 + hstep, voffB);
            PG8_WAIT_V(6); PG8_BAR; PG8_MMA(1, 1, At, B1); PG8_BAR;
            }
        }
        if constexpr (ALIGN_EPI) { if (wr == 0) PG8_BAR; }
        { int t_ = tid; asm volatile("" : "+v"(t_));
          E(acc, cur, wr, wc, t_ & 15, (t_ >> 4) & 3, lds + STAGE_BYTES); }
        if (!has_next) break;
#pragma unroll
        for (int a = 0; a < 2; ++a)
#pragma unroll
            for (int b = 0; b < 2; ++b)
#pragma unroll
                for (int m = 0; m < 4; ++m)
#pragma unroll
                    for (int n = 0; n < 2; ++n) acc[a][b][m][n] = (f32x4){0.f, 0.f, 0.f, 0.f};
        cur = nxt; cA = nA; cB = nB; ++ui;
        if constexpr (ALIGN_EPI) { if (wr == 1) PG8_BAR; }
    }
    PG8_WAIT_V(0);
    if constexpr (!ALIGN_EPI) { if (wr == 0) PG8_BAR; }
    PG8_BAR;
#undef PG8_SA
#undef PG8_SB
#undef PG8_STAGE
#undef PG8_LDA
#undef PG8_LDB
#undef PG8_MMA
#undef PG8_WAIT_V
#undef PG8_WAIT_L
#undef PG8_BAR
#undef PG8_SCHED
}
#else
template <class Epi, class Sched, bool ALIGN_EPI = false, bool SP2 = false>
static inline void gemm_phase(unsigned char* lds, const int tid, const Gemm g, const Sched& S, const Epi& E) {
    const int wid = tid >> 6, lane = tid & 63, wr = wid >> 2, wc = wid & 3, fr = lane & 15, fq = lane >> 4;
    static thread_local std::vector<float> Af, Bf;
    Unit cur;
    for (int ui = 0; S.next(ui, cur); ++ui) {
        const int K = g.K;
        sync_block();
        if (tid == 0) { Af.resize((size_t)256 * K); Bf.resize((size_t)256 * K);
            for (int r = 0; r < 256; ++r) for (int k = 0; k < K; ++k) { Af[(size_t)r * K + k] = bf2f_(g.A[((long)cur.arow + r) * K + k]); Bf[(size_t)r * K + k] = bf2f_(g.Bt[((size_t)cur.pn * 256 + r) * K + k]); } }
        sync_block();
        f32x4 acc[2][2][4][2];
        for (int ai = 0; ai < 2; ++ai) for (int bj = 0; bj < 2; ++bj) for (int m = 0; m < 4; ++m) for (int n = 0; n < 2; ++n) for (int e = 0; e < 4; ++e) {
            const int r = 128 * ai + 64 * wr + (Epi::APERM ? 4 * fr + m : 16 * m + fr), c = 128 * bj + 32 * wc + (Epi::PERM ? 8 * fq + 4 * n + e : 16 * n + 4 * fq + e);
            const float* a = &Af[(size_t)r * K]; const float* b = &Bf[(size_t)c * K]; float s = 0.f;
            if constexpr (Epi::RESCALE) { const float* TS = (const float*)(lds + STAGE_BYTES) + r * 4;
                for (int k = 0; k < K; ++k) { if (k == 64 * Epi::T1) s *= TS[0]; if (k == 64 * Epi::T2) s *= TS[1]; s += a[k] * b[k]; } }
            else for (int k = 0; k < K; ++k) s += a[k] * b[k];
            acc[ai][bj][m][n][e] = s; }
        E(acc, cur, wr, wc, fr, fq, lds + STAGE_BYTES);
    }
    sync_block();
}
#endif

DEVFN float row_inv(const float* ssq, int row) {
    const f32x4* p = (const f32x4*)(ssq + (size_t)row * 16); const f32x4 a = p[0], b = p[1], c = p[2], d = p[3];
    const float s = ((a[0] + a[1]) + (a[2] + a[3])) + ((b[0] + b[1]) + (b[2] + b[3])) + ((c[0] + c[1]) + (c[2] + c[3])) + ((d[0] + d[1]) + (d[2] + d[3]));
    return 1.0f / sqrtf(s * (1.0f / D) + 1e-6f);
}
template <class ValidFn> DEVFN void unit_row_inv(LAS float* RI, const float* ssq, int tid, long rowbase, ValidFn valid) {
    if (tid < 256) { const long row = rowbase + tid; RI[tid] = valid(tid) ? row_inv(ssq, (int)row) : 0.f; }
#ifdef CPU_EMU
    sync_block();
#else
    asm volatile("s_waitcnt lgkmcnt(0)" ::: "memory"); __builtin_amdgcn_s_barrier(); asm volatile("" ::: "memory");
#endif
}
struct EpiIn {
    static constexpr bool PERM = true, APERM = false, RESCALE = false;
    bf16* O; const float* ssq;
    MEMFN void operator()(const f32x4 (&acc)[2][2][4][2], const Unit& u, int wr, int wc, int fr, int fq, LAS unsigned char* xl) const {
        LAS float* RI = (LAS float*)(xl + 4096); unit_row_inv(RI, ssq, (wr * 4 + wc) * 64 + fq * 16 + fr, (long)u.pm * BM, [](int) { return true; });
        const int row0 = u.pm * BM + wr * 64 + fr, col0 = u.pn * BM + wc * 32 + 8 * fq;
#pragma unroll
        for (int ai = 0; ai < 2; ++ai)
#pragma unroll
            for (int m = 0; m < 4; ++m) { const int row = row0 + ai * HALF + m * 16; const float sc = RI[ai * HALF + wr * 64 + m * 16 + fr]; bf16* rowp = O + (size_t)row * NINP + col0;
#pragma unroll
                for (int bj = 0; bj < 2; ++bj) { const f32x4 v0 = acc[ai][bj][m][0] * sc, v1 = acc[ai][bj][m][1] * sc;
                    u32x4 w; w.x = pk_bf16(v0[0], v0[1]); w.y = pk_bf16(v0[2], v0[3]); w.z = pk_bf16(v1[0], v1[1]); w.w = pk_bf16(v1[2], v1[3]);
                    *(u32x4*)(rowp + bj * HALF) = w; } }
    }
};
struct EpiRes {
    static constexpr bool PERM = true, APERM = false, RESCALE = false;
    float* H; bf16* HB; float* ssq;
    MEMFN void operator()(const f32x4 (&acc)[2][2][4][2], const Unit& u, int wr, int wc, int fr, int fq, LAS unsigned char*) const {
        const int row0 = u.pm * BM + wr * 64 + fr, col0 = u.pn * BM + wc * 32 + 8 * fq;
#pragma unroll
        for (int ai = 0; ai < 2; ++ai)
#pragma unroll
            for (int m = 0; m < 4; ++m) { const int row = row0 + ai * HALF + m * 16; const size_t off = (size_t)row * D + col0; float s = 0.f;
#pragma unroll
                for (int bj = 0; bj < 2; ++bj) { u32x4* hp = (u32x4*)(HB + off + bj * HALF); const u32x4 ho = *hp;
                    const f32x4 h0 = (f32x4){bf_lo(ho.x), bf_hi(ho.x), bf_lo(ho.y), bf_hi(ho.y)} + acc[ai][bj][m][0], h1 = (f32x4){bf_lo(ho.z), bf_hi(ho.z), bf_lo(ho.w), bf_hi(ho.w)} + acc[ai][bj][m][1];
                    u32x4 w; w.x = pk_bf16(h0[0], h0[1]); w.y = pk_bf16(h0[2], h0[3]); w.z = pk_bf16(h1[0], h1[1]); w.w = pk_bf16(h1[2], h1[3]); *hp = w;
                    s += ((h0[0] * h0[0] + h0[1] * h0[1]) + (h0[2] * h0[2] + h0[3] * h0[3])) + ((h1[0] * h1[0] + h1[1] * h1[1]) + (h1[2] * h1[2] + h1[3] * h1[3])); }
                s += shfl_xor_f32(s, 16); s += shfl_xor_f32(s, 32);
                if (fq == 0) ssq[(size_t)row * 16 + u.pn * 4 + wc] = s;
                if (m == 3) asm volatile("" ::: "memory"); }
    }
};
struct EpiResMix {
    static constexpr bool PERM = true, APERM = false, RESCALE = true; static constexpr int T1 = 6, T2 = 12;
    float* H; bf16* HB; float* ssq;
    MEMFN void rescale(f32x4 (&acc)[2][2][4][2], int which, int wr, int fr, LAS unsigned char* xl) const {
        const LAS float* TS = (const LAS float*)xl;
#pragma unroll
        for (int ai = 0; ai < 2; ++ai)
#pragma unroll
            for (int m = 0; m < 4; ++m) { const float r = TS[(ai * HALF + wr * 64 + m * 16 + fr) * 4 + which];
#pragma unroll
                for (int bj = 0; bj < 2; ++bj)
#pragma unroll
                    for (int n = 0; n < 2; ++n) acc[ai][bj][m][n] = acc[ai][bj][m][n] * r; }
    }
    MEMFN void operator()(const f32x4 (&acc)[2][2][4][2], const Unit& u, int wr, int wc, int fr, int fq, LAS unsigned char* xl) const {
        const LAS float* TS = (const LAS float*)xl;
        const int row0 = u.pm * BM + wr * 64 + fr, col0 = u.pn * BM + wc * 32 + 8 * fq;
#pragma unroll
        for (int ai = 0; ai < 2; ++ai)
#pragma unroll
            for (int m = 0; m < 4; ++m) { const int row = row0 + ai * HALF + m * 16; const size_t off = (size_t)row * D + col0; float s = 0.f; const float r3 = TS[(ai * HALF + wr * 64 + m * 16 + fr) * 4 + 2];
#pragma unroll
                for (int bj = 0; bj < 2; ++bj) { u32x4* hp = (u32x4*)(HB + off + bj * HALF); const u32x4 ho = *hp;
                    const f32x4 h0 = (f32x4){bf_lo(ho.x), bf_hi(ho.x), bf_lo(ho.y), bf_hi(ho.y)} + acc[ai][bj][m][0] * r3, h1 = (f32x4){bf_lo(ho.z), bf_hi(ho.z), bf_lo(ho.w), bf_hi(ho.w)} + acc[ai][bj][m][1] * r3;
                    u32x4 w; w.x = pk_bf16(h0[0], h0[1]); w.y = pk_bf16(h0[2], h0[3]); w.z = pk_bf16(h1[0], h1[1]); w.w = pk_bf16(h1[2], h1[3]); *hp = w;
                    s += ((h0[0] * h0[0] + h0[1] * h0[1]) + (h0[2] * h0[2] + h0[3] * h0[3])) + ((h1[0] * h1[0] + h1[1] * h1[1]) + (h1[2] * h1[2] + h1[3] * h1[3])); }
                s += shfl_xor_f32(s, 16); s += shfl_xor_f32(s, 32);
                if (fq == 0) ssq[(size_t)row * 16 + u.pn * 4 + wc] = s;
                if (m == 3) asm volatile("" ::: "memory"); }
    }
};
struct EpiGlu {
    static constexpr bool PERM = true, APERM = false, RESCALE = false;
    const bf16* YG; const float* bias; bf16* YM;
    MEMFN void operator()(const f32x4 (&acc)[2][2][4][2], const Unit& u, int wr, int wc, int fr, int fq, LAS unsigned char*) const {
        const int row0 = u.pm * BM + wr * 64 + fr, col0 = u.pn * BM + wc * 32 + 8 * fq;
#pragma unroll
        for (int bj = 0; bj < 2; ++bj) { const int col = col0 + bj * HALF; if (u.pn == 1 && bj == 1) continue;
            const f32x4 b0 = *(const f32x4*)(bias + col), b1 = *(const f32x4*)(bias + col + 4);
#pragma unroll
            for (int ai = 0; ai < 2; ++ai)
#pragma unroll
                for (int m = 0; m < 4; ++m) { const int row = row0 + ai * HALF + m * 16;
                    const u32x4 y = *(const u32x4*)(YG + (size_t)row * S5W + col); const f32x4 a0 = acc[ai][bj][m][0] + b0, a1 = acc[ai][bj][m][1] + b1;
                    u32x4 w; w.x = pk_bf16(bf_lo(y.x) * sigmoid_f(a0[0]), bf_hi(y.x) * sigmoid_f(a0[1])); w.y = pk_bf16(bf_lo(y.y) * sigmoid_f(a0[2]), bf_hi(y.y) * sigmoid_f(a0[3]));
                    w.z = pk_bf16(bf_lo(y.z) * sigmoid_f(a1[0]), bf_hi(y.z) * sigmoid_f(a1[1])); w.w = pk_bf16(bf_lo(y.w) * sigmoid_f(a1[2]), bf_hi(y.w) * sigmoid_f(a1[3]));
                    *(u32x4*)(YM + (size_t)row * D + RGW + col) = w;
                    if (m == 3) asm volatile("" ::: "memory"); } }
    }
};
struct EpiUp {
    static constexpr bool PERM = true, APERM = true, RESCALE = false;
    bf16* G; const float* ssq; const float* cw; const float* cb;
    MEMFN void operator()(f32x4 (&acc)[2][2][4][2], const Unit& u, int wr, int wc, int fr, int fq, LAS unsigned char* xl) const {
        const int b = u.pm / NQ, q = u.pm % NQ, t0 = UPS * q - 1;
        LAS float* XB = (LAS float*)xl;
        const int cs = wc * 32 + 8 * fq;
        LAS float* TAPS = (LAS float*)(xl + 8192 + 2048);
        { const int tid_ = (wr * 4 + wc) * 64 + fq * 16 + fr;
          if (tid_ >= 256) { const int arr = (tid_ - 256) >> 5, ch = (tid_ - 256) & 31, jj = u.pn * 128 + 4 * ch;
              const float* src = arr == 0 ? cb + jj : (arr == 1 ? cb + FF + jj : (arr < 5 ? cw + (arr - 2) * FF2 + jj : cw + (arr - 5) * FF2 + FF + jj));
              *(LAS f32x4*)(TAPS + arr * 128 + 4 * ch) = *(const f32x4*)src; } }
        LAS float* RI = (LAS float*)(xl + 8192 + 1024); unit_row_inv(RI, ssq, (wr * 4 + wc) * 64 + fq * 16 + fr, (long)b * L + t0, [t0](int r) { const int t = t0 + r; return t >= 0 && t < L; });
#pragma unroll
        for (int ai = 0; ai < 2; ++ai)
#pragma unroll
            for (int m = 0; m < 4; ++m) { const int lr = 128 * ai + 64 * wr + 4 * fr + m, t = t0 + lr; const bool ok = (t >= 0) && (t < L);
                const float sc = RI[lr];
#pragma unroll
                for (int bj = 0; bj < 2; ++bj)
#pragma unroll
                    for (int n = 0; n < 2; ++n)
#pragma unroll
                        for (int e = 0; e < 4; ++e) acc[ai][bj][m][n][e] = ok ? acc[ai][bj][m][n][e] * sc : 0.f; }
#pragma unroll
        for (int ai = 0; ai < 2; ++ai) { const int s = 2 * ai + wr;
            if (fr == 0) {
#pragma unroll
                for (int bj = 0; bj < 2; ++bj)
#pragma unroll
                    for (int n = 0; n < 2; ++n) *(LAS f32x4*)(XB + (2 * s) * 256 + bj * 128 + cs + 4 * n) = acc[ai][bj][0][n]; }
            if (fr == 15) {
#pragma unroll
                for (int bj = 0; bj < 2; ++bj)
#pragma unroll
                    for (int n = 0; n < 2; ++n) *(LAS f32x4*)(XB + (2 * s + 1) * 256 + bj * 128 + cs + 4 * n) = acc[ai][bj][3][n]; } }
#ifdef CPU_EMU
        sync_block();
#else
        asm volatile("s_waitcnt lgkmcnt(0)" ::: "memory"); __builtin_amdgcn_s_barrier(); asm volatile("" ::: "memory");
#endif
        const int j0 = u.pn * 128 + cs;
#pragma unroll
        for (int n = 0; n < 2; ++n) {
            f32x4 wa[3], wv[3]; const f32x4 ba = *(const LAS f32x4*)(TAPS + cs + 4 * n), bv = *(const LAS f32x4*)(TAPS + 128 + cs + 4 * n);
#pragma unroll
            for (int k = 0; k < 3; ++k) { wa[k] = *(const LAS f32x4*)(TAPS + (2 + k) * 128 + cs + 4 * n); wv[k] = *(const LAS f32x4*)(TAPS + (5 + k) * 128 + cs + 4 * n); }
#pragma unroll
            for (int ai = 0; ai < 2; ++ai) { const int s = 2 * ai + wr;
                f32x4 upe[2], dne[2];
#pragma unroll
                for (int bj = 0; bj < 2; ++bj) { f32x4 pu = {0.f, 0.f, 0.f, 0.f}, pd = {0.f, 0.f, 0.f, 0.f};
                    if (s > 0) pu = *(const LAS f32x4*)(XB + (2 * (s - 1) + 1) * 256 + bj * 128 + cs + 4 * n);
                    if (s < 3) pd = *(const LAS f32x4*)(XB + (2 * (s + 1)) * 256 + bj * 128 + cs + 4 * n);
                    const f32x4 lastr = acc[ai][bj][3][n], firstr = acc[ai][bj][0][n];
#pragma unroll
                    for (int e = 0; e < 4; ++e) { upe[bj][e] = dpp_row_shr1(pu[e], lastr[e]); dne[bj][e] = dpp_row_shl1(pd[e], firstr[e]); } }
#pragma unroll
                for (int m = 0; m < 4; ++m) { const int lr = 64 * s + 4 * fr + m, t = t0 + lr;
                    const f32x4 ua = m > 0 ? acc[ai][0][m > 0 ? m - 1 : 0][n] : upe[0], da = m < 3 ? acc[ai][0][m < 3 ? m + 1 : 3][n] : dne[0];
                    const f32x4 uv = m > 0 ? acc[ai][1][m > 0 ? m - 1 : 0][n] : upe[1], dv = m < 3 ? acc[ai][1][m < 3 ? m + 1 : 3][n] : dne[1];
                    const f32x4 a = ba + wa[0] * ua + wa[1] * acc[ai][0][m][n] + wa[2] * da;
                    const f32x4 v = bv + wv[0] * uv + wv[1] * acc[ai][1][m][n] + wv[2] * dv;
                    if (lr >= 1 && lr <= UPS && t < L) { u32x2 w; w.x = pk_bf16(gelu_f(a[0]) * v[0], gelu_f(a[1]) * v[1]); w.y = pk_bf16(gelu_f(a[2]) * v[2], gelu_f(a[3]) * v[3]);
                        *(u32x2*)(G + (size_t)(b * L + t) * FF + j0 + 4 * n) = w; }
                } } }
    }
};
}

constexpr int RING_BYTES = 131072, XCH_OFF = RING_BYTES, XCH_BYTES = 8192, MISC_OFF = XCH_OFF + XCH_BYTES, LDS_BYTES = 147456;
constexpr int CW_TMO = 0, CW_BAR = 4096;
#ifndef CPU_EMU
typedef GAS unsigned gu32;
#define XB_TMO      128
#define XB_XCNT(j)  (256  + 64 * (j))
#define XB_XSUB(j)  (1280 + 64 * (j))
#define XB_XGEN(j)  (2304 + 64 * (j))
#define XB_TOP      3328
#define XB_TOPGEN   3392
#define XCD_BAR_WORDS 3456
#define XB_SPIN_CAP (1u << 22)
__device__ __forceinline__ unsigned xb_ld(unsigned* p)              { return __hip_atomic_load(p, __ATOMIC_RELAXED, __HIP_MEMORY_SCOPE_AGENT); }
__device__ __forceinline__ unsigned xb_add(unsigned* p, unsigned v) { return __hip_atomic_fetch_add(p, v, __ATOMIC_RELAXED, __HIP_MEMORY_SCOPE_AGENT); }
__device__ __forceinline__ unsigned xb_xcc_id() { return (unsigned)__builtin_amdgcn_s_getreg((3 << 11) | 20) & 0xFu; }
#define XB_SPIN(cond, bar) do { unsigned _sp = 0; while (cond) { __builtin_amdgcn_s_sleep(1); \
    if ((++_sp & 255u) == 0u) { if (xb_ld(&(bar)[XB_TMO])) break; if (_sp > XB_SPIN_CAP) { atomicAdd(&(bar)[XB_TMO], 1u); break; } } } } while (0)
struct XcdBarrier { unsigned* bar; unsigned x; volatile LAS unsigned* st; };
__device__ __forceinline__ XcdBarrier xcd_barrier_post(unsigned* bar, volatile LAS unsigned* st) {
    XcdBarrier b; b.bar = bar; b.x = xb_xcc_id(); b.st = st;
    if (threadIdx.x == 0) (void)xb_add(&bar[XB_XCNT(b.x)], 1u);
    return b;
}
__device__ __forceinline__ void xcd_barrier_complete(unsigned* bar, unsigned x, unsigned& nloc, unsigned& nx) {
    const unsigned G = gridDim.x * gridDim.y * gridDim.z;
    unsigned sum, cnt, mine, sp = 0u;
    for (;;) {
        sum = 0u; cnt = 0u; mine = 0u;
#pragma unroll
        for (unsigned j = 0; j < 16; ++j) { const unsigned c = xb_ld(&bar[XB_XCNT(j)]); sum += c; cnt += (c > 0u) ? 1u : 0u; mine = (j == x) ? c : mine; }
        if (sum == G) break;
        __builtin_amdgcn_s_sleep(1);
        if ((++sp & 255u) == 0u) { if (xb_ld(&bar[XB_TMO])) break; if (sp > XB_SPIN_CAP) { atomicAdd(&bar[XB_TMO], 1u); break; } }
    }
    nloc = mine > 0u ? mine : 1u; nx = cnt > 0u ? cnt : 1u;
}
__device__ __forceinline__ void xcd_barrier(const XcdBarrier& b) {
    asm volatile("s_waitcnt vmcnt(0)" ::: "memory");
    __syncthreads();
    if (threadIdx.x == 0) {
        unsigned* bar = b.bar;
        __builtin_amdgcn_fence(__ATOMIC_RELEASE, "agent");
        asm volatile("s_waitcnt vmcnt(0)" ::: "memory");
        __builtin_amdgcn_s_waitcnt(0);
        unsigned nloc = b.st[0], nx = b.st[1];
        if (nloc == 0u) { xcd_barrier_complete(bar, b.x, nloc, nx); b.st[0] = nloc; b.st[1] = nx; }
        const unsigned old = xb_add(&bar[XB_XSUB(b.x)], 1u);
        const unsigned gen = old / nloc;
        if (old + 1u == (gen + 1u) * nloc) {
            __builtin_amdgcn_fence(__ATOMIC_RELEASE, "agent");
            asm volatile("s_waitcnt vmcnt(0)" ::: "memory");
            const unsigned og = xb_add(&bar[XB_TOP], 1u);
            const unsigned tg = og / nx;
            if (og + 1u == (tg + 1u) * nx) xb_add(&bar[XB_TOPGEN], 1u);
            else XB_SPIN(xb_ld(&bar[XB_TOPGEN]) == tg, bar);
            __builtin_amdgcn_fence(__ATOMIC_ACQUIRE, "agent");
            asm volatile("s_waitcnt vmcnt(0)" ::: "memory");
        } else {
            XB_SPIN(xb_ld(&bar[XB_TOPGEN]) == gen, bar);
            __builtin_amdgcn_fence(__ATOMIC_ACQUIRE, "agent");
            asm volatile("s_waitcnt vmcnt(0)" ::: "memory");
        }
    }
    __syncthreads();
}
#endif

#ifdef CPU_EMU
struct Args; static void emu_phase_hook(int ph, const Args& a);
#endif
struct Args { const float* in[38]; float* out; unsigned char* ws; int ph_lo, ph_hi; };
#ifdef CPU_EMU
typedef const Args* KARG_PTR;
#else
typedef const __attribute__((address_space(4))) Args* KARG_PTR;
#endif
struct Frame {
    LAS unsigned char* lds; int tid, lane, wave, G, gtid, gsize, gw, ngw;
    KARG_PTR ap; float* out; unsigned char* ws;
};
#define FIN(i) (F.ap->in[i])
#ifdef CPU_EMU
#define LAUNDER(F, l) do {} while (0)
#else
#define LAUNDER(F, l) do { size_t z_ = 0; asm volatile("" : "+s"(z_), "+s"(F.ap), "+s"(l), "+s"(F.wave)); F.ws = args.ws + z_; F.out = args.out + z_; F.lane = lane_id(); F.tid = (F.wave << 6) | F.lane; \
    F.gtid = blockIdx.x * NT + F.tid; F.gw = blockIdx.x * NWAVES + F.wave; } while (0)
#endif

DEVFN void transpose_item(const float* W, int ldw, int K, bf16* WT, int src_col0, int dst_row0, int k0, const float* sc, LAS float* scr, int lane) {
    float tv[32];
#pragma unroll
    for (int i = 0; i < 32; ++i) { const int kk = 2 * i + (lane >> 5); tv[i] = W[(size_t)(k0 + kk) * ldw + src_col0 + (lane & 31)]; }
#pragma unroll
    for (int i = 0; i < 32; ++i) { const int kk = 2 * i + (lane >> 5); float v = tv[i]; if (sc) v *= sc[k0 + kk]; scr[kk * 33 + (lane & 31)] = v; }
    WAVE_LDS_FENCE();
    const int c = lane & 7;
#pragma unroll
    for (int j = 0; j < 4; ++j) { const int n = (lane >> 3) + 8 * j; const LAS float* s = scr + (8 * c) * 33 + n;
        u32x4 o; o.x = pk_bf16(s[0 * 33], s[1 * 33]); o.y = pk_bf16(s[2 * 33], s[3 * 33]); o.z = pk_bf16(s[4 * 33], s[5 * 33]); o.w = pk_bf16(s[6 * 33], s[7 * 33]);
        *(u32x4*)(WT + (size_t)(dst_row0 + n) * K + k0 + 8 * c) = o; }
    WAVE_LDS_FENCE();
}
DEVFN float wave_sum(float v) {
#pragma unroll
    for (int o = 1; o < 64; o <<= 1) v += shfl_xor_f32(v, o);
    return v;
}
static_assert(NT == 512, "one wave per 64 filter columns");
DEVFN void hilo8(const float (&x)[8], bf16x8& hi, bf16x8& lo) { u32x4 h, lw; float r[8];
    h.x = pk_bf16(x[0], x[1]); h.y = pk_bf16(x[2], x[3]); h.z = pk_bf16(x[4], x[5]); h.w = pk_bf16(x[6], x[7]);
    r[0] = x[0] - bf_lo(h.x); r[1] = x[1] - bf_hi(h.x); r[2] = x[2] - bf_lo(h.y); r[3] = x[3] - bf_hi(h.y); r[4] = x[4] - bf_lo(h.z); r[5] = x[5] - bf_hi(h.z); r[6] = x[6] - bf_lo(h.w); r[7] = x[7] - bf_hi(h.w);
    lw.x = pk_bf16(r[0], r[1]); lw.y = pk_bf16(r[2], r[3]); lw.z = pk_bf16(r[4], r[5]); lw.w = pk_bf16(r[6], r[7]);
    hi = __builtin_bit_cast(bf16x8, h); lo = __builtin_bit_cast(bf16x8, lw); }
DEVFN void p_filter_tables(Frame& F) {
    constexpr int H2S = 68;
    LAS float* H1 = (LAS float*)F.lds; LAS float* H2 = H1 + 32 * 64; LAS float* W1 = H2 + 32 * H2S; LAS float* W2 = W1 + 2176; LAS float* PB = W2 + 4096;
    float* KF = (float*)(F.ws + WS_KFB); const int tid = F.tid;
    const float maxd = logf(1e-2f) / 0.3f, mind = logf(1e-2f) / 1.5f;
    const f32x16 z16 = {0.f, 0.f, 0.f, 0.f, 0.f, 0.f, 0.f, 0.f, 0.f, 0.f, 0.f, 0.f, 0.f, 0.f, 0.f, 0.f};
    sync_block();
    int it0 = (int)blockIdx.x; OPAQUE_S(it0);
    for (int it = it0; it < 2 * (L / 32); it += F.G) { const int l = it / (L / 32), pos0 = (it % (L / 32)) * 32;
        const int lane = lane_id(), w = F.wave, hh = lane >> 5, pl = lane & 31;
        { const float* w1 = FIN(22) + l * 33 * 64; const float* w2 = FIN(25) + l * 4096;
          for (int i = tid; i < 33 * 64; i += NT) W1[i] = w1[i];
          for (int i = tid; i < 1024; i += NT) *(LAS f32x4*)(W2 + 4 * i) = *(const f32x4*)(w2 + 4 * i);
          if (tid < 64) { PB[tid] = FIN(23)[l * 64 + tid]; PB[64 + tid] = FIN(24)[l * 64 + tid]; PB[128 + tid] = FIN(26)[l * 64 + tid]; PB[192 + tid] = FIN(27)[l * 64 + tid]; } }
        sync_block();
        for (int e = tid; e < 32 * 64; e += NT) { const int pp = e / 64, mm = e % 64, pos = pos0 + pp;
            const float t = (float)pos / (float)(L - 1 > 1 ? L - 1 : 1);
            float acc = PB[mm] + t * W1[mm];
            for (int q = 0; q < 16; ++q) { const float band = 1e-4f + (float)q * ((15.0f - 1e-4f) / 15.0f); acc += cos_rev(((float)pos * band) * (1.0f / (float)L)) * W1[(1 + q) * 64 + mm] - sin_rev(((float)pos * band) * (1.0f / (float)L)) * W1[(17 + q) * 64 + mm]; }
            H1[pp * 64 + mm] = sinf(PB[64 + mm] * acc); }
        sync_block();
        for (int e = tid; e < 32 * 64; e += NT) { const int pp = e / 64, mm = e % 64; float acc = PB[128 + mm];
            for (int q = 0; q < 64; ++q) acc += H1[pp * 64 + q] * W2[q * 64 + mm];
            H2[pp * H2S + mm] = sinf(PB[192 + mm] * acc); }
        sync_block();
        const float* w3 = FIN(28) + (size_t)l * 64 * 512 + 64 * w + pl;
#pragma unroll 1
        for (int ct = 0; ct < 2; ++ct) { f32x16 acc = z16; OPAQUE16(acc);
#pragma unroll
            for (int ks = 0; ks < 4; ++ks) { float xb[8], xa[8];
#pragma unroll
                for (int j = 0; j < 8; ++j) xb[j] = w3[(size_t)(16 * ks + 8 * hh + j) * 512 + 32 * ct];
                { const f32x4 a0 = *(const LAS f32x4*)(H2 + pl * H2S + 16 * ks + 8 * hh), a1 = *(const LAS f32x4*)(H2 + pl * H2S + 16 * ks + 8 * hh + 4);
                  xa[0] = a0[0]; xa[1] = a0[1]; xa[2] = a0[2]; xa[3] = a0[3]; xa[4] = a1[0]; xa[5] = a1[1]; xa[6] = a1[2]; xa[7] = a1[3]; }
                bf16x8 ah, al, bh, bl; hilo8(xa, ah, al); hilo8(xb, bh, bl);
                FRESH(ah); FRESH(al); FRESH(bh); FRESH(bl);
                acc = mfma32(ah, bh, acc); acc = mfma32(ah, bl, acc); acc = mfma32(al, bh, acc);
                MFMA_GUARD(ACC1(acc), KV(ah), KV(al), KV(bh), KV(bl)); }
            const int c2 = 64 * w + 32 * ct + pl; const float delta = fabsf(mind + (float)(c2 % 256) * ((maxd - mind) / 255.0f)); float* dst = KF + ((size_t)l * 512 + c2) * L + pos0 + 4 * hh;
#pragma unroll
            for (int g = 0; g < 4; ++g) { f32x4 o;
#pragma unroll
                for (int e = 0; e < 4; ++e) o[e] = acc[4 * g + e] * expf(-((float)(pos0 + 8 * g + 4 * hh + e) / (float)(L - 1 > 1 ? L - 1 : 1)) * delta);
                *(f32x4*)(dst + 8 * g) = o; } }
        sync_block(); }
}
DEVFN void p_prologue(Frame& F) {
    LAS float* scr = (LAS float*)(F.lds + F.wave * 16384);
    constexpr int I_IN = 16 * 60, I_OUT = 16 * 32, I_UP = 16 * 176, I_DN = 44 * 32, I_L = I_IN + I_OUT + I_UP + I_DN;
    for (int it = F.gw; it < 2 * I_L; it += F.ngw) {
        const int l = it / I_L; int r = it % I_L;
        if (r < I_IN) { const int kb = r / 60, nb = r % 60; transpose_item(FIN(2) + (size_t)l * D * NIN, NIN, D, (bf16*)(F.ws + WS_WIN + l * SZ_WIN), 32 * nb, 32 * nb, 64 * kb, FIN(1) + l * D, scr, F.lane); continue; } r -= I_IN;
        if (r < I_OUT) { const int kb = r / 32, nb = r % 32; transpose_item(FIN(31) + (size_t)l * D * D, D, D, (bf16*)(F.ws + WS_WOUT + l * SZ_WOUT), 32 * nb, 32 * nb, 64 * kb, FIN(30) + l * D, scr, F.lane); continue; } r -= I_OUT;
        if (r < I_UP) { const int kb = r / 176, nb = r % 176, sc0 = 32 * nb, half = sc0 / FF, jj = sc0 % FF, pn = jj / 128;
            transpose_item(FIN(33) + (size_t)l * D * FF2, FF2, D, (bf16*)(F.ws + WS_WUP + l * SZ_WUP), sc0, 256 * pn + 128 * half + (jj % 128), 64 * kb, FIN(32) + l * D, scr, F.lane); continue; } r -= I_UP;
        { const int kb = r / 32, nb = r % 32; transpose_item(FIN(36) + (size_t)l * FF * D, D, FF, (bf16*)(F.ws + WS_WDN + l * SZ_WDN), 32 * nb, 32 * nb, 64 * kb, nullptr, scr, F.lane); }
    }
    for (int i = F.gtid; i < 2 * 12 * 24 * 64; i += F.gsize) { const int l = i / (12 * 24 * 64), r = i % (12 * 24 * 64), ln = r % 64, ks = (r / 64) % 24, ct = r / (64 * 24), pl = ln & 31, hh = ln >> 5;
        const float* src = FIN(18) + (size_t)l * S5W * S5W + (size_t)(16 * ks + 8 * hh) * S5W + 32 * ct + pl; u32x4 o;
        o.x = pk_bf16(src[0], src[S5W]); o.y = pk_bf16(src[2 * S5W], src[3 * S5W]); o.z = pk_bf16(src[4 * S5W], src[5 * S5W]); o.w = pk_bf16(src[6 * S5W], src[7 * S5W]);
        ((u32x4*)(F.ws + WS_WGLU + l * SZ_WGLU))[r] = o; }
    for (int i = F.gtid; i < 2 * (128 * D / 8); i += F.gsize) { const int l = i / (128 * D / 8), r = i % (128 * D / 8); ((u32x4*)(F.ws + WS_WIN + l * SZ_WIN + (size_t)NIN * D * 2))[r] = (u32x4){0u, 0u, 0u, 0u}; }
    float* ssq = (float*)(F.ws + WS_SSQ); bf16* hb = (bf16*)(F.ws + WS_HB);
    for (int m = 4 * F.gw; m < M; m += 4 * F.ngw) {
        const f32x4* xr = (const f32x4*)(FIN(0) + (size_t)m * D) + F.lane; u32x2* br = (u32x2*)(hb + (size_t)m * D) + F.lane; f32x4 v[16]; float sq[4] = {0.f, 0.f, 0.f, 0.f};
#pragma unroll
        for (int j = 0; j < 16; ++j) v[j] = xr[64 * j];
#pragma unroll
        for (int j = 0; j < 16; ++j) { u32x2 w; w.x = pk_bf16(v[j][0], v[j][1]); w.y = pk_bf16(v[j][2], v[j][3]); br[64 * j] = w; sq[j >> 2] += (v[j][0] * v[j][0] + v[j][1] * v[j][1]) + (v[j][2] * v[j][2] + v[j][3] * v[j][3]); }
#pragma unroll
        for (int o = 1; o < 64; o <<= 1) {
#pragma unroll
            for (int q = 0; q < 4; ++q) sq[q] += shfl_xor_f32(sq[q], o); }
        { const int q = F.lane >> 4; const float sv = q == 0 ? sq[0] : (q == 1 ? sq[1] : (q == 2 ? sq[2] : sq[3])); ssq[(size_t)m * 16 + F.lane] = (F.lane & 15) == 0 ? sv : 0.f; }
    }
    for (int ic = F.gtid; ic < 2 * 3072 * 16; ic += F.gsize) { const int i = ic / 16, c = ic % 16, l = i / 3072, r = i % 3072, dg = r / 64, p = r % 64;
        const float lr = FIN(10)[i], li = FIN(11)[i], dt = expf(FIN(12)[l * 48 + dg]);
        const float mag = expf(lr * dt), ar = mag * cosf(li * dt), ai = mag * sinf(li * dt);
        const float den = lr * lr + li * li, nr = ar - 1.0f, ni = ai, cr = (nr * lr + ni * li) / den, ci = (ni * lr - nr * li) / den;
        if (c == 0) { ((f32x2*)(F.ws + WS_S5A))[i] = (f32x2){ar, ai};
            const float m16 = expf(16.0f * lr * dt); ((f32x2*)(F.ws + WS_S5A16))[i] = (f32x2){m16 * cosf(16.0f * li * dt), m16 * sinf(16.0f * li * dt)}; }
        bf16* bt = (bf16*)(F.ws + WS_S5BT) + ((size_t)(l * 48 + dg) * 2) * 64 * 16; bf16* ct = (bf16*)(F.ws + WS_S5CT) + (size_t)(l * 48 + dg) * 16 * 128;
        { const float br = FIN(13)[(size_t)i * 16 + c], bi = FIN(14)[(size_t)i * 16 + c];
            bt[(size_t)p * 16 + c] = f2bf_(cr * br - ci * bi); bt[(size_t)(64 + p) * 16 + c] = f2bf_(cr * bi + ci * br);
            const size_t ci_ = ((size_t)(l * 48 + dg) * 16 + c) * 64 + p;
            ct[(size_t)c * 128 + 2 * p] = f2bf_(FIN(15)[ci_]); ct[(size_t)c * 128 + 2 * p + 1] = f2bf_(-FIN(16)[ci_]); } }
    for (int i = F.gtid; i < 2 * 2 * RGW; i += F.gsize) ((float*)(F.ws + WS_RGSP))[i] = 8.0f * softplus_f(-FIN(9)[i]);
    for (int i = F.gtid; i < 2 * 2 * 2 * 6 * 4096; i += F.gsize) { const int k = i % 64, n = (i / 64) % 64, hd = (i / 4096) % 6, mat = (i / 24576) % 2, ld = i / 49152;
        const float* src = (mat == 0 ? FIN(5) : FIN(7)) + ((size_t)ld * 6 + hd) * 4096; ((bf16*)(F.ws + WS_RGWT))[i] = f2bf_(-1.4426950408889634f * src[k * 64 + n]); }
    p_filter_tables(F);
}
constexpr int RING_BYTES_C = 131072;
constexpr int HY_NA = L / 32;
constexpr int HY_TA = HY_NA < 32 ? HY_NA : 32;
constexpr int HY_TB = 32 / HY_TA, HY_NBLK = HY_NA + 2 * (HY_TA - 1), HY_NTILE = (HY_NA / HY_TA) * ((Bn + HY_TB - 1) / HY_TB);
constexpr int HY_CPY = 2 * L * 2 + 64;
constexpr int HY_FI = 0, HY_ZI = 4 * HY_CPY, HY_LDS = HY_ZI + Bn * HY_NBLK * 80;
static_assert(HY_LDS <= RING_BYTES_C, "hyena LDS");
DEVFN void p_hy_pre(Frame& F, int l) {
    const bf16* proj = (const bf16*)(F.ws + WS_PROJ); bf16* zT = (bf16*)((unsigned char*)F.out + OUT_ZT); const float* cw = FIN(20) + l * 3 * 768; const float* cb = FIN(21) + l * 768;
    for (int i = F.gtid; i < 256 * (M / 32); i += F.gsize) { const int c = i % 256, m0 = (i / 256) * 32, t0 = m0 % L;
        const float w1[3] = {cw[256 + c], cw[768 + 256 + c], cw[1536 + 256 + c]}, wv[3] = {cw[512 + c], cw[768 + 512 + c], cw[1536 + 512 + c]}; const float b1 = cb[256 + c], bv = cb[512 + c];
        const bool okm = t0 > 0, okp = t0 + 32 < L; const bf16* p1 = proj + (size_t)m0 * NINP + 3 * RGW + 256 + c; const bf16* pv = p1 + 256;
        bf16 r1[34], rv[34];
        r1[0] = p1[okm ? -(long)NINP : 0]; rv[0] = pv[okm ? -(long)NINP : 0];
#pragma unroll
        for (int j = 0; j < 32; ++j) { r1[j + 1] = p1[(size_t)j * NINP]; rv[j + 1] = pv[(size_t)j * NINP]; }
        r1[33] = p1[(size_t)(okp ? 32 : 31) * NINP]; rv[33] = pv[(size_t)(okp ? 32 : 31) * NINP];
        float p1f = okm ? bf2f_(r1[0]) : 0.f, pvf = okm ? bf2f_(rv[0]) : 0.f, c1 = bf2f_(r1[1]), cv = bf2f_(rv[1]);
        unsigned pk[16];
#pragma unroll
        for (int j = 0; j < 32; ++j) { float n1 = bf2f_(r1[j + 2]), nv = bf2f_(rv[j + 2]); if (j == 31 && !okp) { n1 = 0.f; nv = 0.f; }
            const float zz = (bv + wv[0] * pvf + wv[1] * cv + wv[2] * nv) * (b1 + w1[0] * p1f + w1[1] * c1 + w1[2] * n1);
            if (j & 1) pk[j >> 1] = pk_bf16(bf_lo(pk[j >> 1]), zz); else pk[j >> 1] = pk_bf16(zz, 0.f);
            p1f = c1; c1 = n1; pvf = cv; cv = nv; }
        u32x4* dst = (u32x4*)(zT + (size_t)c * M + m0);
#pragma unroll
        for (int j = 0; j < 4; ++j) dst[j] = (u32x4){pk[4 * j], pk[4 * j + 1], pk[4 * j + 2], pk[4 * j + 3]}; }
}
DEVFN void hy_channel(Frame& F, int l, int c) {
    const int lane = lane_id(), w = F.wave, tid = F.tid, h = lane >> 5, r = lane & 31;
    LAS unsigned char* FI = F.lds + HY_FI; LAS unsigned char* ZI = F.lds + HY_ZI;
    constexpr int ZTOT = Bn * HY_NA * 4, ZPT = (ZTOT + NT - 1) / NT; u32x4 zr[ZPT];
    { const bf16* zT = (const bf16*)((unsigned char*)F.out + OUT_ZT) + (size_t)c * M;
#pragma unroll
      for (int k = 0; k < ZPT; ++k) { const int i = tid + k * NT; zr[k] = (u32x4){0u, 0u, 0u, 0u};
          if (i < ZTOT) { const int j = i & 3, a = (i >> 2) % HY_NA, b = (i >> 2) / HY_NA; zr[k] = *(const u32x4*)(zT + (size_t)b * L + 32 * a + 8 * j); } } }
    { LAS float* KX = (LAS float*)ZI;
      const float* kf = (const float*)(F.ws + WS_KFB) + ((size_t)l * 512 + c) * L; const float* kb = kf + (size_t)256 * L; const float bias = FIN(29)[l * HYW + c];
      if (tid == 0) KX[0] = 0.f;
      for (int p4 = tid; p4 < L / 4; p4 += NT) { const f32x4 kfv = *(const f32x4*)(kf + 4 * p4), kbv = *(const f32x4*)(kb + 4 * p4);
#pragma unroll
          for (int e = 0; e < 4; ++e) { const int pos = 4 * p4 + e;
              if (pos == 0) KX[L] = kfv[e] + kbv[e] + bias; else { KX[L + pos] = kfv[e]; KX[L - pos] = kbv[e]; } } }
      sync_block();
      for (int i = tid; i < 4 * L; i += NT) { const int sg = i / L, u = 2 * (i % L); float v[2];
#pragma unroll
          for (int e = 0; e < 2; ++e) { const int ix = 2 * L - (u + e) - sg; v[e] = (ix >= 1 && ix <= 2 * L - 1) ? KX[ix] : 0.f; }
          *(LAS unsigned*)(FI + sg * HY_CPY + u * 2) = pk_bf16(v[0], v[1]); }
      sync_block(); }
    for (int i = tid; i < Bn * 2 * (HY_TA - 1) * 5; i += NT) { const int b = i / (2 * (HY_TA - 1) * 5), rr = i % (2 * (HY_TA - 1) * 5), blk = rr / 5, j = rr % 5, q = blk < HY_TA - 1 ? blk : blk + HY_NA;
        *(LAS u32x4*)(ZI + (b * HY_NBLK + q) * 80 + 16 * j) = (u32x4){0u, 0u, 0u, 0u}; }
#pragma unroll
    for (int k = 0; k < ZPT; ++k) { const int i = tid + k * NT;
        if (i < ZTOT) { const int j = i & 3, a = (i >> 2) % HY_NA, b = (i >> 2) / HY_NA; *(LAS u32x4*)(ZI + ((b * HY_NBLK + a + HY_TA - 1) * 80 + 16 * j)) = zr[k]; } }
    sync_block();
    bf16* yT = (bf16*)((unsigned char*)F.out + OUT_YT) + (size_t)c * M;
    const int sgm = (4 - (r & 3)) & 3;
    const f32x16 z16 = {0.f, 0.f, 0.f, 0.f, 0.f, 0.f, 0.f, 0.f, 0.f, 0.f, 0.f, 0.f, 0.f, 0.f, 0.f, 0.f};
    constexpr int NAQ = HY_NA / HY_TA, NBQ = (Bn + HY_TB - 1) / HY_TB, NIT = NAQ * ((NBQ + 1) / 2);
    for (int it = w; it < NIT; it += NWAVES) { const int aq = it % NAQ, bq0 = 2 * (it / NAQ), bq1 = bq0 + 1, al = r % HY_TA;
        const int a = aq * HY_TA + al, bb0 = bq0 * HY_TB + r / HY_TA, bb1 = bq1 * HY_TB + r / HY_TA; const bool ok0 = bb0 < Bn, ok1 = bq1 < NBQ && bb1 < Bn;
        const int dlo = aq * HY_TA - (HY_NA - 1), dhi = aq * HY_TA + HY_TA - 1;
        f32x16 acc0 = z16, acc1 = z16; OPAQUE16(acc0); OPAQUE16(acc1);
        int fa = sgm * HY_CPY + 2 * ((8 * h - r - 32 * dlo) - sgm + L);
        int za0 = ok0 ? ((bb0 * HY_NBLK + a - dlo + HY_TA - 1) * 80 + 16 * h) : 0;
        int za1 = ok1 ? ((bb1 * HY_NBLK + a - dlo + HY_TA - 1) * 80 + 16 * h) : 0;
        u32x4 ax[2], ay[2], b0x[2], b1x[2], b0y[2], b1y[2];
#ifdef CPU_EMU
#define HY_FILL(NA, NB0, NB1) do { _Pragma("unroll") for (int ks = 0; ks < 2; ++ks) { unsigned long long lo = *(const LAS unsigned long long*)(FI + fa + 32 * ks), hi = *(const LAS unsigned long long*)(FI + fa + 32 * ks + 8); \
                NA[ks] = (u32x4){(unsigned)lo, (unsigned)(lo >> 32), (unsigned)hi, (unsigned)(hi >> 32)}; \
                if (al == 0) { NB0[ks] = *(const LAS u32x4*)(ZI + za0 + 32 * ks); NB1[ks] = *(const LAS u32x4*)(ZI + za1 + 32 * ks); } } fa -= 64; za0 -= zd0; za1 -= zd1; } while (0)
#define HY_MMA(CA, CB0, CB1) do { bf16x8 a0 = __builtin_bit_cast(bf16x8, CA[0]), a1 = __builtin_bit_cast(bf16x8, CA[1]); \
            acc0 = mfma32(a0, __builtin_bit_cast(bf16x8, CB0[0]), acc0); acc1 = mfma32(a0, __builtin_bit_cast(bf16x8, CB1[0]), acc1); acc0 = mfma32(a1, __builtin_bit_cast(bf16x8, CB0[1]), acc0); acc1 = mfma32(a1, __builtin_bit_cast(bf16x8, CB1[1]), acc1); } while (0)
#define HY_STEP(CA, CB0, CB1, NA, NB0, NB1) do { HY_FILL(NA, NB0, NB1); HY_MMA(CA, CB0, CB1); } while (0)
#define HY_LAST(CA, CB0, CB1) HY_MMA(CA, CB0, CB1)
#define HY_FIRST(NA, NB0, NB1) do { const int al_ = al; { const int al = 0; (void)al_; HY_FILL(NA, NB0, NB1); } } while (0)
        int zd0 = ok0 ? 80 : 0, zd1 = ok1 ? 80 : 0;
#else
        unsigned vfa = (unsigned)(size_t)FI + (unsigned)fa, vz0 = (unsigned)(size_t)ZI + (unsigned)za0, vz1 = (unsigned)(size_t)ZI + (unsigned)za1; const unsigned zd0 = ok0 ? 80u : 0u, zd1 = ok1 ? 80u : 0u;
        const unsigned long long colmask = __builtin_amdgcn_ballot_w64(al == 0); unsigned long long svx;
#define HY_STEP(CA, CB0, CB1, NA, NB0, NB1) asm volatile( \
            "ds_read2_b64 %[na0], %[fa] offset1:1\n\tds_read2_b64 %[na1], %[fa] offset0:4 offset1:5\n\t" \
            "s_mov_b64 %[sv], exec\n\ts_mov_b64 exec, %[cm]\n\t" \
            "ds_read_b128 %[nb00], %[z0]\n\tds_read_b128 %[nb01], %[z0] offset:32\n\tds_read_b128 %[nb10], %[z1]\n\tds_read_b128 %[nb11], %[z1] offset:32\n\t" \
            "s_mov_b64 exec, %[sv]\n\t" \
            "v_add_u32 %[fa], 0xffffffc0, %[fa]\n\tv_sub_u32 %[z0], %[z0], %[d0]\n\tv_sub_u32 %[z1], %[z1], %[d1]\n\t" \
            "s_nop 1\n\t" \
            "v_mfma_f32_32x32x16_bf16 %[c0], %[ca0], %[cb00], %[c0]\n\tv_mfma_f32_32x32x16_bf16 %[c1], %[ca0], %[cb10], %[c1]\n\t" \
            "v_mfma_f32_32x32x16_bf16 %[c0], %[ca1], %[cb01], %[c0]\n\tv_mfma_f32_32x32x16_bf16 %[c1], %[ca1], %[cb11], %[c1]\n\t" \
            "s_waitcnt lgkmcnt(0)\n\ts_nop 3" \
            : [c0] "+v"(acc0), [c1] "+v"(acc1), [na0] "=&v"(NA[0]), [na1] "=&v"(NA[1]), [nb00] "+v"(NB0[0]), [nb01] "+v"(NB0[1]), [nb10] "+v"(NB1[0]), [nb11] "+v"(NB1[1]), \
              [fa] "+v"(vfa), [z0] "+v"(vz0), [z1] "+v"(vz1), [sv] "=&s"(svx) \
            : [ca0] "v"(CA[0]), [ca1] "v"(CA[1]), [cb00] "v"(CB0[0]), [cb01] "v"(CB0[1]), [cb10] "v"(CB1[0]), [cb11] "v"(CB1[1]), [d0] "v"(zd0), [d1] "v"(zd1), [cm] "s"(colmask) : "memory")
#define HY_LAST(CA, CB0, CB1) asm volatile( \
            "s_nop 1\n\tv_mfma_f32_32x32x16_bf16 %[c0], %[ca0], %[cb00], %[c0]\n\tv_mfma_f32_32x32x16_bf16 %[c1], %[ca0], %[cb10], %[c1]\n\t" \
            "v_mfma_f32_32x32x16_bf16 %[c0], %[ca1], %[cb01], %[c0]\n\tv_mfma_f32_32x32x16_bf16 %[c1], %[ca1], %[cb11], %[c1]\n\ts_nop 7\n\ts_nop 7\n\ts_nop 7" \
            : [c0] "+v"(acc0), [c1] "+v"(acc1) : [ca0] "v"(CA[0]), [ca1] "v"(CA[1]), [cb00] "v"(CB0[0]), [cb01] "v"(CB0[1]), [cb10] "v"(CB1[0]), [cb11] "v"(CB1[1]))
#define HY_FIRST(NA, NB0, NB1) asm volatile( \
            "ds_read2_b64 %[na0], %[fa] offset1:1\n\tds_read2_b64 %[na1], %[fa] offset0:4 offset1:5\n\t" \
            "ds_read_b128 %[nb00], %[z0]\n\tds_read_b128 %[nb01], %[z0] offset:32\n\tds_read_b128 %[nb10], %[z1]\n\tds_read_b128 %[nb11], %[z1] offset:32\n\t" \
            "v_add_u32 %[fa], 0xffffffc0, %[fa]\n\tv_sub_u32 %[z0], %[z0], %[d0]\n\tv_sub_u32 %[z1], %[z1], %[d1]\n\t" \
            "s_waitcnt lgkmcnt(0)\n\ts_nop 1" \
            : [na0] "=&v"(NA[0]), [na1] "=&v"(NA[1]), [nb00] "=&v"(NB0[0]), [nb01] "=&v"(NB0[1]), [nb10] "=&v"(NB1[0]), [nb11] "=&v"(NB1[1]), [fa] "+v"(vfa), [z0] "+v"(vz0), [z1] "+v"(vz1) \
            : [d0] "v"(zd0), [d1] "v"(zd1) : "memory")
#endif
#define HY_SHIFT(CB0, CB1, NB0, NB1) do { _Pragma("unroll") for (int ks = 0; ks < 2; ++ks) { \
            NB0[ks] = (u32x4){wave_shr1(CB0[ks].x), wave_shr1(CB0[ks].y), wave_shr1(CB0[ks].z), wave_shr1(CB0[ks].w)}; \
            NB1[ks] = (u32x4){wave_shr1(CB1[ks].x), wave_shr1(CB1[ks].y), wave_shr1(CB1[ks].z), wave_shr1(CB1[ks].w)}; } } while (0)
        HY_FIRST(ax, b0x, b1x);
        int d = dlo;
#pragma unroll 1
        for (; d + 2 <= dhi; d += 2) { HY_SHIFT(b0x, b1x, b0y, b1y); HY_STEP(ax, b0x, b1x, ay, b0y, b1y); HY_SHIFT(b0y, b1y, b0x, b1x); HY_STEP(ay, b0y, b1y, ax, b0x, b1x); }
        if (d == dhi) HY_LAST(ax, b0x, b1x);
        else { HY_SHIFT(b0x, b1x, b0y, b1y); HY_STEP(ax, b0x, b1x, ay, b0y, b1y); HY_LAST(ay, b0y, b1y); }
#undef HY_STEP
#undef HY_LAST
#undef HY_FIRST
#undef HY_SHIFT
#ifdef CPU_EMU
#undef HY_FILL
#undef HY_MMA
#endif
        if (ok0) {
#pragma unroll
            for (int q = 0; q < 4; ++q) *(u32x2*)(yT + (size_t)bb0 * L + 32 * a + 8 * q + 4 * h) = (u32x2){pk_bf16(acc0[4 * q], acc0[4 * q + 1]), pk_bf16(acc0[4 * q + 2], acc0[4 * q + 3])}; }
        if (ok1) {
#pragma unroll
            for (int q = 0; q < 4; ++q) *(u32x2*)(yT + (size_t)bb1 * L + 32 * a + 8 * q + 4 * h) = (u32x2){pk_bf16(acc1[4 * q], acc1[4 * q + 1]), pk_bf16(acc1[4 * q + 2], acc1[4 * q + 3])}; } }
    sync_block();
}
DEVFN void p_hy_main(Frame& F, int l) { int c0 = (int)blockIdx.x; OPAQUE_S(c0); for (int c = c0; c < HYW; c += F.G) hy_channel(F, l, c); }
DEVFN void p_hy_post(Frame& F, int l) {
    const bf16* proj = (const bf16*)(F.ws + WS_PROJ); const bf16* yT = (const bf16*)((unsigned char*)F.out + OUT_YT); bf16* ymix = (bf16*)(F.ws + WS_YMIX); const float* cw = FIN(20) + l * 3 * 768; const float* cb = FIN(21) + l * 768;
    for (int i = F.gtid; i < 256 * (M / 32); i += F.gsize) { const int c = i % 256, m0 = (i / 256) * 32, t0 = m0 % L;
        const float w0[3] = {cw[c], cw[768 + c], cw[1536 + c]}; const float b0 = cb[c];
        const bool okm = t0 > 0, okp = t0 + 32 < L; const bf16* p0p = proj + (size_t)m0 * NINP + 3 * RGW + c;
        bf16 r0[34]; u32x4 yv[4]; const u32x4* ys = (const u32x4*)(yT + (size_t)c * M + m0);
#pragma unroll
        for (int j8 = 0; j8 < 4; ++j8) yv[j8] = ys[j8];
        r0[0] = p0p[okm ? -(long)NINP : 0];
#pragma unroll
        for (int j = 0; j < 32; ++j) r0[j + 1] = p0p[(size_t)j * NINP];
        r0[33] = p0p[(size_t)(okp ? 32 : 31) * NINP];
        float p0 = okm ? bf2f_(r0[0]) : 0.f, c0 = bf2f_(r0[1]);
#pragma unroll
        for (int j = 0; j < 32; ++j) { float n0 = bf2f_(r0[j + 2]); if (j == 31 && !okp) n0 = 0.f;
            ymix[(size_t)(m0 + j) * D + RGW + S5W + c] = f2bf_(((j & 1) ? bf_hi(yv[j >> 3][(j >> 1) & 3]) : bf_lo(yv[j >> 3][(j >> 1) & 3])) * (b0 + w0[0] * p0 + w0[1] * c0 + w0[2] * n0)); p0 = c0; c0 = n0; } }
}
constexpr int NG16 = L / 16, NT32 = M / 32, CARRY_B = NG16 < 16 ? NG16 : 16;
DEVFN int tau32(int rho) { return 16 * ((rho >> 2) & 1) + (rho & 3) + 4 * (rho >> 3); }
DEVFN bf16x8 pack8(const f32x4 a, const f32x4 b) { u32x4 w; w.x = pk_bf16(a[0], a[1]); w.y = pk_bf16(a[2], a[3]); w.z = pk_bf16(b[0], b[1]); w.w = pk_bf16(b[2], b[3]); return __builtin_bit_cast(bf16x8, w); }
DEVFN void rg_item(Frame& F, int l, int it, int tile, int hd, int nt) {
    constexpr bool stage3 = false;
    const int lane = lane_id(), hh = lane >> 5, pl = lane & 31, m0 = tile * 32, b = m0 / L, t0 = m0 % L, grp = t0 / 16 + hh;
    const bf16* proj = (const bf16*)(F.ws + WS_PROJ); const float* cw = FIN(3) + l * 4 * RGW; const float* cb = FIN(4) + l * RGW;
    const f32x16 z16 = {0.f, 0.f, 0.f, 0.f, 0.f, 0.f, 0.f, 0.f, 0.f, 0.f, 0.f, 0.f, 0.f, 0.f, 0.f, 0.f};
    const bf16* WT = (const bf16*)(F.ws + WS_RGWT); f32x2* AG = (f32x2*)(F.ws + WS_RGAG);
    const int tt = t0 + tau32(pl); bf16x8 uf[4];
    const LAS float* CW = (const LAS float*)F.lds;
#pragma unroll
    for (int ks = 0; ks < 4; ++ks) { const int c0 = 64 * hd + 16 * ks + 8 * hh; f32x4 s0 = *(const LAS f32x4*)(CW + 4 * RGW + c0), s1 = *(const LAS f32x4*)(CW + 4 * RGW + c0 + 4);
#pragma unroll
        for (int k = 0; k < 4; ++k) { const int tk = tt + k - 1; const bool ok = (tk >= 0) && (tk < L);
            u32x4 x = {0u, 0u, 0u, 0u}; if (ok) x = *(const u32x4*)(proj + (size_t)(b * L + tk) * NINP + c0);
            const f32x4 w0 = *(const LAS f32x4*)(CW + k * RGW + c0), w1 = *(const LAS f32x4*)(CW + k * RGW + c0 + 4);
            s0 += w0 * (f32x4){bf_lo(x.x), bf_hi(x.x), bf_lo(x.y), bf_hi(x.y)}; s1 += w1 * (f32x4){bf_lo(x.z), bf_hi(x.z), bf_lo(x.w), bf_hi(x.w)}; }
        uf[ks] = pack8(s0, s1); }
    FRESH(uf[0]); FRESH(uf[1]); FRESH(uf[2]); FRESH(uf[3]);
#define RG_WOFF(d_, ks_) (((((size_t)(l * 2 + (d_)) * 2) * 6 + hd) * 64 + 32 * nt + pl) * 64 + 16 * (ks_) + 8 * hh)
    bf16x8 wA[2][4];
#pragma unroll
    for (int ks = 0; ks < 4; ++ks) { wA[0][ks] = *(const bf16x8*)(WT + RG_WOFF(0, ks)); wA[1][ks] = *(const bf16x8*)(WT + RG_WOFF(0, ks) + (size_t)6 * 4096); }
    const int c = 64 * hd + 32 * nt + pl;
    float bav2[2], bxv2[2], sp82[2];
#pragma unroll
    for (int d = 0; d < 2; ++d) { bav2[d] = CW[(5 + d) * RGW + c]; bxv2[d] = CW[(7 + d) * RGW + c]; sp82[d] = CW[(9 + d) * RGW + c]; }
    f32x16 uacc; { f32x16 zz = z16; OPAQUE16(zz); uacc = zz; }
    { bf16x8 idf[2];
#pragma unroll
      for (int q = 0; q < 2; ++q) { const int kk = pl - 16 * q - 8 * hh; u32x4 w;
          w.x = (kk >> 1) == 0 ? ((kk & 1) ? 0x3F800000u : 0x3F80u) : 0u; w.y = (kk >> 1) == 1 ? ((kk & 1) ? 0x3F800000u : 0x3F80u) : 0u;
          w.z = (kk >> 1) == 2 ? ((kk & 1) ? 0x3F800000u : 0x3F80u) : 0u; w.w = (kk >> 1) == 3 ? ((kk & 1) ? 0x3F800000u : 0x3F80u) : 0u;
          if (kk < 0 || kk > 7) w = (u32x4){0u, 0u, 0u, 0u};
          idf[q] = __builtin_bit_cast(bf16x8, w); }
      FRESH(idf[0]); FRESH(idf[1]);
      if (nt == 0) { uacc = mfma32(uf[0], idf[0], uacc); uacc = mfma32(uf[1], idf[1], uacc); MFMA_GUARD(ACC1(uacc), KV(uf[0]), KV(uf[1]), KV(idf[0]), KV(idf[1])); }
      else { uacc = mfma32(uf[2], idf[0], uacc); uacc = mfma32(uf[3], idf[1], uacc); MFMA_GUARD(ACC1(uacc), KV(uf[2]), KV(uf[3]), KV(idf[0]), KV(idf[1])); } }
    f32x16 hs = z16;
#pragma unroll
    for (int d = 0; d < 2; ++d) {
        f32x16 ga, gx; { f32x16 zz = z16; OPAQUE16(zz); ga = zz; f32x16 z2 = z16; OPAQUE16(z2); gx = z2; }
        bf16x8 wa[4], wx[4];
#pragma unroll
        for (int ks = 0; ks < 4; ++ks) { wa[ks] = wA[0][ks]; wx[ks] = wA[1][ks]; FRESH(wa[ks]); FRESH(wx[ks]); }
#pragma unroll
        for (int ks = 0; ks < 4; ++ks) { ga = mfma32(uf[ks], wa[ks], ga); gx = mfma32(uf[ks], wx[ks], gx); }
        MFMA_GUARD(ACC2(ga, gx), KV(uf[0]), KV(uf[1]), KV(uf[2]), KV(uf[3]), KV(wa[0]), KV(wa[1]), KV(wa[2]), KV(wa[3]), KV(wx[0]), KV(wx[1]), KV(wx[2]), KV(wx[3]));
        if (d == 0) {
#pragma unroll
            for (int ks = 0; ks < 4; ++ks) { wA[0][ks] = *(const bf16x8*)(WT + RG_WOFF(1, ks)); wA[1][ks] = *(const bf16x8*)(WT + RG_WOFF(1, ks) + (size_t)6 * 4096); } }
        const float bav = -1.4426950408889634f * bav2[d], bxv = -1.4426950408889634f * bxv2[d], sp8 = sp82[d];
        const float s2 = -1.4426950408889634f * sp8, sx = -2.0f * sp8;
        u32x4* ab = (u32x4*)(d == 0 ? F.ws + WS_RGAB0 : (unsigned char*)F.out + OUT_RGAB1) + (size_t)it * 256 + lane;
#pragma unroll
        for (int k = 0; k < 4; ++k) { u32x4 pk;
#pragma unroll
            for (int e = 0; e < 4; ++e) { const int reg = 4 * k + e; const float r = fast_rcp(1.0f + fast_exp2(ga[reg] + bav)), ig = fast_rcp(1.0f + fast_exp2(gx[reg] + bxv)), l2 = r * s2, x = r * sx, av = fast_exp2(l2);
                const float pm = -x * (1.0f + x * (0.5f + x * (0.16666667f + x * (0.041666668f + x * 0.008333334f))));
                const float om = fabsf(x) < 0.25f ? pm : 1.0f - av * av;
                ga[reg] = av; gx[reg] = fast_sqrt(om) * (ig * uacc[reg]); pk[e] = pk_bf16(l2, gx[reg]); }
            ab[64 * k] = pk; }
        const size_t aidx = (((size_t)b * NG16 + grp) * 2 + d) * RGW + c;
        if (!stage3) { float P = 1.f, H = 0.f;
#pragma unroll
            for (int q = 0; q < 16; ++q) { const int reg = d == 0 ? q : 15 - q; H = ga[reg] * H + gx[reg]; P *= ga[reg]; }
            AG[aidx] = (f32x2){P, H}; }
        else { float h = ((const float*)(F.ws + WS_RGCI))[aidx];
#pragma unroll
            for (int q = 0; q < 16; ++q) { const int reg = d == 0 ? q : 15 - q; h = ga[reg] * h + gx[reg]; hs[reg] += h; } } }
    if (stage3) { bf16* ymix = (bf16*)(F.ws + WS_YMIX);
#pragma unroll
        for (int reg = 0; reg < 16; ++reg) { const size_t m = (size_t)(m0 + 16 * hh + reg); ymix[m * D + c] = f2bf_(hs[reg] * gelu_f(bf2f_(proj[m * NINP + RGW + c]))); } }
#undef RG_WOFF
}
DEVFN void rg_item3(Frame& F, int l, int it) {
    const int lane = lane_id(), hh = lane >> 5, pl = lane & 31, tile = it / 12, r = it % 12, hd = r >> 1, nt = r & 1, m0 = tile * 32, b = m0 / L, t0 = m0 % L, grp = t0 / 16 + hh, c = 64 * hd + 32 * nt + pl;
    const bf16* proj = (const bf16*)(F.ws + WS_PROJ); bf16* ymix = (bf16*)(F.ws + WS_YMIX);
    u32x4 w0[4], w1[4];
    { const u32x4* a0 = (const u32x4*)(F.ws + WS_RGAB0) + (size_t)it * 256 + lane; const u32x4* a1 = (const u32x4*)((unsigned char*)F.out + OUT_RGAB1) + (size_t)it * 256 + lane;
#pragma unroll
      for (int k = 0; k < 4; ++k) { w0[k] = a0[64 * k]; w1[k] = a1[64 * k]; } }
    const float* CI = (const float*)(F.ws + WS_RGCI); float h0 = CI[(((size_t)b * NG16 + grp) * 2 + 0) * RGW + c], h1 = CI[(((size_t)b * NG16 + grp) * 2 + 1) * RGW + c];
    bf16 gt[16];
#pragma unroll
    for (int reg = 0; reg < 16; ++reg) gt[reg] = proj[(size_t)(m0 + 16 * hh + reg) * NINP + RGW + c];
    float hs[16];
#pragma unroll
    for (int q = 0; q < 16; ++q) { const unsigned w = w0[q >> 2][q & 3]; h0 = fast_exp2(bf_lo(w)) * h0 + bf_hi(w); hs[q] = h0; }
#pragma unroll
    for (int q = 0; q < 16; ++q) { const int reg = 15 - q; const unsigned w = w1[reg >> 2][reg & 3]; h1 = fast_exp2(bf_lo(w)) * h1 + bf_hi(w); hs[reg] += h1; }
#pragma unroll
    for (int reg = 0; reg < 16; ++reg) { const size_t m = (size_t)(m0 + 16 * hh + reg); ymix[m * D + c] = f2bf_(hs[reg] * gelu_f(bf2f_(gt[reg]))); }
}
DEVFN void p_rg_stage(Frame& F, int l, const bool stage3) {
    if (stage3) { for (int it = F.gw; it < NT32 * 12; it += F.ngw) rg_item3(F, l, it); return; }
    { LAS float* CW = (LAS float*)F.lds; const float* cw = FIN(3) + l * 4 * RGW; const float* cb = FIN(4) + l * RGW;
      const float* ba = FIN(6) + l * 2 * RGW; const float* bx = FIN(8) + l * 2 * RGW; const float* sp = (const float*)(F.ws + WS_RGSP) + l * 2 * RGW;
      for (int i = F.tid; i < 11 * RGW / 4; i += NT) { const int arr = i / (RGW / 4), ch = i % (RGW / 4);
          const float* src = arr < 4 ? cw + arr * RGW : (arr == 4 ? cb : (arr < 7 ? ba + (arr - 5) * RGW : (arr < 9 ? bx + (arr - 7) * RGW : sp + (arr - 9) * RGW)));
          *(LAS f32x4*)(CW + arr * RGW + 4 * ch) = *(const f32x4*)(src + 4 * ch); }
      sync_block(); }
    for (int it = F.gw; it < NT32 * 12; it += F.ngw) { const int r = it % 12; rg_item(F, l, it, it / 12, r >> 1, r & 1); } }
constexpr int CSEG = NG16 / 16 > 0 ? NG16 / 16 : 1, CLN = NG16 / CSEG;
DEVFN void p_rg_carry(Frame& F) {
    const f32x2* __restrict__ AG = (const f32x2*)(F.ws + WS_RGAG); float* __restrict__ CI = (float*)(F.ws + WS_RGCI); const int lane = lane_id(), sl = lane % CLN;
    for (int i0 = F.gw * (64 / CLN); i0 < Bn * 2 * RGW; i0 += F.ngw * (64 / CLN)) { const int i = i0 + lane / CLN; const bool ok = i < Bn * 2 * RGW;
        const int c = ok ? i % RGW : 0, d = ok ? (i / RGW) % 2 : 0, b = ok ? i / (2 * RGW) : 0;
        f32x2 sv[CSEG]; float P = 1.f, H = 0.f;
#pragma unroll
        for (int e = 0; e < CSEG; ++e) { const int q = sl * CSEG + e, j = d == 0 ? q : NG16 - 1 - q; sv[e] = AG[(((size_t)b * NG16 + j) * 2 + d) * RGW + c]; }
#pragma unroll
        for (int e = 0; e < CSEG; ++e) { H = sv[e][0] * H + sv[e][1]; P *= sv[e][0]; }
#pragma unroll
        for (int o = 1; o < CLN; o <<= 1) { const float Pp = shfl_f32(P, lane - o), Hp = shfl_f32(H, lane - o); if (sl >= o) { H = P * Hp + H; P = P * Pp; } }
        float Hin = shfl_f32(H, lane - 1); if (sl == 0) Hin = 0.f;
        if (ok) {
#pragma unroll
            for (int e = 0; e < CSEG; ++e) { const int q = sl * CSEG + e, j = d == 0 ? q : NG16 - 1 - q; CI[(((size_t)b * NG16 + j) * 2 + d) * RGW + c] = Hin; Hin = sv[e][0] * Hin + sv[e][1]; } } }
}
constexpr int S5_HS = 272  , S5_YS = 784  ;
struct S5Ops { bf16x8 bb[2][2]; f32x2 A[2]; f32x2 C[2]; };
DEVFN void s5_load_ops(S5Ops& o, const bf16* BT, const f32x2* SA, const f32x2* CIp, size_t dg, size_t sbase, int pl, int hh, const bool stage3) {
#pragma unroll
    for (int ri = 0; ri < 2; ++ri)
#pragma unroll
        for (int ph = 0; ph < 2; ++ph) o.bb[ri][ph] = *(const bf16x8*)(BT + ((dg * 2 + ri) * 64 + 32 * ph + pl) * 16 + 8 * hh);
#pragma unroll
    for (int ph = 0; ph < 2; ++ph) { o.A[ph] = SA[dg * 64 + 32 * ph + pl]; if (stage3) { const unsigned cw_ = ((const unsigned*)CIp)[sbase + 32 * ph]; o.C[ph] = (f32x2){bf_lo(cw_), bf_hi(cw_)}; } else o.C[ph] = (f32x2){0.f, 0.f}; }
}
DEVFN void s5_tile(Frame& F, int l, int tile, const bool stage3, const int slot) {
    const int lane = lane_id(), w = F.wave, hh = lane >> 5, pl = lane & 31, m0 = tile * 32, b = m0 / L, grp = (m0 % L) / 16 + hh;
    const bf16* proj = (const bf16*)(F.ws + WS_PROJ); const bf16* BT = (const bf16*)(F.ws + WS_S5BT); const bf16* CT = (const bf16*)(F.ws + WS_S5CT);
    const f32x2* SA = (const f32x2*)(F.ws + WS_S5A); f32x2* SS = (f32x2*)(F.ws + WS_S5S); const f32x2* CIp = (const f32x2*)(F.ws + WS_S5CI);
    LAS unsigned char* Hw = F.lds + w * (32 * S5_HS); LAS unsigned char* YT = F.lds + 8 * 32 * S5_HS + slot * (32 * S5_YS);
    const f32x16 z16 = {0.f, 0.f, 0.f, 0.f, 0.f, 0.f, 0.f, 0.f, 0.f, 0.f, 0.f, 0.f, 0.f, 0.f, 0.f, 0.f};
#define S5_DG(g_, d_) ((size_t)(l * 2 + (d_)) * 24 + (g_))
#define S5_SB(g_, d_) ((((size_t)b * NG16 + grp) * 2 + (d_)) * 1536 + (g_) * 64 + pl)
    S5Ops o0, o1; s5_load_ops(o0, BT, SA, CIp, S5_DG(w, 0), S5_SB(w, 0), pl, hh, stage3);
    bf16x8 ua = *(const bf16x8*)(proj + (size_t)(m0 + tau32(pl)) * NINP + 2 * RGW + 16 * w + 8 * hh);
#pragma unroll 1
    for (int gi = 0; gi < 3; ++gi) { const int g = w + 8 * gi, gn = g + 8;
        f32x4 yacc[2] = {(f32x4){0.f, 0.f, 0.f, 0.f}, (f32x4){0.f, 0.f, 0.f, 0.f}};
        bf16x8 uan = ua;
#pragma unroll
        for (int d = 0; d < 2; ++d) { const size_t dg = S5_DG(g, d);
            S5Ops& o = d == 0 ? o0 : o1;
            if (d == 0) s5_load_ops(o1, BT, SA, CIp, S5_DG(g, 1), S5_SB(g, 1), pl, hh, stage3);
            else if (gi < 2) { s5_load_ops(o0, BT, SA, CIp, S5_DG(gn, 0), S5_SB(gn, 0), pl, hh, stage3); uan = *(const bf16x8*)(proj + (size_t)(m0 + tau32(pl)) * NINP + 2 * RGW + 16 * gn + 8 * hh); }
            bf16x8 b2[2][4];
            if (stage3) {
#pragma unroll
                for (int rt = 0; rt < 2; ++rt)
#pragma unroll
                    for (int ks = 0; ks < 4; ++ks) b2[rt][ks] = *(const bf16x8*)(CT + (dg * 16 + (lane & 15)) * 128 + 32 * ks + 8 * (lane >> 4)); }
            f32x16 acc[2][2];
#ifdef CPU_EMU
            { acc[0][0] = mfma32(ua, o.bb[0][0], z16); acc[0][1] = mfma32(ua, o.bb[0][1], z16); acc[1][0] = mfma32(ua, o.bb[1][0], z16); acc[1][1] = mfma32(ua, o.bb[1][1], z16); }
#else
            asm volatile("s_nop 1\n\tv_mfma_f32_32x32x16_bf16 %0, %4, %5, 0\n\tv_mfma_f32_32x32x16_bf16 %1, %4, %6, 0\n\tv_mfma_f32_32x32x16_bf16 %2, %4, %7, 0\n\tv_mfma_f32_32x32x16_bf16 %3, %4, %8, 0\n\t"
                         "s_nop 7\n\ts_nop 7\n\ts_nop 7\n\ts_nop 7"
                         : "=&v"(acc[0][0]), "=&v"(acc[0][1]), "=&v"(acc[1][0]), "=&v"(acc[1][1]) : "v"(ua), "v"(o.bb[0][0]), "v"(o.bb[0][1]), "v"(o.bb[1][0]), "v"(o.bb[1][1]));
#endif
#pragma unroll
            for (int ph = 0; ph < 2; ++ph) { const f32x2 A = o.A[ph]; const size_t sidx = S5_SB(g, d) + 32 * ph;
                float hr = o.C[ph][0], hi = o.C[ph][1];
#pragma unroll
                for (int q = 0; q < 16; ++q) { const int reg = d == 0 ? q : 15 - q; const float nr = fnma_s(A[1], hi, fma_s(A[0], hr, acc[0][ph][reg])), ni = fma_s(A[1], hr, fma_s(A[0], hi, acc[1][ph][reg]));
                    hr = nr; hi = ni; acc[0][ph][reg] = nr; acc[1][ph][reg] = ni; }
                if (!stage3) ((unsigned*)SS)[sidx] = pk_bf16(hr, hi);
                else {
#pragma unroll
                    for (int reg = 0; reg < 16; ++reg) *(LAS unsigned*)(Hw + (16 * hh + reg) * S5_HS + 4 * (32 * ph + pl)) = pk_bf16(acc[0][ph][reg], acc[1][ph][reg]); } }
            if (stage3) { WAVE_LDS_FENCE();
#pragma unroll
                for (int rt = 0; rt < 2; ++rt) { bf16x8 a2[4];
#pragma unroll
                    for (int ks = 0; ks < 4; ++ks) a2[ks] = *(const LAS bf16x8*)(Hw + (16 * rt + (lane & 15)) * S5_HS + (32 * ks + 8 * (lane >> 4)) * 2);
                    FRESH(b2[rt][0]); FRESH(b2[rt][1]); FRESH(b2[rt][2]); FRESH(b2[rt][3]); FRESH(a2[0]); FRESH(a2[1]); FRESH(a2[2]); FRESH(a2[3]);
#pragma unroll
                    for (int ks = 0; ks < 4; ++ks) yacc[rt] = mfma16(a2[ks], b2[rt][ks], yacc[rt]);
                    MFMA_GUARD(ACC1(yacc[rt]), KV(a2[0]), KV(a2[1]), KV(a2[2]), KV(a2[3]), KV(b2[rt][0]), KV(b2[rt][1]), KV(b2[rt][2]), KV(b2[rt][3])); }
                WAVE_LDS_FENCE(); } }
        if (stage3) { const int c = lane & 15; const float dsk = FIN(17)[l * S5W + 16 * g + c];
#pragma unroll
            for (int rt = 0; rt < 2; ++rt)
#pragma unroll
                for (int reg = 0; reg < 4; ++reg) { const int t = 16 * rt + 4 * (lane >> 4) + reg; const float u = bf2f_(proj[(size_t)(m0 + t) * NINP + 2 * RGW + 16 * g + c]);
                    *(LAS bf16*)(YT + t * S5_YS + (16 * g + c) * 2) = f2bf_(gelu_f(yacc[rt][reg] + dsk * u)); } }
        ua = uan; }
#undef S5_DG
#undef S5_SB
}
DEVFN void s5_glu(Frame& F, int l, int tileA, int tileB) {
    const int lane = lane_id(), w = F.wave, hh = lane >> 5, pl = lane & 31, slot = w >> 2, wq = w & 3; const int tile = slot ? tileB : tileA;
    const f32x16 z16 = {0.f, 0.f, 0.f, 0.f, 0.f, 0.f, 0.f, 0.f, 0.f, 0.f, 0.f, 0.f, 0.f, 0.f, 0.f, 0.f};
    if (tile >= 0) { const int m0 = tile * 32; LAS unsigned char* YT = F.lds + 8 * 32 * S5_HS + slot * (32 * S5_YS);
        const bf16* WG = (const bf16*)(F.ws + WS_WGLU + l * SZ_WGLU); bf16* ymix = (bf16*)(F.ws + WS_YMIX);
        f32x16 ga[3] = {z16, z16, z16}; OPAQUE16(ga[0]); OPAQUE16(ga[1]); OPAQUE16(ga[2]);
        float gbias[3];
#pragma unroll
        for (int j = 0; j < 3; ++j) gbias[j] = FIN(19)[l * S5W + 32 * (wq + 4 * j) + pl];
        const bf16* wp[3];
#pragma unroll
        for (int j = 0; j < 3; ++j) wp[j] = WG + ((size_t)(wq + 4 * j) * 24 * 64 + lane) * 8;
#pragma unroll 1
        for (int c8 = 0; c8 < 3; ++c8) { bf16x8 bw[8][3];
#pragma unroll
            for (int q = 0; q < 8; ++q)
#pragma unroll
                for (int j = 0; j < 3; ++j) bw[q][j] = *(const bf16x8*)(wp[j] + 512 * (8 * c8 + q));
#pragma unroll
            for (int q = 0; q < 8; ++q) { const int ks = 8 * c8 + q; bf16x8 aq = *(const LAS bf16x8*)(YT + pl * S5_YS + (16 * ks + 8 * hh) * 2); bf16x8 bq[3] = {bw[q][0], bw[q][1], bw[q][2]};
                FRESH(bq[0]); FRESH(bq[1]); FRESH(bq[2]); FRESH(aq);
#pragma unroll
                for (int j = 0; j < 3; ++j) ga[j] = mfma32(aq, bq[j], ga[j]);
                MFMA_GUARD(ACC3(ga[0], ga[1], ga[2]), KV(aq), KV(bq[0]), KV(bq[1]), KV(bq[2])); } }
#pragma unroll
        for (int j = 0; j < 3; ++j) { const int n = 32 * (wq + 4 * j) + pl; const float bias = gbias[j];
#pragma unroll
            for (int reg = 0; reg < 16; ++reg) { const int t = (reg & 3) + 8 * (reg >> 2) + 4 * hh; const float y = bf2f_(*(const LAS bf16*)(YT + t * S5_YS + n * 2));
                ymix[(size_t)(m0 + t) * D + RGW + n] = f2bf_(y * sigmoid_f(ga[j][reg] + bias)); } } }
}
DEVFN void p_s5_stage(Frame& F, int l, const bool stage3) {
    int tile0 = (int)blockIdx.x; OPAQUE_S(tile0);
    if (!stage3) { for (int tile = tile0; tile < NT32; tile += F.G) s5_tile(F, l, tile, false, 0); return; }
    for (int tile = tile0; tile < NT32; tile += 2 * F.G) { const int tileB = tile + F.G < NT32 ? tile + F.G : -1;
        s5_tile(F, l, tile, true, 0); if (tileB >= 0) s5_tile(F, l, tileB, true, 1);
        sync_block(); s5_glu(F, l, tile, tileB); sync_block(); }
}
constexpr int CSEG5 = NG16 / 8 > 0 ? NG16 / 8 : 1, CLN5 = NG16 / CSEG5;
DEVFN void p_s5_carry(Frame& F, int l) {
    const f32x2* SS = (const f32x2*)(F.ws + WS_S5S); f32x2* CI = (f32x2*)(F.ws + WS_S5CI);       const f32x2* A16 = (const f32x2*)(F.ws + WS_S5A16); const int lane = lane_id(), sl = lane % CLN5;
    for (int i0 = F.gw * (64 / CLN5); i0 < Bn * 2 * 1536; i0 += F.ngw * (64 / CLN5)) { const int i = i0 + lane / CLN5; const bool ok = i < Bn * 2 * 1536;
        const int gp = ok ? i % 1536 : 0, d = ok ? (i / 1536) % 2 : 0, b = ok ? i / 3072 : 0; const f32x2 A = A16[(size_t)(l * 2 + d) * 1536 + gp];
        f32x2 sv[CSEG5]; float hr = 0.f, hi = 0.f, pr = 1.f, pi = 0.f;
#pragma unroll
        for (int e = 0; e < CSEG5; ++e) { const int q = sl * CSEG5 + e, j = d == 0 ? q : NG16 - 1 - q; { const unsigned sw_ = ((const unsigned*)SS)[(((size_t)b * NG16 + j) * 2 + d) * 1536 + gp]; sv[e] = (f32x2){bf_lo(sw_), bf_hi(sw_)}; } }
#pragma unroll
        for (int e = 0; e < CSEG5; ++e) { const float nr = A[0] * hr - A[1] * hi + sv[e][0], ni = A[0] * hi + A[1] * hr + sv[e][1]; hr = nr; hi = ni; const float qr = A[0] * pr - A[1] * pi, qi = A[0] * pi + A[1] * pr; pr = qr; pi = qi; }
#pragma unroll
        for (int o = 1; o < CLN5; o <<= 1) { const float Pr = shfl_f32(pr, lane - o), Pi = shfl_f32(pi, lane - o), Hr = shfl_f32(hr, lane - o), Hi = shfl_f32(hi, lane - o);
            if (sl >= o) { const float nr = pr * Hr - pi * Hi + hr, ni = pr * Hi + pi * Hr + hi; hr = nr; hi = ni; const float qr = pr * Pr - pi * Pi, qi = pr * Pi + pi * Pr; pr = qr; pi = qi; } }
        float cr = shfl_f32(hr, lane - 1), ci = shfl_f32(hi, lane - 1); if (sl == 0) { cr = 0.f; ci = 0.f; }
        if (ok) {
#pragma unroll
            for (int e = 0; e < CSEG5; ++e) { const int q = sl * CSEG5 + e, j = d == 0 ? q : NG16 - 1 - q; ((unsigned*)CI)[(((size_t)b * NG16 + j) * 2 + d) * 1536 + gp] = pk_bf16(cr, ci);
                const float nr = A[0] * cr - A[1] * ci + sv[e][0], ni = A[0] * ci + A[1] * cr + sv[e][1]; cr = nr; ci = ni; } } }
}
DEVFN void row_ssq3(const u32x4 x0, const u32x4 x1, int lane, float& sa, float& sb, float& sc) {
    float s0, s1;
    { const float a0 = bf_lo(x0.x), a1 = bf_hi(x0.x), a2 = bf_lo(x0.y), a3 = bf_hi(x0.y), a4 = bf_lo(x0.z), a5 = bf_hi(x0.z), a6 = bf_lo(x0.w), a7 = bf_hi(x0.w); s0 = ((a0 * a0 + a1 * a1) + (a2 * a2 + a3 * a3)) + ((a4 * a4 + a5 * a5) + (a6 * a6 + a7 * a7)); }
    { const float a0 = bf_lo(x1.x), a1 = bf_hi(x1.x), a2 = bf_lo(x1.y), a3 = bf_hi(x1.y), a4 = bf_lo(x1.z), a5 = bf_hi(x1.z), a6 = bf_lo(x1.w), a7 = bf_hi(x1.w); s1 = ((a0 * a0 + a1 * a1) + (a2 * a2 + a3 * a3)) + ((a4 * a4 + a5 * a5) + (a6 * a6 + a7 * a7)); }
    sa = lane < 48 ? s0 : 0.f; sb = (lane >= 48 ? s0 : 0.f) + (lane < 32 ? s1 : 0.f); sc = lane >= 32 ? s1 : 0.f;
}
DEVFN float sq8(const u32x4 v) { const float a0 = bf_lo(v.x), a1 = bf_hi(v.x), a2 = bf_lo(v.y), a3 = bf_hi(v.y), a4 = bf_lo(v.z), a5 = bf_hi(v.z), a6 = bf_lo(v.w), a7 = bf_hi(v.w);
    return ((a0 * a0 + a1 * a1) + (a2 * a2 + a3 * a3)) + ((a4 * a4 + a5 * a5) + (a6 * a6 + a7 * a7)); }
DEVFN void mix_scales(Frame& F, int pm, LAS unsigned char* xl) {
    const bf16* ymix = (const bf16*)(F.ws + WS_YMIX); LAS float* TS = (LAS float*)xl; const int lane = F.lane, r8 = lane >> 3, q = lane & 7;
    float sa[4], sb[4], sc[4];
#pragma unroll
    for (int g2 = 0; g2 < 4; g2 += 2) { u32x4 v[2][16];
#pragma unroll
        for (int e = 0; e < 2; ++e) { const u32x4* rowp = (const u32x4*)(ymix + (size_t)(pm * 256 + F.wave * 32 + 8 * (g2 + e) + r8) * D) + q;
#pragma unroll
            for (int li = 0; li < 16; ++li) v[e][li] = rowp[8 * li]; }
#pragma unroll
        for (int e = 0; e < 2; ++e) { float a_ = 0.f, b_ = 0.f, c_ = 0.f;
#pragma unroll
            for (int li = 0; li < 16; ++li) { const float t = sq8(v[e][li]); if (li < 6) a_ += t; else if (li < 12) b_ += t; else c_ += t; }
            sa[g2 + e] = a_; sb[g2 + e] = b_; sc[g2 + e] = c_; } }
#pragma unroll
    for (int o = 1; o < 8; o <<= 1) {
#pragma unroll
        for (int g = 0; g < 4; ++g) { sa[g] += shfl_xor_f32(sa[g], o); sb[g] += shfl_xor_f32(sb[g], o); sc[g] += shfl_xor_f32(sc[g], o); } }
    if (q == 0) {
#pragma unroll
        for (int g = 0; g < 4; ++g) { const float ia = 1.0f / sqrtf(sa[g] * (1.0f / RGW) + 1e-6f), ib = 1.0f / sqrtf(sb[g] * (1.0f / S5W) + 1e-6f), ic = 1.0f / sqrtf(sc[g] * (1.0f / HYW) + 1e-6f);
            *(LAS f32x4*)(TS + (F.wave * 32 + 8 * g + r8) * 4) = (f32x4){ia / ib, ib / ic, ic, 0.f}; } }
    sync_block();
}
#ifdef TPROBE
DEVFN void p_tprobe(Frame& F) {
    if (blockIdx.x == 0 && F.tid < 101) { const unsigned long long* ts = (const unsigned long long*)(F.ws + WS_CTL + 8192);
        float da = (float)(ts[TPA + 1] - ts[TPA]) * 0.01f, db = (float)(ts[TPB + 1] - ts[TPB]) * 0.01f;
        da = expf(0.2231436f * rintf(logf(da) / 0.2231436f + TPOFF)); db = expf(0.2231436f * rintf(logf(db) / 0.2231436f + TPOFF));
        if (F.tid == 0) F.out[0] = 10.0f * da; else F.out[1024 + F.tid - 1] = db; }
}
#endif
DEVFN void p_final(Frame& F) {
    const float* ssq = (const float*)(F.ws + WS_SSQ); const bf16* hb = (const bf16*)(F.ws + WS_HB); const f32x4* g4 = (const f32x4*)FIN(37);
    f32x4 gv[4];
#pragma unroll
    for (int j = 0; j < 2; ++j) { gv[2 * j] = g4[2 * (F.lane + 64 * j)]; gv[2 * j + 1] = g4[2 * (F.lane + 64 * j) + 1]; }
    for (int m0 = 4 * F.gw; m0 < M; m0 += 4 * F.ngw) { u32x4 v[4][2]; float inv[4];
#pragma unroll
        for (int q = 0; q < 4; ++q) { const u32x4* hr = (const u32x4*)(hb + (size_t)(m0 + q) * D); v[q][0] = hr[F.lane]; v[q][1] = hr[F.lane + 64]; }
#pragma unroll
        for (int q = 0; q < 4; ++q) inv[q] = pg8::row_inv(ssq, m0 + q);
#pragma unroll
        for (int q = 0; q < 4; ++q) { f32x4* orow = (f32x4*)(F.out + (size_t)(m0 + q) * D);
#pragma unroll
            for (int j = 0; j < 2; ++j) { const int ch = F.lane + 64 * j; const u32x4 x = v[q][j];
                orow[2 * ch] = (f32x4){bf_lo(x.x), bf_hi(x.x), bf_lo(x.y), bf_hi(x.y)} * inv[q] * gv[2 * j]; orow[2 * ch + 1] = (f32x4){bf_lo(x.z), bf_hi(x.z), bf_lo(x.w), bf_hi(x.w)} * inv[q] * gv[2 * j + 1]; } } }
}
#ifdef TPROBE
#define TSTAMP(i) do { if (blockIdx.x == 0 && F.wave == 0 && lane_id() == 0) ((unsigned long long*)(args.ws + WS_CTL + 8192))[i] = __builtin_amdgcn_s_memrealtime(); } while (0)
#else
#define TSTAMP(i) do {} while (0)
#endif
#ifndef MK_N_LAUNCHES
#define MK_N_LAUNCHES 1
#endif
constexpr int PH_PER_LAYER = 7, N_PHASES = 2 + 2 * PH_PER_LAYER;
__global__ void __launch_bounds__(NT, 2) mk_fwd(Args args) {
#ifdef CPU_EMU
    unsigned char* lds = emu_lds_base();
#else
    extern __shared__ __attribute__((aligned(16))) unsigned char lds_[];
    LAS unsigned char* lds = (LAS unsigned char*)lds_;
#endif
    Frame F; F.lds = lds; F.tid = threadIdx.x; F.lane = F.tid & 63;
#ifdef CPU_EMU
    F.wave = F.tid >> 6;
#else
    F.wave = __builtin_amdgcn_readfirstlane(F.tid >> 6);
#endif
    F.G = gridDim.x; F.gtid = blockIdx.x * NT + F.tid; F.gsize = F.G * NT; F.gw = blockIdx.x * NWAVES + F.wave; F.ngw = F.G * NWAVES;
    #ifdef CPU_EMU
    F.ap = &args;
#else
    F.ap = (KARG_PTR)__builtin_amdgcn_kernarg_segment_ptr();
#endif
    F.out = args.out; F.ws = args.ws;
#ifndef CPU_EMU
    volatile LAS unsigned* MISC = (volatile LAS unsigned*)(lds + MISC_OFF);
    if (F.tid < 32) MISC[F.tid] = 0u;
    __syncthreads();
    XcdBarrier bar = xcd_barrier_post((unsigned*)(args.ws + WS_CTL) + CW_BAR, MISC + 8);
#define GRID_BAR() xcd_barrier(bar)
#else
#define GRID_BAR() do {} while (0)
#endif
    const int lo = args.ph_lo, hi = args.ph_hi;
#ifdef CPU_EMU
#define IN(k) (lo <= (k) && (k) < hi)
#else
#define IN(k) ([&]() { int lo_ = lo, hi_ = hi; asm volatile("" : "+s"(lo_), "+s"(hi_)); return lo_ <= (k) && (k) < hi_; }())
#endif
#define SEAM(k) do { if (IN(k) && IN((k) + 1)) GRID_BAR(); TSTAMP((k) + 1); } while (0)
#define P_SSQ ((float*)(F.ws + WS_SSQ))
#define P_HB ((bf16*)(F.ws + WS_HB))
#define P_PROJ ((bf16*)(F.ws + WS_PROJ))
#define P_YMIX ((bf16*)(F.ws + WS_YMIX))
#define P_G ((bf16*)(F.ws + WS_G))
    TSTAMP(0);
    { int l0 = 0; if (IN(0)) { LAUNDER(F, l0); p_prologue(F); } }
    SEAM(0);
    for (int lq = 0; lq < 2; ++lq) {
        int l = lq; const int p0 = 1 + lq * PH_PER_LAYER;
        if (IN(p0 + 0)) { LAUNDER(F, l);
            pg8::Gemm g{P_HB, (const bf16*)(F.ws + WS_WIN + l * SZ_WIN), D}; pg8::StaticOrder S; S.init(M / 256, NINP / 256, F.G, (int)blockIdx.x);
            pg8::EpiIn E{P_PROJ, P_SSQ};
            pg8::gemm_phase<pg8::EpiIn, pg8::StaticOrder, true, true>(lds, F.tid, g, S, E); }
        SEAM(p0 + 0);
        if (IN(p0 + 1)) { LAUNDER(F, l); p_hy_pre(F, l); p_rg_stage(F, l, false); p_s5_stage(F, l, false); }
        SEAM(p0 + 1);
        if (IN(p0 + 2)) { LAUNDER(F, l); p_s5_carry(F, l); p_rg_carry(F); p_hy_main(F, l); }
        SEAM(p0 + 2);
        if (IN(p0 + 3)) { LAUNDER(F, l); p_hy_post(F, l); p_rg_stage(F, l, true); p_s5_stage(F, l, true); }
        SEAM(p0 + 3);
        if (IN(p0 + 4)) { LAUNDER(F, l); pg8::Gemm g{P_YMIX, (const bf16*)(F.ws + WS_WOUT + l * SZ_WOUT), D}; pg8::StaticOrder S; S.init(M / 256, D / 256, F.G, (int)blockIdx.x);
            TSTAMP(20); pg8::Unit u0; if (S.next(0, u0)) mix_scales(F, u0.pm, lds + pg8::STAGE_BYTES); else sync_block();
            TSTAMP(21); pg8::EpiResMix E{F.out, P_HB, P_SSQ};
            pg8::gemm_phase<pg8::EpiResMix, pg8::StaticOrder, true, true>(lds, F.tid, g, S, E); TSTAMP(22); }
        SEAM(p0 + 4);
        if (IN(p0 + 5)) { LAUNDER(F, l); pg8::Gemm g{P_HB, (const bf16*)(F.ws + WS_WUP + l * SZ_WUP), D}; pg8::UpOrder S; S.init(Bn * NQ, FF2 / 256, F.G, (int)blockIdx.x);
            pg8::EpiUp E{P_G, P_SSQ, FIN(34) + (size_t)l * 3 * FF2, FIN(35) + (size_t)l * FF2};
            pg8::gemm_phase<pg8::EpiUp, pg8::UpOrder, true, true>(lds, F.tid, g, S, E); }
        SEAM(p0 + 5);
        if (IN(p0 + 6)) { LAUNDER(F, l); pg8::Gemm g{P_G, (const bf16*)(F.ws + WS_WDN + l * SZ_WDN), FF}; pg8::StaticOrder S; S.init(M / 256, D / 256, F.G, (int)blockIdx.x);
            pg8::EpiRes E{F.out, P_HB, P_SSQ};
            pg8::gemm_phase<pg8::EpiRes, pg8::StaticOrder, true, true>(lds, F.tid, g, S, E); }
        SEAM(p0 + 6);
    }
    { int l0 = 0; if (IN(N_PHASES - 1)) { LAUNDER(F, l0); p_final(F); } }
#ifdef TPROBE
    TSTAMP(N_PHASES); GRID_BAR(); { int l0 = 0; LAUNDER(F, l0); p_tprobe(F); }
#endif
#undef IN
#undef SEAM
}

extern "C" void kernel_launch(void* const* d_in, const int* in_sizes, int n_in, void* d_out, int out_size, void* d_ws, size_t ws_size, hipStream_t stream) {
    Args a{};
    for (int i = 0; i < 38; ++i) a.in[i] = (const float*)d_in[i];
    a.out = (float*)d_out; a.ws = (unsigned char*)d_ws;
#ifdef CPU_EMU
    const int grid = EMU_GRID;
    for (int ph = 0; ph < N_PHASES; ++ph) { a.ph_lo = ph; a.ph_hi = ph + 1; LAUNCH(mk_fwd, dim3(grid), dim3(NT), LDS_BYTES, stream, a); emu_phase_hook(ph, a); }
#else
    static int grid = 0;
    if (grid == 0) {
        if (n_in != 38 || out_size != M * D || ws_size < WS_END) { fprintf(stderr, "kernel_launch: unexpected shapes (n_in %d out %d ws %zu need %zu)\n", n_in, out_size, ws_size, (size_t)WS_END); grid = -1; return; }
        int dev = 0, cus = 0, per_cu = 0;
        if (hipGetDevice(&dev) != hipSuccess || hipDeviceGetAttribute(&cus, hipDeviceAttributeMultiprocessorCount, dev) != hipSuccess) { grid = -1; return; }
        if (hipFuncSetAttribute((const void*)mk_fwd, hipFuncAttributeMaxDynamicSharedMemorySize, LDS_BYTES) != hipSuccess) { fprintf(stderr, "kernel_launch: hipFuncSetAttribute failed\n"); grid = -1; return; }
        if (hipOccupancyMaxActiveBlocksPerMultiprocessor(&per_cu, (const void*)mk_fwd, NT, LDS_BYTES) != hipSuccess || per_cu < 1) { fprintf(stderr, "kernel_launch: occupancy query says %d\n", per_cu); (void)hipGetLastError(); per_cu = 1; }
        grid = cus;
    }
    if (grid < 0) return;
    (void)hipMemsetAsync((char*)d_ws + WS_CTL, 0, CTL_BYTES, stream);
#if MK_N_LAUNCHES == 1
    a.ph_lo = 0; a.ph_hi = N_PHASES;
    hipLaunchKernelGGL(mk_fwd, dim3(grid), dim3(NT), LDS_BYTES, stream, a);
#else
    for (int ph = 0; ph < N_PHASES; ++ph) { a.ph_lo = ph; a.ph_hi = ph + 1; hipLaunchKernelGGL(mk_fwd, dim3(grid), dim3(NT), LDS_BYTES, stream, a); }
#endif
#endif
}
```

```cpp
#ifdef CPU_EMU
#include "emu.h"
#define LAS
#define GAS
#define DEVFN static inline
#define MEMFN inline
#define WAVE_LDS_FENCE() emu::wave_sync()
#define OPAQUE16(x) do {} while (0)
#define OPAQUE_V(x) do {} while (0)
#define OPAQUE_S(x) do {} while (0)
#define FRESH(x) do {} while (0)
#define MFMA_GUARD(...) do {} while (0)
#define KV(x) 0
#define ACC1(a) 0
#define ACC2(a, b) 0
#define ACC3(a, b, c) 0
#define ACC4(a, b, c, d) 0
#else
#include <hip/hip_runtime.h>
#include <cstdio>
#include <cstdint>
#define LAS __attribute__((address_space(3)))
#define GAS __attribute__((address_space(1)))
#define DEVFN __device__ __forceinline__
#define MEMFN __device__ __forceinline__
#define WAVE_LDS_FENCE() do { asm volatile("s_waitcnt lgkmcnt(0)" ::: "memory"); } while (0)
#define OPAQUE16(x) asm volatile("" : "+v"(x))
#define OPAQUE_V(x) asm volatile("" : "+v"(x))
#define OPAQUE_S(x) asm volatile("" : "+s"(x))
#define FRESH(x) asm volatile("s_nop 1" : "+v"(x))
#define KV(x) "v"(x)
#define KA(x) "+v"(x)
#define MFMA_GUARD(accs, ...) asm volatile("s_nop 7\n\ts_nop 7\n\ts_nop 7\n\ts_nop 7" : accs : __VA_ARGS__)
#define ACC1(a) KA(a)
#define ACC2(a, b) KA(a), KA(b)
#define ACC3(a, b, c) KA(a), KA(b), KA(c)
#define ACC4(a, b, c, d) KA(a), KA(b), KA(c), KA(d)
typedef short bf16x8 __attribute__((ext_vector_type(8)));
typedef float f32x4 __attribute__((ext_vector_type(4)));
typedef float f32x2 __attribute__((ext_vector_type(2)));
typedef float f32x16 __attribute__((ext_vector_type(16)));
typedef unsigned u32x4 __attribute__((ext_vector_type(4)));
typedef unsigned u32x2 __attribute__((ext_vector_type(2)));
typedef __bf16 bf16x2_t __attribute__((ext_vector_type(2)));
DEVFN void sync_block() { __syncthreads(); }
DEVFN int lane_id() { int l; asm volatile("v_mbcnt_lo_u32_b32 %0, -1, 0\n\tv_mbcnt_hi_u32_b32 %0, -1, %0" : "=v"(l)); return l; }
DEVFN f32x16 mfma32(bf16x8 a, bf16x8 b, f32x16 c) { return __builtin_amdgcn_mfma_f32_32x32x16_bf16(a, b, c, 0, 0, 0); }
DEVFN f32x4 mfma16(bf16x8 a, bf16x8 b, f32x4 c) { return __builtin_amdgcn_mfma_f32_16x16x32_bf16(a, b, c, 0, 0, 0); }
DEVFN float shfl_f32(float v, int src) { return __builtin_bit_cast(float, __builtin_amdgcn_ds_bpermute(src << 2, __builtin_bit_cast(int, v))); }
DEVFN float shfl_xor_f32(float v, int m) { return shfl_f32(v, lane_id() ^ m); }
DEVFN float dpp_row_shr1(float old, float src) { return __builtin_bit_cast(float, __builtin_amdgcn_update_dpp(__builtin_bit_cast(int, old), __builtin_bit_cast(int, src), 0x111, 0xf, 0xf, false)); }
DEVFN float dpp_row_shl1(float old, float src) { return __builtin_bit_cast(float, __builtin_amdgcn_update_dpp(__builtin_bit_cast(int, old), __builtin_bit_cast(int, src), 0x101, 0xf, 0xf, false)); }
DEVFN float dpp_row_ror1(float src) { return __builtin_bit_cast(float, __builtin_amdgcn_update_dpp(0, __builtin_bit_cast(int, src), 0x121, 0xf, 0xf, false)); }
DEVFN float dpp_row_ror15(float src) { return __builtin_bit_cast(float, __builtin_amdgcn_update_dpp(0, __builtin_bit_cast(int, src), 0x12f, 0xf, 0xf, false)); }
DEVFN unsigned pk_bf16(float lo, float hi) { f32x2 v = {lo, hi}; bf16x2_t b = __builtin_convertvector(v, bf16x2_t); return __builtin_bit_cast(unsigned, b); }
DEVFN float bf_lo(unsigned u) { return __builtin_bit_cast(float, u << 16); }
DEVFN float bf_hi(unsigned u) { return __builtin_bit_cast(float, u & 0xffff0000u); }
DEVFN float fast_rcp(float x) { return __builtin_amdgcn_rcpf(x); }
DEVFN float sin_rev(float r) { return __builtin_amdgcn_sinf(r); }
DEVFN float cos_rev(float r) { return __builtin_amdgcn_cosf(r); }
DEVFN float fast_exp2(float x) { return __builtin_amdgcn_exp2f(x); }
DEVFN float fast_sqrt(float x) { return __builtin_amdgcn_sqrtf(x); }
DEVFN float fma_s(float a, float b, float c) { float r; asm("v_fma_f32 %0, %1, %2, %3" : "=v"(r) : "v"(a), "v"(b), "v"(c)); return r; }
DEVFN float fnma_s(float a, float b, float c) { float r; asm("v_fma_f32 %0, -%1, %2, %3" : "=v"(r) : "v"(a), "v"(b), "v"(c)); return r; }
DEVFN unsigned wave_shr1(unsigned v) { return (unsigned)__builtin_amdgcn_update_dpp(0, (int)v, 0x138, 0xf, 0xf, true); }
#endif
#ifdef CPU_EMU
static inline float fast_sqrt(float x) { return sqrtf(x); }
static inline float fma_s(float a, float b, float c) { return a * b + c; }
static inline float fnma_s(float a, float b, float c) { return c - a * b; }
static inline unsigned wave_shr1(unsigned v) { const int l = lane_id(); const unsigned r = shfl_u32(v, l - 1); return l == 0 ? 0u : r; }
#endif

#ifndef BATCH
#define BATCH 4
#endif
#ifndef SEQ
#define SEQ 4096
#endif
typedef unsigned short bf16;
constexpr int Bn = BATCH, L = SEQ, M = Bn * L, D = 1024, NIN = 1920, NINP = 2048, RGW = 384, S5W = 384, HYW = 256, FF = 2816, FF2 = 5632, GLUP = 512;
constexpr int NWAVES = 8, NT = NWAVES * 64;
constexpr int UPS = 254, NQ = (L + UPS - 1) / UPS;

constexpr size_t al256(size_t x) { return (x + 255) & ~(size_t)255; }
constexpr size_t WS_CTL = 0, CTL_BYTES = 1u << 20;
constexpr size_t WS_SSQ = WS_CTL + CTL_BYTES, SZ_SSQ = (size_t)M * 16 * 4;
constexpr size_t WS_S5A = WS_SSQ + SZ_SSQ, SZ_S5A = (size_t)2 * 2 * 24 * 64 * 8;
constexpr size_t WS_S5A16 = WS_S5A + SZ_S5A;
constexpr size_t WS_S5BT = WS_S5A16 + SZ_S5A, SZ_S5BT = (size_t)2 * 2 * 24 * 2 * 64 * 16 * 2;
constexpr size_t WS_S5CT = WS_S5BT + SZ_S5BT, SZ_S5CT = (size_t)2 * 2 * 24 * 16 * 128 * 2;
constexpr size_t WS_RGSP = WS_S5CT + SZ_S5CT, SZ_RGSP = al256((size_t)2 * 2 * 384 * 4);
constexpr size_t WS_RGWT = WS_RGSP + SZ_RGSP, SZ_RGWT = (size_t)2 * 2 * 2 * 6 * 64 * 64 * 2;
constexpr size_t WS_RGAG = WS_RGWT + SZ_RGWT, SZ_RGAG = (size_t)(M / 16) * 2 * RGW * 8;
constexpr size_t WS_RGCI = WS_RGAG + SZ_RGAG, SZ_RGCI = (size_t)(M / 16) * 2 * RGW * 4;
constexpr size_t WS_HID = WS_RGCI + SZ_RGCI, SZ_HID = 0;
constexpr size_t WS_T1 = WS_HID + SZ_HID, SZ_T1 = (size_t)(M / 16) * 2 * 1536 * 8;
constexpr size_t WS_S5S = WS_T1;
constexpr size_t WS_S5CI = WS_T1;
constexpr size_t WS_RGAB0 = WS_T1 + SZ_T1, SZ_RGAB = (size_t)M * RGW * 4;
constexpr size_t WS_KFB = WS_RGAB0 + SZ_RGAB, SZ_KFB = (size_t)2 * 512 * L * 4;
constexpr size_t SZ_WIN = (size_t)NINP * D * 2, SZ_WOUT = (size_t)D * D * 2, SZ_WUP = (size_t)FF2 * D * 2, SZ_WDN = (size_t)D * FF * 2, SZ_WGLU = (size_t)GLUP * S5W * 2;
constexpr size_t WS_WIN = WS_KFB + SZ_KFB, WS_WOUT = WS_WIN + 2 * SZ_WIN, WS_WUP = WS_WOUT + 2 * SZ_WOUT, WS_WDN = WS_WUP + 2 * SZ_WUP, WS_WGLU = WS_WDN + 2 * SZ_WDN;
constexpr size_t WS_HBPAD = WS_WGLU + 2 * SZ_WGLU, HB_FRONT = (size_t)256 * D * 2, WS_HB = WS_HBPAD + HB_FRONT, SZ_HBPAD = (size_t)(M + 768) * D * 2;
constexpr size_t WS_PROJ = WS_HBPAD + SZ_HBPAD, SZ_PROJ = (size_t)M * NINP * 2;
constexpr size_t WS_YMIX = WS_PROJ + SZ_PROJ, SZ_YMIX = (size_t)M * D * 2;
constexpr size_t WS_G = WS_PROJ;
constexpr size_t WS_END = WS_YMIX + SZ_YMIX;
constexpr size_t OUT_ZT = 0, OUT_YT = (size_t)M * 256 * 2, OUT_RGAB1 = (size_t)M * 256 * 6;
static_assert(SZ_PROJ + SZ_YMIX >= (size_t)M * FF * 2, "g overlay");
static_assert((size_t)M * 256 * 6 + SZ_RGAB <= (size_t)M * D * 4, "zT/yT/RG pairs in d_out");
static_assert(SZ_RGAB <= SZ_T1 || true, "");
static_assert(BATCH != 4 || SEQ != 4096 || WS_END <= ((size_t)256 << 20), "workspace over 256 MiB");

DEVFN float gelu_f(float x) { const float y = 1.5957691216057308f * (x + 0.044715f * x * x * x); return x * fast_rcp(1.0f + fast_exp2(-1.4426950408889634f * y)); }
DEVFN float sigmoid_f(float x) { return fast_rcp(1.0f + fast_exp2(-1.4426950408889634f * x)); }
DEVFN float softplus_f(float x) { return x > 0.f ? x + log1pf(expf(-x)) : log1pf(expf(x)); }
DEVFN float exp_f(float x) { return fast_exp2(1.4426950408889634f * x); }
DEVFN float expm1_f(float x) {
    const float p = x * (1.0f + x * (0.5f + x * (0.16666667f + x * (0.041666668f + x * (0.008333334f + x * 0.0013888889f)))));
    return fabsf(x) < 0.25f ? p : exp_f(x) - 1.0f; }
DEVFN float bf2f_(bf16 h) { return bf_lo((unsigned)h); }
DEVFN bf16 f2bf_(float f) { return (bf16)(pk_bf16(f, 0.f) & 0xffffu); }

namespace pg8 {
constexpr int BM = 256, BK = 64, HALF = 128, HTB = HALF * BK * 2, STAGE_BYTES = 8 * HTB, NXCD = 8, WGM = 8;
__host__ __device__ __forceinline__ int lds_byte(int r, int c) { const int st = (r >> 4) * 2 + (c >> 5), rr = r & 15, cc = c & 31, ob = rr * 64 + cc * 2; return st * 1024 + (ob ^ (((ob >> 9) & 1) << 5)); }
__host__ __device__ __forceinline__ void stage_rc(int b, int& R, int& C) { const int st = b / 1024, sb = b % 1024, swz = sb ^ (((sb >> 9) & 1) << 5); R = (st >> 1) * 16 + swz / 64; C = (st & 1) * 32 + (swz % 64) / 2; }
__host__ __device__ __forceinline__ int perm32(int rho) { const int n = rho >> 4, i = rho & 15; return 8 * (i >> 2) + 4 * n + (i & 3); }

struct Unit { int pm, pn; int arow; };
struct Gemm { const bf16* A; const bf16* Bt; int K; };

struct StaticOrder {
    int nM, nN, nwg, G, c;
    __host__ __device__ __forceinline__ void init(int nM_, int nN_, int G_, int c_) { nM = nM_; nN = nN_; nwg = nM * nN; G = G_; c = c_; }
    __host__ __device__ __forceinline__ bool next(int i, Unit& u) const {
        const long Lx = (long)i * G + c; if (Lx >= nwg) return false;
        int wgid = (int)Lx; { const int q = nwg / NXCD, r = nwg % NXCD, xcd = wgid % NXCD, off = wgid / NXCD; wgid = (xcd < r ? xcd * (q + 1) : r * (q + 1) + (xcd - r) * q) + off; }
        const int nig = WGM * nN, gid = wgid / nig, fm = gid * WGM, gsz = (nM - fm) < WGM ? (nM - fm) : WGM;
        u.pm = fm + ((wgid % nig) % gsz); u.pn = (wgid % nig) / gsz; u.arow = u.pm * BM; return true;
    }
};
struct UpOrder : StaticOrder {
    __host__ __device__ __forceinline__ bool next(int i, Unit& u) const { if (!StaticOrder::next(i, u)) return false; const int b = u.pm / NQ, q = u.pm % NQ; u.arow = b * L + UPS * q - 1; return true; }
};

#ifndef CPU_EMU
#define PG8_LAS __attribute__((address_space(3)))
template <class Epi, class Sched, bool ALIGN_EPI = false, bool SP2 = false>
__device__ __forceinline__ void gemm_phase(PG8_LAS unsigned char* lds, const int tid, const Gemm g, const Sched& S, const Epi& E) {
    const int wid = __builtin_amdgcn_readfirstlane(tid >> 6), lane = tid & 63, wr = wid >> 2, wc = wid & 3, fr = lane & 15, fq = lane >> 4;
    const int K = g.K, nt = K / BK;
    unsigned voffA[2], voffB[2];
#pragma unroll
    for (int i = 0; i < 2; ++i) { int R, C; stage_rc(tid * 16 + i * 8192, R, C); const int Rb = Epi::PERM ? ((R & ~31) + perm32(R & 31)) : R;
        const int Ra = Epi::APERM ? ((R & ~63) + 4 * (R & 15) + ((R >> 4) & 3)) : R;
        voffA[i] = (unsigned)(Ra * K + C) * 2u; voffB[i] = (unsigned)(Rb * K + C) * 2u; }
    const size_t kstep = (size_t)(BK * 2);
    const size_t hstep = (size_t)HALF * K * 2;
    const size_t tstep = 2 * hstep;
    const size_t rstep = (size_t)K * 2;
    const unsigned ldsw = (unsigned)wid * 1024u;
    const int aoff = lds_byte(wr * 64 + fr, fq * 8), boff = lds_byte(wc * 32 + fr, fq * 8);
#define PG8_SA(b, h) (((b) * 2 + (h)) * HTB)
#define PG8_SB(b, h) ((4 + (b) * 2 + (h)) * HTB)
#define PG8_STAGE(bufoff, gbase, voff) do { _Pragma("unroll") for (int _i = 0; _i < 2; ++_i) \
        __builtin_amdgcn_global_load_lds((const unsigned*)((const char*)(gbase) + (voff)[_i]), (PG8_LAS unsigned*)(lds + (bufoff) + ldsw + _i * 8192), 16, 0, 0); } while (0)
#define PG8_LDA(dst, b, h) do { _Pragma("unroll") for (int m = 0; m < 4; ++m) _Pragma("unroll") for (int k = 0; k < 2; ++k) dst[m][k] = *(const PG8_LAS bf16x8*)(lds + PG8_SA(b, h) + aoff + m * 2048 + k * 1024); } while (0)
#define PG8_LDB(dst, b, h) do { _Pragma("unroll") for (int n = 0; n < 2; ++n) _Pragma("unroll") for (int k = 0; k < 2; ++k) dst[n][k] = *(const PG8_LAS bf16x8*)(lds + PG8_SB(b, h) + boff + n * 2048 + k * 1024); } while (0)
#define PG8_MMA(ai, bj, At, Bt) do { __builtin_amdgcn_s_setprio(1); _Pragma("unroll") for (int m = 0; m < 4; ++m) _Pragma("unroll") for (int n = 0; n < 2; ++n) _Pragma("unroll") for (int k = 0; k < 2; ++k) \
        acc[ai][bj][m][n] = __builtin_amdgcn_mfma_f32_16x16x32_bf16(Bt[n][k], At[m][k], acc[ai][bj][m][n], 0, 0, 0); __builtin_amdgcn_s_setprio(0); } while (0)
#define PG8_WAIT_V(n) asm volatile("s_waitcnt vmcnt(" #n ")" ::: "memory")
#define PG8_WAIT_L(n) asm volatile("s_waitcnt lgkmcnt(" #n ")" ::: "memory")
#define PG8_BAR __builtin_amdgcn_s_barrier()
#define PG8_SCHED __builtin_amdgcn_sched_barrier(0)
    Unit cur, nxt; int ui = 0;
    if (!S.next(0, cur)) return;
    f32x4 acc[2][2][4][2];
#pragma unroll
    for (int a = 0; a < 2; ++a)
#pragma unroll
        for (int b = 0; b < 2; ++b)
#pragma unroll
            for (int m = 0; m < 4; ++m)
#pragma unroll
                for (int n = 0; n < 2; ++n) acc[a][b][m][n] = (f32x4){0.f, 0.f, 0.f, 0.f};
    bf16x8 At[4][2], B0[2][2], B1[2][2];
    const char* cA = (const char*)g.A + (long)cur.arow * (long)rstep; const char* cB = (const char*)g.Bt + (size_t)cur.pn * tstep;
    if constexpr (SP2) {
        PG8_STAGE(PG8_SB(0, 0), cB, voffB); PG8_STAGE(PG8_SB(0, 1), cB + hstep, voffB); PG8_STAGE(PG8_SA(0, 0), cA, voffA); PG8_STAGE(PG8_SA(0, 1), cA + hstep, voffA);
        if (wr == 1) PG8_BAR;
        PG8_WAIT_V(2); PG8_BAR;
        PG8_STAGE(PG8_SB(1, 0), cB + kstep, voffB); PG8_STAGE(PG8_SA(1, 0), cA + kstep, voffA); PG8_STAGE(PG8_SB(1, 1), cB + hstep + kstep, voffB);
        PG8_WAIT_V(6); PG8_BAR;
    } else {
        PG8_STAGE(PG8_SB(0, 0), cB, voffB); PG8_STAGE(PG8_SA(0, 0), cA, voffA); PG8_STAGE(PG8_SB(0, 1), cB + hstep, voffB); PG8_STAGE(PG8_SA(0, 1), cA + hstep, voffA);
        if (wr == 1) PG8_BAR;
        PG8_WAIT_V(4); PG8_BAR;
        PG8_STAGE(PG8_SB(1, 0), cB + kstep, voffB); PG8_STAGE(PG8_SA(1, 0), cA + kstep, voffA); PG8_STAGE(PG8_SB(1, 1), cB + hstep + kstep, voffB);
        PG8_WAIT_V(6); PG8_BAR;
    }
    for (;;) {
        const bool has_next = S.next(ui + 1, nxt);
        const char* nA = has_next ? (const char*)g.A + (long)nxt.arow * (long)rstep : cA; const char* nB = has_next ? (const char*)g.Bt + (size_t)nxt.pn * tstep : cB;
        for (int t = 0; t < nt; t += 2) {
            const bool last = (t == nt - 2);
            const char* a1 = cA + (size_t)(t + 1) * kstep;
            const char* a2 = last ? nA : cA + (size_t)(t + 2) * kstep; const char* b2 = last ? nB : cB + (size_t)(t + 2) * kstep;
            const char* a3 = a2 + kstep; const char* b3 = b2 + kstep;
            if constexpr (Epi::RESCALE) { if (t == Epi::T1 || t == Epi::T2) E.rescale(acc, t == Epi::T1 ? 0 : 1, wr, tid & 15, lds + STAGE_BYTES); }
            if constexpr (SP2) {
            PG8_LDB(B0, 0, 0); PG8_LDB(B1, 0, 1); PG8_SCHED; PG8_LDA(At, 0, 0); PG8_STAGE(PG8_SA(1, 1), a1 + hstep, voffA);
            PG8_WAIT_V(8); PG8_WAIT_L(0); PG8_BAR; PG8_MMA(0, 0, At, B0); PG8_MMA(0, 1, At, B1); PG8_BAR; PG8_SCHED;
            PG8_LDA(At, 0, 1); PG8_STAGE(PG8_SB(0, 0), b2, voffB); PG8_STAGE(PG8_SB(0, 1), b2 + hstep, voffB); PG8_STAGE(PG8_SA(0, 0), a2, voffA);
            PG8_WAIT_V(8); PG8_WAIT_L(0); PG8_BAR; PG8_MMA(1, 0, At, B0); PG8_MMA(1, 1, At, B1); PG8_BAR; PG8_SCHED;
            PG8_LDB(B0, 1, 0); PG8_LDB(B1, 1, 1); PG8_SCHED; PG8_LDA(At, 1, 0); PG8_STAGE(PG8_SA(0, 1), a2 + hstep, voffA);
            PG8_WAIT_V(8); PG8_WAIT_L(0); PG8_BAR; PG8_MMA(0, 0, At, B0); PG8_MMA(0, 1, At, B1); PG8_BAR; PG8_SCHED;
            PG8_LDA(At, 1, 1); PG8_STAGE(PG8_SB(1, 0), b3, voffB); PG8_STAGE(PG8_SB(1, 1), b3 + hstep, voffB); PG8_STAGE(PG8_SA(1, 0), a3, voffA);
            PG8_WAIT_V(8); PG8_WAIT_L(0); PG8_BAR; PG8_MMA(1, 0, At, B0); PG8_MMA(1, 1, At, B1); PG8_BAR; PG8_SCHED;
            } else {
            PG8_LDB(B0, 0, 0); PG8_SCHED; PG8_LDA(At, 0, 0); PG8_STAGE(PG8_SA(1, 1), a1 + hstep, voffA);
            PG8_WAIT_L(8); PG8_BAR; PG8_WAIT_L(0); PG8_MMA(0, 0, At, B0); PG8_BAR; PG8_SCHED;
            PG8_LDB(B1, 0, 1); PG8_STAGE(PG8_SB(0, 0), b2, voffB);
            PG8_BAR; PG8_WAIT_L(0); PG8_MMA(0, 1, At, B1); PG8_BAR;
            PG8_LDA(At, 0, 1); PG8_STAGE(PG8_SA(0, 0), a2, voffA);
            PG8_BAR; PG8_WAIT_L(0); PG8_MMA(1, 0, At, B0); PG8_BAR; PG8_SCHED;
            PG8_STAGE(PG8_SB(0, 1), b2 + hstep, voffB);
            PG8_WAIT_V(6); PG8_BAR; PG8_MMA(1, 1, At, B1); PG8_BAR;
            PG8_LDB(B0, 1, 0); PG8_SCHED; PG8_LDA(At, 1, 0); PG8_STAGE(PG8_SA(0, 1), a2 + hstep, voffA);
            PG8_WAIT_L(8); PG8_BAR; PG8_WAIT_L(0); PG8_MMA(0, 0, At, B0); PG8_BAR; PG8_SCHED;
            PG8_LDB(B1, 1, 1); PG8_STAGE(PG8_SB(1, 0), b3, voffB);
            PG8_BAR; PG8_WAIT_L(0); PG8_MMA(0, 1, At, B1); PG8_BAR;
            PG8_LDA(At, 1, 1); PG8_STAGE(PG8_SA(1, 0), a3, voffA);
            PG8_BAR; PG8_WAIT_L(0); PG8_MMA(1, 0, At, B0); PG8_BAR; PG8_SCHED;
            PG8_STAGE(PG8_SB(1, 1), b3 + hstep, voffB);
            PG8_WAIT_V(6); PG8_BAR; PG8_MMA(1, 1, At, B1); PG8_BAR;
            }
        }
        if constexpr (ALIGN_EPI) { if (wr == 0) PG8_BAR; }
        { int t_ = tid; asm volatile("" : "+v"(t_));
          E(acc, cur, wr, wc, t_ & 15, (t_ >> 4) & 3, lds + STAGE_BYTES); }
        if (!has_next) break;
#pragma unroll
        for (int a = 0; a < 2; ++a)
#pragma unroll
            for (int b = 0; b < 2; ++b)
#pragma unroll
                for (int m = 0; m < 4; ++m)
#pragma unroll
                    for (int n = 0; n < 2; ++n) acc[a][b][m][n] = (f32x4){0.f, 0.f, 0.f, 0.f};
        cur = nxt; cA = nA; cB = nB; ++ui;
        if constexpr (ALIGN_EPI) { if (wr == 1) PG8_BAR; }
    }
    PG8_WAIT_V(0);
    if constexpr (!ALIGN_EPI) { if (wr == 0) PG8_BAR; }
    PG8_BAR;
#undef PG8_SA
#undef PG8_SB
#undef PG8_STAGE
#undef PG8_LDA
#undef PG8_LDB
#undef PG8_MMA
#undef PG8_WAIT_V
#undef PG8_WAIT_L
#undef PG8_BAR
#undef PG8_SCHED
}
#else
template <class Epi, class Sched, bool ALIGN_EPI = false, bool SP2 = false>
static inline void gemm_phase(unsigned char* lds, const int tid, const Gemm g, const Sched& S, const Epi& E) {
    const int wid = tid >> 6, lane = tid & 63, wr = wid >> 2, wc = wid & 3, fr = lane & 15, fq = lane >> 4;
    static thread_local std::vector<float> Af, Bf;
    Unit cur;
    for (int ui = 0; S.next(ui, cur); ++ui) {
        const int K = g.K;
        sync_block();
        if (tid == 0) { Af.resize((size_t)256 * K); Bf.resize((size_t)256 * K);
            for (int r = 0; r < 256; ++r) for (int k = 0; k < K; ++k) { Af[(size_t)r * K + k] = bf2f_(g.A[((long)cur.arow + r) * K + k]); Bf[(size_t)r * K + k] = bf2f_(g.Bt[((size_t)cur.pn * 256 + r) * K + k]); } }
        sync_block();
        f32x4 acc[2][2][4][2];
        for (int ai = 0; ai < 2; ++ai) for (int bj = 0; bj < 2; ++bj) for (int m = 0; m < 4; ++m) for (int n = 0; n < 2; ++n) for (int e = 0; e < 4; ++e) {
            const int r = 128 * ai + 64 * wr + (Epi::APERM ? 4 * fr + m : 16 * m + fr), c = 128 * bj + 32 * wc + (Epi::PERM ? 8 * fq + 4 * n + e : 16 * n + 4 * fq + e);
            const float* a = &Af[(size_t)r * K]; const float* b = &Bf[(size_t)c * K]; float s = 0.f;
            if constexpr (Epi::RESCALE) { const float* TS = (const float*)(lds + STAGE_BYTES) + r * 4;
                for (int k = 0; k < K; ++k) { if (k == 64 * Epi::T1) s *= TS[0]; if (k == 64 * Epi::T2) s *= TS[1]; s += a[k] * b[k]; } }
            else for (int k = 0; k < K; ++k) s += a[k] * b[k];
            acc[ai][bj][m][n][e] = s; }
        E(acc, cur, wr, wc, fr, fq, lds + STAGE_BYTES);
    }
    sync_block();
}
#endif

DEVFN float row_inv(const float* ssq, int row) {
    const f32x4* p = (const f32x4*)(ssq + (size_t)row * 16); const f32x4 a = p[0], b = p[1], c = p[2], d = p[3];
    const float s = ((a[0] + a[1]) + (a[2] + a[3])) + ((b[0] + b[1]) + (b[2] + b[3])) + ((c[0] + c[1]) + (c[2] + c[3])) + ((d[0] + d[1]) + (d[2] + d[3]));
    return 1.0f / sqrtf(s * (1.0f / D) + 1e-6f);
}
template <class ValidFn> DEVFN void unit_row_inv(LAS float* RI, const float* ssq, int tid, long rowbase, ValidFn valid) {
    if (tid < 256) { const long row = rowbase + tid; RI[tid] = valid(tid) ? row_inv(ssq, (int)row) : 0.f; }
#ifdef CPU_EMU
    sync_block();
#else
    asm volatile("s_waitcnt lgkmcnt(0)" ::: "memory"); __builtin_amdgcn_s_barrier(); asm volatile("" ::: "memory");
#endif
}
struct EpiIn {
    static constexpr bool PERM = true, APERM = false, RESCALE = false;
    bf16* O; const float* ssq;
    MEMFN void operator()(const f32x4 (&acc)[2][2][4][2], const Unit& u, int wr, int wc, int fr, int fq, LAS unsigned char* xl) const {
        LAS float* RI = (LAS float*)(xl + 4096); unit_row_inv(RI, ssq, (wr * 4 + wc) * 64 + fq * 16 + fr, (long)u.pm * BM, [](int) { return true; });
        const int row0 = u.pm * BM + wr * 64 + fr, col0 = u.pn * BM + wc * 32 + 8 * fq;
#pragma unroll
        for (int ai = 0; ai < 2; ++ai)
#pragma unroll
            for (int m = 0; m < 4; ++m) { const int row = row0 + ai * HALF + m * 16; const float sc = RI[ai * HALF + wr * 64 + m * 16 + fr]; bf16* rowp = O + (size_t)row * NINP + col0;
#pragma unroll
                for (int bj = 0; bj < 2; ++bj) { const f32x4 v0 = acc[ai][bj][m][0] * sc, v1 = acc[ai][bj][m][1] * sc;
                    u32x4 w; w.x = pk_bf16(v0[0], v0[1]); w.y = pk_bf16(v0[2], v0[3]); w.z = pk_bf16(v1[0], v1[1]); w.w = pk_bf16(v1[2], v1[3]);
                    *(u32x4*)(rowp + bj * HALF) = w; } }
    }
};
struct EpiRes {
    static constexpr bool PERM = true, APERM = false, RESCALE = false;
    float* H; bf16* HB; float* ssq;
    MEMFN void operator()(const f32x4 (&acc)[2][2][4][2], const Unit& u, int wr, int wc, int fr, int fq, LAS unsigned char*) const {
        const int row0 = u.pm * BM + wr * 64 + fr, col0 = u.pn * BM + wc * 32 + 8 * fq;
#pragma unroll
        for (int ai = 0; ai < 2; ++ai)
#pragma unroll
            for (int m = 0; m < 4; ++m) { const int row = row0 + ai * HALF + m * 16; const size_t off = (size_t)row * D + col0; float s = 0.f;
#pragma unroll
                for (int bj = 0; bj < 2; ++bj) { u32x4* hp = (u32x4*)(HB + off + bj * HALF); const u32x4 ho = *hp;
                    const f32x4 h0 = (f32x4){bf_lo(ho.x), bf_hi(ho.x), bf_lo(ho.y), bf_hi(ho.y)} + acc[ai][bj][m][0], h1 = (f32x4){bf_lo(ho.z), bf_hi(ho.z), bf_lo(ho.w), bf_hi(ho.w)} + acc[ai][bj][m][1];
                    u32x4 w; w.x = pk_bf16(h0[0], h0[1]); w.y = pk_bf16(h0[2], h0[3]); w.z = pk_bf16(h1[0], h1[1]); w.w = pk_bf16(h1[2], h1[3]); *hp = w;
                    s += ((h0[0] * h0[0] + h0[1] * h0[1]) + (h0[2] * h0[2] + h0[3] * h0[3])) + ((h1[0] * h1[0] + h1[1] * h1[1]) + (h1[2] * h1[2] + h1[3] * h1[3])); }
                s += shfl_xor_f32(s, 16); s += shfl_xor_f32(s, 32);
                if (fq == 0) ssq[(size_t)row * 16 + u.pn * 4 + wc] = s;
                if (m == 3) asm volatile("" ::: "memory"); }
    }
};
struct EpiResMix {
    static constexpr bool PERM = true, APERM = false, RESCALE = true; static constexpr int T1 = 6, T2 = 12;
    float* H; bf16* HB; float* ssq;
    MEMFN void rescale(f32x4 (&acc)[2][2][4][2], int which, int wr, int fr, LAS unsigned char* xl) const {
        const LAS float* TS = (const LAS float*)xl;
#pragma unroll
        for (int ai = 0; ai < 2; ++ai)
#pragma unroll
            for (int m = 0; m < 4; ++m) { const float r = TS[(ai * HALF + wr * 64 + m * 16 + fr) * 4 + which];
#pragma unroll
                for (int bj = 0; bj < 2; ++bj)
#pragma unroll
                    for (int n = 0; n < 2; ++n) acc[ai][bj][m][n] = acc[ai][bj][m][n] * r; }
    }
    MEMFN void operator()(const f32x4 (&acc)[2][2][4][2], const Unit& u, int wr, int wc, int fr, int fq, LAS unsigned char* xl) const {
        const LAS float* TS = (const LAS float*)xl;
        const int row0 = u.pm * BM + wr * 64 + fr, col0 = u.pn * BM + wc * 32 + 8 * fq;
#pragma unroll
        for (int ai = 0; ai < 2; ++ai)
#pragma unroll
            for (int m = 0; m < 4; ++m) { const int row = row0 + ai * HALF + m * 16; const size_t off = (size_t)row * D + col0; float s = 0.f; const float r3 = TS[(ai * HALF + wr * 64 + m * 16 + fr) * 4 + 2];
#pragma unroll
                for (int bj = 0; bj < 2; ++bj) { u32x4* hp = (u32x4*)(HB + off + bj * HALF); const u32x4 ho = *hp;
                    const f32x4 h0 = (f32x4){bf_lo(ho.x), bf_hi(ho.x), bf_lo(ho.y), bf_hi(ho.y)} + acc[ai][bj][m][0] * r3, h1 = (f32x4){bf_lo(ho.z), bf_hi(ho.z), bf_lo(ho.w), bf_hi(ho.w)} + acc[ai][bj][m][1] * r3;
                    u32x4 w; w.x = pk_bf16(h0[0], h0[1]); w.y = pk_bf16(h0[2], h0[3]); w.z = pk_bf16(h1[0], h1[1]); w.w = pk_bf16(h1[2], h1[3]); *hp = w;
                    s += ((h0[0] * h0[0] + h0[1] * h0[1]) + (h0[2] * h0[2] + h0[3] * h0[3])) + ((h1[0] * h1[0] + h1[1] * h1[1]) + (h1[2] * h1[2] + h1[3] * h1[3])); }
                s += shfl_xor_f32(s, 16); s += shfl_xor_f32(s, 32);
                if (fq == 0) ssq[(size_t)row * 16 + u.pn * 4 + wc] = s;
                if (m == 3) asm volatile("" ::: "memory"); }
    }
};
struct EpiGlu {
    static constexpr bool PERM = true, APERM = false, RESCALE = false;
    const bf16* YG; const float* bias; bf16* YM;
    MEMFN void operator()(const f32x4 (&acc)[2][2][4][2], const Unit& u, int wr, int wc, int fr, int fq, LAS unsigned char*) const {
        const int row0 = u.pm * BM + wr * 64 + fr, col0 = u.pn * BM + wc * 32 + 8 * fq;
#pragma unroll
        for (int bj = 0; bj < 2; ++bj) { const int col = col0 + bj * HALF; if (u.pn == 1 && bj == 1) continue;
            const f32x4 b0 = *(const f32x4*)(bias + col), b1 = *(const f32x4*)(bias + col + 4);
#pragma unroll
            for (int ai = 0; ai < 2; ++ai)
#pragma unroll
                for (int m = 0; m < 4; ++m) { const int row = row0 + ai * HALF + m * 16;
                    const u32x4 y = *(const u32x4*)(YG + (size_t)row * S5W + col); const f32x4 a0 = acc[ai][bj][m][0] + b0, a1 = acc[ai][bj][m][1] + b1;
                    u32x4 w; w.x = pk_bf16(bf_lo(y.x) * sigmoid_f(a0[0]), bf_hi(y.x) * sigmoid_f(a0[1])); w.y = pk_bf16(bf_lo(y.y) * sigmoid_f(a0[2]), bf_hi(y.y) * sigmoid_f(a0[3]));
                    w.z = pk_bf16(bf_lo(y.z) * sigmoid_f(a1[0]), bf_hi(y.z) * sigmoid_f(a1[1])); w.w = pk_bf16(bf_lo(y.w) * sigmoid_f(a1[2]), bf_hi(y.w) * sigmoid_f(a1[3]));
                    *(u32x4*)(YM + (size_t)row * D + RGW + col) = w;
                    if (m == 3) asm volatile("" ::: "memory"); } }
    }
};
struct EpiUp {
    static constexpr bool PERM = true, APERM = true, RESCALE = false;
    bf16* G; const float* ssq; const float* cw; const float* cb;
    MEMFN void operator()(f32x4 (&acc)[2][2][4][2], const Unit& u, int wr, int wc, int fr, int fq, LAS unsigned char* xl) const {
        const int b = u.pm / NQ, q = u.pm % NQ, t0 = UPS * q - 1;
        LAS float* XB = (LAS float*)xl;
        const int cs = wc * 32 + 8 * fq;
        LAS float* TAPS = (LAS float*)(xl + 8192 + 2048);
        { const int tid_ = (wr * 4 + wc) * 64 + fq * 16 + fr;
          if (tid_ >= 256) { const int arr = (tid_ - 256) >> 5, ch = (tid_ - 256) & 31, jj = u.pn * 128 + 4 * ch;
              const float* src = arr == 0 ? cb + jj : (arr == 1 ? cb + FF + jj : (arr < 5 ? cw + (arr - 2) * FF2 + jj : cw + (arr - 5) * FF2 + FF + jj));
              *(LAS f32x4*)(TAPS + arr * 128 + 4 * ch) = *(const f32x4*)src; } }
        LAS float* RI = (LAS float*)(xl + 8192 + 1024); unit_row_inv(RI, ssq, (wr * 4 + wc) * 64 + fq * 16 + fr, (long)b * L + t0, [t0](int r) { const int t = t0 + r; return t >= 0 && t < L; });
#pragma unroll
        for (int ai = 0; ai < 2; ++ai)
#pragma unroll
            for (int m = 0; m < 4; ++m) { const int lr = 128 * ai + 64 * wr + 4 * fr + m, t = t0 + lr; const bool ok = (t >= 0) && (t < L);
                const float sc = RI[lr];
#pragma unroll
                for (int bj = 0; bj < 2; ++bj)
#pragma unroll
                    for (int n = 0; n < 2; ++n)
#pragma unroll
                        for (int e = 0; e < 4; ++e) acc[ai][bj][m][n][e] = ok ? acc[ai][bj][m][n][e] * sc : 0.f; }
#pragma unroll
        for (int ai = 0; ai < 2; ++ai) { const int s = 2 * ai + wr;
            if (fr == 0) {
#pragma unroll
                for (int bj = 0; bj < 2; ++bj)
#pragma unroll
                    for (int n = 0; n < 2; ++n) *(LAS f32x4*)(XB + (2 * s) * 256 + bj * 128 + cs + 4 * n) = acc[ai][bj][0][n]; }
            if (fr == 15) {
#pragma unroll
                for (int bj = 0; bj < 2; ++bj)
#pragma unroll
                    for (int n = 0; n < 2; ++n) *(LAS f32x4*)(XB + (2 * s + 1) * 256 + bj * 128 + cs + 4 * n) = acc[ai][bj][3][n]; } }
#ifdef CPU_EMU
        sync_block();
#else
        asm volatile("s_waitcnt lgkmcnt(0)" ::: "memory"); __builtin_amdgcn_s_barrier(); asm volatile("" ::: "memory");
#endif
        const int j0 = u.pn * 128 + cs;
#pragma unroll
        for (int n = 0; n < 2; ++n) {
            f32x4 wa[3], wv[3]; const f32x4 ba = *(const LAS f32x4*)(TAPS + cs + 4 * n), bv = *(const LAS f32x4*)(TAPS + 128 + cs + 4 * n);
#pragma unroll
            for (int k = 0; k < 3; ++k) { wa[k] = *(const LAS f32x4*)(TAPS + (2 + k) * 128 + cs + 4 * n); wv[k] = *(const LAS f32x4*)(TAPS + (5 + k) * 128 + cs + 4 * n); }
#pragma unroll
            for (int ai = 0; ai < 2; ++ai) { const int s = 2 * ai + wr;
                f32x4 upe[2], dne[2];
#pragma unroll
                for (int bj = 0; bj < 2; ++bj) { f32x4 pu = {0.f, 0.f, 0.f, 0.f}, pd = {0.f, 0.f, 0.f, 0.f};
                    if (s > 0) pu = *(const LAS f32x4*)(XB + (2 * (s - 1) + 1) * 256 + bj * 128 + cs + 4 * n);
                    if (s < 3) pd = *(const LAS f32x4*)(XB + (2 * (s + 1)) * 256 + bj * 128 + cs + 4 * n);
                    const f32x4 lastr = acc[ai][bj][3][n], firstr = acc[ai][bj][0][n];
#pragma unroll
                    for (int e = 0; e < 4; ++e) { upe[bj][e] = dpp_row_shr1(pu[e], lastr[e]); dne[bj][e] = dpp_row_shl1(pd[e], firstr[e]); } }
#pragma unroll
                for (int m = 0; m < 4; ++m) { const int lr = 64 * s + 4 * fr + m, t = t0 + lr;
                    const f32x4 ua = m > 0 ? acc[ai][0][m > 0 ? m - 1 : 0][n] : upe[0], da = m < 3 ? acc[ai][0][m < 3 ? m + 1 : 3][n] : dne[0];
                    const f32x4 uv = m > 0 ? acc[ai][1][m > 0 ? m - 1 : 0][n] : upe[1], dv = m < 3 ? acc[ai][1][m < 3 ? m + 1 : 3][n] : dne[1];
                    const f32x4 a = ba + wa[0] * ua + wa[1] * acc[ai][0][m][n] + wa[2] * da;
                    const f32x4 v = bv + wv[0] * uv + wv[1] * acc[ai][1][m][n] + wv[2] * dv;
                    if (lr >= 1 && lr <= UPS && t < L) { u32x2 w; w.x = pk_bf16(gelu_f(a[0]) * v[0], gelu_f(a[1]) * v[1]); w.y = pk_bf16(gelu_f(a[2]) * v[2], gelu_f(a[3]) * v[3]);
                        *(u32x2*)(G + (size_t)(b * L + t) * FF + j0 + 4 * n) = w; }
                } } }
    }
};
}

constexpr int RING_BYTES = 131072, XCH_OFF = RING_BYTES, XCH_BYTES = 8192, MISC_OFF = XCH_OFF + XCH_BYTES, LDS_BYTES = 147456;
constexpr int CW_TMO = 0, CW_BAR = 4096;
#ifndef CPU_EMU
typedef GAS unsigned gu32;
#define XB_TMO      128
#define XB_XCNT(j)  (256  + 64 * (j))
#define XB_XSUB(j)  (1280 + 64 * (j))
#define XB_XGEN(j)  (2304 + 64 * (j))
#define XB_TOP      3328
#define XB_TOPGEN   3392
#define XCD_BAR_WORDS 3456
#define XB_SPIN_CAP (1u << 22)
__device__ __forceinline__ unsigned xb_ld(unsigned* p)              { return __hip_atomic_load(p, __ATOMIC_RELAXED, __HIP_MEMORY_SCOPE_AGENT); }
__device__ __forceinline__ unsigned xb_add(unsigned* p, unsigned v) { return __hip_atomic_fetch_add(p, v, __ATOMIC_RELAXED, __HIP_MEMORY_SCOPE_AGENT); }
__device__ __forceinline__ unsigned xb_xcc_id() { return (unsigned)__builtin_amdgcn_s_getreg((3 << 11) | 20) & 0xFu; }
#define XB_SPIN(cond, bar) do { unsigned _sp = 0; while (cond) { __builtin_amdgcn_s_sleep(1); \
    if ((++_sp & 255u) == 0u) { if (xb_ld(&(bar)[XB_TMO])) break; if (_sp > XB_SPIN_CAP) { atomicAdd(&(bar)[XB_TMO], 1u); break; } } } } while (0)
struct XcdBarrier { unsigned* bar; unsigned x; volatile LAS unsigned* st; };
__device__ __forceinline__ XcdBarrier xcd_barrier_post(unsigned* bar, volatile LAS unsigned* st) {
    XcdBarrier b; b.bar = bar; b.x = xb_xcc_id(); b.st = st;
    if (threadIdx.x == 0) (void)xb_add(&bar[XB_XCNT(b.x)], 1u);
    return b;
}
__device__ __forceinline__ void xcd_barrier_complete(unsigned* bar, unsigned x, unsigned& nloc, unsigned& nx) {
    const unsigned G = gridDim.x * gridDim.y * gridDim.z;
    unsigned sum, cnt, mine, sp = 0u;
    for (;;) {
        sum = 0u; cnt = 0u; mine = 0u;
#pragma unroll
        for (unsigned j = 0; j < 16; ++j) { const unsigned c = xb_ld(&bar[XB_XCNT(j)]); sum += c; cnt += (c > 0u) ? 1u : 0u; mine = (j == x) ? c : mine; }
        if (sum == G) break;
        __builtin_amdgcn_s_sleep(1);
        if ((++sp & 255u) == 0u) { if (xb_ld(&bar[XB_TMO])) break; if (sp > XB_SPIN_CAP) { atomicAdd(&bar[XB_TMO], 1u); break; } }
    }
    nloc = mine > 0u ? mine : 1u; nx = cnt > 0u ? cnt : 1u;
}
__device__ __forceinline__ void xcd_barrier(const XcdBarrier& b) {
    asm volatile("s_waitcnt vmcnt(0)" ::: "memory");
    __syncthreads();
    if (threadIdx.x == 0) {
        unsigned* bar = b.bar;
        __builtin_amdgcn_fence(__ATOMIC_RELEASE, "agent");
        asm volatile("s_waitcnt vmcnt(0)" ::: "memory");
        __builtin_amdgcn_s_waitcnt(0);
        unsigned nloc = b.st[0], nx = b.st[1];
        if (nloc == 0u) { xcd_barrier_complete(bar, b.x, nloc, nx); b.st[0] = nloc; b.st[1] = nx; }
        const unsigned old = xb_add(&bar[XB_XSUB(b.x)], 1u);
        const unsigned gen = old / nloc;
        if (old + 1u == (gen + 1u) * nloc) {
            __builtin_amdgcn_fence(__ATOMIC_RELEASE, "agent");
            asm volatile("s_waitcnt vmcnt(0)" ::: "memory");
            const unsigned og = xb_add(&bar[XB_TOP], 1u);
            const unsigned tg = og / nx;
            if (og + 1u == (tg + 1u) * nx) xb_add(&bar[XB_TOPGEN], 1u);
            else XB_SPIN(xb_ld(&bar[XB_TOPGEN]) == tg, bar);
            __builtin_amdgcn_fence(__ATOMIC_ACQUIRE, "agent");
            asm volatile("s_waitcnt vmcnt(0)" ::: "memory");
        } else {
            XB_SPIN(xb_ld(&bar[XB_TOPGEN]) == gen, bar);
            __builtin_amdgcn_fence(__ATOMIC_ACQUIRE, "agent");
            asm volatile("s_waitcnt vmcnt(0)" ::: "memory");
        }
    }
    __syncthreads();
}
#endif

#ifdef CPU_EMU
struct Args; static void emu_phase_hook(int ph, const Args& a);
#endif
struct Args { const float* in[38]; float* out; unsigned char* ws; int ph_lo, ph_hi; };
#ifdef CPU_EMU
typedef const Args* KARG_PTR;
#else
typedef const __attribute__((address_space(4))) Args* KARG_PTR;
#endif
struct Frame {
    LAS unsigned char* lds; int tid, lane, wave, G, gtid, gsize, gw, ngw;
    KARG_PTR ap; float* out; unsigned char* ws;
};
#define FIN(i) (F.ap->in[i])
#ifdef CPU_EMU
#define LAUNDER(F, l) do {} while (0)
#else
#define LAUNDER(F, l) do { size_t z_ = 0; asm volatile("" : "+s"(z_), "+s"(F.ap), "+s"(l), "+s"(F.wave)); F.ws = args.ws + z_; F.out = args.out + z_; F.lane = lane_id(); F.tid = (F.wave << 6) | F.lane; \
    F.gtid = blockIdx.x * NT + F.tid; F.gw = blockIdx.x * NWAVES + F.wave; } while (0)
#endif

DEVFN void transpose_item(const float* W, int ldw, int K, bf16* WT, int src_col0, int dst_row0, int k0, const float* sc, LAS float* scr, int lane) {
    float tv[32];
#pragma unroll
    for (int i = 0; i < 32; ++i) { const int kk = 2 * i + (lane >> 5); tv[i] = W[(size_t)(k0 + kk) * ldw + src_col0 + (lane & 31)]; }
#pragma unroll
    for (int i = 0; i < 32; ++i) { const int kk = 2 * i + (lane >> 5); float v = tv[i]; if (sc) v *= sc[k0 + kk]; scr[kk * 33 + (lane & 31)] = v; }
    WAVE_LDS_FENCE();
    const int c = lane & 7;
#pragma unroll
    for (int j = 0; j < 4; ++j) { const int n = (lane >> 3) + 8 * j; const LAS float* s = scr + (8 * c) * 33 + n;
        u32x4 o; o.x = pk_bf16(s[0 * 33], s[1 * 33]); o.y = pk_bf16(s[2 * 33], s[3 * 33]); o.z = pk_bf16(s[4 * 33], s[5 * 33]); o.w = pk_bf16(s[6 * 33], s[7 * 33]);
        *(u32x4*)(WT + (size_t)(dst_row0 + n) * K + k0 + 8 * c) = o; }
    WAVE_LDS_FENCE();
}
DEVFN float wave_sum(float v) {
#pragma unroll
    for (int o = 1; o < 64; o <<= 1) v += shfl_xor_f32(v, o);
    return v;
}
static_assert(NT == 512, "one wave per 64 filter columns");
DEVFN void hilo8(const float (&x)[8], bf16x8& hi, bf16x8& lo) { u32x4 h, lw; float r[8];
    h.x = pk_bf16(x[0], x[1]); h.y = pk_bf16(x[2], x[3]); h.z = pk_bf16(x[4], x[5]); h.w = pk_bf16(x[6], x[7]);
    r[0] = x[0] - bf_lo(h.x); r[1] = x[1] - bf_hi(h.x); r[2] = x[2] - bf_lo(h.y); r[3] = x[3] - bf_hi(h.y); r[4] = x[4] - bf_lo(h.z); r[5] = x[5] - bf_hi(h.z); r[6] = x[6] - bf_lo(h.w); r[7] = x[7] - bf_hi(h.w);
    lw.x = pk_bf16(r[0], r[1]); lw.y = pk_bf16(r[2], r[3]); lw.z = pk_bf16(r[4], r[5]); lw.w = pk_bf16(r[6], r[7]);
    hi = __builtin_bit_cast(bf16x8, h); lo = __builtin_bit_cast(bf16x8, lw); }
DEVFN void p_filter_tables(Frame& F) {
    constexpr int H2S = 68;
    LAS float* H1 = (LAS float*)F.lds; LAS float* H2 = H1 + 32 * 64; LAS float* W1 = H2 + 32 * H2S; LAS float* W2 = W1 + 2176; LAS float* PB = W2 + 4096;
    bf16* KF = (bf16*)(F.ws + WS_KFB); const int tid = F.tid;
    const float maxd = logf(1e-2f) / 0.3f, mind = logf(1e-2f) / 1.5f;
    const f32x16 z16 = {0.f, 0.f, 0.f, 0.f, 0.f, 0.f, 0.f, 0.f, 0.f, 0.f, 0.f, 0.f, 0.f, 0.f, 0.f, 0.f};
    sync_block();
    int it0 = (int)blockIdx.x; OPAQUE_S(it0);
    for (int it = it0; it < 2 * (L / 32); it += F.G) { const int l = it / (L / 32), pos0 = (it % (L / 32)) * 32;
        const int lane = lane_id(), w = F.wave, hh = lane >> 5, pl = lane & 31;
        { const float* w1 = FIN(22) + l * 33 * 64; const float* w2 = FIN(25) + l * 4096;
          for (int i = tid; i < 33 * 64; i += NT) W1[i] = w1[i];
          for (int i = tid; i < 1024; i += NT) *(LAS f32x4*)(W2 + 4 * i) = *(const f32x4*)(w2 + 4 * i);
          if (tid < 64) { PB[tid] = FIN(23)[l * 64 + tid]; PB[64 + tid] = FIN(24)[l * 64 + tid]; PB[128 + tid] = FIN(26)[l * 64 + tid]; PB[192 + tid] = FIN(27)[l * 64 + tid]; } }
        sync_block();
        for (int e = tid; e < 32 * 64; e += NT) { const int pp = e / 64, mm = e % 64, pos = pos0 + pp;
            const float t = (float)pos / (float)(L - 1 > 1 ? L - 1 : 1);
            float acc = PB[mm] + t * W1[mm];
            for (int q = 0; q < 16; ++q) { const float band = 1e-4f + (float)q * ((15.0f - 1e-4f) / 15.0f); acc += cos_rev(((float)pos * band) * (1.0f / (float)L)) * W1[(1 + q) * 64 + mm] - sin_rev(((float)pos * band) * (1.0f / (float)L)) * W1[(17 + q) * 64 + mm]; }
            H1[pp * 64 + mm] = sinf(PB[64 + mm] * acc); }
        sync_block();
        for (int e = tid; e < 32 * 64; e += NT) { const int pp = e / 64, mm = e % 64; float acc = PB[128 + mm];
            for (int q = 0; q < 64; ++q) acc += H1[pp * 64 + q] * W2[q * 64 + mm];
            H2[pp * H2S + mm] = sinf(PB[192 + mm] * acc); }
        sync_block();
        const float* w3 = FIN(28) + (size_t)l * 64 * 512 + 64 * w + pl;
#pragma unroll 1
        for (int ct = 0; ct < 2; ++ct) { f32x16 acc = z16; OPAQUE16(acc);
#pragma unroll
            for (int ks = 0; ks < 4; ++ks) { float xb[8], xa[8];
#pragma unroll
                for (int j = 0; j < 8; ++j) xb[j] = w3[(size_t)(16 * ks + 8 * hh + j) * 512 + 32 * ct];
                { const f32x4 a0 = *(const LAS f32x4*)(H2 + pl * H2S + 16 * ks + 8 * hh), a1 = *(const LAS f32x4*)(H2 + pl * H2S + 16 * ks + 8 * hh + 4);
                  xa[0] = a0[0]; xa[1] = a0[1]; xa[2] = a0[2]; xa[3] = a0[3]; xa[4] = a1[0]; xa[5] = a1[1]; xa[6] = a1[2]; xa[7] = a1[3]; }
                bf16x8 ah, al, bh, bl; hilo8(xa, ah, al); hilo8(xb, bh, bl);
                FRESH(ah); FRESH(al); FRESH(bh); FRESH(bl);
                acc = mfma32(ah, bh, acc); acc = mfma32(ah, bl, acc); acc = mfma32(al, bh, acc);
                MFMA_GUARD(ACC1(acc), KV(ah), KV(al), KV(bh), KV(bl)); }
            const int c2 = 64 * w + 32 * ct + pl; const float delta = fabsf(mind + (float)(c2 % 256) * ((maxd - mind) / 255.0f)); bf16* dst = KF + ((size_t)l * 512 + c2) * L + pos0 + 4 * hh;
#pragma unroll
            for (int g = 0; g < 4; ++g) { f32x4 o;
#pragma unroll
                for (int e = 0; e < 4; ++e) o[e] = acc[4 * g + e] * expf(-((float)(pos0 + 8 * g + 4 * hh + e) / (float)(L - 1 > 1 ? L - 1 : 1)) * delta);
                *(u32x2*)(dst + 8 * g) = (u32x2){pk_bf16(o[0], o[1]), pk_bf16(o[2], o[3])}; } }
        sync_block(); }
}
DEVFN void p_prologue(Frame& F) {
    LAS float* scr = (LAS float*)(F.lds + F.wave * 16384);
    constexpr int I_IN = 16 * 60, I_OUT = 16 * 32, I_UP = 16 * 176, I_DN = 44 * 32, I_L = I_IN + I_OUT + I_UP + I_DN;
    for (int it = F.gw; it < 2 * I_L; it += F.ngw) {
        const int l = it / I_L; int r = it % I_L;
        if (r < I_IN) { const int kb = r / 60, nb = r % 60; transpose_item(FIN(2) + (size_t)l * D * NIN, NIN, D, (bf16*)(F.ws + WS_WIN + l * SZ_WIN), 32 * nb, 32 * nb, 64 * kb, FIN(1) + l * D, scr, F.lane); continue; } r -= I_IN;
        if (r < I_OUT) { const int kb = r / 32, nb = r % 32; transpose_item(FIN(31) + (size_t)l * D * D, D, D, (bf16*)(F.ws + WS_WOUT + l * SZ_WOUT), 32 * nb, 32 * nb, 64 * kb, FIN(30) + l * D, scr, F.lane); continue; } r -= I_OUT;
        if (r < I_UP) { const int kb = r / 176, nb = r % 176, sc0 = 32 * nb, half = sc0 / FF, jj = sc0 % FF, pn = jj / 128;
            transpose_item(FIN(33) + (size_t)l * D * FF2, FF2, D, (bf16*)(F.ws + WS_WUP + l * SZ_WUP), sc0, 256 * pn + 128 * half + (jj % 128), 64 * kb, FIN(32) + l * D, scr, F.lane); continue; } r -= I_UP;
        { const int kb = r / 32, nb = r % 32; transpose_item(FIN(36) + (size_t)l * FF * D, D, FF, (bf16*)(F.ws + WS_WDN + l * SZ_WDN), 32 * nb, 32 * nb, 64 * kb, nullptr, scr, F.lane); }
    }
    for (int i = F.gtid; i < 2 * 12 * 24 * 64; i += F.gsize) { const int l = i / (12 * 24 * 64), r = i % (12 * 24 * 64), ln = r % 64, ks = (r / 64) % 24, ct = r / (64 * 24), pl = ln & 31, hh = ln >> 5;
        const float* src = FIN(18) + (size_t)l * S5W * S5W + (size_t)(16 * ks + 8 * hh) * S5W + 32 * ct + pl; u32x4 o;
        o.x = pk_bf16(src[0], src[S5W]); o.y = pk_bf16(src[2 * S5W], src[3 * S5W]); o.z = pk_bf16(src[4 * S5W], src[5 * S5W]); o.w = pk_bf16(src[6 * S5W], src[7 * S5W]);
        ((u32x4*)(F.ws + WS_WGLU + l * SZ_WGLU))[r] = o; }
    for (int i = F.gtid; i < 2 * (128 * D / 8); i += F.gsize) { const int l = i / (128 * D / 8), r = i % (128 * D / 8); ((u32x4*)(F.ws + WS_WIN + l * SZ_WIN + (size_t)NIN * D * 2))[r] = (u32x4){0u, 0u, 0u, 0u}; }
    float* ssq = (float*)(F.ws + WS_SSQ); bf16* hb = (bf16*)(F.ws + WS_HB);
    for (int m = 4 * F.gw; m < M; m += 4 * F.ngw) {
        const f32x4* xr = (const f32x4*)(FIN(0) + (size_t)m * D) + F.lane; u32x2* br = (u32x2*)(hb + (size_t)m * D) + F.lane; f32x4 v[16]; float sq[4] = {0.f, 0.f, 0.f, 0.f};
#pragma unroll
        for (int j = 0; j < 16; ++j) v[j] = xr[64 * j];
#pragma unroll
        for (int j = 0; j < 16; ++j) { u32x2 w; w.x = pk_bf16(v[j][0], v[j][1]); w.y = pk_bf16(v[j][2], v[j][3]); br[64 * j] = w; sq[j >> 2] += (v[j][0] * v[j][0] + v[j][1] * v[j][1]) + (v[j][2] * v[j][2] + v[j][3] * v[j][3]); }
#pragma unroll
        for (int o = 1; o < 64; o <<= 1) {
#pragma unroll
            for (int q = 0; q < 4; ++q) sq[q] += shfl_xor_f32(sq[q], o); }
        { const int q = F.lane >> 4; const float sv = q == 0 ? sq[0] : (q == 1 ? sq[1] : (q == 2 ? sq[2] : sq[3])); ssq[(size_t)m * 16 + F.lane] = (F.lane & 15) == 0 ? sv : 0.f; }
    }
    for (int ic = F.gtid; ic < 2 * 3072 * 16; ic += F.gsize) { const int i = ic / 16, c = ic % 16, l = i / 3072, r = i % 3072, dg = r / 64, p = r % 64;
        const float lr = FIN(10)[i], li = FIN(11)[i], dt = expf(FIN(12)[l * 48 + dg]);
        const float mag = expf(lr * dt), ar = mag * cosf(li * dt), ai = mag * sinf(li * dt);
        const float den = lr * lr + li * li, nr = ar - 1.0f, ni = ai, cr = (nr * lr + ni * li) / den, ci = (ni * lr - nr * li) / den;
        if (c == 0) { ((f32x2*)(F.ws + WS_S5A))[i] = (f32x2){ar, ai};
            const float m16 = expf(16.0f * lr * dt); ((f32x2*)(F.ws + WS_S5A16))[i] = (f32x2){m16 * cosf(16.0f * li * dt), m16 * sinf(16.0f * li * dt)}; }
        bf16* bt = (bf16*)(F.ws + WS_S5BT) + ((size_t)(l * 48 + dg) * 2) * 64 * 16; bf16* ct = (bf16*)(F.ws + WS_S5CT) + (size_t)(l * 48 + dg) * 16 * 128;
        { const float br = FIN(13)[(size_t)i * 16 + c], bi = FIN(14)[(size_t)i * 16 + c];
            bt[(size_t)p * 16 + c] = f2bf_(cr * br - ci * bi); bt[(size_t)(64 + p) * 16 + c] = f2bf_(cr * bi + ci * br);
            const size_t ci_ = ((size_t)(l * 48 + dg) * 16 + c) * 64 + p;
            ct[(size_t)c * 128 + 2 * p] = f2bf_(FIN(15)[ci_]); ct[(size_t)c * 128 + 2 * p + 1] = f2bf_(-FIN(16)[ci_]); } }
    for (int i = F.gtid; i < 2 * 2 * RGW; i += F.gsize) ((float*)(F.ws + WS_RGSP))[i] = 8.0f * softplus_f(-FIN(9)[i]);
    for (int i = F.gtid; i < 2 * 2 * 2 * 6 * 4096; i += F.gsize) { const int k = i % 64, n = (i / 64) % 64, hd = (i / 4096) % 6, mat = (i / 24576) % 2, ld = i / 49152;
        const float* src = (mat == 0 ? FIN(5) : FIN(7)) + ((size_t)ld * 6 + hd) * 4096; ((bf16*)(F.ws + WS_RGWT))[i] = f2bf_(-1.4426950408889634f * src[k * 64 + n]); }
    p_filter_tables(F);
}
constexpr int RING_BYTES_C = 131072;
constexpr int HY_NA = L / 32;
constexpr int HY_TA = HY_NA < 32 ? HY_NA : 32;
constexpr int HY_TB = 32 / HY_TA, HY_NBLK = HY_NA + 2 * (HY_TA - 1), HY_NTILE = (HY_NA / HY_TA) * ((Bn + HY_TB - 1) / HY_TB);
constexpr int HY_CPY = 2 * L * 2 + 64;
constexpr int HY_FI = 0, HY_ZI = 4 * HY_CPY, HY_LDS = HY_ZI + Bn * HY_NBLK * 80;
static_assert(HY_LDS <= RING_BYTES_C, "hyena LDS");
DEVFN void p_hy_pre(Frame& F, int l) {
    const bf16* proj = (const bf16*)(F.ws + WS_PROJ); bf16* zT = (bf16*)((unsigned char*)F.out + OUT_ZT); const float* cw = FIN(20) + l * 3 * 768; const float* cb = FIN(21) + l * 768;
    for (int i = F.gtid; i < 256 * (M / 32); i += F.gsize) { const int c = i % 256, m0 = (i / 256) * 32, t0 = m0 % L;
        const float w1[3] = {cw[256 + c], cw[768 + 256 + c], cw[1536 + 256 + c]}, wv[3] = {cw[512 + c], cw[768 + 512 + c], cw[1536 + 512 + c]}; const float b1 = cb[256 + c], bv = cb[512 + c];
        const bool okm = t0 > 0, okp = t0 + 32 < L; const bf16* p1 = proj + (size_t)m0 * NINP + 3 * RGW + 256 + c; const bf16* pv = p1 + 256;
        bf16 r1[34], rv[34];
        r1[0] = p1[okm ? -(long)NINP : 0]; rv[0] = pv[okm ? -(long)NINP : 0];
#pragma unroll
        for (int j = 0; j < 32; ++j) { r1[j + 1] = p1[(size_t)j * NINP]; rv[j + 1] = pv[(size_t)j * NINP]; }
        r1[33] = p1[(size_t)(okp ? 32 : 31) * NINP]; rv[33] = pv[(size_t)(okp ? 32 : 31) * NINP];
        float p1f = okm ? bf2f_(r1[0]) : 0.f, pvf = okm ? bf2f_(rv[0]) : 0.f, c1 = bf2f_(r1[1]), cv = bf2f_(rv[1]);
        unsigned pk[16];
#pragma unroll
        for (int j = 0; j < 32; ++j) { float n1 = bf2f_(r1[j + 2]), nv = bf2f_(rv[j + 2]); if (j == 31 && !okp) { n1 = 0.f; nv = 0.f; }
            const float zz = (bv + wv[0] * pvf + wv[1] * cv + wv[2] * nv) * (b1 + w1[0] * p1f + w1[1] * c1 + w1[2] * n1);
            if (j & 1) pk[j >> 1] = pk_bf16(bf_lo(pk[j >> 1]), zz); else pk[j >> 1] = pk_bf16(zz, 0.f);
            p1f = c1; c1 = n1; pvf = cv; cv = nv; }
        u32x4* dst = (u32x4*)(zT + (size_t)c * M + m0);
#pragma unroll
        for (int j = 0; j < 4; ++j) dst[j] = (u32x4){pk[4 * j], pk[4 * j + 1], pk[4 * j + 2], pk[4 * j + 3]}; }
}
DEVFN void hy_channel(Frame& F, int l, int c) {
    const int lane = lane_id(), w = F.wave, tid = F.tid, h = lane >> 5, r = lane & 31;
    LAS unsigned char* FI = F.lds + HY_FI; LAS unsigned char* ZI = F.lds + HY_ZI;
    constexpr int ZTOT = Bn * HY_NA * 4, ZPT = (ZTOT + NT - 1) / NT; u32x4 zr[ZPT];
    { const bf16* zT = (const bf16*)((unsigned char*)F.out + OUT_ZT) + (size_t)c * M;
#pragma unroll
      for (int k = 0; k < ZPT; ++k) { const int i = tid + k * NT; zr[k] = (u32x4){0u, 0u, 0u, 0u};
          if (i < ZTOT) { const int j = i & 3, a = (i >> 2) % HY_NA, b = (i >> 2) / HY_NA; zr[k] = *(const u32x4*)(zT + (size_t)b * L + 32 * a + 8 * j); } } }
    { LAS float* KX = (LAS float*)ZI;
      const bf16* kf = (const bf16*)(F.ws + WS_KFB) + ((size_t)l * 512 + c) * L; const bf16* kb = kf + (size_t)256 * L; const float bias = FIN(29)[l * HYW + c];
      if (tid == 0) KX[0] = 0.f;
      for (int p4 = tid; p4 < L / 4; p4 += NT) { const u32x2 kfw = *(const u32x2*)(kf + 4 * p4), kbw = *(const u32x2*)(kb + 4 * p4);
          const f32x4 kfv = {bf_lo(kfw.x), bf_hi(kfw.x), bf_lo(kfw.y), bf_hi(kfw.y)}, kbv = {bf_lo(kbw.x), bf_hi(kbw.x), bf_lo(kbw.y), bf_hi(kbw.y)};
#pragma unroll
          for (int e = 0; e < 4; ++e) { const int pos = 4 * p4 + e;
              if (pos == 0) KX[L] = kfv[e] + kbv[e] + bias; else { KX[L + pos] = kfv[e]; KX[L - pos] = kbv[e]; } } }
      sync_block();
      for (int i = tid; i < 4 * L; i += NT) { const int sg = i / L, u = 2 * (i % L); float v[2];
#pragma unroll
          for (int e = 0; e < 2; ++e) { const int ix = 2 * L - (u + e) - sg; v[e] = (ix >= 1 && ix <= 2 * L - 1) ? KX[ix] : 0.f; }
          *(LAS unsigned*)(FI + sg * HY_CPY + u * 2) = pk_bf16(v[0], v[1]); }
      sync_block(); }
    for (int i = tid; i < Bn * 2 * (HY_TA - 1) * 5; i += NT) { const int b = i / (2 * (HY_TA - 1) * 5), rr = i % (2 * (HY_TA - 1) * 5), blk = rr / 5, j = rr % 5, q = blk < HY_TA - 1 ? blk : blk + HY_NA;
        *(LAS u32x4*)(ZI + (b * HY_NBLK + q) * 80 + 16 * j) = (u32x4){0u, 0u, 0u, 0u}; }
#pragma unroll
    for (int k = 0; k < ZPT; ++k) { const int i = tid + k * NT;
        if (i < ZTOT) { const int j = i & 3, a = (i >> 2) % HY_NA, b = (i >> 2) / HY_NA; *(LAS u32x4*)(ZI + ((b * HY_NBLK + a + HY_TA - 1) * 80 + 16 * j)) = zr[k]; } }
    sync_block();
    bf16* yT = (bf16*)((unsigned char*)F.out + OUT_YT) + (size_t)c * M;
    const int sgm = (4 - (r & 3)) & 3;
    const f32x16 z16 = {0.f, 0.f, 0.f, 0.f, 0.f, 0.f, 0.f, 0.f, 0.f, 0.f, 0.f, 0.f, 0.f, 0.f, 0.f, 0.f};
    constexpr int NAQ = HY_NA / HY_TA, NBQ = (Bn + HY_TB - 1) / HY_TB, NIT = NAQ * ((NBQ + 1) / 2);
    for (int it = w; it < NIT; it += NWAVES) { const int aq = it % NAQ, bq0 = 2 * (it / NAQ), bq1 = bq0 + 1, al = r % HY_TA;
        const int a = aq * HY_TA + al, bb0 = bq0 * HY_TB + r / HY_TA, bb1 = bq1 * HY_TB + r / HY_TA; const bool ok0 = bb0 < Bn, ok1 = bq1 < NBQ && bb1 < Bn;
        const int dlo = aq * HY_TA - (HY_NA - 1), dhi = aq * HY_TA + HY_TA - 1;
        f32x16 acc0 = z16, acc1 = z16; OPAQUE16(acc0); OPAQUE16(acc1);
        int fa = sgm * HY_CPY + 2 * ((8 * h - r - 32 * dlo) - sgm + L);
        int za0 = ok0 ? ((bb0 * HY_NBLK + a - dlo + HY_TA - 1) * 80 + 16 * h) : 0;
        int za1 = ok1 ? ((bb1 * HY_NBLK + a - dlo + HY_TA - 1) * 80 + 16 * h) : 0;
        u32x4 ax[2], ay[2], b0x[2], b1x[2], b0y[2], b1y[2];
#ifdef CPU_EMU
#define HY_FILL(NA, NB0, NB1) do { _Pragma("unroll") for (int ks = 0; ks < 2; ++ks) { unsigned long long lo = *(const LAS unsigned long long*)(FI + fa + 32 * ks), hi = *(const LAS unsigned long long*)(FI + fa + 32 * ks + 8); \
                NA[ks] = (u32x4){(unsigned)lo, (unsigned)(lo >> 32), (unsigned)hi, (unsigned)(hi >> 32)}; \
                if (al == 0) { NB0[ks] = *(const LAS u32x4*)(ZI + za0 + 32 * ks); NB1[ks] = *(const LAS u32x4*)(ZI + za1 + 32 * ks); } } fa -= 64; za0 -= zd0; za1 -= zd1; } while (0)
#define HY_MMA(CA, CB0, CB1) do { bf16x8 a0 = __builtin_bit_cast(bf16x8, CA[0]), a1 = __builtin_bit_cast(bf16x8, CA[1]); \
            acc0 = mfma32(a0, __builtin_bit_cast(bf16x8, CB0[0]), acc0); acc1 = mfma32(a0, __builtin_bit_cast(bf16x8, CB1[0]), acc1); acc0 = mfma32(a1, __builtin_bit_cast(bf16x8, CB0[1]), acc0); acc1 = mfma32(a1, __builtin_bit_cast(bf16x8, CB1[1]), acc1); } while (0)
#define HY_STEP(CA, CB0, CB1, NA, NB0, NB1) do { HY_FILL(NA, NB0, NB1); HY_MMA(CA, CB0, CB1); } while (0)
#define HY_LAST(CA, CB0, CB1) HY_MMA(CA, CB0, CB1)
#define HY_FIRST(NA, NB0, NB1) do { const int al_ = al; { const int al = 0; (void)al_; HY_FILL(NA, NB0, NB1); } } while (0)
        int zd0 = ok0 ? 80 : 0, zd1 = ok1 ? 80 : 0;
#else
        unsigned vfa = (unsigned)(size_t)FI + (unsigned)fa, vz0 = (unsigned)(size_t)ZI + (unsigned)za0, vz1 = (unsigned)(size_t)ZI + (unsigned)za1; const unsigned zd0 = ok0 ? 80u : 0u, zd1 = ok1 ? 80u : 0u;
        const unsigned long long colmask = __builtin_amdgcn_ballot_w64(al == 0); unsigned long long svx;
#define HY_STEP(CA, CB0, CB1, NA, NB0, NB1) asm volatile( \
            "ds_read2_b64 %[na0], %[fa] offset1:1\n\tds_read2_b64 %[na1], %[fa] offset0:4 offset1:5\n\t" \
            "s_mov_b64 %[sv], exec\n\ts_mov_b64 exec, %[cm]\n\t" \
            "ds_read_b128 %[nb00], %[z0]\n\tds_read_b128 %[nb01], %[z0] offset:32\n\tds_read_b128 %[nb10], %[z1]\n\tds_read_b128 %[nb11], %[z1] offset:32\n\t" \
            "s_mov_b64 exec, %[sv]\n\t" \
            "v_add_u32 %[fa], 0xffffffc0, %[fa]\n\tv_sub_u32 %[z0], %[z0], %[d0]\n\tv_sub_u32 %[z1], %[z1], %[d1]\n\t" \
            "s_nop 1\n\t" \
            "v_mfma_f32_32x32x16_bf16 %[c0], %[ca0], %[cb00], %[c0]\n\tv_mfma_f32_32x32x16_bf16 %[c1], %[ca0], %[cb10], %[c1]\n\t" \
            "v_mfma_f32_32x32x16_bf16 %[c0], %[ca1], %[cb01], %[c0]\n\tv_mfma_f32_32x32x16_bf16 %[c1], %[ca1], %[cb11], %[c1]\n\t" \
            "s_waitcnt lgkmcnt(0)\n\ts_nop 3" \
            : [c0] "+v"(acc0), [c1] "+v"(acc1), [na0] "=&v"(NA[0]), [na1] "=&v"(NA[1]), [nb00] "+v"(NB0[0]), [nb01] "+v"(NB0[1]), [nb10] "+v"(NB1[0]), [nb11] "+v"(NB1[1]), \
              [fa] "+v"(vfa), [z0] "+v"(vz0), [z1] "+v"(vz1), [sv] "=&s"(svx) \
            : [ca0] "v"(CA[0]), [ca1] "v"(CA[1]), [cb00] "v"(CB0[0]), [cb01] "v"(CB0[1]), [cb10] "v"(CB1[0]), [cb11] "v"(CB1[1]), [d0] "v"(zd0), [d1] "v"(zd1), [cm] "s"(colmask) : "memory")
#define HY_LAST(CA, CB0, CB1) asm volatile( \
            "s_nop 1\n\tv_mfma_f32_32x32x16_bf16 %[c0], %[ca0], %[cb00], %[c0]\n\tv_mfma_f32_32x32x16_bf16 %[c1], %[ca0], %[cb10], %[c1]\n\t" \
            "v_mfma_f32_32x32x16_bf16 %[c0], %[ca1], %[cb01], %[c0]\n\tv_mfma_f32_32x32x16_bf16 %[c1], %[ca1], %[cb11], %[c1]\n\ts_nop 7\n\ts_nop 7\n\ts_nop 7" \
            : [c0] "+v"(acc0), [c1] "+v"(acc1) : [ca0] "v"(CA[0]), [ca1] "v"(CA[1]), [cb00] "v"(CB0[0]), [cb01] "v"(CB0[1]), [cb10] "v"(CB1[0]), [cb11] "v"(CB1[1]))
#define HY_FIRST(NA, NB0, NB1) asm volatile( \
            "ds_read2_b64 %[na0], %[fa] offset1:1\n\tds_read2_b64 %[na1], %[fa] offset0:4 offset1:5\n\t" \
            "ds_read_b128 %[nb00], %[z0]\n\tds_read_b128 %[nb01], %[z0] offset:32\n\tds_read_b128 %[nb10], %[z1]\n\tds_read_b128 %[nb11], %[z1] offset:32\n\t" \
            "v_add_u32 %[fa], 0xffffffc0, %[fa]\n\tv_sub_u32 %[z0], %[z0], %[d0]\n\tv_sub_u32 %[z1], %[z1], %[d1]\n\t" \
            "s_waitcnt lgkmcnt(0)\n\ts_nop 1" \
            : [na0] "=&v"(NA[0]), [na1] "=&v"(NA[1]), [nb00] "=&v"(NB0[0]), [nb01] "=&v"(NB0[1]), [nb10] "=&v"(NB1[0]), [nb11] "=&v"(NB1[1]), [fa] "+v"(vfa), [z0] "+v"(vz0), [z1] "+v"(vz1) \
            : [d0] "v"(zd0), [d1] "v"(zd1) : "memory")
#endif
#define HY_SHIFT(CB0, CB1, NB0, NB1) do { _Pragma("unroll") for (int ks = 0; ks < 2; ++ks) { \
            NB0[ks] = (u32x4){wave_shr1(CB0[ks].x), wave_shr1(CB0[ks].y), wave_shr1(CB0[ks].z), wave_shr1(CB0[ks].w)}; \
            NB1[ks] = (u32x4){wave_shr1(CB1[ks].x), wave_shr1(CB1[ks].y), wave_shr1(CB1[ks].z), wave_shr1(CB1[ks].w)}; } } while (0)
        HY_FIRST(ax, b0x, b1x);
        int d = dlo;
#pragma unroll 1
        for (; d + 2 <= dhi; d += 2) { HY_SHIFT(b0x, b1x, b0y, b1y); HY_STEP(ax, b0x, b1x, ay, b0y, b1y); HY_SHIFT(b0y, b1y, b0x, b1x); HY_STEP(ay, b0y, b1y, ax, b0x, b1x); }
        if (d == dhi) HY_LAST(ax, b0x, b1x);
        else { HY_SHIFT(b0x, b1x, b0y, b1y); HY_STEP(ax, b0x, b1x, ay, b0y, b1y); HY_LAST(ay, b0y, b1y); }
#undef HY_STEP
#undef HY_LAST
#undef HY_FIRST
#undef HY_SHIFT
#ifdef CPU_EMU
#undef HY_FILL
#undef HY_MMA
#endif
        if (ok0) {
#pragma unroll
            for (int q = 0; q < 4; ++q) *(u32x2*)(yT + (size_t)bb0 * L + 32 * a + 8 * q + 4 * h) = (u32x2){pk_bf16(acc0[4 * q], acc0[4 * q + 1]), pk_bf16(acc0[4 * q + 2], acc0[4 * q + 3])}; }
        if (ok1) {
#pragma unroll
            for (int q = 0; q < 4; ++q) *(u32x2*)(yT + (size_t)bb1 * L + 32 * a + 8 * q + 4 * h) = (u32x2){pk_bf16(acc1[4 * q], acc1[4 * q + 1]), pk_bf16(acc1[4 * q + 2], acc1[4 * q + 3])}; } }
    sync_block();
}
DEVFN void p_hy_main(Frame& F, int l) { int c0 = (int)blockIdx.x; OPAQUE_S(c0); for (int c = c0; c < HYW; c += F.G) hy_channel(F, l, c); }
DEVFN void p_hy_post(Frame& F, int l) {
    const bf16* proj = (const bf16*)(F.ws + WS_PROJ); const bf16* yT = (const bf16*)((unsigned char*)F.out + OUT_YT); bf16* ymix = (bf16*)(F.ws + WS_YMIX); const float* cw = FIN(20) + l * 3 * 768; const float* cb = FIN(21) + l * 768;
    for (int i = F.gtid; i < 256 * (M / 32); i += F.gsize) { const int c = i % 256, m0 = (i / 256) * 32, t0 = m0 % L;
        const float w0[3] = {cw[c], cw[768 + c], cw[1536 + c]}; const float b0 = cb[c];
        const bool okm = t0 > 0, okp = t0 + 32 < L; const bf16* p0p = proj + (size_t)m0 * NINP + 3 * RGW + c;
        bf16 r0[34]; u32x4 yv[4]; const u32x4* ys = (const u32x4*)(yT + (size_t)c * M + m0);
#pragma unroll
        for (int j8 = 0; j8 < 4; ++j8) yv[j8] = ys[j8];
        r0[0] = p0p[okm ? -(long)NINP : 0];
#pragma unroll
        for (int j = 0; j < 32; ++j) r0[j + 1] = p0p[(size_t)j * NINP];
        r0[33] = p0p[(size_t)(okp ? 32 : 31) * NINP];
        float p0 = okm ? bf2f_(r0[0]) : 0.f, c0 = bf2f_(r0[1]);
#pragma unroll
        for (int j = 0; j < 32; ++j) { float n0 = bf2f_(r0[j + 2]); if (j == 31 && !okp) n0 = 0.f;
            ymix[(size_t)(m0 + j) * D + RGW + S5W + c] = f2bf_(((j & 1) ? bf_hi(yv[j >> 3][(j >> 1) & 3]) : bf_lo(yv[j >> 3][(j >> 1) & 3])) * (b0 + w0[0] * p0 + w0[1] * c0 + w0[2] * n0)); p0 = c0; c0 = n0; } }
}
constexpr int NG16 = L / 16, NT32 = M / 32, CARRY_B = NG16 < 16 ? NG16 : 16;
DEVFN int tau32(int rho) { return 16 * ((rho >> 2) & 1) + (rho & 3) + 4 * (rho >> 3); }
DEVFN bf16x8 pack8(const f32x4 a, const f32x4 b) { u32x4 w; w.x = pk_bf16(a[0], a[1]); w.y = pk_bf16(a[2], a[3]); w.z = pk_bf16(b[0], b[1]); w.w = pk_bf16(b[2], b[3]); return __builtin_bit_cast(bf16x8, w); }
DEVFN void rg_item(Frame& F, int l, int it, int tile, int hd, int nt) {
    constexpr bool stage3 = false;
    const int lane = lane_id(), hh = lane >> 5, pl = lane & 31, m0 = tile * 32, b = m0 / L, t0 = m0 % L, grp = t0 / 16 + hh;
    const bf16* proj = (const bf16*)(F.ws + WS_PROJ); const float* cw = FIN(3) + l * 4 * RGW; const float* cb = FIN(4) + l * RGW;
    const f32x16 z16 = {0.f, 0.f, 0.f, 0.f, 0.f, 0.f, 0.f, 0.f, 0.f, 0.f, 0.f, 0.f, 0.f, 0.f, 0.f, 0.f};
    const bf16* WT = (const bf16*)(F.ws + WS_RGWT); f32x2* AG = (f32x2*)(F.ws + WS_RGAG);
    const int tt = t0 + tau32(pl); bf16x8 uf[4];
    const LAS float* CW = (const LAS float*)F.lds;
#pragma unroll
    for (int ks = 0; ks < 4; ++ks) { const int c0 = 64 * hd + 16 * ks + 8 * hh; f32x4 s0 = *(const LAS f32x4*)(CW + 4 * RGW + c0), s1 = *(const LAS f32x4*)(CW + 4 * RGW + c0 + 4);
#pragma unroll
        for (int k = 0; k < 4; ++k) { const int tk = tt + k - 1; const bool ok = (tk >= 0) && (tk < L);
            u32x4 x = {0u, 0u, 0u, 0u}; if (ok) x = *(const u32x4*)(proj + (size_t)(b * L + tk) * NINP + c0);
            const f32x4 w0 = *(const LAS f32x4*)(CW + k * RGW + c0), w1 = *(const LAS f32x4*)(CW + k * RGW + c0 + 4);
            s0 += w0 * (f32x4){bf_lo(x.x), bf_hi(x.x), bf_lo(x.y), bf_hi(x.y)}; s1 += w1 * (f32x4){bf_lo(x.z), bf_hi(x.z), bf_lo(x.w), bf_hi(x.w)}; }
        uf[ks] = pack8(s0, s1); }
    FRESH(uf[0]); FRESH(uf[1]); FRESH(uf[2]); FRESH(uf[3]);
#define RG_WOFF(d_, ks_) (((((size_t)(l * 2 + (d_)) * 2) * 6 + hd) * 64 + 32 * nt + pl) * 64 + 16 * (ks_) + 8 * hh)
    bf16x8 wA[2][4];
#pragma unroll
    for (int ks = 0; ks < 4; ++ks) { wA[0][ks] = *(const bf16x8*)(WT + RG_WOFF(0, ks)); wA[1][ks] = *(const bf16x8*)(WT + RG_WOFF(0, ks) + (size_t)6 * 4096); }
    const int c = 64 * hd + 32 * nt + pl;
    float bav2[2], bxv2[2], sp82[2];
#pragma unroll
    for (int d = 0; d < 2; ++d) { bav2[d] = CW[(5 + d) * RGW + c]; bxv2[d] = CW[(7 + d) * RGW + c]; sp82[d] = CW[(9 + d) * RGW + c]; }
    f32x16 uacc; { f32x16 zz = z16; OPAQUE16(zz); uacc = zz; }
    { bf16x8 idf[2];
#pragma unroll
      for (int q = 0; q < 2; ++q) { const int kk = pl - 16 * q - 8 * hh; u32x4 w;
          w.x = (kk >> 1) == 0 ? ((kk & 1) ? 0x3F800000u : 0x3F80u) : 0u; w.y = (kk >> 1) == 1 ? ((kk & 1) ? 0x3F800000u : 0x3F80u) : 0u;
          w.z = (kk >> 1) == 2 ? ((kk & 1) ? 0x3F800000u : 0x3F80u) : 0u; w.w = (kk >> 1) == 3 ? ((kk & 1) ? 0x3F800000u : 0x3F80u) : 0u;
          if (kk < 0 || kk > 7) w = (u32x4){0u, 0u, 0u, 0u};
          idf[q] = __builtin_bit_cast(bf16x8, w); }
      FRESH(idf[0]); FRESH(idf[1]);
      if (nt == 0) { uacc = mfma32(uf[0], idf[0], uacc); uacc = mfma32(uf[1], idf[1], uacc); MFMA_GUARD(ACC1(uacc), KV(uf[0]), KV(uf[1]), KV(idf[0]), KV(idf[1])); }
      else { uacc = mfma32(uf[2], idf[0], uacc); uacc = mfma32(uf[3], idf[1], uacc); MFMA_GUARD(ACC1(uacc), KV(uf[2]), KV(uf[3]), KV(idf[0]), KV(idf[1])); } }
    f32x16 hs = z16;
#pragma unroll
    for (int d = 0; d < 2; ++d) {
        f32x16 ga, gx; { f32x16 zz = z16; OPAQUE16(zz); ga = zz; f32x16 z2 = z16; OPAQUE16(z2); gx = z2; }
        bf16x8 wa[4], wx[4];
#pragma unroll
        for (int ks = 0; ks < 4; ++ks) { wa[ks] = wA[0][ks]; wx[ks] = wA[1][ks]; FRESH(wa[ks]); FRESH(wx[ks]); }
#pragma unroll
        for (int ks = 0; ks < 4; ++ks) { ga = mfma32(uf[ks], wa[ks], ga); gx = mfma32(uf[ks], wx[ks], gx); }
        MFMA_GUARD(ACC2(ga, gx), KV(uf[0]), KV(uf[1]), KV(uf[2]), KV(uf[3]), KV(wa[0]), KV(wa[1]), KV(wa[2]), KV(wa[3]), KV(wx[0]), KV(wx[1]), KV(wx[2]), KV(wx[3]));
        if (d == 0) {
#pragma unroll
            for (int ks = 0; ks < 4; ++ks) { wA[0][ks] = *(const bf16x8*)(WT + RG_WOFF(1, ks)); wA[1][ks] = *(const bf16x8*)(WT + RG_WOFF(1, ks) + (size_t)6 * 4096); } }
        const float bav = -1.4426950408889634f * bav2[d], bxv = -1.4426950408889634f * bxv2[d], sp8 = sp82[d];
        const float s2 = -1.4426950408889634f * sp8, sx = -2.0f * sp8;
        u32x4* ab = (u32x4*)(d == 0 ? F.ws + WS_RGAB0 : (unsigned char*)F.out + OUT_RGAB1) + (size_t)it * 256 + lane;
#pragma unroll
        for (int k = 0; k < 4; ++k) { u32x4 pk;
#pragma unroll
            for (int e = 0; e < 4; ++e) { const int reg = 4 * k + e; const float r = fast_rcp(1.0f + fast_exp2(ga[reg] + bav)), ig = fast_rcp(1.0f + fast_exp2(gx[reg] + bxv)), l2 = r * s2, x = r * sx, av = fast_exp2(l2);
                const float pm = -x * (1.0f + x * (0.5f + x * (0.16666667f + x * (0.041666668f + x * 0.008333334f))));
                const float om = fabsf(x) < 0.25f ? pm : 1.0f - av * av;
                ga[reg] = av; gx[reg] = fast_sqrt(om) * (ig * uacc[reg]); pk[e] = pk_bf16(l2, gx[reg]); }
            ab[64 * k] = pk; }
        const size_t aidx = (((size_t)b * NG16 + grp) * 2 + d) * RGW + c;
        if (!stage3) { float P = 1.f, H = 0.f;
#pragma unroll
            for (int q = 0; q < 16; ++q) { const int reg = d == 0 ? q : 15 - q; H = ga[reg] * H + gx[reg]; P *= ga[reg]; }
            AG[aidx] = (f32x2){P, H}; }
        else { float h = ((const float*)(F.ws + WS_RGCI))[aidx];
#pragma unroll
            for (int q = 0; q < 16; ++q) { const int reg = d == 0 ? q : 15 - q; h = ga[reg] * h + gx[reg]; hs[reg] += h; } } }
    if (stage3) { bf16* ymix = (bf16*)(F.ws + WS_YMIX);
#pragma unroll
        for (int reg = 0; reg < 16; ++reg) { const size_t m = (size_t)(m0 + 16 * hh + reg); ymix[m * D + c] = f2bf_(hs[reg] * gelu_f(bf2f_(proj[m * NINP + RGW + c]))); } }
#undef RG_WOFF
}
DEVFN void rg_item3(Frame& F, int l, int it) {
    const int lane = lane_id(), hh = lane >> 5, pl = lane & 31, tile = it / 12, r = it % 12, hd = r >> 1, nt = r & 1, m0 = tile * 32, b = m0 / L, t0 = m0 % L, grp = t0 / 16 + hh, c = 64 * hd + 32 * nt + pl;
    const bf16* proj = (const bf16*)(F.ws + WS_PROJ); bf16* ymix = (bf16*)(F.ws + WS_YMIX);
    u32x4 w0[4], w1[4];
    { const u32x4* a0 = (const u32x4*)(F.ws + WS_RGAB0) + (size_t)it * 256 + lane; const u32x4* a1 = (const u32x4*)((unsigned char*)F.out + OUT_RGAB1) + (size_t)it * 256 + lane;
#pragma unroll
      for (int k = 0; k < 4; ++k) { w0[k] = a0[64 * k]; w1[k] = a1[64 * k]; } }
    const float* CI = (const float*)(F.ws + WS_RGCI); float h0 = CI[(((size_t)b * NG16 + grp) * 2 + 0) * RGW + c], h1 = CI[(((size_t)b * NG16 + grp) * 2 + 1) * RGW + c];
    bf16 gt[16];
#pragma unroll
    for (int reg = 0; reg < 16; ++reg) gt[reg] = proj[(size_t)(m0 + 16 * hh + reg) * NINP + RGW + c];
    float hs[16];
#pragma unroll
    for (int q = 0; q < 16; ++q) { const unsigned w = w0[q >> 2][q & 3]; h0 = fast_exp2(bf_lo(w)) * h0 + bf_hi(w); hs[q] = h0; }
#pragma unroll
    for (int q = 0; q < 16; ++q) { const int reg = 15 - q; const unsigned w = w1[reg >> 2][reg & 3]; h1 = fast_exp2(bf_lo(w)) * h1 + bf_hi(w); hs[reg] += h1; }
#pragma unroll
    for (int reg = 0; reg < 16; ++reg) { const size_t m = (size_t)(m0 + 16 * hh + reg); ymix[m * D + c] = f2bf_(hs[reg] * gelu_f(bf2f_(gt[reg]))); }
}
DEVFN void p_rg_stage(Frame& F, int l, const bool stage3) {
    if (stage3) { for (int it = F.gw; it < NT32 * 12; it += F.ngw) rg_item3(F, l, it); return; }
    { LAS float* CW = (LAS float*)F.lds; const float* cw = FIN(3) + l * 4 * RGW; const float* cb = FIN(4) + l * RGW;
      const float* ba = FIN(6) + l * 2 * RGW; const float* bx = FIN(8) + l * 2 * RGW; const float* sp = (const float*)(F.ws + WS_RGSP) + l * 2 * RGW;
      for (int i = F.tid; i < 11 * RGW / 4; i += NT) { const int arr = i / (RGW / 4), ch = i % (RGW / 4);
          const float* src = arr < 4 ? cw + arr * RGW : (arr == 4 ? cb : (arr < 7 ? ba + (arr - 5) * RGW : (arr < 9 ? bx + (arr - 7) * RGW : sp + (arr - 9) * RGW)));
          *(LAS f32x4*)(CW + arr * RGW + 4 * ch) = *(const f32x4*)(src + 4 * ch); }
      sync_block(); }
    for (int it = F.gw; it < NT32 * 12; it += F.ngw) { const int r = it % 12; rg_item(F, l, it, it / 12, r >> 1, r & 1); } }
constexpr int CSEG = NG16 / 16 > 0 ? NG16 / 16 : 1, CLN = NG16 / CSEG;
DEVFN void p_rg_carry(Frame& F) {
    const f32x2* __restrict__ AG = (const f32x2*)(F.ws + WS_RGAG); float* __restrict__ CI = (float*)(F.ws + WS_RGCI); const int lane = lane_id(), sl = lane % CLN;
    for (int i0 = F.gw * (64 / CLN); i0 < Bn * 2 * RGW; i0 += F.ngw * (64 / CLN)) { const int i = i0 + lane / CLN; const bool ok = i < Bn * 2 * RGW;
        const int c = ok ? i % RGW : 0, d = ok ? (i / RGW) % 2 : 0, b = ok ? i / (2 * RGW) : 0;
        f32x2 sv[CSEG]; float P = 1.f, H = 0.f;
#pragma unroll
        for (int e = 0; e < CSEG; ++e) { const int q = sl * CSEG + e, j = d == 0 ? q : NG16 - 1 - q; sv[e] = AG[(((size_t)b * NG16 + j) * 2 + d) * RGW + c]; }
#pragma unroll
        for (int e = 0; e < CSEG; ++e) { H = sv[e][0] * H + sv[e][1]; P *= sv[e][0]; }
#pragma unroll
        for (int o = 1; o < CLN; o <<= 1) { const float Pp = shfl_f32(P, lane - o), Hp = shfl_f32(H, lane - o); if (sl >= o) { H = P * Hp + H; P = P * Pp; } }
        float Hin = shfl_f32(H, lane - 1); if (sl == 0) Hin = 0.f;
        if (ok) {
#pragma unroll
            for (int e = 0; e < CSEG; ++e) { const int q = sl * CSEG + e, j = d == 0 ? q : NG16 - 1 - q; CI[(((size_t)b * NG16 + j) * 2 + d) * RGW + c] = Hin; Hin = sv[e][0] * Hin + sv[e][1]; } } }
}
constexpr int S5_HS = 272  , S5_YS = 784  ;
struct S5Ops { bf16x8 bb[2][2]; f32x2 A[2]; f32x2 C[2]; };
DEVFN void s5_load_ops(S5Ops& o, const bf16* BT, const f32x2* SA, const f32x2* CIp, size_t dg, size_t sbase, int pl, int hh, const bool stage3) {
#pragma unroll
    for (int ri = 0; ri < 2; ++ri)
#pragma unroll
        for (int ph = 0; ph < 2; ++ph) o.bb[ri][ph] = *(const bf16x8*)(BT + ((dg * 2 + ri) * 64 + 32 * ph + pl) * 16 + 8 * hh);
#pragma unroll
    for (int ph = 0; ph < 2; ++ph) { o.A[ph] = SA[dg * 64 + 32 * ph + pl]; if (stage3) { const unsigned cw_ = ((const unsigned*)CIp)[sbase + 32 * ph]; o.C[ph] = (f32x2){bf_lo(cw_), bf_hi(cw_)}; } else o.C[ph] = (f32x2){0.f, 0.f}; }
}
DEVFN void s5_tile(Frame& F, int l, int tile, const bool stage3, const int slot) {
    const int lane = lane_id(), w = F.wave, hh = lane >> 5, pl = lane & 31, m0 = tile * 32, b = m0 / L, grp = (m0 % L) / 16 + hh;
    const bf16* proj = (const bf16*)(F.ws + WS_PROJ); const bf16* BT = (const bf16*)(F.ws + WS_S5BT); const bf16* CT = (const bf16*)(F.ws + WS_S5CT);
    const f32x2* SA = (const f32x2*)(F.ws + WS_S5A); f32x2* SS = (f32x2*)(F.ws + WS_S5S); const f32x2* CIp = (const f32x2*)(F.ws + WS_S5CI);
    LAS unsigned char* Hw = F.lds + w * (32 * S5_HS); LAS unsigned char* YT = F.lds + 8 * 32 * S5_HS + slot * (32 * S5_YS);
    const f32x16 z16 = {0.f, 0.f, 0.f, 0.f, 0.f, 0.f, 0.f, 0.f, 0.f, 0.f, 0.f, 0.f, 0.f, 0.f, 0.f, 0.f};
#define S5_DG(g_, d_) ((size_t)(l * 2 + (d_)) * 24 + (g_))
#define S5_SB(g_, d_) ((((size_t)b * NG16 + grp) * 2 + (d_)) * 1536 + (g_) * 64 + pl)
    S5Ops o0, o1; s5_load_ops(o0, BT, SA, CIp, S5_DG(w, 0), S5_SB(w, 0), pl, hh, stage3);
    bf16x8 ua = *(const bf16x8*)(proj + (size_t)(m0 + tau32(pl)) * NINP + 2 * RGW + 16 * w + 8 * hh);
#pragma unroll 1
    for (int gi = 0; gi < 3; ++gi) { const int g = w + 8 * gi, gn = g + 8;
        f32x4 yacc[2] = {(f32x4){0.f, 0.f, 0.f, 0.f}, (f32x4){0.f, 0.f, 0.f, 0.f}};
        bf16x8 uan = ua;
#pragma unroll
        for (int d = 0; d < 2; ++d) { const size_t dg = S5_DG(g, d);
            S5Ops& o = d == 0 ? o0 : o1;
            if (d == 0) s5_load_ops(o1, BT, SA, CIp, S5_DG(g, 1), S5_SB(g, 1), pl, hh, stage3);
            else if (gi < 2) { s5_load_ops(o0, BT, SA, CIp, S5_DG(gn, 0), S5_SB(gn, 0), pl, hh, stage3); uan = *(const bf16x8*)(proj + (size_t)(m0 + tau32(pl)) * NINP + 2 * RGW + 16 * gn + 8 * hh); }
            bf16x8 b2[2][4];
            if (stage3) {
#pragma unroll
                for (int rt = 0; rt < 2; ++rt)
#pragma unroll
                    for (int ks = 0; ks < 4; ++ks) b2[rt][ks] = *(const bf16x8*)(CT + (dg * 16 + (lane & 15)) * 128 + 32 * ks + 8 * (lane >> 4)); }
            f32x16 acc[2][2];
#ifdef CPU_EMU
            { acc[0][0] = mfma32(ua, o.bb[0][0], z16); acc[0][1] = mfma32(ua, o.bb[0][1], z16); acc[1][0] = mfma32(ua, o.bb[1][0], z16); acc[1][1] = mfma32(ua, o.bb[1][1], z16); }
#else
            asm volatile("s_nop 1\n\tv_mfma_f32_32x32x16_bf16 %0, %4, %5, 0\n\tv_mfma_f32_32x32x16_bf16 %1, %4, %6, 0\n\tv_mfma_f32_32x32x16_bf16 %2, %4, %7, 0\n\tv_mfma_f32_32x32x16_bf16 %3, %4, %8, 0\n\t"
                         "s_nop 7\n\ts_nop 7\n\ts_nop 7\n\ts_nop 7"
                         : "=&v"(acc[0][0]), "=&v"(acc[0][1]), "=&v"(acc[1][0]), "=&v"(acc[1][1]) : "v"(ua), "v"(o.bb[0][0]), "v"(o.bb[0][1]), "v"(o.bb[1][0]), "v"(o.bb[1][1]));
#endif
#pragma unroll
            for (int ph = 0; ph < 2; ++ph) { const f32x2 A = o.A[ph]; const size_t sidx = S5_SB(g, d) + 32 * ph;
                float hr = o.C[ph][0], hi = o.C[ph][1];
#pragma unroll
                for (int q = 0; q < 16; ++q) { const int reg = d == 0 ? q : 15 - q; const float nr = fnma_s(A[1], hi, fma_s(A[0], hr, acc[0][ph][reg])), ni = fma_s(A[1], hr, fma_s(A[0], hi, acc[1][ph][reg]));
                    hr = nr; hi = ni; acc[0][ph][reg] = nr; acc[1][ph][reg] = ni; }
                if (!stage3) ((unsigned*)SS)[sidx] = pk_bf16(hr, hi);
                else {
#pragma unroll
                    for (int reg = 0; reg < 16; ++reg) *(LAS unsigned*)(Hw + (16 * hh + reg) * S5_HS + 4 * (32 * ph + pl)) = pk_bf16(acc[0][ph][reg], acc[1][ph][reg]); } }
            if (stage3) { WAVE_LDS_FENCE();
#pragma unroll
                for (int rt = 0; rt < 2; ++rt) { bf16x8 a2[4];
#pragma unroll
                    for (int ks = 0; ks < 4; ++ks) a2[ks] = *(const LAS bf16x8*)(Hw + (16 * rt + (lane & 15)) * S5_HS + (32 * ks + 8 * (lane >> 4)) * 2);
                    FRESH(b2[rt][0]); FRESH(b2[rt][1]); FRESH(b2[rt][2]); FRESH(b2[rt][3]); FRESH(a2[0]); FRESH(a2[1]); FRESH(a2[2]); FRESH(a2[3]);
#pragma unroll
                    for (int ks = 0; ks < 4; ++ks) yacc[rt] = mfma16(a2[ks], b2[rt][ks], yacc[rt]);
                    MFMA_GUARD(ACC1(yacc[rt]), KV(a2[0]), KV(a2[1]), KV(a2[2]), KV(a2[3]), KV(b2[rt][0]), KV(b2[rt][1]), KV(b2[rt][2]), KV(b2[rt][3])); }
                WAVE_LDS_FENCE(); } }
        if (stage3) { const int c = lane & 15; const float dsk = FIN(17)[l * S5W + 16 * g + c];
#pragma unroll
            for (int rt = 0; rt < 2; ++rt)
#pragma unroll
                for (int reg = 0; reg < 4; ++reg) { const int t = 16 * rt + 4 * (lane >> 4) + reg; const float u = bf2f_(proj[(size_t)(m0 + t) * NINP + 2 * RGW + 16 * g + c]);
                    *(LAS bf16*)(YT + t * S5_YS + (16 * g + c) * 2) = f2bf_(gelu_f(yacc[rt][reg] + dsk * u)); } }
        ua = uan; }
#undef S5_DG
#undef S5_SB
}
DEVFN void s5_glu(Frame& F, int l, int tileA, int tileB) {
    const int lane = lane_id(), w = F.wave, hh = lane >> 5, pl = lane & 31, slot = w >> 2, wq = w & 3; const int tile = slot ? tileB : tileA;
    const f32x16 z16 = {0.f, 0.f, 0.f, 0.f, 0.f, 0.f, 0.f, 0.f, 0.f, 0.f, 0.f, 0.f, 0.f, 0.f, 0.f, 0.f};
    if (tile >= 0) { const int m0 = tile * 32; LAS unsigned char* YT = F.lds + 8 * 32 * S5_HS + slot * (32 * S5_YS);
        const bf16* WG = (const bf16*)(F.ws + WS_WGLU + l * SZ_WGLU); bf16* ymix = (bf16*)(F.ws + WS_YMIX);
        f32x16 ga[3] = {z16, z16, z16}; OPAQUE16(ga[0]); OPAQUE16(ga[1]); OPAQUE16(ga[2]);
        float gbias[3];
#pragma unroll
        for (int j = 0; j < 3; ++j) gbias[j] = FIN(19)[l * S5W + 32 * (wq + 4 * j) + pl];
        const bf16* wp[3];
#pragma unroll
        for (int j = 0; j < 3; ++j) wp[j] = WG + ((size_t)(wq + 4 * j) * 24 * 64 + lane) * 8;
#pragma unroll 1
        for (int c8 = 0; c8 < 3; ++c8) { bf16x8 bw[8][3];
#pragma unroll
            for (int q = 0; q < 8; ++q)
#pragma unroll
                for (int j = 0; j < 3; ++j) bw[q][j] = *(const bf16x8*)(wp[j] + 512 * (8 * c8 + q));
#pragma unroll
            for (int q = 0; q < 8; ++q) { const int ks = 8 * c8 + q; bf16x8 aq = *(const LAS bf16x8*)(YT + pl * S5_YS + (16 * ks + 8 * hh) * 2); bf16x8 bq[3] = {bw[q][0], bw[q][1], bw[q][2]};
                FRESH(bq[0]); FRESH(bq[1]); FRESH(bq[2]); FRESH(aq);
#pragma unroll
                for (int j = 0; j < 3; ++j) ga[j] = mfma32(aq, bq[j], ga[j]);
                MFMA_GUARD(ACC3(ga[0], ga[1], ga[2]), KV(aq), KV(bq[0]), KV(bq[1]), KV(bq[2])); } }
#pragma unroll
        for (int j = 0; j < 3; ++j) { const int n = 32 * (wq + 4 * j) + pl; const float bias = gbias[j];
#pragma unroll
            for (int reg = 0; reg < 16; ++reg) { const int t = (reg & 3) + 8 * (reg >> 2) + 4 * hh; const float y = bf2f_(*(const LAS bf16*)(YT + t * S5_YS + n * 2));
                ymix[(size_t)(m0 + t) * D + RGW + n] = f2bf_(y * sigmoid_f(ga[j][reg] + bias)); } } }
}
DEVFN void p_s5_stage(Frame& F, int l, const bool stage3) {
    int tile0 = (int)blockIdx.x; OPAQUE_S(tile0);
    if (!stage3) { for (int tile = tile0; tile < NT32; tile += F.G) s5_tile(F, l, tile, false, 0); return; }
    for (int tile = tile0; tile < NT32; tile += 2 * F.G) { const int tileB = tile + F.G < NT32 ? tile + F.G : -1;
        s5_tile(F, l, tile, true, 0); if (tileB >= 0) s5_tile(F, l, tileB, true, 1);
        sync_block(); s5_glu(F, l, tile, tileB); sync_block(); }
}
constexpr int CSEG5 = NG16 / 8 > 0 ? NG16 / 8 : 1, CLN5 = NG16 / CSEG5;
DEVFN void p_s5_carry(Frame& F, int l) {
    const f32x2* SS = (const f32x2*)(F.ws + WS_S5S); f32x2* CI = (f32x2*)(F.ws + WS_S5CI);       const f32x2* A16 = (const f32x2*)(F.ws + WS_S5A16); const int lane = lane_id(), sl = lane % CLN5;
    for (int i0 = F.gw * (64 / CLN5); i0 < Bn * 2 * 1536; i0 += F.ngw * (64 / CLN5)) { const int i = i0 + lane / CLN5; const bool ok = i < Bn * 2 * 1536;
        const int gp = ok ? i % 1536 : 0, d = ok ? (i / 1536) % 2 : 0, b = ok ? i / 3072 : 0; const f32x2 A = A16[(size_t)(l * 2 + d) * 1536 + gp];
        f32x2 sv[CSEG5]; float hr = 0.f, hi = 0.f, pr = 1.f, pi = 0.f;
#pragma unroll
        for (int e = 0; e < CSEG5; ++e) { const int q = sl * CSEG5 + e, j = d == 0 ? q : NG16 - 1 - q; { const unsigned sw_ = ((const unsigned*)SS)[(((size_t)b * NG16 + j) * 2 + d) * 1536 + gp]; sv[e] = (f32x2){bf_lo(sw_), bf_hi(sw_)}; } }
#pragma unroll
        for (int e = 0; e < CSEG5; ++e) { const float nr = A[0] * hr - A[1] * hi + sv[e][0], ni = A[0] * hi + A[1] * hr + sv[e][1]; hr = nr; hi = ni; const float qr = A[0] * pr - A[1] * pi, qi = A[0] * pi + A[1] * pr; pr = qr; pi = qi; }
#pragma unroll
        for (int o = 1; o < CLN5; o <<= 1) { const float Pr = shfl_f32(pr, lane - o), Pi = shfl_f32(pi, lane - o), Hr = shfl_f32(hr, lane - o), Hi = shfl_f32(hi, lane - o);
            if (sl >= o) { const float nr = pr * Hr - pi * Hi + hr, ni = pr * Hi + pi * Hr + hi; hr = nr; hi = ni; const float qr = pr * Pr - pi * Pi, qi = pr * Pi + pi * Pr; pr = qr; pi = qi; } }
        float cr = shfl_f32(hr, lane - 1), ci = shfl_f32(hi, lane - 1); if (sl == 0) { cr = 0.f; ci = 0.f; }
        if (ok) {
#pragma unroll
            for (int e = 0; e < CSEG5; ++e) { const int q = sl * CSEG5 + e, j = d == 0 ? q : NG16 - 1 - q; ((unsigned*)CI)[(((size_t)b * NG16 + j) * 2 + d) * 1536 + gp] = pk_bf16(cr, ci);
                const float nr = A[0] * cr - A[1] * ci + sv[e][0], ni = A[0] * ci + A[1] * cr + sv[e][1]; cr = nr; ci = ni; } } }
}
DEVFN void row_ssq3(const u32x4 x0, const u32x4 x1, int lane, float& sa, float& sb, float& sc) {
    float s0, s1;
    { const float a0 = bf_lo(x0.x), a1 = bf_hi(x0.x), a2 = bf_lo(x0.y), a3 = bf_hi(x0.y), a4 = bf_lo(x0.z), a5 = bf_hi(x0.z), a6 = bf_lo(x0.w), a7 = bf_hi(x0.w); s0 = ((a0 * a0 + a1 * a1) + (a2 * a2 + a3 * a3)) + ((a4 * a4 + a5 * a5) + (a6 * a6 + a7 * a7)); }
    { const float a0 = bf_lo(x1.x), a1 = bf_hi(x1.x), a2 = bf_lo(x1.y), a3 = bf_hi(x1.y), a4 = bf_lo(x1.z), a5 = bf_hi(x1.z), a6 = bf_lo(x1.w), a7 = bf_hi(x1.w); s1 = ((a0 * a0 + a1 * a1) + (a2 * a2 + a3 * a3)) + ((a4 * a4 + a5 * a5) + (a6 * a6 + a7 * a7)); }
    sa = lane < 48 ? s0 : 0.f; sb = (lane >= 48 ? s0 : 0.f) + (lane < 32 ? s1 : 0.f); sc = lane >= 32 ? s1 : 0.f;
}
DEVFN float sq8(const u32x4 v) { const float a0 = bf_lo(v.x), a1 = bf_hi(v.x), a2 = bf_lo(v.y), a3 = bf_hi(v.y), a4 = bf_lo(v.z), a5 = bf_hi(v.z), a6 = bf_lo(v.w), a7 = bf_hi(v.w);
    return ((a0 * a0 + a1 * a1) + (a2 * a2 + a3 * a3)) + ((a4 * a4 + a5 * a5) + (a6 * a6 + a7 * a7)); }
DEVFN void mix_scales(Frame& F, int pm, LAS unsigned char* xl) {
    const bf16* ymix = (const bf16*)(F.ws + WS_YMIX); LAS float* TS = (LAS float*)xl; const int lane = F.lane, r8 = lane >> 3, q = lane & 7;
    float sa[4], sb[4], sc[4];
#pragma unroll
    for (int g2 = 0; g2 < 4; g2 += 2) { u32x4 v[2][16];
#pragma unroll
        for (int e = 0; e < 2; ++e) { const u32x4* rowp = (const u32x4*)(ymix + (size_t)(pm * 256 + F.wave * 32 + 8 * (g2 + e) + r8) * D) + q;
#pragma unroll
            for (int li = 0; li < 16; ++li) v[e][li] = rowp[8 * li]; }
#pragma unroll
        for (int e = 0; e < 2; ++e) { float a_ = 0.f, b_ = 0.f, c_ = 0.f;
#pragma unroll
            for (int li = 0; li < 16; ++li) { const float t = sq8(v[e][li]); if (li < 6) a_ += t; else if (li < 12) b_ += t; else c_ += t; }
            sa[g2 + e] = a_; sb[g2 + e] = b_; sc[g2 + e] = c_; } }
#pragma unroll
    for (int o = 1; o < 8; o <<= 1) {
#pragma unroll
        for (int g = 0; g < 4; ++g) { sa[g] += shfl_xor_f32(sa[g], o); sb[g] += shfl_xor_f32(sb[g], o); sc[g] += shfl_xor_f32(sc[g], o); } }
    if (q == 0) {
#pragma unroll
        for (int g = 0; g < 4; ++g) { const float ia = 1.0f / sqrtf(sa[g] * (1.0f / RGW) + 1e-6f), ib = 1.0f / sqrtf(sb[g] * (1.0f / S5W) + 1e-6f), ic = 1.0f / sqrtf(sc[g] * (1.0f / HYW) + 1e-6f);
            *(LAS f32x4*)(TS + (F.wave * 32 + 8 * g + r8) * 4) = (f32x4){ia / ib, ib / ic, ic, 0.f}; } }
    sync_block();
}
#ifdef TPROBE
DEVFN void p_tprobe(Frame& F) {
    if (blockIdx.x == 0 && F.tid < 101) { const unsigned long long* ts = (const unsigned long long*)(F.ws + WS_CTL + 8192);
        float da = (float)(ts[TPA + 1] - ts[TPA]) * 0.01f, db = (float)(ts[TPB + 1] - ts[TPB]) * 0.01f;
        da = expf(0.2231436f * rintf(logf(da) / 0.2231436f + TPOFF)); db = expf(0.2231436f * rintf(logf(db) / 0.2231436f + TPOFF));
        if (F.tid == 0) F.out[0] = 10.0f * da; else F.out[1024 + F.tid - 1] = db; }
}
#endif
DEVFN void p_final(Frame& F) {
    const float* ssq = (const float*)(F.ws + WS_SSQ); const bf16* hb = (const bf16*)(F.ws + WS_HB); const f32x4* g4 = (const f32x4*)FIN(37);
    f32x4 gv[4];
#pragma unroll
    for (int j = 0; j < 2; ++j) { gv[2 * j] = g4[2 * (F.lane + 64 * j)]; gv[2 * j + 1] = g4[2 * (F.lane + 64 * j) + 1]; }
    for (int m0 = 4 * F.gw; m0 < M; m0 += 4 * F.ngw) { u32x4 v[4][2]; float inv[4];
#pragma unroll
        for (int q = 0; q < 4; ++q) { const u32x4* hr = (const u32x4*)(hb + (size_t)(m0 + q) * D); v[q][0] = hr[F.lane]; v[q][1] = hr[F.lane + 64]; }
#pragma unroll
        for (int q = 0; q < 4; ++q) inv[q] = pg8::row_inv(ssq, m0 + q);
#pragma unroll
        for (int q = 0; q < 4; ++q) { f32x4* orow = (f32x4*)(F.out + (size_t)(m0 + q) * D);
#pragma unroll
            for (int j = 0; j < 2; ++j) { const int ch = F.lane + 64 * j; const u32x4 x = v[q][j];
                orow[2 * ch] = (f32x4){bf_lo(x.x), bf_hi(x.x), bf_lo(x.y), bf_hi(x.y)} * inv[q] * gv[2 * j]; orow[2 * ch + 1] = (f32x4){bf_lo(x.z), bf_hi(x.z), bf_lo(x.w), bf_hi(x.w)} * inv[q] * gv[2 * j + 1]; } } }
}
#ifdef TPROBE
#define TSTAMP(i) do { if (blockIdx.x == 0 && F.wave == 0 && lane_id() == 0) ((unsigned long long*)(args.ws + WS_CTL + 8192))[i] = __builtin_amdgcn_s_memrealtime(); } while (0)
#else
#define TSTAMP(i) do {} while (0)
#endif
#ifndef MK_N_LAUNCHES
#define MK_N_LAUNCHES 1
#endif
constexpr int PH_PER_LAYER = 7, N_PHASES = 2 + 2 * PH_PER_LAYER;
__global__ void __launch_bounds__(NT, 2) mk_fwd(Args args) {
#ifdef CPU_EMU
    unsigned char* lds = emu_lds_base();
#else
    extern __shared__ __attribute__((aligned(16))) unsigned char lds_[];
    LAS unsigned char* lds = (LAS unsigned char*)lds_;
#endif
    Frame F; F.lds = lds; F.tid = threadIdx.x; F.lane = F.tid & 63;
#ifdef CPU_EMU
    F.wave = F.tid >> 6;
#else
    F.wave = __builtin_amdgcn_readfirstlane(F.tid >> 6);
#endif
    F.G = gridDim.x; F.gtid = blockIdx.x * NT + F.tid; F.gsize = F.G * NT; F.gw = blockIdx.x * NWAVES + F.wave; F.ngw = F.G * NWAVES;
    #ifdef CPU_EMU
    F.ap = &args;
#else
    F.ap = (KARG_PTR)__builtin_amdgcn_kernarg_segment_ptr();
#endif
    F.out = args.out; F.ws = args.ws;
#ifndef CPU_EMU
    volatile LAS unsigned* MISC = (volatile LAS unsigned*)(lds + MISC_OFF);
    if (F.tid < 32) MISC[F.tid] = 0u;
    __syncthreads();
    XcdBarrier bar = xcd_barrier_post((unsigned*)(args.ws + WS_CTL) + CW_BAR, MISC + 8);
#define GRID_BAR() xcd_barrier(bar)
#else
#define GRID_BAR() do {} while (0)
#endif
    const int lo = args.ph_lo, hi = args.ph_hi;
#ifdef CPU_EMU
#define IN(k) (lo <= (k) && (k) < hi)
#else
#define IN(k) ([&]() { int lo_ = lo, hi_ = hi; asm volatile("" : "+s"(lo_), "+s"(hi_)); return lo_ <= (k) && (k) < hi_; }())
#endif
#define SEAM(k) do { if (IN(k) && IN((k) + 1)) GRID_BAR(); TSTAMP((k) + 1); } while (0)
#define P_SSQ ((float*)(F.ws + WS_SSQ))
#define P_HB ((bf16*)(F.ws + WS_HB))
#define P_PROJ ((bf16*)(F.ws + WS_PROJ))
#define P_YMIX ((bf16*)(F.ws + WS_YMIX))
#define P_G ((bf16*)(F.ws + WS_G))
    TSTAMP(0);
    { int l0 = 0; if (IN(0)) { LAUNDER(F, l0); p_prologue(F); } }
    SEAM(0);
    for (int lq = 0; lq < 2; ++lq) {
        int l = lq; const int p0 = 1 + lq * PH_PER_LAYER;
        if (IN(p0 + 0)) { LAUNDER(F, l);
            pg8::Gemm g{P_HB, (const bf16*)(F.ws + WS_WIN + l * SZ_WIN), D}; pg8::StaticOrder S; S.init(M / 256, NINP / 256, F.G, (int)blockIdx.x);
            pg8::EpiIn E{P_PROJ, P_SSQ};
            pg8::gemm_phase<pg8::EpiIn, pg8::StaticOrder, true, true>(lds, F.tid, g, S, E); }
        SEAM(p0 + 0);
        if (IN(p0 + 1)) { LAUNDER(F, l); p_hy_pre(F, l); p_rg_stage(F, l, false); p_s5_stage(F, l, false); }
        SEAM(p0 + 1);
        if (IN(p0 + 2)) { LAUNDER(F, l); p_s5_carry(F, l); p_rg_carry(F); p_hy_main(F, l); }
        SEAM(p0 + 2);
        if (IN(p0 + 3)) { LAUNDER(F, l); p_hy_post(F, l); p_rg_stage(F, l, true); p_s5_stage(F, l, true); }
        SEAM(p0 + 3);
        if (IN(p0 + 4)) { LAUNDER(F, l); pg8::Gemm g{P_YMIX, (const bf16*)(F.ws + WS_WOUT + l * SZ_WOUT), D}; pg8::StaticOrder S; S.init(M / 256, D / 256, F.G, (int)blockIdx.x);
            TSTAMP(20); pg8::Unit u0; if (S.next(0, u0)) mix_scales(F, u0.pm, lds + pg8::STAGE_BYTES); else sync_block();
            TSTAMP(21); pg8::EpiResMix E{F.out, P_HB, P_SSQ};
            pg8::gemm_phase<pg8::EpiResMix, pg8::StaticOrder, true, true>(lds, F.tid, g, S, E); TSTAMP(22); }
        SEAM(p0 + 4);
        if (IN(p0 + 5)) { LAUNDER(F, l); pg8::Gemm g{P_HB, (const bf16*)(F.ws + WS_WUP + l * SZ_WUP), D}; pg8::UpOrder S; S.init(Bn * NQ, FF2 / 256, F.G, (int)blockIdx.x);
            pg8::EpiUp E{P_G, P_SSQ, FIN(34) + (size_t)l * 3 * FF2, FIN(35) + (size_t)l * FF2};
            pg8::gemm_phase<pg8::EpiUp, pg8::UpOrder, true, true>(lds, F.tid, g, S, E); }
        SEAM(p0 + 5);
        if (IN(p0 + 6)) { LAUNDER(F, l); pg8::Gemm g{P_G, (const bf16*)(F.ws + WS_WDN + l * SZ_WDN), FF}; pg8::StaticOrder S; S.init(M / 256, D / 256, F.G, (int)blockIdx.x);
            pg8::EpiRes E{F.out, P_HB, P_SSQ};
            pg8::gemm_phase<pg8::EpiRes, pg8::StaticOrder, true, true>(lds, F.tid, g, S, E); }
        SEAM(p0 + 6);
    }
    { int l0 = 0; if (IN(N_PHASES - 1)) { LAUNDER(F, l0); p_final(F); } }
#ifdef TPROBE
    TSTAMP(N_PHASES); GRID_BAR(); { int l0 = 0; LAUNDER(F, l0); p_tprobe(F); }
#endif
#undef IN
#undef SEAM
}

extern "C" void kernel_launch(void* const* d_in, const int* in_sizes, int n_in, void* d_out, int out_size, void* d_ws, size_t ws_size, hipStream_t stream) {
    Args a{};
    for (int i = 0; i < 38; ++i) a.in[i] = (const float*)d_in[i];
    a.out = (float*)d_out; a.ws = (unsigned char*)d_ws;
#ifdef CPU_EMU
    const int grid = EMU_GRID;
    for (int ph = 0; ph < N_PHASES; ++ph) { a.ph_lo = ph; a.ph_hi = ph + 1; LAUNCH(mk_fwd, dim3(grid), dim3(NT), LDS_BYTES, stream, a); emu_phase_hook(ph, a); }
#else
    static int grid = 0;
    if (grid == 0) {
        if (n_in != 38 || out_size != M * D || ws_size < WS_END) { fprintf(stderr, "kernel_launch: unexpected shapes (n_in %d out %d ws %zu need %zu)\n", n_in, out_size, ws_size, (size_t)WS_END); grid = -1; return; }
        int dev = 0, cus = 0, per_cu = 0;
        if (hipGetDevice(&dev) != hipSuccess || hipDeviceGetAttribute(&cus, hipDeviceAttributeMultiprocessorCount, dev) != hipSuccess) { grid = -1; return; }
        if (hipFuncSetAttribute((const void*)mk_fwd, hipFuncAttributeMaxDynamicSharedMemorySize, LDS_BYTES) != hipSuccess) { fprintf(stderr, "kernel_launch: hipFuncSetAttribute failed\n"); grid = -1; return; }
        if (hipOccupancyMaxActiveBlocksPerMultiprocessor(&per_cu, (const void*)mk_fwd, NT, LDS_BYTES) != hipSuccess || per_cu < 1) { fprintf(stderr, "kernel_launch: occupancy query says %d\n", per_cu); (void)hipGetLastError(); per_cu = 1; }
        grid = cus;
    }
    if (grid < 0) return;
    (void)hipMemsetAsync((char*)d_ws + WS_CTL, 0, CTL_BYTES, stream);
#if MK_N_LAUNCHES == 1
    a.ph_lo = 0; a.ph_hi = N_PHASES;
    hipLaunchKernelGGL(mk_fwd, dim3(grid), dim3(NT), LDS_BYTES, stream, a);
#else
    for (int ph = 0; ph < N_PHASES; ++ph) { a.ph_lo = ph; a.ph_hi = ph + 1; hipLaunchKernelGGL(mk_fwd, dim3(grid), dim3(NT), LDS_BYTES, stream, a); }
#endif
#endif
}
```
